# Optimizing an MI355X kernel written in HIP

```python
import jax, jax.numpy as jnp
from jax import lax
import numpy as np

D_MODEL = 1024
BATCH = 4
SEQ = 8192
DEPTH = 1

CHUNK = 64
MIX_WIDTH = D_MODEL
LRU_WIDTH = MIX_WIDTH // 2
LRU_HEADS = 8
LRU_HEAD_DIM = LRU_WIDTH // LRU_HEADS
CONV_WIDTH = 4
LRU_C = 8.0
RWKV_WIDTH = MIX_WIDTH - LRU_WIDTH
RWKV_HEAD_DIM = 64
RWKV_HEADS = RWKV_WIDTH // RWKV_HEAD_DIM
DECAY_LORA = 64
AAA_LORA = 64
GATE_LORA = 128
RWKV_PROJ = 3 * RWKV_WIDTH + DECAY_LORA + AAA_LORA + GATE_LORA
PROJ_WIDTH = 2 * LRU_WIDTH + RWKV_PROJ
N_GROUPS = 4
EXPERTS_PER_GROUP = 8
N_EXPERTS = N_GROUPS * EXPERTS_PER_GROUP
TOP_K = 2
D_EXPERT = 512
RMS_EPS = 1e-6
GN_EPS = 64e-5

kernel_name = 'hybrid_rglru_rwkv7_hmoe_adaln'


def _rmsnorm(x, g):
    x32 = x.astype(jnp.float32)
    y = x32 * lax.rsqrt(jnp.mean(x32 * x32, axis=-1, keepdims=True) + RMS_EPS)
    return (y * g.astype(jnp.float32)).astype(x.dtype)


def _adaln(x, g, shift, scale):
    return (_rmsnorm(x, g) * (1 + scale[:, None, :]) + shift[:, None, :]).astype(x.dtype)


def _lin_combine(e1, e2):
    a1, b1 = e1
    a2, b2 = e2
    return a1 * a2, a2 * b1 + b2


def _rglru_group(u_x, u_gate, conv_w, conv_b, wa, ba, wi, bi, lam, norm_g):
    f32 = jnp.float32
    bsz, t, w = u_x.shape
    xc = lax.conv_general_dilated(u_x, conv_w[:, None, :].astype(u_x.dtype), (1,), [(CONV_WIDTH - 1, 0)],
                                  dimension_numbers=('NWC', 'WIO', 'NWC'), feature_group_count=w)
    xc = (xc + conv_b).astype(f32)
    xh = xc.reshape(bsz, t, LRU_HEADS, LRU_HEAD_DIM)
    r = jax.nn.sigmoid(jnp.einsum('bthi,hij->bthj', xh, wa.astype(f32)) + ba.astype(f32)).reshape(bsz, t, w)
    i = jax.nn.sigmoid(jnp.einsum('bthi,hij->bthj', xh, wi.astype(f32)) + bi.astype(f32)).reshape(bsz, t, w)
    log_a = -LRU_C * r * jax.nn.softplus(-lam.astype(f32))
    a = jnp.exp(log_a)
    b = jnp.sqrt(-jnp.expm1(2.0 * log_a)) * (i * xc)
    _, h = lax.associative_scan(_lin_combine, (a, b), axis=1)
    y = h * jax.nn.gelu(u_gate.astype(f32))
    yh = y.reshape(bsz, t, LRU_HEADS, LRU_HEAD_DIM)
    yh = yh * lax.rsqrt(jnp.mean(yh * yh, axis=-1, keepdims=True) + RMS_EPS)
    return yh.reshape(bsz, t, w) * norm_g.astype(f32)


def _rwkv7_group(u, mu, w0, w_up, a0, a_up, g_up, k_k, k_a, r_k, ln_w, ln_b):
    f32 = jnp.float32
    bsz, t, _ = u.shape
    u = u.astype(f32)
    prev = jnp.pad(u, ((0, 0), (1, 0), (0, 0)))[:, :-1]
    u = u + (prev - u) * mu.astype(f32)
    s = [RWKV_WIDTH, 2 * RWKV_WIDTH, 3 * RWKV_WIDTH, 3 * RWKV_WIDTH + DECAY_LORA,
         3 * RWKV_WIDTH + DECAY_LORA + AAA_LORA]
    r, k, v, wd, ad, gd = jnp.split(u, s, axis=-1)
    w = -jax.nn.softplus(-(w0.astype(f32) + jnp.tanh(wd) @ w_up.astype(f32))) - 0.5
    decay = jnp.exp(-jnp.exp(w))
    a = jax.nn.sigmoid(a0.astype(f32) + ad @ a_up.astype(f32))
    g = jax.nn.sigmoid(gd) @ g_up.astype(f32)

    def heads(z):
        return z.reshape(bsz, t, RWKV_HEADS, RWKV_HEAD_DIM)

    kk = heads(k * k_k.astype(f32))
    kk = kk / jnp.maximum(jnp.sqrt(jnp.sum(kk * kk, axis=-1, keepdims=True)), 1e-12)
    k = k * (1 + (a - 1) * k_a.astype(f32))
    r, k, v, decay, a = heads(r), heads(k), heads(v), heads(decay), heads(a)
    n_chunks = t // CHUNK

    def to_chunks(z):
        return z.transpose(1, 0, 2, 3).reshape(n_chunks, CHUNK, bsz, RWKV_HEADS, RWKV_HEAD_DIM)

    def step(state, inp):
        r_t, w_t, k_t, v_t, kk_t, a_t = inp
        sa = jnp.einsum('bhvk,bhk->bhv', state, -kk_t)
        state = (state * w_t[:, :, None, :] + sa[..., None] * (kk_t * a_t)[:, :, None, :]
                 + v_t[..., None] * k_t[:, :, None, :])
        return state, jnp.einsum('bhvk,bhk->bhv', state, r_t)

    def chunk_step(state, chunk_inp):
        return lax.scan(step, state, chunk_inp)

    s0 = jnp.zeros((bsz, RWKV_HEADS, RWKV_HEAD_DIM, RWKV_HEAD_DIM), f32)
    xs = (to_chunks(r), to_chunks(decay), to_chunks(k), to_chunks(v), to_chunks(kk), to_chunks(a))
    _, o = lax.scan(chunk_step, s0, xs)
    o = o.reshape(t, bsz, RWKV_HEADS, RWKV_HEAD_DIM).transpose(1, 0, 2, 3)
    mean = jnp.mean(o, axis=-1, keepdims=True)
    var = jnp.mean(jnp.square(o - mean), axis=-1, keepdims=True)
    hshape = (RWKV_HEADS, RWKV_HEAD_DIM)
    o = (o - mean) * lax.rsqrt(var + GN_EPS) * ln_w.astype(f32).reshape(hshape) + ln_b.astype(f32).reshape(hshape)
    bonus = jnp.sum(r * k * r_k.astype(f32), axis=-1, keepdims=True) * v
    return (o + bonus).reshape(bsz, t, RWKV_WIDTH) * g


def _hier_moe(h, w_grp, b_grp, w_exp, b_exp, w1, w3, w2):
    f32 = jnp.float32
    bsz, t, d = h.shape
    hf = h.reshape(-1, d)
    n = hf.shape[0]
    grp_p = jax.nn.softmax((hf @ w_grp).astype(f32) + b_grp.astype(f32), axis=-1)
    g_w, g_idx = lax.top_k(grp_p, 1)
    exp_logits = ((hf @ w_exp).astype(f32) + b_exp.astype(f32)).reshape(n, N_GROUPS, EXPERTS_PER_GROUP)
    in_grp = jnp.take_along_axis(exp_logits, g_idx[:, :, None], axis=1)[:, 0]
    top_v, top_i = lax.top_k(in_grp, TOP_K)
    e_w = jax.nn.softmax(top_v, axis=-1) * g_w
    e_id = g_idx * EXPERTS_PER_GROUP + top_i
    flat_e = e_id.reshape(-1)
    flat_tok = jnp.repeat(jnp.arange(n, dtype=jnp.int32), TOP_K)
    order = jnp.argsort(flat_e)
    tok = flat_tok[order]
    sizes = jnp.bincount(flat_e, length=N_EXPERTS).astype(jnp.int32)
    xs = hf[tok]
    hid = jax.nn.silu(lax.ragged_dot(xs, w1, sizes)) * lax.ragged_dot(xs, w3, sizes)
    ys = lax.ragged_dot(hid, w2, sizes)
    ys = ys * e_w.reshape(-1)[order][:, None].astype(ys.dtype)
    out = jnp.zeros_like(hf).at[tok].add(ys)
    return out.reshape(bsz, t, d)


def setup_inputs(seed: int = 0) -> dict:
    key = jax.random.key(seed)
    ks = iter(jax.random.split(key, 48))
    f32 = jnp.float32
    L = DEPTH

    def nrm(shape, scale):
        return jax.random.normal(next(ks), shape, f32) * scale

    x = nrm((BATCH, SEQ, D_MODEL), 1.0)
    c = nrm((BATCH, D_MODEL), 1.0)
    w_ada = nrm((L, D_MODEL, 6 * D_MODEL), 0.3 * D_MODEL ** -0.5)
    b_ada = nrm((L, 6 * D_MODEL), 0.02)
    norm1_g = 1.0 + nrm((L, D_MODEL), 0.02)
    w_in = nrm((L, D_MODEL, PROJ_WIDTH), D_MODEL ** -0.5)
    conv_w = nrm((L, CONV_WIDTH, LRU_WIDTH), CONV_WIDTH ** -0.5)
    conv_b = nrm((L, LRU_WIDTH), 0.02)
    lru_wa = nrm((L, LRU_HEADS, LRU_HEAD_DIM, LRU_HEAD_DIM), LRU_HEAD_DIM ** -0.5)
    lru_ba = nrm((L, LRU_HEADS, LRU_HEAD_DIM), 0.02)
    lru_wi = nrm((L, LRU_HEADS, LRU_HEAD_DIM, LRU_HEAD_DIM), LRU_HEAD_DIM ** -0.5)
    lru_bi = nrm((L, LRU_HEADS, LRU_HEAD_DIM), 0.02)
    u = jax.random.uniform(next(ks), (L, LRU_WIDTH), f32, 0.9, 0.999)
    a_base = u ** (1.0 / LRU_C)
    lru_lam = jnp.log(a_base) - jnp.log1p(-a_base)
    lru_norm_g = 1.0 + nrm((L, LRU_WIDTH), 0.02)
    tok_mu = jax.random.uniform(next(ks), (L, RWKV_PROJ), f32, 0.0, 1.0)
    w0 = jnp.linspace(-6.5, -1.5, RWKV_WIDTH, dtype=f32)[None, :] + nrm((L, RWKV_WIDTH), 0.1)
    w_up = nrm((L, DECAY_LORA, RWKV_WIDTH), 0.5 * DECAY_LORA ** -0.5)
    a0 = nrm((L, RWKV_WIDTH), 0.1)
    a_up = nrm((L, AAA_LORA, RWKV_WIDTH), AAA_LORA ** -0.5)
    g_up = nrm((L, GATE_LORA, RWKV_WIDTH), GATE_LORA ** -0.5)
    k_k = 0.85 + nrm((L, RWKV_WIDTH), 0.02)
    k_a = 1.0 + nrm((L, RWKV_WIDTH), 0.02)
    r_k = -0.04 + nrm((L, RWKV_HEADS, RWKV_HEAD_DIM), 0.1)
    ln_x_w = 1.0 + nrm((L, RWKV_WIDTH), 0.02)
    ln_x_b = nrm((L, RWKV_WIDTH), 0.02)
    w_out = nrm((L, MIX_WIDTH, D_MODEL), MIX_WIDTH ** -0.5)
    norm2_g = 1.0 + nrm((L, D_MODEL), 0.02)
    w_grp = nrm((L, D_MODEL, N_GROUPS), D_MODEL ** -0.5)
    b_grp = nrm((L, N_GROUPS), 0.01)
    w_exp = nrm((L, D_MODEL, N_EXPERTS), D_MODEL ** -0.5)
    b_exp = nrm((L, N_EXPERTS), 0.01)
    w1 = nrm((L, N_EXPERTS, D_MODEL, D_EXPERT), D_MODEL ** -0.5)
    w3 = nrm((L, N_EXPERTS, D_MODEL, D_EXPERT), D_MODEL ** -0.5)
    w2 = nrm((L, N_EXPERTS, D_EXPERT, D_MODEL), D_EXPERT ** -0.5)
    final_g = 1.0 + nrm((D_MODEL,), 0.02)
    return {'x': x, 'c': c, 'w_ada': w_ada, 'b_ada': b_ada, 'norm1_g': norm1_g, 'w_in': w_in,
            'conv_w': conv_w, 'conv_b': conv_b, 'lru_wa': lru_wa, 'lru_ba': lru_ba, 'lru_wi': lru_wi,
            'lru_bi': lru_bi, 'lru_lam': lru_lam, 'lru_norm_g': lru_norm_g, 'tok_mu': tok_mu, 'w0': w0,
            'w_up': w_up, 'a0': a0, 'a_up': a_up, 'g_up': g_up, 'k_k': k_k, 'k_a': k_a, 'r_k': r_k,
            'ln_x_w': ln_x_w, 'ln_x_b': ln_x_b, 'w_out': w_out, 'norm2_g': norm2_g, 'w_grp': w_grp,
            'b_grp': b_grp, 'w_exp': w_exp, 'b_exp': b_exp, 'w1': w1, 'w3': w3, 'w2': w2,
            'final_g': final_g}


def reference(x, c, w_ada, b_ada, norm1_g, w_in, conv_w, conv_b, lru_wa, lru_ba, lru_wi, lru_bi,
              lru_lam, lru_norm_g, tok_mu, w0, w_up, a0, a_up, g_up, k_k, k_a, r_k, ln_x_w, ln_x_b,
              w_out, norm2_g, w_grp, b_grp, w_exp, b_exp, w1, w3, w2, final_g):
    cond = jax.nn.silu(c)
    for l in range(DEPTH):
        mod = cond @ w_ada[l] + b_ada[l]
        sh1, sc1, g1, sh2, sc2, g2 = jnp.split(mod, 6, axis=-1)
        h = _adaln(x, norm1_g[l], sh1, sc1)
        p = h @ w_in[l]
        y_lru = _rglru_group(p[..., :LRU_WIDTH], p[..., LRU_WIDTH:2 * LRU_WIDTH], conv_w[l], conv_b[l],
                             lru_wa[l], lru_ba[l], lru_wi[l], lru_bi[l], lru_lam[l], lru_norm_g[l])
        y_rwkv = _rwkv7_group(p[..., 2 * LRU_WIDTH:], tok_mu[l], w0[l], w_up[l], a0[l], a_up[l], g_up[l],
                              k_k[l], k_a[l], r_k[l], ln_x_w[l], ln_x_b[l])
        y = jnp.concatenate([y_lru, y_rwkv], axis=-1).astype(x.dtype) @ w_out[l]
        x = x + g1[:, None, :] * y
        h2 = _adaln(x, norm2_g[l], sh2, sc2)
        x = x + g2[:, None, :] * _hier_moe(h2, w_grp[l], b_grp[l], w_exp[l], b_exp[l], w1[l], w3[l], w2[l])
    return _rmsnorm(x, final_g)
```

```cpp
#include <hip/hip_runtime.h>
#include <stdint.h>
#include <cstdio>

typedef unsigned short bf16;
__device__ __forceinline__ bf16 f2bf(float f) { unsigned u = __float_as_uint(f); return (bf16)((u + 0x7fffu + ((u >> 16) & 1u)) >> 16); }
__device__ __forceinline__ float bf2f(bf16 b) { return __uint_as_float(((unsigned)b) << 16); }

constexpr int NB = 4, T = 8192, D = 1024, NTOK = NB * T;
constexpr int LRU_W = 512, RW = 512, PW = 2816;
constexpr int C_UX = 0, C_GATE = 512, C_R = 1024, C_K = 1536, C_V = 2048, C_WD = 2560, C_AD = 2624, C_GD = 2688;
constexpr int NE = 32, DE = 512;
constexpr size_t MiB = 1u << 20;
constexpr size_t WS_CTL = 0;
constexpr int CW_BAR = 4096;
constexpr size_t WS_CNT = 512 * 1024;
constexpr size_t WS_MOD = 1 * MiB;
constexpr size_t WS_SELW = 1 * MiB + 256 * 1024;
constexpr size_t WS_SEL = 1 * MiB + 512 * 1024;
constexpr size_t FW_WLORAT = 2 * MiB;
constexpr size_t FW_WGT = 3 * MiB;
constexpr size_t FW_WINT = 4 * MiB;
constexpr size_t FW_WOUTT = 10 * MiB;
constexpr size_t WS_LIST = 12 * MiB;
constexpr size_t WS_H = 16 * MiB;
constexpr size_t WS_YMIX = WS_H;
constexpr size_t WS_P = 80 * MiB;
constexpr size_t WS_HID = WS_P;
constexpr size_t WS_YS = 256 * MiB;
constexpr size_t FW_W13T = 416 * MiB;
constexpr size_t FW_W2T = 480 * MiB;
constexpr size_t WS_END = 512 * MiB;

__device__ __forceinline__ float wave_sum(float v) {
#pragma unroll
    for (int o = 1; o < 64; o <<= 1) v += __shfl_xor(v, o);
    return v;
}
__device__ __forceinline__ float sigmoidf_(float x) { return 1.f / (1.f + __expf(-x)); }
__device__ __forceinline__ float softplusf_(float x) { return x > 20.f ? x : log1pf(__expf(x)); }
__device__ __forceinline__ float gelu_tanh(float x) { const float u = 0.7978845608028654f * (x + 0.044715f * x * x * x); return 0.5f * x * (1.f + tanhf(u)); }

__global__ void k_mod(const float* c, const float* w_ada, const float* b_ada, float* mod) {
    const int j = blockIdx.x * blockDim.x + threadIdx.x;
    const int b = blockIdx.y;
    float acc = 0.f;
    for (int k = 0; k < D; ++k) { const float cv = c[b * D + k]; const float s = cv / (1.f + __expf(-cv)); acc += s * w_ada[(size_t)k * 6144 + j]; }
    mod[b * 6144 + j] = acc + b_ada[j];
}

__global__ void __launch_bounds__(256) k_adaln(const float* x, const float* g, const float* mod, int sh_off, int sc_off, bf16* out) {
    const int wave = (blockIdx.x * blockDim.x + threadIdx.x) >> 6, lane = threadIdx.x & 63;
    if (wave >= NTOK) return;
    const int b = wave / T;
    const float* xr = x + (size_t)wave * D;
    float v[16]; float ss = 0.f;
#pragma unroll
    for (int i = 0; i < 16; ++i) { v[i] = xr[lane + 64 * i]; ss += v[i] * v[i]; }
    ss = wave_sum(ss);
    const float rinv = rsqrtf(ss * (1.f / D) + 1e-6f);
#pragma unroll
    for (int i = 0; i < 16; ++i) { const int k = lane + 64 * i;
        const float y = v[i] * rinv * g[k];
        out[(size_t)wave * D + k] = f2bf(y * (1.f + mod[b * 6144 + sc_off + k]) + mod[b * 6144 + sh_off + k]); }
}

struct EpiP { bf16* P; __device__ void operator()(int m, int n, float v) const { P[(size_t)m * PW + n] = f2bf(v); } };
struct EpiX1 { const float* x; const float* mod; float* out; __device__ void operator()(int m, int n, float v) const { const int b = m / T; out[(size_t)m * D + n] = x[(size_t)m * D + n] + mod[b * 6144 + 2048 + n] * v; } };
template <class Epi>
__global__ void __launch_bounds__(256) k_gemm_naive(const bf16* A, int lda, const float* W, int ldw, int M, int N, int K, Epi epi) {
    __shared__ float sA[16][65];
    __shared__ float sB[16][65];
    const int tx = threadIdx.x & 15, ty = threadIdx.x >> 4;
    const int m0 = blockIdx.y * 64, n0 = blockIdx.x * 64;
    float acc[4][4];
#pragma unroll
    for (int i = 0; i < 4; ++i)
#pragma unroll
        for (int j = 0; j < 4; ++j) acc[i][j] = 0.f;
    for (int k0 = 0; k0 < K; k0 += 16) {
#pragma unroll
        for (int e = threadIdx.x; e < 64 * 16; e += 256) { const int r = e >> 4, kk = e & 15; sA[kk][r] = bf2f(A[(size_t)(m0 + r) * lda + k0 + kk]); }
#pragma unroll
        for (int e = threadIdx.x; e < 64 * 16; e += 256) { const int kk = e >> 6, cc = e & 63; sB[kk][cc] = W[(size_t)(k0 + kk) * ldw + n0 + cc]; }
        __syncthreads();
#pragma unroll
        for (int kk = 0; kk < 16; ++kk) {
            float a[4], bb[4];
#pragma unroll
            for (int i = 0; i < 4; ++i) a[i] = sA[kk][ty * 4 + i];
#pragma unroll
            for (int j = 0; j < 4; ++j) bb[j] = sB[kk][tx + 16 * j];
#pragma unroll
            for (int i = 0; i < 4; ++i)
#pragma unroll
                for (int j = 0; j < 4; ++j) acc[i][j] += a[i] * bb[j];
        }
        __syncthreads();
    }
#pragma unroll
    for (int i = 0; i < 4; ++i)
#pragma unroll
        for (int j = 0; j < 4; ++j) epi(m0 + ty * 4 + i, n0 + tx + 16 * j, acc[i][j]);
}

__global__ void __launch_bounds__(64) k_lru(const bf16* P, const float* conv_w, const float* conv_b, const float* wa, const float* ba, const float* wi, const float* bi,
                                            const float* lam, const float* norm_g, bf16* ymix) {
    __shared__ float s_xc[64];
    __shared__ float s_wa[64][64];
    __shared__ float s_wi[64][64];
    const int b = blockIdx.x >> 3, h = blockIdx.x & 7, j = threadIdx.x, ch = h * 64 + j;
    for (int i = 0; i < 64; ++i) { s_wa[i][j] = wa[(h * 64 + i) * 64 + j]; s_wi[i][j] = wi[(h * 64 + i) * 64 + j]; }
    const float cw0 = conv_w[0 * 512 + ch], cw1 = conv_w[1 * 512 + ch], cw2 = conv_w[2 * 512 + ch], cw3 = conv_w[3 * 512 + ch], cb = conv_b[ch];
    const float bav = ba[ch], biv = bi[ch], sp = softplusf_(-lam[ch]), ng = norm_g[ch];
    float x3 = 0.f, x2 = 0.f, x1 = 0.f, hst = 0.f;
    __syncthreads();
    const bf16* Pb = P + (size_t)b * T * PW;
    float nx = bf2f(Pb[ch]), ngate = bf2f(Pb[C_GATE + ch]);
    for (int t = 0; t < T; ++t) {
        const float x0 = nx, gate = ngate;
        if (t + 1 < T) { nx = bf2f(Pb[(size_t)(t + 1) * PW + ch]); ngate = bf2f(Pb[(size_t)(t + 1) * PW + C_GATE + ch]); }
        const float xc = x3 * cw0 + x2 * cw1 + x1 * cw2 + x0 * cw3 + cb;
        x3 = x2; x2 = x1; x1 = x0;
        __syncthreads();
        s_xc[j] = xc;
        __syncthreads();
        float ra = bav, ia = biv;
#pragma unroll 16
        for (int i = 0; i < 64; ++i) { const float xi = s_xc[i]; ra += xi * s_wa[i][j]; ia += xi * s_wi[i][j]; }
        const float r = sigmoidf_(ra), ig = sigmoidf_(ia);
        const float log_a = -8.f * r * sp;
        const float a = __expf(log_a);
        const float bb = sqrtf(fmaxf(-expm1f(2.f * log_a), 0.f)) * (ig * xc);
        hst = a * hst + bb;
        float y = hst * gelu_tanh(gate);
        const float ss = wave_sum(y * y) * (1.f / 64.f);
        y = y * rsqrtf(ss + 1e-6f) * ng;
        ymix[(size_t)(b * T + t) * D + ch] = f2bf(y);
    }
}

__global__ void __launch_bounds__(64) k_rwkv(const bf16* P, const float* mu, const float* w0, const float* w_up, const float* a0, const float* a_up, const float* g_up,
                                             const float* k_k, const float* k_a, const float* r_k, const float* ln_w, const float* ln_b, bf16* ymix) {
    __shared__ float s_wup[64][64];
    __shared__ float s_aup[64][64];
    __shared__ float s_gup[128][64];
    __shared__ float s_tw[64], s_ad[64], s_sg[128];
    __shared__ float s_al[64], s_be[64], s_wd[64], s_km[64], s_r[64];
    const int b = blockIdx.x >> 3, h = blockIdx.x & 7, j = threadIdx.x, ch = h * 64 + j;
    for (int i = 0; i < 64; ++i) { s_wup[i][j] = w_up[i * 512 + ch]; s_aup[i][j] = a_up[i * 512 + ch]; }
    for (int i = 0; i < 128; ++i) s_gup[i][j] = g_up[i * 512 + ch];
    const float mu_r = mu[C_R - 1024 + ch], mu_k = mu[C_K - 1024 + ch], mu_v = mu[C_V - 1024 + ch];
    const float mu_wd = mu[C_WD - 1024 + j], mu_ad = mu[C_AD - 1024 + j], mu_g0 = mu[C_GD - 1024 + j], mu_g1 = mu[C_GD - 1024 + 64 + j];
    const float w0v = w0[ch], a0v = a0[ch], kkv = k_k[ch], kav = k_a[ch], rkv = r_k[ch], lnw = ln_w[ch], lnb = ln_b[ch];
    float S[64];
#pragma unroll
    for (int k = 0; k < 64; ++k) S[k] = 0.f;
    float pr = 0.f, pk = 0.f, pv = 0.f, pwd = 0.f, pad = 0.f, pg0 = 0.f, pg1 = 0.f;
    const bf16* Pb = P + (size_t)b * T * PW;
    __syncthreads();
    for (int t = 0; t < T; ++t) {
        const bf16* row = Pb + (size_t)t * PW;
        const float cr = bf2f(row[C_R + ch]), ck = bf2f(row[C_K + ch]), cv = bf2f(row[C_V + ch]);
        const float cwd = bf2f(row[C_WD + j]), cad = bf2f(row[C_AD + j]), cg0 = bf2f(row[C_GD + j]), cg1 = bf2f(row[C_GD + 64 + j]);
        const float r = cr + (pr - cr) * mu_r, kx = ck + (pk - ck) * mu_k, v = cv + (pv - cv) * mu_v;
        const float wd = cwd + (pwd - cwd) * mu_wd, ad = cad + (pad - cad) * mu_ad, g0 = cg0 + (pg0 - cg0) * mu_g0, g1 = cg1 + (pg1 - cg1) * mu_g1;
        pr = cr; pk = ck; pv = cv; pwd = cwd; pad = cad; pg0 = cg0; pg1 = cg1;
        __syncthreads();
        s_tw[j] = tanhf(wd); s_ad[j] = ad; s_sg[j] = sigmoidf_(g0); s_sg[64 + j] = sigmoidf_(g1);
        __syncthreads();
        float lw = 0.f, la = 0.f, g = 0.f;
#pragma unroll 16
        for (int i = 0; i < 64; ++i) { lw += s_tw[i] * s_wup[i][j]; la += s_ad[i] * s_aup[i][j]; }
#pragma unroll 16
        for (int i = 0; i < 128; ++i) g += s_sg[i] * s_gup[i][j];
        const float w = -softplusf_(-(w0v + lw)) - 0.5f;
        const float decay = __expf(-__expf(w));
        const float a = sigmoidf_(a0v + la);
        float kk = kx * kkv;
        const float nrm = sqrtf(wave_sum(kk * kk));
        kk = kk / fmaxf(nrm, 1e-12f);
        const float km = kx * (1.f + (a - 1.f) * kav);
        const float sb = wave_sum(r * km * rkv);
        s_al[j] = -kk; s_be[j] = kk * a; s_wd[j] = decay; s_km[j] = km; s_r[j] = r;
        __syncthreads();
        float sa = 0.f;
#pragma unroll
        for (int k = 0; k < 64; ++k) sa += S[k] * s_al[k];
        float o = 0.f;
#pragma unroll
        for (int k = 0; k < 64; ++k) { S[k] = S[k] * s_wd[k] + sa * s_be[k] + v * s_km[k]; o += S[k] * s_r[k]; }
        const float mean = wave_sum(o) * (1.f / 64.f);
        const float dv = o - mean;
        const float var = wave_sum(dv * dv) * (1.f / 64.f);
        const float on = dv * rsqrtf(var + 64e-5f) * lnw + lnb;
        ymix[(size_t)(b * T + t) * D + 512 + ch] = f2bf((on + sb * v) * g);
    }
}

__global__ void __launch_bounds__(256) k_adaln2_route(const float* x1, const float* g, const float* mod, const float* w_grp, const float* b_grp, const float* w_exp, const float* b_exp,
                               bf16* h2, int* sel_e, float* sel_w) {
    const int wave = (blockIdx.x * blockDim.x + threadIdx.x) >> 6, lane = threadIdx.x & 63;
    if (wave >= NTOK) return;
    const int b = wave / T;
    const float* xr = x1 + (size_t)wave * D;
    float v[16]; float ss = 0.f;
#pragma unroll
    for (int i = 0; i < 16; ++i) { v[i] = xr[lane + 64 * i]; ss += v[i] * v[i]; }
    ss = wave_sum(ss);
    const float rinv = rsqrtf(ss * (1.f / D) + 1e-6f);
#pragma unroll
    for (int i = 0; i < 16; ++i) { const int k = lane + 64 * i;
        v[i] = v[i] * rinv * g[k] * (1.f + mod[b * 6144 + 4096 + k]) + mod[b * 6144 + 3072 + k];
        h2[(size_t)wave * D + k] = f2bf(v[i]); }
    float gl[4], el[32];
#pragma unroll
    for (int e = 0; e < 4; ++e) { float p = 0.f;
#pragma unroll
        for (int i = 0; i < 16; ++i) p += v[i] * w_grp[(lane + 64 * i) * 4 + e];
        gl[e] = wave_sum(p) + b_grp[e]; }
#pragma unroll
    for (int e = 0; e < 32; ++e) { float p = 0.f;
#pragma unroll
        for (int i = 0; i < 16; ++i) p += v[i] * w_exp[(lane + 64 * i) * 32 + e];
        el[e] = wave_sum(p) + b_exp[e]; }
    int gi = 0; float gm = gl[0];
#pragma unroll
    for (int e = 1; e < 4; ++e) if (gl[e] > gm) { gm = gl[e]; gi = e; }
    float den = 0.f;
#pragma unroll
    for (int e = 0; e < 4; ++e) den += __expf(gl[e] - gm);
    const float gw = 1.f / den;
    float v1 = -3.4e38f, v2 = -3.4e38f; int i1 = 0, i2 = 0;
#pragma unroll
    for (int e = 0; e < 32; ++e) { if ((e >> 3) == gi) { const float x = el[e]; const int ii = e & 7;
            if (x > v1) { v2 = v1; i2 = i1; v1 = x; i1 = ii; } else if (x > v2) { v2 = x; i2 = ii; } } }
    const float e2 = __expf(v2 - v1), w1 = 1.f / (1.f + e2), w2 = e2 / (1.f + e2);
    if (lane == 0) { sel_e[wave * 2] = gi * 8 + i1; sel_e[wave * 2 + 1] = gi * 8 + i2; sel_w[wave * 2] = w1 * gw; sel_w[wave * 2 + 1] = w2 * gw; }
}

__global__ void __launch_bounds__(256) k_moe(const bf16* h2, const int* sel_e, const float* sel_w, const float* w1, const float* w3, const float* w2, bf16* ys) {
    __shared__ float sx[1024];
    __shared__ float sh[512];
    const int slot = blockIdx.x, tok = slot >> 1, e = sel_e[slot]; const float ew = sel_w[slot];
    for (int k = threadIdx.x; k < 1024; k += 256) sx[k] = bf2f(h2[(size_t)tok * D + k]);
    __syncthreads();
    const float* W1 = w1 + (size_t)e * 1024 * 512; const float* W3 = w3 + (size_t)e * 1024 * 512; const float* W2 = w2 + (size_t)e * 512 * 1024;
    for (int j = threadIdx.x; j < 512; j += 256) { float a = 0.f, bq = 0.f;
        for (int k = 0; k < 1024; ++k) { const float xv = sx[k]; a += xv * W1[(size_t)k * 512 + j]; bq += xv * W3[(size_t)k * 512 + j]; }
        sh[j] = a / (1.f + __expf(-a)) * bq; }
    __syncthreads();
    for (int n = threadIdx.x; n < 1024; n += 256) { float y = 0.f;
        for (int jj = 0; jj < 512; ++jj) y += sh[jj] * W2[(size_t)jj * 1024 + n];
        ys[(size_t)slot * D + n] = f2bf(y * ew); }
}

__global__ void __launch_bounds__(256) k_final(float* out, const bf16* ys, const float* mod, const float* fg) {
    const int wave = (blockIdx.x * blockDim.x + threadIdx.x) >> 6, lane = threadIdx.x & 63;
    if (wave >= NTOK) return;
    const int b = wave / T;
    float* xr = out + (size_t)wave * D;
    float v[16]; float ss = 0.f;
#pragma unroll
    for (int i = 0; i < 16; ++i) { const int k = lane + 64 * i;
        const float m = bf2f(ys[(size_t)(wave * 2) * D + k]) + bf2f(ys[(size_t)(wave * 2 + 1) * D + k]);
        v[i] = xr[k] + mod[b * 6144 + 5120 + k] * m; ss += v[i] * v[i]; }
    ss = wave_sum(ss);
    const float rinv = rsqrtf(ss * (1.f / D) + 1e-6f);
#pragma unroll
    for (int i = 0; i < 16; ++i) { const int k = lane + 64 * i; xr[k] = v[i] * rinv * fg[k]; }
}

namespace pg8 {
#define PG8_LAS __attribute__((address_space(3)))
typedef unsigned short bf16_t;
typedef short bf16x8 __attribute__((ext_vector_type(8)));
typedef float f32x4 __attribute__((ext_vector_type(4)));
typedef unsigned u32x4 __attribute__((ext_vector_type(4)));
constexpr int BM = 256, BK = 64, HALF = 128, HTB = HALF * BK * 2  , STAGE_BYTES = 8 * HTB, NXCD = 8, WGM = 8;

__host__ __device__ __forceinline__ int lds_byte(int r, int c) { const int st = (r >> 4) * 2 + (c >> 5), rr = r & 15, cc = c & 31, ob = rr * 64 + cc * 2; return st * 1024 + (ob ^ (((ob >> 9) & 1) << 5)); }
__host__ __device__ __forceinline__ void stage_rc(int b, int& R, int& C) { const int st = b / 1024, sb = b % 1024, swz = sb ^ (((sb >> 9) & 1) << 5); R = (st >> 1) * 16 + swz / 64; C = (st & 1) * 32 + (swz % 64) / 2; }
__host__ __device__ __forceinline__ int perm32(int rho) { const int n = rho >> 4, i = rho & 15; return 8 * (i >> 2) + 4 * n + (i & 3); }

struct Unit { int pm, pn, e, nrows, row0; };
struct Gemm { const bf16_t* A; const bf16_t* Bt; int lda, ldb, K; };

__device__ __forceinline__ unsigned cvt_pk_bf16(float lo, float hi) { unsigned r; asm volatile("v_cvt_pk_bf16_f32 %0, %1, %2" : "=v"(r) : "v"(lo), "v"(hi)); return r; }

struct DenseOrder {
    static constexpr bool GATHER = false;
    int nM, nN, nwg, G, c;
    __device__ void init(int M, int N, int G_, int c_) { nM = M / BM; nN = N / BM; nwg = nM * nN; G = G_; c = c_; }
    __device__ bool next(int i, Unit& u) const {
        const long L = (long)i * G + c; if (L >= nwg) return false;
        int wgid = (int)L; { const int q = nwg / NXCD, r = nwg % NXCD, xcd = wgid % NXCD, off = wgid / NXCD; wgid = (xcd < r ? xcd * (q + 1) : r * (q + 1) + (xcd - r) * q) + off; }
        const int nig = WGM * nN, gid = wgid / nig, fm = gid * WGM, gsz = (nM - fm) < WGM ? (nM - fm) : WGM;
        u.pm = fm + ((wgid % nig) % gsz); u.pn = (wgid % nig) / gsz; u.e = 0; u.nrows = 256; u.row0 = 0; return true;
    }
    __device__ __forceinline__ const char* a_base(const Gemm& g, const Unit& u) const { return (const char*)g.A + (size_t)u.pm * (BM * 2) * g.lda; }
    __device__ __forceinline__ const char* b_base(const Gemm& g, const Unit& u) const { return (const char*)g.Bt + (size_t)u.pn * (BM * 2) * g.ldb; }
    __device__ __forceinline__ int row(const Unit&, int) const { return 0; }
};

template <class Epi, class Sched>
__device__ __forceinline__ void gemm_phase(PG8_LAS unsigned char* lds, const Gemm g, const Sched& S, const Epi& E, const int tid) {
    const int wid = __builtin_amdgcn_readfirstlane(tid >> 6), lane = tid & 63, wr = wid >> 2, wc = wid & 3, fr = lane & 15, fq = lane >> 4;
    const int K = g.K, nt = K / BK;
    unsigned voffA[2], voffB[2]; int sR[2], sC[2];
#pragma unroll
    for (int i = 0; i < 2; ++i) { int R, C; stage_rc(tid * 16 + i * 8192, R, C); const int Rb = Epi::PERM ? ((R & ~31) + perm32(R & 31)) : R;
        voffA[i] = (unsigned)(R * g.lda + C) * 2u; voffB[i] = (unsigned)(Rb * g.ldb + C) * 2u; sR[i] = R; sC[i] = C; }
    const size_t kstep = (size_t)(BK * 2);
    const size_t hstepA = Sched::GATHER ? 0 : (size_t)HALF * g.lda * 2, hstepB = (size_t)HALF * g.ldb * 2;
    const unsigned ldsw = (unsigned)wid * 1024u;
    const int aoff = lds_byte(wr * 64 + fr, fq * 8), boff = lds_byte(wc * 32 + fr, fq * 8);
    unsigned gA[2][2], gN[2][2];
#define PG8_SA(b, h) (((b) * 2 + (h)) * HTB)
#define PG8_SB(b, h) ((4 + (b) * 2 + (h)) * HTB)
#define PG8_STAGE(bufoff, gbase, voff) do { _Pragma("unroll") for (int _i = 0; _i < 2; ++_i) \
        __builtin_amdgcn_global_load_lds((const unsigned*)((const char*)(gbase) + (voff)[_i]), (PG8_LAS unsigned*)(lds + (bufoff) + ldsw + _i * 8192), 16, 0, 0); } while (0)
#define PG8_STAGE_A(bufoff, kp, h, OFF) do { if constexpr (Sched::GATHER) PG8_STAGE(bufoff, kp, OFF[h]); else PG8_STAGE(bufoff, (kp) + (h) * hstepA, voffA); } while (0)
#define PG8_LDA(dst, b, h) do { _Pragma("unroll") for (int m = 0; m < 4; ++m) _Pragma("unroll") for (int k = 0; k < 2; ++k) dst[m][k] = *(const PG8_LAS bf16x8*)(lds + PG8_SA(b, h) + aoff + m * 2048 + k * 1024); } while (0)
#define PG8_LDB(dst, b, h) do { _Pragma("unroll") for (int n = 0; n < 2; ++n) _Pragma("unroll") for (int k = 0; k < 2; ++k) dst[n][k] = *(const PG8_LAS bf16x8*)(lds + PG8_SB(b, h) + boff + n * 2048 + k * 1024); } while (0)
#define PG8_MMA(ai, bj, At, Bt) do { __builtin_amdgcn_s_setprio(1); _Pragma("unroll") for (int m = 0; m < 4; ++m) _Pragma("unroll") for (int n = 0; n < 2; ++n) _Pragma("unroll") for (int k = 0; k < 2; ++k) \
        acc[ai][bj][m][n] = __builtin_amdgcn_mfma_f32_16x16x32_bf16(Bt[n][k], At[m][k], acc[ai][bj][m][n], 0, 0, 0); __builtin_amdgcn_s_setprio(0); } while (0)
#define PG8_WAIT_V(n) asm volatile("s_waitcnt vmcnt(" #n ")" ::: "memory")
#define PG8_WAIT_L(n) asm volatile("s_waitcnt lgkmcnt(" #n ")" ::: "memory")
#define PG8_BAR __builtin_amdgcn_s_barrier()
#define PG8_SCHED __builtin_amdgcn_sched_barrier(0)
    Unit cur, nxt; int ui = 0;
    if (!S.next(0, cur)) return;
    f32x4 acc[2][2][4][2];
#pragma unroll
    for (int a = 0; a < 2; ++a)
#pragma unroll
        for (int b = 0; b < 2; ++b)
#pragma unroll
            for (int m = 0; m < 4; ++m)
#pragma unroll
                for (int n = 0; n < 2; ++n) acc[a][b][m][n] = (f32x4){0.f, 0.f, 0.f, 0.f};
    bf16x8 At[4][2], B0[2][2], B1[2][2];
    const char* cA = S.a_base(g, cur); const char* cB = S.b_base(g, cur);
    if constexpr (Sched::GATHER) {
#pragma unroll
        for (int h = 0; h < 2; ++h)
#pragma unroll
            for (int i = 0; i < 2; ++i) gA[h][i] = (unsigned)(S.row(cur, h * HALF + sR[i]) * g.lda + sC[i]) * 2u;
    }
    PG8_STAGE(PG8_SB(0, 0), cB, voffB); PG8_STAGE(PG8_SB(0, 1), cB + hstepB, voffB); PG8_STAGE_A(PG8_SA(0, 0), cA, 0, gA); PG8_STAGE_A(PG8_SA(0, 1), cA, 1, gA);
    if (wr == 1) PG8_BAR;
    PG8_WAIT_V(2); PG8_BAR;
    PG8_STAGE(PG8_SB(1, 0), cB + kstep, voffB); PG8_STAGE_A(PG8_SA(1, 0), cA + kstep, 0, gA); PG8_STAGE(PG8_SB(1, 1), cB + hstepB + kstep, voffB);
    PG8_WAIT_V(6); PG8_BAR;
    for (;;) {
        const bool has_next = S.next(ui + 1, nxt);
        const char* nA = has_next ? S.a_base(g, nxt) : cA; const char* nB = has_next ? S.b_base(g, nxt) : cB;
        if constexpr (Sched::GATHER) {
#pragma unroll
            for (int h = 0; h < 2; ++h)
#pragma unroll
                for (int i = 0; i < 2; ++i) gN[h][i] = has_next ? (unsigned)(S.row(nxt, h * HALF + sR[i]) * g.lda + sC[i]) * 2u : gA[h][i];
        }
#pragma unroll 1
        for (int t = 0; t < nt; t += 2) {
            const bool last = (t == nt - 2);
            const char* a1 = cA + (size_t)(t + 1) * kstep;
            const char* a2 = last ? nA : cA + (size_t)(t + 2) * kstep; const char* b2 = last ? nB : cB + (size_t)(t + 2) * kstep;
            const char* a3 = a2 + kstep; const char* b3 = b2 + kstep;
            unsigned o2[2][2];
            if constexpr (Sched::GATHER) {
#pragma unroll
                for (int h = 0; h < 2; ++h)
#pragma unroll
                    for (int i = 0; i < 2; ++i) o2[h][i] = last ? gN[h][i] : gA[h][i];
            }
            PG8_LDB(B0, 0, 0); PG8_LDB(B1, 0, 1); PG8_SCHED; PG8_LDA(At, 0, 0); PG8_STAGE_A(PG8_SA(1, 1), a1, 1, gA);
            PG8_WAIT_V(8); PG8_WAIT_L(0); PG8_BAR; PG8_MMA(0, 0, At, B0); PG8_MMA(0, 1, At, B1); PG8_BAR; PG8_SCHED;
            PG8_LDA(At, 0, 1); PG8_STAGE(PG8_SB(0, 0), b2, voffB); PG8_STAGE(PG8_SB(0, 1), b2 + hstepB, voffB); PG8_STAGE_A(PG8_SA(0, 0), a2, 0, o2);
            PG8_WAIT_V(8); PG8_WAIT_L(0); PG8_BAR; PG8_MMA(1, 0, At, B0); PG8_MMA(1, 1, At, B1); PG8_BAR; PG8_SCHED;
            PG8_LDB(B0, 1, 0); PG8_LDB(B1, 1, 1); PG8_SCHED; PG8_LDA(At, 1, 0); PG8_STAGE_A(PG8_SA(0, 1), a2, 1, o2);
            PG8_WAIT_V(8); PG8_WAIT_L(0); PG8_BAR; PG8_MMA(0, 0, At, B0); PG8_MMA(0, 1, At, B1); PG8_BAR; PG8_SCHED;
            PG8_LDA(At, 1, 1); PG8_STAGE(PG8_SB(1, 0), b3, voffB); PG8_STAGE(PG8_SB(1, 1), b3 + hstepB, voffB); PG8_STAGE_A(PG8_SA(1, 0), a3, 0, o2);
            PG8_WAIT_V(8); PG8_WAIT_L(0); PG8_BAR; PG8_MMA(1, 0, At, B0); PG8_MMA(1, 1, At, B1); PG8_BAR; PG8_SCHED;
        }
        if (wr == 0) PG8_BAR;
        E(acc, cur, wr, wc, fr, fq);
        if (!has_next) break;
#pragma unroll
        for (int a = 0; a < 2; ++a)
#pragma unroll
            for (int b = 0; b < 2; ++b)
#pragma unroll
                for (int m = 0; m < 4; ++m)
#pragma unroll
                    for (int n = 0; n < 2; ++n) acc[a][b][m][n] = (f32x4){0.f, 0.f, 0.f, 0.f};
        cur = nxt; cA = nA; cB = nB; ++ui;
        if constexpr (Sched::GATHER) {
#pragma unroll
            for (int h = 0; h < 2; ++h)
#pragma unroll
                for (int i = 0; i < 2; ++i) gA[h][i] = gN[h][i];
        }
        if (wr == 1) PG8_BAR;
    }
    PG8_WAIT_V(0);
    PG8_BAR;
#undef PG8_SA
#undef PG8_SB
#undef PG8_STAGE
#undef PG8_STAGE_A
#undef PG8_LDA
#undef PG8_LDB
#undef PG8_MMA
#undef PG8_WAIT_V
#undef PG8_WAIT_L
#undef PG8_BAR
#undef PG8_SCHED
}

struct EpiBf16Store {
    static constexpr bool PERM = true;
    bf16_t* O; int ldc;
    __device__ __forceinline__ void operator()(const f32x4 (&acc)[2][2][4][2], const Unit& u, int wr, int wc, int fr, int fq) const {
        const int row0 = u.pm * BM + wr * 64 + fr, col0 = u.pn * BM + wc * 32 + 8 * fq;
#pragma unroll
        for (int ai = 0; ai < 2; ++ai)
#pragma unroll
            for (int m = 0; m < 4; ++m) { bf16_t* rowp = O + (size_t)(row0 + ai * HALF + m * 16) * ldc + col0;
#pragma unroll
                for (int bj = 0; bj < 2; ++bj) { const f32x4 v0 = acc[ai][bj][m][0], v1 = acc[ai][bj][m][1];
                    u32x4 w; w.x = cvt_pk_bf16(v0[0], v0[1]); w.y = cvt_pk_bf16(v0[2], v0[3]); w.z = cvt_pk_bf16(v1[0], v1[1]); w.w = cvt_pk_bf16(v1[2], v1[3]);
                    *(u32x4*)(rowp + bj * HALF) = w; } }
    }
};
}
constexpr int NWAVES = 8;
constexpr int RING_OFF = 0, RING_BYTES = 131072;
constexpr int ROUTER_LDS = 147456;
constexpr int LDSCTL_OFF = ROUTER_LDS, MISC_OFF = LDSCTL_OFF + 320;
constexpr int LDS_TAB_OFF = LDSCTL_OFF + 1024;
constexpr int LDS_BYTES = 155648;

#define GAS __attribute__((address_space(1)))
#define LAS __attribute__((address_space(3)))
typedef unsigned v4u __attribute__((ext_vector_type(4)));
typedef unsigned v2u __attribute__((ext_vector_type(2)));
typedef float f32x4 __attribute__((ext_vector_type(4)));
#define LDS_WAIT() asm volatile("s_waitcnt lgkmcnt(0)" ::: "memory")
#define VM_WAIT() asm volatile("s_waitcnt vmcnt(0)" ::: "memory")
__device__ __forceinline__ unsigned pk2(float lo, float hi) { return (unsigned)f2bf(lo) | ((unsigned)f2bf(hi) << 16); }


struct Frame {
    LAS unsigned char* lds;
    int tid, lane, wave, vcu, G;
    const float* const* in;
    float* out; unsigned char* ws;
};

__device__ __forceinline__ void p0_transpose_item(const float* W, int ldw, bf16* WT, int ldt, int k0, int n0, int row0, LAS float* scr, int lane) {
#pragma unroll 8
    for (int i = 0; i < 32; ++i) { const int kk = 2 * i + (lane >> 5); scr[kk * 33 + (lane & 31)] = W[(size_t)(k0 + kk) * ldw + n0 + (lane & 31)]; }
    LDS_WAIT(); asm volatile("" ::: "memory");
    const int c = lane & 7;
#pragma unroll
    for (int j = 0; j < 4; ++j) { const int n = (lane >> 3) + 8 * j; const LAS float* s = scr + (8 * c) * 33 + n;
        v4u o; o.x = pk2(s[0 * 33], s[1 * 33]); o.y = pk2(s[2 * 33], s[3 * 33]); o.z = pk2(s[4 * 33], s[5 * 33]); o.w = pk2(s[6 * 33], s[7 * 33]);
        *(v4u*)(WT + (size_t)(row0 + n) * ldt + k0 + 8 * c) = o; }
    LDS_WAIT(); asm volatile("" ::: "memory");
}

__device__ __forceinline__ void p0_mod_task(Frame& F, int task) {
    LAS float* sc = (LAS float*)(F.lds);
    LAS float* red = (LAS float*)(F.lds + 16384);
    const float* c = F.in[1]; const float* w_ada = F.in[2]; const float* b_ada = F.in[3];
    for (int i = F.tid; i < 4096; i += 512) { const float cv = c[i]; sc[i] = cv / (1.f + __expf(-cv)); }
    __syncthreads();
    const int j = task * 64 + F.lane;
    float a0 = 0.f, a1 = 0.f, a2 = 0.f, a3 = 0.f;
    const int kb = F.wave * 128;
#pragma unroll 16
    for (int k = kb; k < kb + 128; ++k) { const float w = w_ada[(size_t)k * 6144 + j]; a0 += sc[k] * w; a1 += sc[1024 + k] * w; a2 += sc[2048 + k] * w; a3 += sc[3072 + k] * w; }
    red[(F.wave * 4 + 0) * 64 + F.lane] = a0; red[(F.wave * 4 + 1) * 64 + F.lane] = a1; red[(F.wave * 4 + 2) * 64 + F.lane] = a2; red[(F.wave * 4 + 3) * 64 + F.lane] = a3;
    __syncthreads();
    if (F.tid < 256) { const int b = F.tid >> 6, l = F.tid & 63; float s = 0.f;
#pragma unroll
        for (int w = 0; w < 8; ++w) s += red[(w * 4 + b) * 64 + l];
        ((float*)(F.ws + WS_MOD))[b * 6144 + task * 64 + l] = s + b_ada[task * 64 + l]; }
    __syncthreads();
}

__device__ __forceinline__ void phase0(Frame& F) {
    if (blockIdx.x < 96) p0_mod_task(F, blockIdx.x);
    LAS float* scr = (LAS float*)(F.lds + RING_OFF + F.wave * 16384);
    const int gw = F.vcu * NWAVES + F.wave, NGW = F.G * NWAVES;
    constexpr int I_IN = (D / 64) * (PW / 32), I_OUT = (D / 64) * (D / 32);
    constexpr int I_E13 = NE * 2 * 256, I_E2 = NE * 256;
    constexpr int NITEMS = I_IN + I_OUT + I_E13 + I_E2;
    for (int it = gw; it < NITEMS; it += NGW) {
        int r = it;
        if (r < I_IN) { const int nb = PW / 32, kb = r / nb, n = r % nb; p0_transpose_item(F.in[5], PW, (bf16*)(F.ws + FW_WINT), D, 64 * kb, 32 * n, 32 * n, scr, F.lane); continue; } r -= I_IN;
        if (r < I_OUT) { const int nb = D / 32, kb = r / nb, n = r % nb; p0_transpose_item(F.in[25], D, (bf16*)(F.ws + FW_WOUTT), D, 64 * kb, 32 * n, 32 * n, scr, F.lane); continue; } r -= I_OUT;
        if (r < I_E13) {
            const int e = r >> 9, which = (r >> 8) & 1, q = r & 255, kb = q >> 4, n = q & 15, n0 = 32 * n;
            const float* W = (which ? F.in[32] : F.in[31]) + (size_t)e * D * DE;
            p0_transpose_item(W, DE, (bf16*)(F.ws + FW_W13T) + (size_t)e * 1024 * 1024, D, 64 * kb, n0, (n0 >> 7) * 256 + which * 128 + (n0 & 127), scr, F.lane); continue; } r -= I_E13;
        {
            const int e = r >> 8, q = r & 255, kb = q >> 5, n = q & 31;
            p0_transpose_item(F.in[33] + (size_t)e * DE * D, D, (bf16*)(F.ws + FW_W2T) + (size_t)e * 1024 * DE, DE, 64 * kb, 32 * n, 32 * n, scr, F.lane); }
    }
}

__device__ __forceinline__ void adaln_row(const float* xrow, const float* g, const float* sh, const float* sc, bf16* orow, int lane) {
    const f32x4* xr = (const f32x4*)xrow + lane;
    f32x4 v[4]; float s = 0.f;
#pragma unroll
    for (int j = 0; j < 4; ++j) { v[j] = xr[64 * j]; s += (v[j].x * v[j].x + v[j].y * v[j].y) + (v[j].z * v[j].z + v[j].w * v[j].w); }
    const float rinv = rsqrtf(wave_sum(s) * (1.f / D) + 1e-6f);
    v2u* o8 = (v2u*)orow + lane;
#pragma unroll
    for (int j = 0; j < 4; ++j) { const f32x4 gg = ((const f32x4*)g)[lane + 64 * j], s1 = ((const f32x4*)sc)[lane + 64 * j], s0 = ((const f32x4*)sh)[lane + 64 * j];
        f32x4 y = v[j] * rinv * gg; y = y * (s1 + 1.f) + s0;
        v2u w; w.x = pk2(y.x, y.y); w.y = pk2(y.z, y.w); o8[64 * j] = w; }
}
__device__ __forceinline__ void phase1(Frame& F) {
    const int gw = F.vcu * NWAVES + F.wave, NGW = F.G * NWAVES;
    const float* mod = (const float*)(F.ws + WS_MOD);
    for (int m = gw; m < NTOK; m += NGW) { const int b = m / T;
        adaln_row(F.in[0] + (size_t)m * D, F.in[4], mod + b * 6144, mod + b * 6144 + 1024, (bf16*)(F.ws + WS_H) + (size_t)m * D, F.lane); }
}
__device__ __forceinline__ void phase2(Frame& F) {
    pg8::Gemm g{(const bf16*)(F.ws + WS_H), (const bf16*)(F.ws + FW_WINT), D, D, D};
    pg8::DenseOrder S; S.init(NTOK, PW, F.G, (int)blockIdx.x);
    pg8::EpiBf16Store E{(bf16*)(F.ws + WS_P), PW};
    pg8::gemm_phase<pg8::EpiBf16Store, pg8::DenseOrder>(F.lds + RING_OFF, g, S, E, F.tid);
}


namespace pg8 {
struct EpiX1F {
    static constexpr bool PERM = false;
    const float* const* in; unsigned char* ws; float* out;
    __device__ __forceinline__ void operator()(const f32x4 (&acc)[2][2][4][2], const Unit& u, int wr, int wc, int fr, int fq) const {
        const float* x = in[0]; const float* mod = (const float*)(ws + WS_MOD);
        const int row0 = u.pm * BM + wr * 64 + fr, col0 = u.pn * BM + wc * 32 + 4 * fq;
        const float* g1 = mod + ((u.pm * BM) / T) * 6144 + 2048;
        f32x4 gv[2][2];
#pragma unroll
        for (int bj = 0; bj < 2; ++bj)
#pragma unroll
            for (int n = 0; n < 2; ++n) gv[bj][n] = *(const f32x4*)(g1 + col0 + bj * HALF + n * 16);
#pragma unroll
        for (int ai = 0; ai < 2; ++ai)
#pragma unroll
            for (int m = 0; m < 4; ++m) { const size_t ro = (size_t)(row0 + ai * HALF + m * 16) * D + col0;
#pragma unroll
                for (int bj = 0; bj < 2; ++bj)
#pragma unroll
                    for (int n = 0; n < 2; ++n) { const f32x4 xv = *(const f32x4*)(x + ro + bj * HALF + n * 16);
                        *(f32x4*)(out + ro + bj * HALF + n * 16) = xv + gv[bj][n] * acc[ai][bj][m][n]; } }
    }
};
template <bool GATH> struct MoeOrder {
    static constexpr bool GATHER = GATH;
    const LAS int* ub; const LAS int* rb; const LAS int* cn; const int* list; int G, c, brows;
    __device__ bool next(int i, Unit& u) const {
        const int L = i * G + c; if (L >= ub[32]) return false;
        int e = 0;
#pragma unroll
        for (int k = 16; k >= 1; k >>= 1) if (ub[e + k] <= L) e += k;
        const int local = L - ub[e], tiles = rb[e + 1] - rb[e], pn = local / tiles, mt = local - pn * tiles;
        u.e = e; u.pn = pn; u.pm = rb[e] + mt; u.row0 = e * NTOK + mt * 256; u.nrows = min(256, cn[e] - mt * 256); return true;
    }
    __device__ __forceinline__ const char* a_base(const Gemm& g, const Unit& u) const { return GATH ? (const char*)g.A : (const char*)g.A + (size_t)u.pm * (BM * 2) * g.lda; }
    __device__ __forceinline__ const char* b_base(const Gemm& g, const Unit& u) const { return (const char*)g.Bt + ((size_t)u.e * brows + (size_t)u.pn * BM) * 2 * g.ldb; }
    __device__ __forceinline__ int row(const Unit& u, int r) const { return r < u.nrows ? (list[u.row0 + r] >> 1) : 0; }
};
struct EpiSwiglu {
    static constexpr bool PERM = true;
    bf16_t* HID;
    __device__ __forceinline__ void operator()(const f32x4 (&acc)[2][2][4][2], const Unit& u, int wr, int wc, int fr, int fq) const {
        const int col0 = u.pn * HALF + wc * 32 + 8 * fq;
#pragma unroll
        for (int ai = 0; ai < 2; ++ai)
#pragma unroll
            for (int m = 0; m < 4; ++m) { const int r = ai * HALF + wr * 64 + m * 16 + fr;
                if (r < u.nrows) { float h[8];
#pragma unroll
                    for (int n = 0; n < 2; ++n)
#pragma unroll
                        for (int i = 0; i < 4; ++i) { const float a = acc[ai][0][m][n][i], b = acc[ai][1][m][n][i]; h[n * 4 + i] = a / (1.f + __expf(-a)) * b; }
                    u32x4 w; w.x = cvt_pk_bf16(h[0], h[1]); w.y = cvt_pk_bf16(h[2], h[3]); w.z = cvt_pk_bf16(h[4], h[5]); w.w = cvt_pk_bf16(h[6], h[7]);
                    *(u32x4*)(HID + (size_t)(u.pm * BM + r) * DE + col0) = w; } }
    }
};
struct EpiYs {
    static constexpr bool PERM = true;
    unsigned char* ws;
    __device__ __forceinline__ void operator()(const f32x4 (&acc)[2][2][4][2], const Unit& u, int wr, int wc, int fr, int fq) const {
        bf16_t* YS = (bf16_t*)(ws + WS_YS); const int* list = (const int*)(ws + WS_LIST); const float* selw = (const float*)(ws + WS_SELW);
        const int col0 = u.pn * BM + wc * 32 + 8 * fq;
#pragma unroll
        for (int ai = 0; ai < 2; ++ai)
#pragma unroll
            for (int m = 0; m < 4; ++m) { const int r = ai * HALF + wr * 64 + m * 16 + fr;
                if (r < u.nrows) { const int li = list[u.row0 + r]; const float w8 = selw[li]; bf16_t* rowp = YS + (size_t)li * D + col0;
#pragma unroll
                    for (int bj = 0; bj < 2; ++bj) { const f32x4 v0 = acc[ai][bj][m][0] * w8, v1 = acc[ai][bj][m][1] * w8;
                        u32x4 w; w.x = cvt_pk_bf16(v0[0], v0[1]); w.y = cvt_pk_bf16(v0[2], v0[3]); w.z = cvt_pk_bf16(v1[0], v1[1]); w.w = cvt_pk_bf16(v1[2], v1[3]);
                        *(u32x4*)(rowp + bj * HALF) = w; } } }
    }
};
}

__device__ __forceinline__ void phase_outproj(Frame& F) {
    pg8::Gemm g{(const bf16*)(F.ws + WS_YMIX), (const bf16*)(F.ws + FW_WOUTT), D, D, D};
    pg8::DenseOrder S; S.init(NTOK, D, F.G, (int)blockIdx.x);
    pg8::EpiX1F E{F.in, F.ws, F.out};
    pg8::gemm_phase<pg8::EpiX1F, pg8::DenseOrder>(F.lds + RING_OFF, g, S, E, F.tid);
}

__device__ __forceinline__ void phase_route(Frame& F) {
    LAS float* wt = (LAS float*)F.lds;
    const float* w_grp = F.in[27]; const float* w_exp = F.in[29];
    for (int i = F.tid; i < 1024 * 4; i += 512) { const int k = i >> 2, e = i & 3; wt[e * 1024 + k] = w_grp[i]; }
    for (int i = F.tid; i < 1024 * 32; i += 512) { const int k = i >> 5, e = i & 31; wt[(4 + e) * 1024 + k] = w_exp[i]; }
    __syncthreads();
    const float* mod = (const float*)(F.ws + WS_MOD); const float* g2n = F.in[26];
    int* cnt = (int*)(F.ws + WS_CNT); int* list = (int*)(F.ws + WS_LIST); float* selw = (float*)(F.ws + WS_SELW);
    bf16* H2 = (bf16*)(F.ws + WS_H);
    const int gw = F.vcu * NWAVES + F.wave, NGW = F.G * NWAVES, lane = F.lane;
    for (int m = gw; m < NTOK; m += NGW) {
        const int b = m / T;
        const f32x4* xr = (const f32x4*)(F.out + (size_t)m * D) + lane;
        f32x4 v[4]; float s = 0.f;
#pragma unroll
        for (int j = 0; j < 4; ++j) { v[j] = xr[64 * j]; s += (v[j].x * v[j].x + v[j].y * v[j].y) + (v[j].z * v[j].z + v[j].w * v[j].w); }
        const float rinv = rsqrtf(wave_sum(s) * (1.f / D) + 1e-6f);
        v2u* o8 = (v2u*)(H2 + (size_t)m * D) + lane;
#pragma unroll
        for (int j = 0; j < 4; ++j) { const f32x4 gg = ((const f32x4*)g2n)[lane + 64 * j], s1 = ((const f32x4*)(mod + b * 6144 + 4096))[lane + 64 * j], s0 = ((const f32x4*)(mod + b * 6144 + 3072))[lane + 64 * j];
            f32x4 y = v[j] * rinv * gg; y = y * (s1 + 1.f) + s0; v[j] = y;
            v2u w; w.x = pk2(y.x, y.y); w.y = pk2(y.z, y.w); o8[64 * j] = w; }
        const float* b_grp = F.in[28]; const float* b_exp = F.in[30];
        int gi = 0; float gm = -3.4e38f, den = 0.f;
#pragma unroll 1
        for (int e = 0; e < 4; ++e) { float p = 0.f;
#pragma unroll
            for (int j = 0; j < 4; ++j) { const f32x4 w = *(const LAS f32x4*)(wt + e * 1024 + lane * 4 + 256 * j); p += (v[j].x * w.x + v[j].y * w.y) + (v[j].z * w.z + v[j].w * w.w); }
            const float gl = wave_sum(p) + b_grp[e];
            if (gl > gm) { den = den * __expf(gm - gl) + 1.f; gm = gl; gi = e; } else den += __expf(gl - gm); }
        gi = __builtin_amdgcn_readfirstlane(gi);
        const float gwt = 1.f / den;
        float v1 = -3.4e38f, v2 = -3.4e38f; int i1 = 0, i2 = 0;
#pragma unroll 1
        for (int ii = 0; ii < 8; ++ii) { const int e = gi * 8 + ii; float p = 0.f;
#pragma unroll
            for (int j = 0; j < 4; ++j) { const f32x4 w = *(const LAS f32x4*)(wt + (4 + e) * 1024 + lane * 4 + 256 * j); p += (v[j].x * w.x + v[j].y * w.y) + (v[j].z * w.z + v[j].w * w.w); }
            const float xx = wave_sum(p) + b_exp[e];
            if (xx > v1) { v2 = v1; i2 = i1; v1 = xx; i1 = ii; } else if (xx > v2) { v2 = xx; i2 = ii; } }
        const float e2 = __expf(v2 - v1), w1 = 1.f / (1.f + e2), w2 = e2 / (1.f + e2);
        if (lane == 0) { const int ea = gi * 8 + i1, eb = gi * 8 + i2;
            selw[m * 2] = w1 * gwt; selw[m * 2 + 1] = w2 * gwt;
            const int pa = atomicAdd(&cnt[ea], 1); list[ea * NTOK + pa] = m * 2;
            const int pb = atomicAdd(&cnt[eb], 1); list[eb * NTOK + pb] = m * 2 + 1; }
    }
    __syncthreads();
}

__device__ __forceinline__ void moe_tables(Frame& F, int npn) {
    LAS int* tab = (LAS int*)(F.lds + LDS_TAB_OFF);
    if (F.tid == 0) { const int* cnt = (const int*)(F.ws + WS_CNT); int ub = 0, rb = 0;
        for (int e = 0; e < 32; ++e) { const int c = __hip_atomic_load(cnt + e, __ATOMIC_RELAXED, __HIP_MEMORY_SCOPE_AGENT); const int tl = (c + 255) >> 8; tab[e] = ub; tab[33 + e] = rb; tab[66 + e] = c; ub += tl * npn; rb += tl; }
        tab[32] = ub; tab[33 + 32] = rb; }
    __syncthreads();
}
__device__ __forceinline__ void phase_m1(Frame& F) {
    moe_tables(F, 4);
    const LAS int* tab = (const LAS int*)(F.lds + LDS_TAB_OFF);
    pg8::Gemm g{(const bf16*)(F.ws + WS_H), (const bf16*)(F.ws + FW_W13T), D, D, D};
    pg8::MoeOrder<true> S{tab, tab + 33, tab + 66, (const int*)(F.ws + WS_LIST), F.G, (int)blockIdx.x, 1024};
    pg8::EpiSwiglu E{(bf16*)(F.ws + WS_HID)};
    pg8::gemm_phase<pg8::EpiSwiglu, pg8::MoeOrder<true>>(F.lds + RING_OFF, g, S, E, F.tid);
}
__device__ __forceinline__ void phase_m2(Frame& F) {
    moe_tables(F, 4);
    const LAS int* tab = (const LAS int*)(F.lds + LDS_TAB_OFF);
    pg8::Gemm g{(const bf16*)(F.ws + WS_HID), (const bf16*)(F.ws + FW_W2T), DE, DE, DE};
    pg8::MoeOrder<false> S{tab, tab + 33, tab + 66, (const int*)(F.ws + WS_LIST), F.G, (int)blockIdx.x, 1024};
    pg8::EpiYs E{F.ws};
    pg8::gemm_phase<pg8::EpiYs, pg8::MoeOrder<false>>(F.lds + RING_OFF, g, S, E, F.tid);
}
__device__ __forceinline__ void phase_final(Frame& F) {
    const int gw = F.vcu * NWAVES + F.wave, NGW = F.G * NWAVES, lane = F.lane;
    const float* mod = (const float*)(F.ws + WS_MOD); const float* fg = F.in[34]; const bf16* YS = (const bf16*)(F.ws + WS_YS);
    for (int m = gw; m < NTOK; m += NGW) { const int b = m / T;
        f32x4* xr = (f32x4*)(F.out + (size_t)m * D) + lane;
        const v2u* y0 = (const v2u*)(YS + (size_t)(2 * m) * D) + lane; const v2u* y1 = (const v2u*)(YS + (size_t)(2 * m + 1) * D) + lane;
        f32x4 v[4]; float s = 0.f;
#pragma unroll
        for (int j = 0; j < 4; ++j) { const v2u a = y0[64 * j], c = y1[64 * j]; const f32x4 g2 = ((const f32x4*)(mod + b * 6144 + 5120))[lane + 64 * j];
            f32x4 mo; mo.x = __uint_as_float(a.x << 16) + __uint_as_float(c.x << 16); mo.y = __uint_as_float(a.x & 0xffff0000u) + __uint_as_float(c.x & 0xffff0000u);
            mo.z = __uint_as_float(a.y << 16) + __uint_as_float(c.y << 16); mo.w = __uint_as_float(a.y & 0xffff0000u) + __uint_as_float(c.y & 0xffff0000u);
            v[j] = xr[64 * j] + g2 * mo; s += (v[j].x * v[j].x + v[j].y * v[j].y) + (v[j].z * v[j].z + v[j].w * v[j].w); }
        const float rinv = rsqrtf(wave_sum(s) * (1.f / D) + 1e-6f);
#pragma unroll
        for (int j = 0; j < 4; ++j) xr[64 * j] = v[j] * rinv * ((const f32x4*)fg)[lane + 64 * j];
    }
}
#define XB_TMO      128
#define XB_XCNT(j)  (256  + 64 * (j))
#define XB_XSUB(j)  (1280 + 64 * (j))
#define XB_XGEN(j)  (2304 + 64 * (j))
#define XB_TOP      3328
#define XB_TOPGEN   3392
#define XCD_BAR_WORDS 3456
#define XB_SPIN_CAP (1u << 18)

__device__ __forceinline__ unsigned xb_ld(unsigned* p)              { return __hip_atomic_load(p, __ATOMIC_RELAXED, __HIP_MEMORY_SCOPE_AGENT); }
__device__ __forceinline__ unsigned xb_add(unsigned* p, unsigned v) { return __hip_atomic_fetch_add(p, v, __ATOMIC_RELAXED, __HIP_MEMORY_SCOPE_AGENT); }
__device__ __forceinline__ unsigned xb_xcc_id() { return (unsigned)__builtin_amdgcn_s_getreg((3 << 11) | 20) & 0xFu; }
#define XB_SPIN(cond, bar) do { unsigned _sp = 0; while (cond) { __builtin_amdgcn_s_sleep(1); \
    if ((++_sp & 255u) == 0u) { if (xb_ld(&(bar)[XB_TMO])) break; if (_sp > XB_SPIN_CAP) { atomicAdd(&(bar)[XB_TMO], 1u); break; } } } } while (0)

struct XcdBarrier {
    unsigned* bar; unsigned x;
    volatile LAS unsigned* st;
};

__device__ __forceinline__ XcdBarrier xcd_barrier_post(unsigned* bar, volatile LAS unsigned* st) {
    XcdBarrier b; b.bar = bar; b.x = xb_xcc_id(); b.st = st;
    if (threadIdx.x == 0) (void)xb_add(&bar[XB_XCNT(b.x)], 1u);
    return b;
}
__device__ __forceinline__ void xcd_barrier_complete(unsigned* bar, unsigned x, unsigned& nloc, unsigned& nx) {
    const unsigned G = gridDim.x * gridDim.y * gridDim.z;
    unsigned sum, cnt, mine, sp = 0u;
    for (;;) {
        sum = 0u; cnt = 0u; mine = 0u;
#pragma unroll
        for (unsigned j = 0; j < 16; ++j) { const unsigned c = xb_ld(&bar[XB_XCNT(j)]); sum += c; cnt += (c > 0u) ? 1u : 0u; mine = (j == x) ? c : mine; }
        if (sum == G) break;
        __builtin_amdgcn_s_sleep(1);
        if ((++sp & 255u) == 0u) { if (xb_ld(&bar[XB_TMO])) break; if (sp > XB_SPIN_CAP) { atomicAdd(&bar[XB_TMO], 1u); break; } }
    }
    nloc = mine > 0u ? mine : 1u; nx = cnt > 0u ? cnt : 1u;
}

__device__ __forceinline__ void xcd_barrier(const XcdBarrier& b) {
    asm volatile("s_waitcnt vmcnt(0)" ::: "memory");
    __syncthreads();
    if (threadIdx.x == 0) {
        unsigned* bar = b.bar;
        __builtin_amdgcn_s_waitcnt(0);
        unsigned nloc = b.st[0], nx = b.st[1];
        if (nloc == 0u) { xcd_barrier_complete(bar, b.x, nloc, nx); b.st[0] = nloc; b.st[1] = nx; }
        const unsigned old = xb_add(&bar[XB_XSUB(b.x)], 1u);
        const unsigned gen = old / nloc;
        if (old + 1u == (gen + 1u) * nloc) {
            __builtin_amdgcn_fence(__ATOMIC_RELEASE, "agent");
            asm volatile("s_waitcnt vmcnt(0)" ::: "memory");
            const unsigned og = xb_add(&bar[XB_TOP], 1u);
            const unsigned tg = og / nx;
            if (og + 1u == (tg + 1u) * nx) xb_add(&bar[XB_TOPGEN], 1u);
            else XB_SPIN(xb_ld(&bar[XB_TOPGEN]) == tg, bar);
            __builtin_amdgcn_fence(__ATOMIC_ACQUIRE, "agent");
            xb_add(&bar[XB_XGEN(b.x)], 1u);
            asm volatile("s_waitcnt vmcnt(0)" ::: "memory");
        } else {
            XB_SPIN(xb_ld(&bar[XB_XGEN(b.x)]) == gen, bar);
            __builtin_amdgcn_fence(__ATOMIC_ACQUIRE, "agent");
            asm volatile("s_waitcnt vmcnt(0)" ::: "memory");
        }
    }
    __syncthreads();
}


constexpr size_t WS_XC = WS_H;
constexpr size_t WS_ALORA = WS_H + 32 * MiB;
constexpr size_t WS_LOGA = 256 * MiB;
constexpr size_t WS_OLOC = 320 * MiB;
constexpr size_t WS_QHAT = 352 * MiB;
constexpr size_t WS_GG = 384 * MiB;
constexpr size_t WS_SB = 12 * MiB;
constexpr size_t WS_LRUA = 13 * MiB;
constexpr size_t WS_LRUB = 14 * MiB;
constexpr size_t WS_LRUH = 15 * MiB;
constexpr size_t DO_LWA = 0;
constexpr size_t DO_PC = 64 * MiB;
constexpr size_t DO_QCT = 96 * MiB;
constexpr size_t DO_HIN = 0;

__device__ __forceinline__ float bflo(unsigned u) { return __uint_as_float(u << 16); }
__device__ __forceinline__ float bfhi(unsigned u) { return __uint_as_float(u & 0xffff0000u); }

__device__ __forceinline__ void phase_prepA(Frame& F) {
    const int gw = F.vcu * NWAVES + F.wave, NGW = F.G * NWAVES, lane = F.lane;
    const bf16* P = (const bf16*)(F.ws + WS_P);
    bf16* XC = (bf16*)(F.ws + WS_XC); bf16* AL = (bf16*)(F.ws + WS_ALORA);
    const float* conv_w = F.in[6]; const float* conv_b = F.in[7]; const float* mu = F.in[14];
    float cw[4][8], cb[8];
#pragma unroll
    for (int i = 0; i < 8; ++i) { cb[i] = conv_b[8 * lane + i];
#pragma unroll
        for (int j = 0; j < 4; ++j) cw[j][i] = conv_w[j * 512 + 8 * lane + i]; }
    float mu4[4];
#pragma unroll
    for (int i = 0; i < 4; ++i) mu4[i] = mu[(C_WD - 1024) + 4 * lane + i];
    for (int task = gw; task < NTOK / 16; task += NGW) {
        const int m0 = task * 16, t0 = m0 % T;
        float x1[8], x2[8], x3[8], pl[4];
#pragma unroll
        for (int i = 0; i < 8; ++i) { x1[i] = 0.f; x2[i] = 0.f; x3[i] = 0.f; }
#pragma unroll
        for (int i = 0; i < 4; ++i) pl[i] = 0.f;
        if (t0 > 0) {
            const v4u a = *(const v4u*)(P + (size_t)(m0 - 1) * PW + 8 * lane), b = *(const v4u*)(P + (size_t)(m0 - 2) * PW + 8 * lane), c = *(const v4u*)(P + (size_t)(m0 - 3) * PW + 8 * lane);
            x1[0] = bflo(a.x); x1[1] = bfhi(a.x); x1[2] = bflo(a.y); x1[3] = bfhi(a.y); x1[4] = bflo(a.z); x1[5] = bfhi(a.z); x1[6] = bflo(a.w); x1[7] = bfhi(a.w);
            x2[0] = bflo(b.x); x2[1] = bfhi(b.x); x2[2] = bflo(b.y); x2[3] = bfhi(b.y); x2[4] = bflo(b.z); x2[5] = bfhi(b.z); x2[6] = bflo(b.w); x2[7] = bfhi(b.w);
            x3[0] = bflo(c.x); x3[1] = bfhi(c.x); x3[2] = bflo(c.y); x3[3] = bfhi(c.y); x3[4] = bflo(c.z); x3[5] = bfhi(c.z); x3[6] = bflo(c.w); x3[7] = bfhi(c.w);
            const v2u q = *(const v2u*)(P + (size_t)(m0 - 1) * PW + C_WD + 4 * lane);
            pl[0] = bflo(q.x); pl[1] = bfhi(q.x); pl[2] = bflo(q.y); pl[3] = bfhi(q.y);
        }
#pragma unroll 4
        for (int tt = 0; tt < 16; ++tt) {
            const size_t m = (size_t)(m0 + tt);
            const v4u a = *(const v4u*)(P + m * PW + 8 * lane);
            float x0[8] = {bflo(a.x), bfhi(a.x), bflo(a.y), bfhi(a.y), bflo(a.z), bfhi(a.z), bflo(a.w), bfhi(a.w)};
            float xc[8];
#pragma unroll
            for (int i = 0; i < 8; ++i) { xc[i] = x3[i] * cw[0][i] + x2[i] * cw[1][i] + x1[i] * cw[2][i] + x0[i] * cw[3][i] + cb[i]; x3[i] = x2[i]; x2[i] = x1[i]; x1[i] = x0[i]; }
            v4u o; o.x = pk2(xc[0], xc[1]); o.y = pk2(xc[2], xc[3]); o.z = pk2(xc[4], xc[5]); o.w = pk2(xc[6], xc[7]);
            *(v4u*)(XC + m * 512 + 8 * lane) = o;
            const v2u q = *(const v2u*)(P + m * PW + C_WD + 4 * lane);
            const float cl[4] = {bflo(q.x), bfhi(q.x), bflo(q.y), bfhi(q.y)};
            float al[4];
#pragma unroll
            for (int i = 0; i < 4; ++i) { const float u = cl[i] + (pl[i] - cl[i]) * mu4[i]; pl[i] = cl[i];
                al[i] = (lane < 16) ? tanhf(u) : ((lane < 32) ? u : sigmoidf_(u)); }
            v2u o2; o2.x = pk2(al[0], al[1]); o2.y = pk2(al[2], al[3]);
            *(v2u*)(AL + m * 256 + 4 * lane) = o2;
        }
    }
}
__device__ __forceinline__ void p0_small_weights(Frame& F) {
    const int gt = F.vcu * NWAVES * 64 + F.tid, NT = F.G * NWAVES * 64;
    bf16* WG = (bf16*)(F.ws + FW_WGT); bf16* WL = (bf16*)(F.ws + FW_WLORAT);
    const float* wa = F.in[8]; const float* wi = F.in[10]; const float* w_up = F.in[16]; const float* a_up = F.in[18]; const float* g_up = F.in[19];
    for (int i = gt; i < 4 * 256 * 256; i += NT) { const int kk = i & 255, r = (i >> 8) & 255, pn = i >> 16;
        const int gate = r >> 7, ch = 128 * pn + (r & 127), hh = ch >> 6, j = ch & 63, kin = (pn >> 1) * 256 + kk;
        float v = 0.f; if ((kin >> 6) == hh) v = (gate ? wi : wa)[hh * 4096 + (kin & 63) * 64 + j];
        WG[i] = f2bf(v); }
    for (int i = gt; i < 1536 * 256; i += NT) { const int kk = i & 255, n = i >> 8; float v = 0.f;
        if (n < 512) { if (kk < 64) v = w_up[kk * 512 + n]; }
        else if (n < 1024) { if (kk >= 64 && kk < 128) v = a_up[(kk - 64) * 512 + n - 512]; }
        else { if (kk >= 128) v = g_up[(kk - 128) * 512 + n - 1024]; }
        WL[i] = f2bf(v); }
}

namespace pg8 {
struct GateOrder : DenseOrder {
    __device__ __forceinline__ const char* a_base(const Gemm& g, const Unit& u) const { return (const char*)g.A + (size_t)u.pm * (BM * 2) * g.lda + (size_t)(u.pn >> 1) * 512; }
};
struct EpiLruGate {
    static constexpr bool PERM = true;
    unsigned char* ws;
    __device__ __forceinline__ void operator()(const f32x4 (&acc)[2][2][4][2], const Unit& u, int wr, int wc, int fr, int fq) const {
        bf16_t* G = (bf16_t*)(ws + WS_LOGA);
        const int row0 = u.pm * BM + wr * 64 + fr, col0 = u.pn * HALF + wc * 32 + 8 * fq;
#pragma unroll
        for (int ai = 0; ai < 2; ++ai)
#pragma unroll
            for (int m = 0; m < 4; ++m) { bf16_t* rowp = G + (size_t)(row0 + ai * HALF + m * 16) * 1024 + col0;
#pragma unroll
                for (int bj = 0; bj < 2; ++bj) { const f32x4 v0 = acc[ai][bj][m][0], v1 = acc[ai][bj][m][1];
                    u32x4 w; w.x = cvt_pk_bf16(v0[0], v0[1]); w.y = cvt_pk_bf16(v0[2], v0[3]); w.z = cvt_pk_bf16(v1[0], v1[1]); w.w = cvt_pk_bf16(v1[2], v1[3]);
                    *(u32x4*)(rowp + bj * 512) = w; } }
    }
};
struct EpiLoraStore {
    static constexpr bool PERM = true;
    unsigned char* out; unsigned char* ws;
    __device__ __forceinline__ void operator()(const f32x4 (&acc)[2][2][4][2], const Unit& u, int wr, int wc, int fr, int fq) const {
        const int row0 = u.pm * BM + wr * 64 + fr;
        bf16_t* LWA = (bf16_t*)(out + DO_LWA); bf16_t* GG = (bf16_t*)(ws + WS_GG);
        bf16_t* base = u.pn < 4 ? LWA : GG; const int ldc = u.pn < 4 ? 1024 : 512; const int col0 = (u.pn < 4 ? u.pn : u.pn - 4) * BM + wc * 32 + 8 * fq;
#pragma unroll
        for (int ai = 0; ai < 2; ++ai)
#pragma unroll
            for (int m = 0; m < 4; ++m) { bf16_t* rowp = base + (size_t)(row0 + ai * HALF + m * 16) * ldc + col0;
#pragma unroll
                for (int bj = 0; bj < 2; ++bj) { const f32x4 v0 = acc[ai][bj][m][0], v1 = acc[ai][bj][m][1];
                    u32x4 w; w.x = cvt_pk_bf16(v0[0], v0[1]); w.y = cvt_pk_bf16(v0[2], v0[3]); w.z = cvt_pk_bf16(v1[0], v1[1]); w.w = cvt_pk_bf16(v1[2], v1[3]);
                    *(u32x4*)(rowp + bj * HALF) = w; } }
    }
};
}
__device__ __forceinline__ void phase_gategemm(Frame& F) {
    {
        pg8::Gemm g{(const bf16*)(F.ws + WS_XC), (const bf16*)(F.ws + FW_WGT), 512, 256, 256};
        pg8::GateOrder S; S.init(NTOK, 1024, F.G, (int)blockIdx.x);
        pg8::EpiLruGate E{F.ws};
        pg8::gemm_phase<pg8::EpiLruGate, pg8::GateOrder>(F.lds + RING_OFF, g, S, E, F.tid);
    }
}
__device__ __forceinline__ void phase_loragemm(Frame& F) {
    {
        pg8::Gemm g{(const bf16*)(F.ws + WS_ALORA), (const bf16*)(F.ws + FW_WLORAT), 256, 256, 256};
        pg8::DenseOrder S; S.init(NTOK, 1536, F.G, (int)blockIdx.x);
        pg8::EpiLoraStore E{(unsigned char*)F.out, F.ws};
        pg8::gemm_phase<pg8::EpiLoraStore, pg8::DenseOrder>(F.lds + RING_OFF, g, S, E, F.tid);
    }
}

__device__ __forceinline__ void rwkv_prepass_unit(Frame& F, int unit, LAS float* wl) {
    int lane = F.lane; asm volatile("" : "+v"(lane));
    const int c = unit & 127, bh = unit >> 7, h = bh & 7, b = bh >> 3, ch = h * 64 + lane;
    const size_t m0 = (size_t)b * T + (size_t)c * 64;
    const bf16* P = (const bf16*)(F.ws + WS_P); const bf16* LWA = (const bf16*)((const unsigned char*)F.out + DO_LWA);
    bf16* OLOC = (bf16*)(F.ws + WS_OLOC); bf16* QHAT = (bf16*)(F.ws + WS_QHAT); float* SB = (float*)(F.ws + WS_SB);
    const float* mu = F.in[14];
    const float mu_r = mu[ch], mu_k = mu[512 + ch], mu_v = mu[1024 + ch];
    const float w0v = F.in[15][ch], a0v = F.in[17][ch], kkv = F.in[20][ch], kav = F.in[21][ch], rkv = F.in[22][ch];
    float SP[64], SQ[64];
#pragma unroll
    for (int k = 0; k < 64; ++k) { SP[k] = (k == lane) ? 1.f : 0.f; SQ[k] = 0.f; }
    float pr = 0.f, pk = 0.f, pv = 0.f;
    if (c > 0) { const bf16* row = P + (m0 - 1) * PW; pr = bf2f(row[C_R + ch]); pk = bf2f(row[C_K + ch]); pv = bf2f(row[C_V + ch]); }
#pragma unroll 1
    for (int s8 = 0; s8 < 8; ++s8) {
#pragma unroll 1
        for (int tt = 0; tt < 8; ++tt) {
            const size_t m = m0 + s8 * 8 + tt; const bf16* row = P + m * PW;
            const float cr = bf2f(row[C_R + ch]), ck = bf2f(row[C_K + ch]), cv = bf2f(row[C_V + ch]);
            const float lw = bf2f(LWA[m * 1024 + ch]), la = bf2f(LWA[m * 1024 + 512 + ch]);
            const float r = cr + (pr - cr) * mu_r, kx = ck + (pk - ck) * mu_k, v = cv + (pv - cv) * mu_v;
            pr = cr; pk = ck; pv = cv;
            const float w = -softplusf_(-(w0v + lw)) - 0.5f;
            const float decay = __expf(-__expf(w));
            const float a = sigmoidf_(a0v + la);
            float kk = kx * kkv;
            const float nrm = sqrtf(wave_sum(kk * kk));
            kk = kk / fmaxf(nrm, 1e-12f);
            const float km = kx * (1.f + (a - 1.f) * kav);
            const float sbv = wave_sum(r * km * rkv);
            if (lane == 0) SB[m * 8 + h] = sbv;
            LAS float* q = wl + tt * 384;
            q[lane] = -kk; q[64 + lane] = kk * a; q[128 + lane] = decay; q[192 + lane] = km; q[256 + lane] = r; q[320 + lane] = v;
        }
        LDS_WAIT(); asm volatile("" ::: "memory");
#pragma unroll 1
        for (int tt = 0; tt < 8; ++tt) {
            const LAS float* q = wl + tt * 384;
            const LAS f32x4* q4 = (const LAS f32x4*)q;
            float saP = 0.f, saQ = 0.f;
#pragma unroll
            for (int kb = 0; kb < 16; ++kb) { const f32x4 al = q4[kb];
                saP += SP[4 * kb] * al.x; saQ += SQ[4 * kb] * al.x; saP += SP[4 * kb + 1] * al.y; saQ += SQ[4 * kb + 1] * al.y;
                saP += SP[4 * kb + 2] * al.z; saQ += SQ[4 * kb + 2] * al.z; saP += SP[4 * kb + 3] * al.w; saQ += SQ[4 * kb + 3] * al.w;
                }
            const float v = q[320 + lane];
            float oP = 0.f, oQ = 0.f;
#pragma unroll
            for (int kb = 0; kb < 16; ++kb) { const f32x4 be = q4[16 + kb], w = q4[32 + kb], km = q4[48 + kb], rr = q4[64 + kb];
#pragma unroll
                for (int i = 0; i < 4; ++i) { const int k = 4 * kb + i;
                    SP[k] = SP[k] * w[i] + saP * be[i]; SQ[k] = SQ[k] * w[i] + (saQ * be[i] + v * km[i]);
                    oP += SP[k] * rr[i]; oQ += SQ[k] * rr[i]; }
                }
            const size_t m = m0 + s8 * 8 + tt;
            QHAT[m * 512 + ch] = f2bf(oP); OLOC[m * 512 + ch] = f2bf(oQ);
        }
        LDS_WAIT(); asm volatile("" ::: "memory");
    }
    int lane2 = lane; asm volatile("" : "+v"(lane2) :: "memory");
    bf16* PC = (bf16*)((unsigned char*)F.out + DO_PC) + (size_t)unit * 4096 + lane2; bf16* QCT = (bf16*)((unsigned char*)F.out + DO_QCT) + (size_t)unit * 4096 + lane2 * 64;
#pragma unroll
    for (int k = 0; k < 64; ++k) PC[k * 64] = f2bf(SP[k]);
#pragma unroll
    for (int k = 0; k < 64; k += 8) { v4u o; o.x = pk2(SQ[k], SQ[k + 1]); o.y = pk2(SQ[k + 2], SQ[k + 3]); o.z = pk2(SQ[k + 4], SQ[k + 5]); o.w = pk2(SQ[k + 6], SQ[k + 7]);
        *(v4u*)(QCT + k) = o; }
}
__device__ __forceinline__ void phase_lrulocal(Frame& F) {
    const int gw = F.vcu * NWAVES + F.wave, NGW = F.G * NWAVES, lane = F.lane;
    {
        bf16* GT = (bf16*)(F.ws + WS_LOGA); const bf16* XC = (const bf16*)(F.ws + WS_XC);
        float* LA = (float*)(F.ws + WS_LRUA); float* LB = (float*)(F.ws + WS_LRUB);
        for (int task = gw; task < 4 * 128 * 8; task += NGW) { const int cg = task & 7, bc = task >> 3, ch = cg * 64 + lane;
            const float bav = F.in[9][ch], biv = F.in[11][ch], sp = -8.f * softplusf_(-F.in[12][ch]);
            const size_t m0 = (size_t)bc * 64; float sl = 0.f, hl = 0.f;
#pragma unroll 4
            for (int t = 0; t < 64; ++t) { const size_t m = m0 + t;
                const float ra = bf2f(GT[m * 1024 + ch]) + bav, ia = bf2f(GT[m * 1024 + 512 + ch]) + biv, xc = bf2f(XC[m * 512 + ch]);
                const float r = sigmoidf_(ra), ig = sigmoidf_(ia);
                const bf16 lab = f2bf(r * sp); const float la = bf2f(lab);
                const bf16 bbb = f2bf(sqrtf(fmaxf(-expm1f(2.f * la), 0.f)) * (ig * xc)); const float bb = bf2f(bbb);
                GT[m * 1024 + ch] = lab; GT[m * 1024 + 512 + ch] = bbb;
                sl += la; hl = __expf(la) * hl + bb; }
            LA[bc * 512 + ch] = sl; LB[bc * 512 + ch] = hl; }
    }
}
__device__ __forceinline__ void phase_rwkvlocal(Frame& F) {
    const int gw = F.vcu * NWAVES + F.wave, NGW = F.G * NWAVES;
    {
        LAS float* wl = (LAS float*)(F.lds + RING_OFF + F.wave * 12288);
        for (int unit = gw; unit < 4096; unit += NGW) rwkv_prepass_unit(F, unit, wl);
    }
}

typedef short bf16x8_t __attribute__((ext_vector_type(8)));
__device__ __forceinline__ void rwkv_scan(Frame& F, int bh) {
    constexpr int LDT = 72;
    LAS bf16* Shi = (LAS bf16*)(F.lds + RING_OFF); LAS bf16* Slo = Shi + 64 * LDT;
    const int lane = F.lane, w = F.wave, tr = w >> 1, tc0 = (w & 1) * 2, q = lane >> 4, l15 = lane & 15;
    for (int i = F.tid; i < 64 * LDT; i += 512) { Shi[i] = 0; Slo[i] = 0; }
    __syncthreads();
    const bf16* PC = (const bf16*)((const unsigned char*)F.out + DO_PC) + (size_t)bh * 128 * 4096;
    const bf16* QCT = (const bf16*)((const unsigned char*)F.out + DO_QCT) + (size_t)bh * 128 * 4096;
    bf16* HIN = (bf16*)((unsigned char*)F.out + DO_HIN) + (size_t)bh * 128 * 4096;
    bf16x8_t A[2]; v2u Qv[2];
#pragma unroll
    for (int ks = 0; ks < 2; ++ks) A[ks] = *(const bf16x8_t*)(PC + (16 * tr + l15) * 64 + 32 * ks + 8 * q);
#pragma unroll
    for (int t = 0; t < 2; ++t) Qv[t] = *(const v2u*)(QCT + (16 * (tc0 + t) + l15) * 64 + 16 * tr + 4 * q);
    for (int c = 0; c < 128; ++c) {
        { const int j = F.tid >> 3, k8 = (F.tid & 7) * 8; *(v4u*)(HIN + (size_t)c * 4096 + j * 64 + k8) = *(const LAS v4u*)(Shi + j * LDT + k8); }
        pg8::f32x4 acc[2];
#pragma unroll
        for (int t = 0; t < 2; ++t) { acc[t][0] = bflo(Qv[t].x); acc[t][1] = bfhi(Qv[t].x); acc[t][2] = bflo(Qv[t].y); acc[t][3] = bfhi(Qv[t].y); }
#pragma unroll
        for (int ks = 0; ks < 2; ++ks)
#pragma unroll
            for (int t = 0; t < 2; ++t) {
                const bf16x8_t bh_ = *(const LAS bf16x8_t*)(Shi + (16 * (tc0 + t) + l15) * LDT + 32 * ks + 8 * q);
                const bf16x8_t bl_ = *(const LAS bf16x8_t*)(Slo + (16 * (tc0 + t) + l15) * LDT + 32 * ks + 8 * q);
                acc[t] = __builtin_amdgcn_mfma_f32_16x16x32_bf16(A[ks], bh_, acc[t], 0, 0, 0);
                acc[t] = __builtin_amdgcn_mfma_f32_16x16x32_bf16(A[ks], bl_, acc[t], 0, 0, 0);
            }
        if (c + 1 < 128) {
#pragma unroll
            for (int ks = 0; ks < 2; ++ks) A[ks] = *(const bf16x8_t*)(PC + (size_t)(c + 1) * 4096 + (16 * tr + l15) * 64 + 32 * ks + 8 * q);
#pragma unroll
            for (int t = 0; t < 2; ++t) Qv[t] = *(const v2u*)(QCT + (size_t)(c + 1) * 4096 + (16 * (tc0 + t) + l15) * 64 + 16 * tr + 4 * q);
        }
        __syncthreads();
#pragma unroll
        for (int t = 0; t < 2; ++t) { unsigned hi[4], lo[4];
#pragma unroll
            for (int i = 0; i < 4; ++i) { const float x = acc[t][i]; const bf16 hb = f2bf(x); hi[i] = hb; lo[i] = f2bf(x - bf2f(hb)); }
            v2u oh, ol; oh.x = hi[0] | (hi[1] << 16); oh.y = hi[2] | (hi[3] << 16); ol.x = lo[0] | (lo[1] << 16); ol.y = lo[2] | (lo[3] << 16);
            *(LAS v2u*)(Shi + (16 * (tc0 + t) + l15) * LDT + 16 * tr + 4 * q) = oh; *(LAS v2u*)(Slo + (16 * (tc0 + t) + l15) * LDT + 16 * tr + 4 * q) = ol; }
        __syncthreads();
    }
}
__device__ __forceinline__ void phase_scan(Frame& F, int flags) {
    if ((flags & 2) && blockIdx.x < 32) rwkv_scan(F, blockIdx.x);
    if ((flags & 1) && blockIdx.x >= 32 && blockIdx.x < 36) {
        const int idx = (blockIdx.x - 32) * 512 + F.tid, b = idx >> 9, ch = idx & 511;
        const float* LA = (const float*)(F.ws + WS_LRUA); const float* LB = (const float*)(F.ws + WS_LRUB); float* LH = (float*)(F.ws + WS_LRUH);
        float h = 0.f;
#pragma unroll 8
        for (int c = 0; c < 128; ++c) { const int o = (b * 128 + c) * 512 + ch; LH[o] = h; h = __expf(LA[o]) * h + LB[o]; }
    }
}

__device__ __forceinline__ void rwkv_post_unit(Frame& F, int unit) {
    const int lane = F.lane, c = unit & 127, bh = unit >> 7, h = bh & 7, b = bh >> 3, q = lane >> 4, l15 = lane & 15;
    const size_t m0 = (size_t)b * T + (size_t)c * 64;
    const bf16* QHAT = (const bf16*)(F.ws + WS_QHAT); const bf16* OLOC = (const bf16*)(F.ws + WS_OLOC); const bf16* GG = (const bf16*)(F.ws + WS_GG);
    const bf16* HIN = (const bf16*)((const unsigned char*)F.out + DO_HIN) + (size_t)unit * 4096; const bf16* P = (const bf16*)(F.ws + WS_P);
    const float* SB = (const float*)(F.ws + WS_SB); bf16* YMIX = (bf16*)(F.ws + WS_YMIX);
    bf16x8_t Bf[4][2];
#pragma unroll
    for (int tc = 0; tc < 4; ++tc)
#pragma unroll
        for (int ks = 0; ks < 2; ++ks) Bf[tc][ks] = *(const bf16x8_t*)(HIN + (16 * tc + l15) * 64 + 32 * ks + 8 * q);
    float lnw[4], lnb[4], muv[4];
#pragma unroll
    for (int tc = 0; tc < 4; ++tc) { const int ch = h * 64 + 16 * tc + l15; lnw[tc] = F.in[23][ch]; lnb[tc] = F.in[24][ch]; muv[tc] = F.in[14][1024 + ch]; }
#pragma unroll 1
    for (int tr = 0; tr < 4; ++tr) {
        bf16x8_t Af[2];
#pragma unroll
        for (int ks = 0; ks < 2; ++ks) Af[ks] = *(const bf16x8_t*)(QHAT + (m0 + 16 * tr + l15) * 512 + h * 64 + 32 * ks + 8 * q);
        pg8::f32x4 acc[4];
#pragma unroll
        for (int tc = 0; tc < 4; ++tc)
#pragma unroll
            for (int i = 0; i < 4; ++i) acc[tc][i] = bf2f(OLOC[(m0 + 16 * tr + 4 * q + i) * 512 + h * 64 + 16 * tc + l15]);
#pragma unroll
        for (int ks = 0; ks < 2; ++ks)
#pragma unroll
            for (int tc = 0; tc < 4; ++tc) acc[tc] = __builtin_amdgcn_mfma_f32_16x16x32_bf16(Af[ks], Bf[tc][ks], acc[tc], 0, 0, 0);
#pragma unroll
        for (int i = 0; i < 4; ++i) {
            const size_t m = m0 + 16 * tr + 4 * q + i;
            float s = (acc[0][i] + acc[1][i]) + (acc[2][i] + acc[3][i]);
            s += __shfl_xor(s, 1); s += __shfl_xor(s, 2); s += __shfl_xor(s, 4); s += __shfl_xor(s, 8);
            const float mean = s * (1.f / 64.f);
            float d[4], vs = 0.f;
#pragma unroll
            for (int tc = 0; tc < 4; ++tc) { d[tc] = acc[tc][i] - mean; vs += d[tc] * d[tc]; }
            vs += __shfl_xor(vs, 1); vs += __shfl_xor(vs, 2); vs += __shfl_xor(vs, 4); vs += __shfl_xor(vs, 8);
            const float rstd = rsqrtf(vs * (1.f / 64.f) + 64e-5f);
            const float sbv = SB[m * 8 + h];
            const bool first = ((m % T) == 0);
#pragma unroll
            for (int tc = 0; tc < 4; ++tc) { const int ch = h * 64 + 16 * tc + l15;
                const float cv = bf2f(P[m * PW + C_V + ch]); const float pv = first ? 0.f : bf2f(P[(m - 1) * PW + C_V + ch]);
                const float v = cv + (pv - cv) * muv[tc];
                const float on = d[tc] * rstd * lnw[tc] + lnb[tc];
                YMIX[m * D + 512 + ch] = f2bf((on + sbv * v) * bf2f(GG[m * 512 + ch])); }
        }
    }
}
__device__ __forceinline__ void phase_post(Frame& F, int flags) {
    const int gw = F.vcu * NWAVES + F.wave, NGW = F.G * NWAVES, lane = F.lane;
    if (flags & 2) for (int unit = gw; unit < 4096; unit += NGW) rwkv_post_unit(F, unit);
    if (flags & 1) {
        const bf16* GT = (const bf16*)(F.ws + WS_LOGA); const bf16* P = (const bf16*)(F.ws + WS_P);
        const float* LH = (const float*)(F.ws + WS_LRUH); bf16* YMIX = (bf16*)(F.ws + WS_YMIX); const float* ng = F.in[13];
        for (int task = gw; task < 4 * 128 * 8; task += NGW) { const int cg = task & 7, bc = task >> 3, ch = cg * 64 + lane;
            const size_t m0 = (size_t)bc * 64; float hl = LH[bc * 512 + ch]; const float g = ng[ch];
#pragma unroll 4
            for (int t = 0; t < 64; ++t) { const size_t m = m0 + t;
                const float la = bf2f(GT[m * 1024 + ch]), bb = bf2f(GT[m * 1024 + 512 + ch]); hl = __expf(la) * hl + bb;
                float y = hl * gelu_tanh(bf2f(P[m * PW + C_GATE + ch]));
                const float ss = wave_sum(y * y) * (1.f / 64.f);
                YMIX[m * D + ch] = f2bf(y * rsqrtf(ss + 1e-6f) * g); }
        }
    }
}

struct Args { const float* in[35]; float* out; unsigned char* ws; int ph_lo, ph_hi, flags, pad; };
__global__ void __launch_bounds__(NWAVES * 64, 2) mk_fwd(Args args) {
    extern __shared__ __attribute__((aligned(16))) unsigned char lds[];
    Frame F;
    F.lds = (LAS unsigned char*)lds;
    F.tid = threadIdx.x; F.lane = F.tid & 63; F.wave = __builtin_amdgcn_readfirstlane(F.tid >> 6);
    F.G = gridDim.x; { const int bx = blockIdx.x; F.vcu = (F.G % 8 == 0) ? (bx % 8) * (F.G / 8) + bx / 8 : bx; }
    F.in = args.in; F.out = args.out; F.ws = args.ws;
    const int lo = args.ph_lo, hi = args.ph_hi;
#define IN(k) (lo <= (k) && (k) < hi)
    const int flags = args.flags;
    for (int u = threadIdx.x; u < (LDS_BYTES - LDSCTL_OFF) / 4; u += NWAVES * 64) ((LAS unsigned*)(F.lds + LDSCTL_OFF))[u] = 0u;
    __syncthreads();
    XcdBarrier bar; bar.bar = (unsigned*)(args.ws + WS_CTL) + CW_BAR; bar.x = 0; bar.st = nullptr;
    if (hi - lo > 1) bar = xcd_barrier_post((unsigned*)(args.ws + WS_CTL) + CW_BAR, (volatile LAS unsigned*)(F.lds + MISC_OFF) + 8);
#define SEAM(k) if (IN(k) && IN((k) + 1)) xcd_barrier(bar);
#define PH(k, call) if (IN(k)) { int t_ = threadIdx.x; asm volatile("" : "+v"(t_)); F.tid = t_; F.lane = t_ & 63; F.wave = __builtin_amdgcn_readfirstlane(t_ >> 6); call; }
    PH(0, (phase0(F), p0_small_weights(F)))
    SEAM(0)
    PH(1, phase1(F))
    SEAM(1)
    PH(2, phase2(F))
    SEAM(2)
    PH(3, phase_prepA(F))
    SEAM(3)
    if (flags & 1) { PH(4, phase_gategemm(F)) }
    if (flags & 2) { PH(4, phase_loragemm(F)) }
    SEAM(4)
    if (flags & 1) { PH(5, phase_lrulocal(F)) }
    if (flags & 2) { PH(5, phase_rwkvlocal(F)) }
    SEAM(5)
    PH(6, phase_scan(F, flags))
    SEAM(6)
    PH(7, phase_post(F, flags))
    SEAM(7)
    PH(8, phase_outproj(F))
    SEAM(8)
    PH(9, phase_route(F))
    SEAM(9)
    PH(10, phase_m1(F))
    SEAM(10)
    PH(11, phase_m2(F))
    SEAM(11)
    PH(12, phase_final(F))
#undef SEAM
#undef PH
#undef IN
}

extern "C" void kernel_launch(void* const* d_in, const int* in_sizes, int n_in, void* d_out, int out_size, void* d_ws, size_t ws_size, hipStream_t stream) {
    if (n_in != 35 || out_size != NTOK * D || ws_size < WS_END) { fprintf(stderr, "kernel_launch: unexpected shapes (n_in %d out %d ws %zu)\n", n_in, out_size, ws_size); return; }
    static int grid = 0;
    if (grid == 0) {
        int dev = 0, cus = 0;
        if (hipGetDevice(&dev) != hipSuccess || hipDeviceGetAttribute(&cus, hipDeviceAttributeMultiprocessorCount, dev) != hipSuccess) { grid = -1; return; }
        if (hipFuncSetAttribute((const void*)mk_fwd, hipFuncAttributeMaxDynamicSharedMemorySize, LDS_BYTES) != hipSuccess) { fprintf(stderr, "kernel_launch: hipFuncSetAttribute failed\n"); grid = -1; return; }
        int per_cu = 0;
        if (hipOccupancyMaxActiveBlocksPerMultiprocessor(&per_cu, (const void*)mk_fwd, NWAVES * 64, LDS_BYTES) != hipSuccess || per_cu < 1) { fprintf(stderr, "kernel_launch: occupancy query says %d blocks per CU\n", per_cu); (void)hipGetLastError(); }
        grid = cus;
    }
    if (grid < 0) return;
    const float* const* in = (const float* const*)d_in;
    const float *x = in[0], *c = in[1], *w_ada = in[2], *b_ada = in[3], *norm1_g = in[4], *w_in = in[5], *conv_w = in[6], *conv_b = in[7], *lru_wa = in[8], *lru_ba = in[9],
                *lru_wi = in[10], *lru_bi = in[11], *lru_lam = in[12], *lru_norm_g = in[13], *tok_mu = in[14], *w0 = in[15], *w_up = in[16], *a0 = in[17], *a_up = in[18],
                *g_up = in[19], *k_k = in[20], *k_a = in[21], *r_k = in[22], *ln_x_w = in[23], *ln_x_b = in[24], *w_out = in[25], *norm2_g = in[26], *w_grp = in[27],
                *b_grp = in[28], *w_exp = in[29], *b_exp = in[30], *w1 = in[31], *w3 = in[32], *w2 = in[33], *final_g = in[34];
    (void)c; (void)w_ada; (void)b_ada; (void)norm1_g; (void)w_in;
    char* ws = (char*)d_ws; float* out = (float*)d_out;
    float* mod = (float*)(ws + WS_MOD); int* sel_e = (int*)(ws + WS_SEL); float* sel_w = (float*)(ws + WS_SEL + NTOK * 2 * 4);
    bf16* H = (bf16*)(ws + WS_H); bf16* YMIX = (bf16*)(ws + WS_YMIX); bf16* P = (bf16*)(ws + WS_P); bf16* YS = (bf16*)(ws + WS_YS);
    Args a{};
    for (int i = 0; i < 35; ++i) a.in[i] = in[i];
    a.out = out; a.ws = (unsigned char*)d_ws;
    hipMemsetAsync(ws + WS_CTL, 0, 1 * MiB, stream);
#define LAUNCH_PH(p) do { a.ph_lo = (p); a.ph_hi = (p) + 1; hipLaunchKernelGGL(mk_fwd, dim3(grid), dim3(NWAVES * 64), LDS_BYTES, stream, a); } while (0)
#ifndef MIX_FLAGS
#define MIX_FLAGS 3
#endif
    a.flags = MIX_FLAGS;
#ifndef N_LAUNCHES
#define N_LAUNCHES 1
#endif
    if (N_LAUNCHES == 1) { a.ph_lo = 0; a.ph_hi = 13; hipLaunchKernelGGL(mk_fwd, dim3(grid), dim3(NWAVES * 64), LDS_BYTES, stream, a); }
    else { for (int p = 0; p < 13; ++p) LAUNCH_PH(p); }
    (void)sel_e; (void)sel_w; (void)H; (void)YS; (void)w_out; (void)norm2_g; (void)w_grp; (void)b_grp; (void)w_exp; (void)b_exp; (void)w1; (void)w2; (void)w3; (void)final_g; (void)mod; (void)x;
}
```

```cpp
#include <hip/hip_runtime.h>
#include <stdint.h>
#include <cstdio>

#define SCAN_NOLO 1
#ifndef TIMER_A
#define TIMER_A -1
#define TIMER_B -1
#endif
#define TSTAMP(F_, i) do { if (TIMER_A >= 0 && blockIdx.x == 0 && threadIdx.x == 0) ((unsigned long long*)((F_).ws + 8192))[i] = __builtin_amdgcn_s_memrealtime(); } while (0)
#define TSTAMP_B(F_, blk, i) do { if (TIMER_A >= 0 && blockIdx.x == (blk) && threadIdx.x == 0) ((unsigned long long*)((F_).ws + 8192))[i] = __builtin_amdgcn_s_memrealtime(); } while (0)
#define TACCUM(F_, i, t0) do { if (TIMER_A >= 0 && blockIdx.x == 0 && threadIdx.x == 0) ((unsigned long long*)((F_).ws + 8192))[i] += __builtin_amdgcn_s_memrealtime() - (t0); } while (0)
typedef unsigned short bf16;
__device__ __forceinline__ bf16 f2bf(float f) { unsigned u = __float_as_uint(f); return (bf16)((u + 0x7fffu + ((u >> 16) & 1u)) >> 16); }
__device__ __forceinline__ float bf2f(bf16 b) { return __uint_as_float(((unsigned)b) << 16); }

constexpr int NB = 4, T = 8192, D = 1024, NTOK = NB * T;
constexpr int LRU_W = 512, RW = 512, PW = 2816;
constexpr int C_UX = 0, C_GATE = 512, C_R = 1024, C_K = 1536, C_V = 2048, C_WD = 2560, C_AD = 2624, C_GD = 2688;
constexpr int NE = 32, DE = 512;
constexpr size_t MiB = 1u << 20;
constexpr size_t WS_CTL = 0;
constexpr int CW_BAR = 4096;
constexpr size_t WS_CNT = 512 * 1024;
constexpr size_t WS_MOD = 1 * MiB;
constexpr size_t WS_SELW = 1 * MiB + 256 * 1024;
constexpr size_t WS_SEL = 1 * MiB + 512 * 1024;
constexpr size_t FW_WLORAT = 2 * MiB;
constexpr size_t FW_WGT = 3 * MiB;
constexpr size_t FW_WR = 3 * MiB + 512 * 1024;
constexpr size_t FW_WINT = 4 * MiB;
constexpr size_t FW_WOUTT = 10 * MiB;
constexpr size_t WS_LIST = 12 * MiB;
constexpr size_t WS_H = 16 * MiB;
constexpr size_t WS_YMIX = WS_H;
constexpr size_t WS_P = 80 * MiB;
constexpr size_t WS_HID = WS_P;
constexpr size_t WS_YS = 256 * MiB;
constexpr size_t FW_W13T = 416 * MiB;
constexpr size_t FW_W2T = 480 * MiB;
constexpr size_t WS_END = 512 * MiB;

__device__ __forceinline__ float wave_sum(float v) {
    v += __int_as_float(__builtin_amdgcn_update_dpp(0, __float_as_int(v), 0xB1, 0xF, 0xF, true));
    v += __int_as_float(__builtin_amdgcn_update_dpp(0, __float_as_int(v), 0x4E, 0xF, 0xF, true));
    v += __int_as_float(__builtin_amdgcn_update_dpp(0, __float_as_int(v), 0x141, 0xF, 0xF, true));
    v += __int_as_float(__builtin_amdgcn_update_dpp(0, __float_as_int(v), 0x140, 0xF, 0xF, true));
    const int vi = __float_as_int(v);
    const float r0 = __int_as_float(__builtin_amdgcn_readlane(vi, 0)), r1 = __int_as_float(__builtin_amdgcn_readlane(vi, 16));
    const float r2 = __int_as_float(__builtin_amdgcn_readlane(vi, 32)), r3 = __int_as_float(__builtin_amdgcn_readlane(vi, 48));
    return (r0 + r1) + (r2 + r3);
}
__device__ __forceinline__ float sigmoidf_(float x) { return 1.f / (1.f + __expf(-x)); }
__device__ __forceinline__ float softplusf_(float x) { return x > 20.f ? x : log1pf(__expf(x)); }
__device__ __forceinline__ float gelu_tanh(float x) { const float u = 0.7978845608028654f * (x + 0.044715f * x * x * x); return 0.5f * x * (1.f + tanhf(u)); }

namespace pg8 {
#define PG8_LAS __attribute__((address_space(3)))
typedef unsigned short bf16_t;
typedef short bf16x8 __attribute__((ext_vector_type(8)));
typedef float f32x4 __attribute__((ext_vector_type(4)));
typedef unsigned u32x4 __attribute__((ext_vector_type(4)));
constexpr int BM = 256, BK = 64, HALF = 128, HTB = HALF * BK * 2  , STAGE_BYTES = 8 * HTB, NXCD = 8, WGM = 8;

__host__ __device__ __forceinline__ int lds_byte(int r, int c) { const int st = (r >> 4) * 2 + (c >> 5), rr = r & 15, cc = c & 31, ob = rr * 64 + cc * 2; return st * 1024 + (ob ^ (((ob >> 9) & 1) << 5)); }
__host__ __device__ __forceinline__ void stage_rc(int b, int& R, int& C) { const int st = b / 1024, sb = b % 1024, swz = sb ^ (((sb >> 9) & 1) << 5); R = (st >> 1) * 16 + swz / 64; C = (st & 1) * 32 + (swz % 64) / 2; }
__host__ __device__ __forceinline__ int perm32(int rho) { const int n = rho >> 4, i = rho & 15; return 8 * (i >> 2) + 4 * n + (i & 3); }

struct Unit { int pm, pn, e, nrows, row0; };
struct Gemm { const bf16_t* A; const bf16_t* Bt; int lda, ldb, K; };

__device__ __forceinline__ unsigned cvt_pk_bf16(float lo, float hi) { unsigned r; asm volatile("v_cvt_pk_bf16_f32 %0, %1, %2" : "=v"(r) : "v"(lo), "v"(hi)); return r; }

struct DenseOrder {
    static constexpr bool GATHER = false;
    int nM, nN, nwg, G, c;
    __device__ void init(int M, int N, int G_, int c_) { nM = M / BM; nN = N / BM; nwg = nM * nN; G = G_; c = c_; }
    __device__ bool next(int i, Unit& u) const {
        const long L = (long)i * G + c; if (L >= nwg) return false;
        int wgid = (int)L; { const int q = nwg / NXCD, r = nwg % NXCD, xcd = wgid % NXCD, off = wgid / NXCD; wgid = (xcd < r ? xcd * (q + 1) : r * (q + 1) + (xcd - r) * q) + off; }
        const int nig = WGM * nN, gid = wgid / nig, fm = gid * WGM, gsz = (nM - fm) < WGM ? (nM - fm) : WGM;
        u.pm = fm + ((wgid % nig) % gsz); u.pn = (wgid % nig) / gsz; u.e = 0; u.nrows = 256; u.row0 = 0; return true;
    }
    __device__ __forceinline__ const char* a_base(const Gemm& g, const Unit& u) const { return (const char*)g.A + (size_t)u.pm * (BM * 2) * g.lda; }
    __device__ __forceinline__ const char* b_base(const Gemm& g, const Unit& u) const { return (const char*)g.Bt + (size_t)u.pn * (BM * 2) * g.ldb; }
    __device__ __forceinline__ int row(const Unit&, int) const { return 0; }
};

template <class Epi, class Sched>
__device__ __forceinline__ void gemm_phase(PG8_LAS unsigned char* lds, const Gemm g, const Sched& S, const Epi& E, const int tid) {
    const int wid = __builtin_amdgcn_readfirstlane(tid >> 6), lane = tid & 63, wr = wid >> 2, wc = wid & 3, fr = lane & 15, fq = lane >> 4;
    const int K = g.K, nt = K / BK;
    unsigned voffA[2], voffB[2]; int sR[2], sC[2];
#pragma unroll
    for (int i = 0; i < 2; ++i) { int R, C; stage_rc(tid * 16 + i * 8192, R, C); const int Rb = Epi::PERM ? ((R & ~31) + perm32(R & 31)) : R;
        voffA[i] = (unsigned)(R * g.lda + C) * 2u; voffB[i] = (unsigned)(Rb * g.ldb + C) * 2u; sR[i] = R; sC[i] = C; }
    const size_t kstep = (size_t)(BK * 2);
    const size_t hstepA = Sched::GATHER ? 0 : (size_t)HALF * g.lda * 2, hstepB = (size_t)HALF * g.ldb * 2;
    const unsigned ldsw = (unsigned)wid * 1024u;
    const int aoff = lds_byte(wr * 64 + fr, fq * 8), boff = lds_byte(wc * 32 + fr, fq * 8);
    unsigned gA[2][2], gN[2][2];
#define PG8_SA(b, h) (((b) * 2 + (h)) * HTB)
#define PG8_SB(b, h) ((4 + (b) * 2 + (h)) * HTB)
#define PG8_STAGE(bufoff, gbase, voff) do { _Pragma("unroll") for (int _i = 0; _i < 2; ++_i) \
        __builtin_amdgcn_global_load_lds((const unsigned*)((const char*)(gbase) + (voff)[_i]), (PG8_LAS unsigned*)(lds + (bufoff) + ldsw + _i * 8192), 16, 0, 0); } while (0)
#define PG8_STAGE_A(bufoff, kp, h, OFF) do { if constexpr (Sched::GATHER) PG8_STAGE(bufoff, kp, OFF[h]); else PG8_STAGE(bufoff, (kp) + (h) * hstepA, voffA); } while (0)
#define PG8_LDA(dst, b, h) do { _Pragma("unroll") for (int m = 0; m < 4; ++m) _Pragma("unroll") for (int k = 0; k < 2; ++k) dst[m][k] = *(const PG8_LAS bf16x8*)(lds + PG8_SA(b, h) + aoff + m * 2048 + k * 1024); } while (0)
#define PG8_LDB(dst, b, h) do { _Pragma("unroll") for (int n = 0; n < 2; ++n) _Pragma("unroll") for (int k = 0; k < 2; ++k) dst[n][k] = *(const PG8_LAS bf16x8*)(lds + PG8_SB(b, h) + boff + n * 2048 + k * 1024); } while (0)
#define PG8_MMA(ai, bj, At, Bt) do { __builtin_amdgcn_s_setprio(1); _Pragma("unroll") for (int m = 0; m < 4; ++m) _Pragma("unroll") for (int n = 0; n < 2; ++n) _Pragma("unroll") for (int k = 0; k < 2; ++k) \
        acc[ai][bj][m][n] = __builtin_amdgcn_mfma_f32_16x16x32_bf16(Bt[n][k], At[m][k], acc[ai][bj][m][n], 0, 0, 0); __builtin_amdgcn_s_setprio(0); } while (0)
#define PG8_WAIT_V(n) asm volatile("s_waitcnt vmcnt(" #n ")" ::: "memory")
#define PG8_WAIT_L(n) asm volatile("s_waitcnt lgkmcnt(" #n ")" ::: "memory")
#define PG8_BAR __builtin_amdgcn_s_barrier()
#define PG8_SCHED __builtin_amdgcn_sched_barrier(0)
    Unit cur, nxt; int ui = 0;
    if (!S.next(0, cur)) return;
    f32x4 acc[2][2][4][2];
#pragma unroll
    for (int a = 0; a < 2; ++a)
#pragma unroll
        for (int b = 0; b < 2; ++b)
#pragma unroll
            for (int m = 0; m < 4; ++m)
#pragma unroll
                for (int n = 0; n < 2; ++n) acc[a][b][m][n] = (f32x4){0.f, 0.f, 0.f, 0.f};
    bf16x8 At[4][2], B0[2][2], B1[2][2];
    const char* cA = S.a_base(g, cur); const char* cB = S.b_base(g, cur);
    if constexpr (Sched::GATHER) {
#pragma unroll
        for (int h = 0; h < 2; ++h)
#pragma unroll
            for (int i = 0; i < 2; ++i) gA[h][i] = (unsigned)(S.row(cur, h * HALF + sR[i]) * g.lda + sC[i]) * 2u;
    }
    PG8_STAGE(PG8_SB(0, 0), cB, voffB); PG8_STAGE(PG8_SB(0, 1), cB + hstepB, voffB); PG8_STAGE_A(PG8_SA(0, 0), cA, 0, gA); PG8_STAGE_A(PG8_SA(0, 1), cA, 1, gA);
    if (wr == 1) PG8_BAR;
    PG8_WAIT_V(2); PG8_BAR;
    PG8_STAGE(PG8_SB(1, 0), cB + kstep, voffB); PG8_STAGE_A(PG8_SA(1, 0), cA + kstep, 0, gA); PG8_STAGE(PG8_SB(1, 1), cB + hstepB + kstep, voffB);
    PG8_WAIT_V(6); PG8_BAR;
    for (;;) {
        const bool has_next = S.next(ui + 1, nxt);
        const char* nA = has_next ? S.a_base(g, nxt) : cA; const char* nB = has_next ? S.b_base(g, nxt) : cB;
        if constexpr (Sched::GATHER) {
#pragma unroll
            for (int h = 0; h < 2; ++h)
#pragma unroll
                for (int i = 0; i < 2; ++i) gN[h][i] = has_next ? (unsigned)(S.row(nxt, h * HALF + sR[i]) * g.lda + sC[i]) * 2u : gA[h][i];
        }
#pragma unroll 1
        for (int t = 0; t < nt; t += 2) {
            const bool last = (t == nt - 2);
            const char* a1 = cA + (size_t)(t + 1) * kstep;
            const char* a2 = last ? nA : cA + (size_t)(t + 2) * kstep; const char* b2 = last ? nB : cB + (size_t)(t + 2) * kstep;
            const char* a3 = a2 + kstep; const char* b3 = b2 + kstep;
            unsigned o2[2][2];
            if constexpr (Sched::GATHER) {
#pragma unroll
                for (int h = 0; h < 2; ++h)
#pragma unroll
                    for (int i = 0; i < 2; ++i) o2[h][i] = last ? gN[h][i] : gA[h][i];
            }
            PG8_LDB(B0, 0, 0); PG8_LDB(B1, 0, 1); PG8_SCHED; PG8_LDA(At, 0, 0); PG8_STAGE_A(PG8_SA(1, 1), a1, 1, gA);
            PG8_WAIT_V(8); PG8_WAIT_L(0); PG8_BAR; PG8_MMA(0, 0, At, B0); PG8_MMA(0, 1, At, B1); PG8_BAR; PG8_SCHED;
            PG8_LDA(At, 0, 1); PG8_STAGE(PG8_SB(0, 0), b2, voffB); PG8_STAGE(PG8_SB(0, 1), b2 + hstepB, voffB); PG8_STAGE_A(PG8_SA(0, 0), a2, 0, o2);
            PG8_WAIT_V(8); PG8_WAIT_L(0); PG8_BAR; PG8_MMA(1, 0, At, B0); PG8_MMA(1, 1, At, B1); PG8_BAR; PG8_SCHED;
            PG8_LDB(B0, 1, 0); PG8_LDB(B1, 1, 1); PG8_SCHED; PG8_LDA(At, 1, 0); PG8_STAGE_A(PG8_SA(0, 1), a2, 1, o2);
            PG8_WAIT_V(8); PG8_WAIT_L(0); PG8_BAR; PG8_MMA(0, 0, At, B0); PG8_MMA(0, 1, At, B1); PG8_BAR; PG8_SCHED;
            PG8_LDA(At, 1, 1); PG8_STAGE(PG8_SB(1, 0), b3, voffB); PG8_STAGE(PG8_SB(1, 1), b3 + hstepB, voffB); PG8_STAGE_A(PG8_SA(1, 0), a3, 0, o2);
            PG8_WAIT_V(8); PG8_WAIT_L(0); PG8_BAR; PG8_MMA(1, 0, At, B0); PG8_MMA(1, 1, At, B1); PG8_BAR; PG8_SCHED;
        }
        if (wr == 0) PG8_BAR;
        E(acc, cur, wr, wc, fr, fq);
        if (!has_next) break;
#pragma unroll
        for (int a = 0; a < 2; ++a)
#pragma unroll
            for (int b = 0; b < 2; ++b)
#pragma unroll
                for (int m = 0; m < 4; ++m)
#pragma unroll
                    for (int n = 0; n < 2; ++n) acc[a][b][m][n] = (f32x4){0.f, 0.f, 0.f, 0.f};
        cur = nxt; cA = nA; cB = nB; ++ui;
        if constexpr (Sched::GATHER) {
#pragma unroll
            for (int h = 0; h < 2; ++h)
#pragma unroll
                for (int i = 0; i < 2; ++i) gA[h][i] = gN[h][i];
        }
        if (wr == 1) PG8_BAR;
    }
    PG8_WAIT_V(0);
    PG8_BAR;
#undef PG8_SA
#undef PG8_SB
#undef PG8_STAGE
#undef PG8_STAGE_A
#undef PG8_LDA
#undef PG8_LDB
#undef PG8_MMA
#undef PG8_WAIT_V
#undef PG8_WAIT_L
#undef PG8_BAR
#undef PG8_SCHED
}

struct EpiBf16Store {
    static constexpr bool PERM = true;
    bf16_t* O; int ldc;
    __device__ __forceinline__ void operator()(const f32x4 (&acc)[2][2][4][2], const Unit& u, int wr, int wc, int fr, int fq) const {
        const int row0 = u.pm * BM + wr * 64 + fr, col0 = u.pn * BM + wc * 32 + 8 * fq;
#pragma unroll
        for (int ai = 0; ai < 2; ++ai)
#pragma unroll
            for (int m = 0; m < 4; ++m) { bf16_t* rowp = O + (size_t)(row0 + ai * HALF + m * 16) * ldc + col0;
#pragma unroll
                for (int bj = 0; bj < 2; ++bj) { const f32x4 v0 = acc[ai][bj][m][0], v1 = acc[ai][bj][m][1];
                    u32x4 w; w.x = cvt_pk_bf16(v0[0], v0[1]); w.y = cvt_pk_bf16(v0[2], v0[3]); w.z = cvt_pk_bf16(v1[0], v1[1]); w.w = cvt_pk_bf16(v1[2], v1[3]);
                    *(u32x4*)(rowp + bj * HALF) = w; } }
    }
};
}
constexpr int NWAVES = 8;
constexpr int RING_OFF = 0, RING_BYTES = 131072;
constexpr int ROUTER_LDS = 147456;
constexpr int LDSCTL_OFF = ROUTER_LDS, MISC_OFF = LDSCTL_OFF + 320;
constexpr int LDS_TAB_OFF = LDSCTL_OFF + 1024;
constexpr int LDS_BYTES = 155648;

#define GAS __attribute__((address_space(1)))
#define LAS __attribute__((address_space(3)))
typedef unsigned v4u __attribute__((ext_vector_type(4)));
typedef unsigned v2u __attribute__((ext_vector_type(2)));
typedef float f32x4 __attribute__((ext_vector_type(4)));
#define LDS_WAIT() asm volatile("s_waitcnt lgkmcnt(0)" ::: "memory")
#define VM_WAIT() asm volatile("s_waitcnt vmcnt(0)" ::: "memory")
__device__ __forceinline__ unsigned pk2(float lo, float hi) { return (unsigned)f2bf(lo) | ((unsigned)f2bf(hi) << 16); }


struct Frame {
    LAS unsigned char* lds;
    int tid, lane, wave, vcu, G;
    const float* const* in;
    float* out; unsigned char* ws;
};

__device__ __forceinline__ void p0_transpose_item(const float* W, int ldw, bf16* WT, int ldt, int k0, int n0, int row0, LAS float* scr, int lane) {
    {
        f32x4 t[8];
#pragma unroll
        for (int i = 0; i < 8; ++i) t[i] = *(const f32x4*)(W + (size_t)(k0 + 8 * i + (lane >> 3)) * ldw + n0 + 4 * (lane & 7));
#pragma unroll
        for (int i = 0; i < 8; ++i) { LAS float* d = scr + (8 * i + (lane >> 3)) * 33 + 4 * (lane & 7); d[0] = t[i].x; d[1] = t[i].y; d[2] = t[i].z; d[3] = t[i].w; }
    }
    LDS_WAIT(); asm volatile("" ::: "memory");
    const int c = lane & 7;
#pragma unroll
    for (int j = 0; j < 4; ++j) { const int n = (lane >> 3) + 8 * j; const LAS float* s = scr + (8 * c) * 33 + n;
        v4u o; o.x = pk2(s[0 * 33], s[1 * 33]); o.y = pk2(s[2 * 33], s[3 * 33]); o.z = pk2(s[4 * 33], s[5 * 33]); o.w = pk2(s[6 * 33], s[7 * 33]);
        *(v4u*)(WT + (size_t)(row0 + n) * ldt + k0 + 8 * c) = o; }
    LDS_WAIT(); asm volatile("" ::: "memory");
}

__device__ __forceinline__ void p0_mod_task(Frame& F, int task) {
    LAS float* sc = (LAS float*)(F.lds);
    LAS float* red = (LAS float*)(F.lds + 16384);
    const float* c = F.in[1]; const float* w_ada = F.in[2]; const float* b_ada = F.in[3];
    for (int i = F.tid; i < 4096; i += 512) { const float cv = c[i]; sc[i] = cv / (1.f + __expf(-cv)); }
    __syncthreads();
    const int j = task * 64 + F.lane;
    float a0 = 0.f, a1 = 0.f, a2 = 0.f, a3 = 0.f;
    const int kb = F.wave * 128;
#pragma unroll 16
    for (int k = kb; k < kb + 128; ++k) { const float w = w_ada[(size_t)k * 6144 + j]; a0 += sc[k] * w; a1 += sc[1024 + k] * w; a2 += sc[2048 + k] * w; a3 += sc[3072 + k] * w; }
    red[(F.wave * 4 + 0) * 64 + F.lane] = a0; red[(F.wave * 4 + 1) * 64 + F.lane] = a1; red[(F.wave * 4 + 2) * 64 + F.lane] = a2; red[(F.wave * 4 + 3) * 64 + F.lane] = a3;
    __syncthreads();
    if (F.tid < 256) { const int b = F.tid >> 6, l = F.tid & 63; float s = 0.f;
#pragma unroll
        for (int w = 0; w < 8; ++w) s += red[(w * 4 + b) * 64 + l];
        ((float*)(F.ws + WS_MOD))[b * 6144 + task * 64 + l] = s + b_ada[task * 64 + l]; }
    __syncthreads();
}

__device__ __forceinline__ void phase0(Frame& F) {
    if (blockIdx.x < 96) p0_mod_task(F, blockIdx.x);
    LAS float* scr = (LAS float*)(F.lds + RING_OFF + F.wave * 16384);
    const int gw = F.vcu * NWAVES + F.wave, NGW = F.G * NWAVES;
    constexpr int I_IN = (D / 64) * (PW / 32), I_OUT = (D / 64) * (D / 32);
    constexpr int NITEMS = I_IN + I_OUT;
    for (int it = gw; it < NITEMS; it += NGW) {
        int r = it;
        if (r < I_IN) { const int nb = PW / 32, kb = r / nb, n = r % nb; p0_transpose_item(F.in[5], PW, (bf16*)(F.ws + FW_WINT), D, 64 * kb, 32 * n, 32 * n, scr, F.lane); continue; } r -= I_IN;
        { const int nb = D / 32, kb = r / nb, n = r % nb; p0_transpose_item(F.in[25], D, (bf16*)(F.ws + FW_WOUTT), D, 64 * kb, 32 * n, 32 * n, scr, F.lane); }
    }
}
__device__ __forceinline__ void expert_transposes(Frame& F, int wv, int nwv) {
    LAS float* scr = (LAS float*)(F.lds + RING_OFF + F.wave * 16384);
    constexpr int I_E13 = NE * 2 * 256, I_E2 = NE * 256;
    for (int it = wv; it < I_E13 + I_E2; it += nwv) {
        int r = it;
        if (r < I_E13) {
            const int e = r >> 9, which = (r >> 8) & 1, q = r & 255, kb = q >> 4, n = q & 15, n0 = 32 * n;
            const float* W = (which ? F.in[32] : F.in[31]) + (size_t)e * D * DE;
            p0_transpose_item(W, DE, (bf16*)(F.ws + FW_W13T) + (size_t)e * 1024 * 1024, D, 64 * kb, n0, (n0 >> 7) * 256 + which * 128 + (n0 & 127), scr, F.lane); continue; } r -= I_E13;
        {
            const int e = r >> 8, q = r & 255, kb = q >> 5, n = q & 31;
            p0_transpose_item(F.in[33] + (size_t)e * DE * D, D, (bf16*)(F.ws + FW_W2T) + (size_t)e * 1024 * DE, DE, 64 * kb, 32 * n, 32 * n, scr, F.lane); }
    }
}

__device__ __forceinline__ void adaln_row(const float* xrow, const float* g, const float* sh, const float* sc, bf16* orow, int lane) {
    const f32x4* xr = (const f32x4*)xrow + lane;
    f32x4 v[4]; float s = 0.f;
#pragma unroll
    for (int j = 0; j < 4; ++j) { v[j] = xr[64 * j]; s += (v[j].x * v[j].x + v[j].y * v[j].y) + (v[j].z * v[j].z + v[j].w * v[j].w); }
    const float rinv = rsqrtf(wave_sum(s) * (1.f / D) + 1e-6f);
    v2u* o8 = (v2u*)orow + lane;
#pragma unroll
    for (int j = 0; j < 4; ++j) { const f32x4 gg = ((const f32x4*)g)[lane + 64 * j], s1 = ((const f32x4*)sc)[lane + 64 * j], s0 = ((const f32x4*)sh)[lane + 64 * j];
        f32x4 y = v[j] * rinv * gg; y = y * (s1 + 1.f) + s0;
        v2u w; w.x = pk2(y.x, y.y); w.y = pk2(y.z, y.w); o8[64 * j] = w; }
}
__device__ __forceinline__ void phase1(Frame& F) {
    const int gw = F.vcu * NWAVES + F.wave, NGW = F.G * NWAVES;
    const float* mod = (const float*)(F.ws + WS_MOD);
    for (int m = gw; m < NTOK; m += NGW) { const int b = m / T;
        adaln_row(F.in[0] + (size_t)m * D, F.in[4], mod + b * 6144, mod + b * 6144 + 1024, (bf16*)(F.ws + WS_H) + (size_t)m * D, F.lane); }
}
__device__ __forceinline__ void phase2(Frame& F) {
    pg8::Gemm g{(const bf16*)(F.ws + WS_H), (const bf16*)(F.ws + FW_WINT), D, D, D};
    pg8::DenseOrder S; S.init(NTOK, PW, F.G, (int)blockIdx.x);
    pg8::EpiBf16Store E{(bf16*)(F.ws + WS_P), PW};
    pg8::gemm_phase<pg8::EpiBf16Store, pg8::DenseOrder>(F.lds + RING_OFF, g, S, E, F.tid);
}


namespace pg8 {
struct EpiX1F {
    static constexpr bool PERM = false;
    const float* const* in; unsigned char* ws; float* out;
    __device__ __forceinline__ void operator()(const f32x4 (&acc)[2][2][4][2], const Unit& u, int wr, int wc, int fr, int fq) const {
        const float* x = in[0]; const float* mod = (const float*)(ws + WS_MOD);
        const int row0 = u.pm * BM + wr * 64 + fr, col0 = u.pn * BM + wc * 32 + 4 * fq;
        const float* g1 = mod + ((u.pm * BM) / T) * 6144 + 2048;
        f32x4 gv[2][2];
#pragma unroll
        for (int bj = 0; bj < 2; ++bj)
#pragma unroll
            for (int n = 0; n < 2; ++n) gv[bj][n] = *(const f32x4*)(g1 + col0 + bj * HALF + n * 16);
#pragma unroll
        for (int ai = 0; ai < 2; ++ai)
#pragma unroll
            for (int m = 0; m < 4; ++m) { const size_t ro = (size_t)(row0 + ai * HALF + m * 16) * D + col0;
#pragma unroll
                for (int bj = 0; bj < 2; ++bj)
#pragma unroll
                    for (int n = 0; n < 2; ++n) { const f32x4 xv = *(const f32x4*)(x + ro + bj * HALF + n * 16);
                        *(f32x4*)(out + ro + bj * HALF + n * 16) = xv + gv[bj][n] * acc[ai][bj][m][n]; } }
    }
};
template <bool GATH> struct MoeOrder {
    static constexpr bool GATHER = GATH;
    const LAS int* ub; const LAS int* rb; const LAS int* cn; const int* list; int G, c, brows;
    __device__ bool next(int i, Unit& u) const {
        const int L = i * G + c; if (L >= ub[32]) return false;
        int e = 0;
#pragma unroll
        for (int k = 16; k >= 1; k >>= 1) if (ub[e + k] <= L) e += k;
        const int local = L - ub[e], tiles = rb[e + 1] - rb[e], pn = local / tiles, mt = local - pn * tiles;
        u.e = e; u.pn = pn; u.pm = rb[e] + mt; u.row0 = e * NTOK + mt * 256; u.nrows = min(256, cn[e] - mt * 256); return true;
    }
    __device__ __forceinline__ const char* a_base(const Gemm& g, const Unit& u) const { return GATH ? (const char*)g.A : (const char*)g.A + (size_t)u.pm * (BM * 2) * g.lda; }
    __device__ __forceinline__ const char* b_base(const Gemm& g, const Unit& u) const { return (const char*)g.Bt + ((size_t)u.e * brows + (size_t)u.pn * BM) * 2 * g.ldb; }
    __device__ __forceinline__ int row(const Unit& u, int r) const { return r < u.nrows ? (list[u.row0 + r] >> 1) : 0; }
};
struct EpiSwiglu {
    static constexpr bool PERM = true;
    bf16_t* HID;
    __device__ __forceinline__ void operator()(const f32x4 (&acc)[2][2][4][2], const Unit& u, int wr, int wc, int fr, int fq) const {
        const int col0 = u.pn * HALF + wc * 32 + 8 * fq;
#pragma unroll
        for (int ai = 0; ai < 2; ++ai)
#pragma unroll
            for (int m = 0; m < 4; ++m) { const int r = ai * HALF + wr * 64 + m * 16 + fr;
                if (r < u.nrows) { float h[8];
#pragma unroll
                    for (int n = 0; n < 2; ++n)
#pragma unroll
                        for (int i = 0; i < 4; ++i) { const float a = acc[ai][0][m][n][i], b = acc[ai][1][m][n][i]; h[n * 4 + i] = a / (1.f + __expf(-a)) * b; }
                    u32x4 w; w.x = cvt_pk_bf16(h[0], h[1]); w.y = cvt_pk_bf16(h[2], h[3]); w.z = cvt_pk_bf16(h[4], h[5]); w.w = cvt_pk_bf16(h[6], h[7]);
                    *(u32x4*)(HID + (size_t)(u.pm * BM + r) * DE + col0) = w; } }
    }
};
struct EpiYs {
    static constexpr bool PERM = true;
    unsigned char* ws;
    __device__ __forceinline__ void operator()(const f32x4 (&acc)[2][2][4][2], const Unit& u, int wr, int wc, int fr, int fq) const {
        bf16_t* YS = (bf16_t*)(ws + WS_YS); const int* list = (const int*)(ws + WS_LIST); const float* selw = (const float*)(ws + WS_SELW);
        const int col0 = u.pn * BM + wc * 32 + 8 * fq;
#pragma unroll
        for (int ai = 0; ai < 2; ++ai)
#pragma unroll
            for (int m = 0; m < 4; ++m) { const int r = ai * HALF + wr * 64 + m * 16 + fr;
                if (r < u.nrows) { const int li = list[u.row0 + r]; const float w8 = selw[li]; bf16_t* rowp = YS + (size_t)li * D + col0;
#pragma unroll
                    for (int bj = 0; bj < 2; ++bj) { const f32x4 v0 = acc[ai][bj][m][0] * w8, v1 = acc[ai][bj][m][1] * w8;
                        u32x4 w; w.x = cvt_pk_bf16(v0[0], v0[1]); w.y = cvt_pk_bf16(v0[2], v0[3]); w.z = cvt_pk_bf16(v1[0], v1[1]); w.w = cvt_pk_bf16(v1[2], v1[3]);
                        *(u32x4*)(rowp + bj * HALF) = w; } } }
    }
};
}

__device__ __forceinline__ void phase_outproj(Frame& F) {
    pg8::Gemm g{(const bf16*)(F.ws + WS_YMIX), (const bf16*)(F.ws + FW_WOUTT), D, D, D};
    pg8::DenseOrder S; S.init(NTOK, D, F.G, (int)blockIdx.x);
    pg8::EpiX1F E{F.in, F.ws, F.out};
    pg8::gemm_phase<pg8::EpiX1F, pg8::DenseOrder>(F.lds + RING_OFF, g, S, E, F.tid);
}

__device__ __forceinline__ void phase_route(Frame& F) {
    LAS float* wt = (LAS float*)F.lds;
    { const f32x4* WR = (const f32x4*)(F.ws + FW_WR); LAS f32x4* wt4 = (LAS f32x4*)F.lds;
      for (int i = F.tid; i < 36 * 256; i += 512) wt4[i] = WR[i]; }
    __syncthreads();
    const float* mod = (const float*)(F.ws + WS_MOD); const float* g2n = F.in[26];
    int* cnt = (int*)(F.ws + WS_CNT); int* list = (int*)(F.ws + WS_LIST); float* selw = (float*)(F.ws + WS_SELW);
    bf16* H2 = (bf16*)(F.ws + WS_H);
    const int gw = F.vcu * NWAVES + F.wave, NGW = F.G * NWAVES, lane = F.lane;
    LAS int* lcnt = (LAS int*)(F.lds + LDSCTL_OFF + 2048); LAS int* lbase = lcnt + 32; LAS int* tokres = lcnt + 64;
    if (F.tid < 32) lcnt[F.tid] = 0;
    __syncthreads();
    int it = 0;
    for (int m = gw; m < NTOK; m += NGW, ++it) {
        const int b = m / T;
        const f32x4* xr = (const f32x4*)(F.out + (size_t)m * D) + lane;
        f32x4 v[4]; float s = 0.f;
#pragma unroll
        for (int j = 0; j < 4; ++j) { v[j] = xr[64 * j]; s += (v[j].x * v[j].x + v[j].y * v[j].y) + (v[j].z * v[j].z + v[j].w * v[j].w); }
        const float rinv = rsqrtf(wave_sum(s) * (1.f / D) + 1e-6f);
        v2u* o8 = (v2u*)(H2 + (size_t)m * D) + lane;
#pragma unroll
        for (int j = 0; j < 4; ++j) { const f32x4 gg = ((const f32x4*)g2n)[lane + 64 * j], s1 = ((const f32x4*)(mod + b * 6144 + 4096))[lane + 64 * j], s0 = ((const f32x4*)(mod + b * 6144 + 3072))[lane + 64 * j];
            f32x4 y = v[j] * rinv * gg; y = y * (s1 + 1.f) + s0; v[j] = y;
            v2u w; w.x = pk2(y.x, y.y); w.y = pk2(y.z, y.w); o8[64 * j] = w; }
        const float* b_grp = F.in[28]; const float* b_exp = F.in[30];
        int gi = 0; float gm = -3.4e38f, den = 0.f;
#pragma unroll 1
        for (int e = 0; e < 4; ++e) { float p = 0.f;
#pragma unroll
            for (int j = 0; j < 4; ++j) { const f32x4 w = *(const LAS f32x4*)(wt + e * 1024 + lane * 4 + 256 * j); p += (v[j].x * w.x + v[j].y * w.y) + (v[j].z * w.z + v[j].w * w.w); }
            const float gl = wave_sum(p) + b_grp[e];
            if (gl > gm) { den = den * __expf(gm - gl) + 1.f; gm = gl; gi = e; } else den += __expf(gl - gm); }
        gi = __builtin_amdgcn_readfirstlane(gi);
        const float gwt = 1.f / den;
        float v1 = -3.4e38f, v2 = -3.4e38f; int i1 = 0, i2 = 0;
#pragma unroll 1
        for (int ii = 0; ii < 8; ++ii) { const int e = gi * 8 + ii; float p = 0.f;
#pragma unroll
            for (int j = 0; j < 4; ++j) { const f32x4 w = *(const LAS f32x4*)(wt + (4 + e) * 1024 + lane * 4 + 256 * j); p += (v[j].x * w.x + v[j].y * w.y) + (v[j].z * w.z + v[j].w * w.w); }
            const float xx = wave_sum(p) + b_exp[e];
            if (xx > v1) { v2 = v1; i2 = i1; v1 = xx; i1 = ii; } else if (xx > v2) { v2 = xx; i2 = ii; } }
        const float e2 = __expf(v2 - v1), w1 = 1.f / (1.f + e2), w2 = e2 / (1.f + e2);
        if (lane == 0) { const int ea = gi * 8 + i1, eb = gi * 8 + i2;
            selw[m * 2] = w1 * gwt; selw[m * 2 + 1] = w2 * gwt;
            const int ra = atomicAdd((int*)&lcnt[ea], 1), rb2 = atomicAdd((int*)&lcnt[eb], 1);
            tokres[(F.wave * 16 + it) * 2] = ea | (ra << 8); tokres[(F.wave * 16 + it) * 2 + 1] = eb | (rb2 << 8); }
    }
    __syncthreads();
    if (F.tid < 32) { const int c = lcnt[F.tid]; lbase[F.tid] = c ? atomicAdd(&cnt[F.tid * 64], c) : 0; }
    __syncthreads();
    if (lane == 0) { int it = 0;
        for (int m = gw; m < NTOK; m += NGW, ++it) {
            const int a = tokres[(F.wave * 16 + it) * 2], b2 = tokres[(F.wave * 16 + it) * 2 + 1];
            list[(a & 255) * NTOK + lbase[a & 255] + (a >> 8)] = m * 2; list[(b2 & 255) * NTOK + lbase[b2 & 255] + (b2 >> 8)] = m * 2 + 1; } }
    __syncthreads();
}

__device__ __forceinline__ void moe_tables(Frame& F, int npn) {
    LAS int* tab = (LAS int*)(F.lds + LDS_TAB_OFF);
    if (F.tid == 0) { const int* cnt = (const int*)(F.ws + WS_CNT); int ub = 0, rb = 0;
        for (int e = 0; e < 32; ++e) { const int c = __hip_atomic_load(cnt + e * 64, __ATOMIC_RELAXED, __HIP_MEMORY_SCOPE_AGENT); const int tl = (c + 255) >> 8; tab[e] = ub; tab[33 + e] = rb; tab[66 + e] = c; ub += tl * npn; rb += tl; }
        tab[32] = ub; tab[33 + 32] = rb; }
    __syncthreads();
}
__device__ __forceinline__ void phase_m1(Frame& F) {
    moe_tables(F, 4);
    const LAS int* tab = (const LAS int*)(F.lds + LDS_TAB_OFF);
    pg8::Gemm g{(const bf16*)(F.ws + WS_H), (const bf16*)(F.ws + FW_W13T), D, D, D};
    pg8::MoeOrder<true> S{tab, tab + 33, tab + 66, (const int*)(F.ws + WS_LIST), F.G, (int)blockIdx.x, 1024};
    pg8::EpiSwiglu E{(bf16*)(F.ws + WS_HID)};
    pg8::gemm_phase<pg8::EpiSwiglu, pg8::MoeOrder<true>>(F.lds + RING_OFF, g, S, E, F.tid);
}
__device__ __forceinline__ void phase_m2(Frame& F) {
    moe_tables(F, 4);
    const LAS int* tab = (const LAS int*)(F.lds + LDS_TAB_OFF);
    pg8::Gemm g{(const bf16*)(F.ws + WS_HID), (const bf16*)(F.ws + FW_W2T), DE, DE, DE};
    pg8::MoeOrder<false> S{tab, tab + 33, tab + 66, (const int*)(F.ws + WS_LIST), F.G, (int)blockIdx.x, 1024};
    pg8::EpiYs E{F.ws};
    pg8::gemm_phase<pg8::EpiYs, pg8::MoeOrder<false>>(F.lds + RING_OFF, g, S, E, F.tid);
}
__device__ __forceinline__ void phase_final(Frame& F, bool dry = false) {
    const int gw = F.vcu * NWAVES + F.wave, NGW = F.G * NWAVES, lane = F.lane;
    const float* mod = (const float*)(F.ws + WS_MOD); const float* fg = F.in[34]; const bf16* YS = (const bf16*)(F.ws + WS_YS);
    for (int m = gw; m < NTOK; m += NGW) { const int b = m / T;
        f32x4* xr = (f32x4*)(F.out + (size_t)m * D) + lane;
        const v2u* y0 = (const v2u*)(YS + (size_t)(2 * m) * D) + lane; const v2u* y1 = (const v2u*)(YS + (size_t)(2 * m + 1) * D) + lane;
        f32x4 v[4]; float s = 0.f;
#pragma unroll
        for (int j = 0; j < 4; ++j) { const v2u a = y0[64 * j], c = y1[64 * j]; const f32x4 g2 = ((const f32x4*)(mod + b * 6144 + 5120))[lane + 64 * j];
            f32x4 mo; mo.x = __uint_as_float(a.x << 16) + __uint_as_float(c.x << 16); mo.y = __uint_as_float(a.x & 0xffff0000u) + __uint_as_float(c.x & 0xffff0000u);
            mo.z = __uint_as_float(a.y << 16) + __uint_as_float(c.y << 16); mo.w = __uint_as_float(a.y & 0xffff0000u) + __uint_as_float(c.y & 0xffff0000u);
            v[j] = xr[64 * j] + g2 * mo; s += (v[j].x * v[j].x + v[j].y * v[j].y) + (v[j].z * v[j].z + v[j].w * v[j].w); }
        const float rinv = rsqrtf(wave_sum(s) * (1.f / D) + 1e-6f);
        float tdelta = 0.f;
        if (TIMER_A >= 0 && m == 0) { const unsigned long long* ts = (const unsigned long long*)(F.ws + 8192);
            const float us = (float)(TIMER_B == TIMER_A ? ts[TIMER_A] : ts[TIMER_B] - ts[TIMER_A]) * 0.01f; tdelta = sqrtf(32768.f * us * 1e-6f); }
#pragma unroll
        for (int j = 0; j < 4; ++j) (dry ? (f32x4*)(F.ws + WS_P) + (size_t)m * 256 + lane : xr)[64 * j] = v[j] * rinv * ((const f32x4*)fg)[lane + 64 * j] + tdelta;
    }
}
#define XB_TMO      128
#define XB_XCNT(j)  (256  + 64 * (j))
#define XB_XSUB(j)  (1280 + 64 * (j))
#define XB_XGEN(j)  (2304 + 64 * (j))
#define XB_TOP      3328
#define XB_TOPGEN   3392
#define XCD_BAR_WORDS 3456
#define XB_SPIN_CAP (1u << 18)

__device__ __forceinline__ unsigned xb_ld(unsigned* p)              { return __hip_atomic_load(p, __ATOMIC_RELAXED, __HIP_MEMORY_SCOPE_AGENT); }
__device__ __forceinline__ unsigned xb_add(unsigned* p, unsigned v) { return __hip_atomic_fetch_add(p, v, __ATOMIC_RELAXED, __HIP_MEMORY_SCOPE_AGENT); }
__device__ __forceinline__ unsigned xb_xcc_id() { return (unsigned)__builtin_amdgcn_s_getreg((3 << 11) | 20) & 0xFu; }
#define XB_SPIN(cond, bar) do { unsigned _sp = 0; while (cond) { __builtin_amdgcn_s_sleep(1); \
    if ((++_sp & 255u) == 0u) { if (xb_ld(&(bar)[XB_TMO])) break; if (_sp > XB_SPIN_CAP) { atomicAdd(&(bar)[XB_TMO], 1u); break; } } } } while (0)

struct XcdBarrier {
    unsigned* bar; unsigned x;
    volatile LAS unsigned* st;
};

__device__ __forceinline__ XcdBarrier xcd_barrier_post(unsigned* bar, volatile LAS unsigned* st) {
    XcdBarrier b; b.bar = bar; b.x = xb_xcc_id(); b.st = st;
    if (threadIdx.x == 0) (void)xb_add(&bar[XB_XCNT(b.x)], 1u);
    return b;
}
__device__ __forceinline__ void xcd_barrier_complete(unsigned* bar, unsigned x, unsigned& nloc, unsigned& nx) {
    const unsigned G = gridDim.x * gridDim.y * gridDim.z;
    unsigned sum, cnt, mine, sp = 0u;
    for (;;) {
        sum = 0u; cnt = 0u; mine = 0u;
#pragma unroll
        for (unsigned j = 0; j < 16; ++j) { const unsigned c = xb_ld(&bar[XB_XCNT(j)]); sum += c; cnt += (c > 0u) ? 1u : 0u; mine = (j == x) ? c : mine; }
        if (sum == G) break;
        __builtin_amdgcn_s_sleep(1);
        if ((++sp & 255u) == 0u) { if (xb_ld(&bar[XB_TMO])) break; if (sp > XB_SPIN_CAP) { atomicAdd(&bar[XB_TMO], 1u); break; } }
    }
    nloc = mine > 0u ? mine : 1u; nx = cnt > 0u ? cnt : 1u;
}

__device__ __forceinline__ void xcd_barrier(const XcdBarrier& b) {
    asm volatile("s_waitcnt vmcnt(0)" ::: "memory");
    __syncthreads();
    if (threadIdx.x == 0) {
        unsigned* bar = b.bar;
        __builtin_amdgcn_s_waitcnt(0);
        unsigned nloc = b.st[0], nx = b.st[1];
        if (nloc == 0u) { xcd_barrier_complete(bar, b.x, nloc, nx); b.st[0] = nloc; b.st[1] = nx; }
        const unsigned old = xb_add(&bar[XB_XSUB(b.x)], 1u);
        const unsigned gen = old / nloc;
        if (old + 1u == (gen + 1u) * nloc) {
            __builtin_amdgcn_fence(__ATOMIC_RELEASE, "agent");
            asm volatile("s_waitcnt vmcnt(0)" ::: "memory");
            const unsigned og = xb_add(&bar[XB_TOP], 1u);
            const unsigned tg = og / nx;
            if (og + 1u == (tg + 1u) * nx) xb_add(&bar[XB_TOPGEN], 1u);
            else XB_SPIN(xb_ld(&bar[XB_TOPGEN]) == tg, bar);
            __builtin_amdgcn_fence(__ATOMIC_ACQUIRE, "agent");
            xb_add(&bar[XB_XGEN(b.x)], 1u);
            asm volatile("s_waitcnt vmcnt(0)" ::: "memory");
        } else {
            XB_SPIN(xb_ld(&bar[XB_XGEN(b.x)]) == gen, bar);
            __builtin_amdgcn_fence(__ATOMIC_ACQUIRE, "agent");
            asm volatile("s_waitcnt vmcnt(0)" ::: "memory");
        }
    }
    __syncthreads();
}


constexpr size_t WS_XC = WS_H;
constexpr size_t WS_ALORA = WS_H + 32 * MiB;
constexpr size_t WS_LOGA = 256 * MiB;
constexpr size_t WS_OLOC = 320 * MiB;
constexpr size_t WS_QHAT = 352 * MiB;
constexpr size_t WS_GG = 384 * MiB;
constexpr size_t WS_SB = 12 * MiB;
constexpr size_t WS_LRUA = 13 * MiB;
constexpr size_t WS_LRUB = 14 * MiB;
constexpr size_t WS_LRUH = 15 * MiB;
constexpr size_t DO_LWA = 0;
constexpr size_t DO_PC = 64 * MiB;
constexpr size_t DO_QCT = 96 * MiB;
constexpr size_t DO_HIN = 0;

__device__ __forceinline__ float bflo(unsigned u) { return __uint_as_float(u << 16); }
__device__ __forceinline__ float bfhi(unsigned u) { return __uint_as_float(u & 0xffff0000u); }

__device__ __forceinline__ void phase_prepA(Frame& F) {
    const int gw = F.vcu * NWAVES + F.wave, NGW = F.G * NWAVES, lane = F.lane;
    const bf16* P = (const bf16*)(F.ws + WS_P);
    bf16* XC = (bf16*)(F.ws + WS_XC); bf16* AL = (bf16*)(F.ws + WS_ALORA);
    const float* conv_w = F.in[6]; const float* conv_b = F.in[7]; const float* mu = F.in[14];
    float cw[4][8], cb[8];
#pragma unroll
    for (int i = 0; i < 8; ++i) { cb[i] = conv_b[8 * lane + i];
#pragma unroll
        for (int j = 0; j < 4; ++j) cw[j][i] = conv_w[j * 512 + 8 * lane + i]; }
    float mu4[4];
#pragma unroll
    for (int i = 0; i < 4; ++i) mu4[i] = mu[(C_WD - 1024) + 4 * lane + i];
    for (int task = gw; task < NTOK / 16; task += NGW) {
        const int m0 = task * 16, t0 = m0 % T;
        float x1[8], x2[8], x3[8], pl[4];
#pragma unroll
        for (int i = 0; i < 8; ++i) { x1[i] = 0.f; x2[i] = 0.f; x3[i] = 0.f; }
#pragma unroll
        for (int i = 0; i < 4; ++i) pl[i] = 0.f;
        if (t0 > 0) {
            const v4u a = *(const v4u*)(P + (size_t)(m0 - 1) * PW + 8 * lane), b = *(const v4u*)(P + (size_t)(m0 - 2) * PW + 8 * lane), c = *(const v4u*)(P + (size_t)(m0 - 3) * PW + 8 * lane);
            x1[0] = bflo(a.x); x1[1] = bfhi(a.x); x1[2] = bflo(a.y); x1[3] = bfhi(a.y); x1[4] = bflo(a.z); x1[5] = bfhi(a.z); x1[6] = bflo(a.w); x1[7] = bfhi(a.w);
            x2[0] = bflo(b.x); x2[1] = bfhi(b.x); x2[2] = bflo(b.y); x2[3] = bfhi(b.y); x2[4] = bflo(b.z); x2[5] = bfhi(b.z); x2[6] = bflo(b.w); x2[7] = bfhi(b.w);
            x3[0] = bflo(c.x); x3[1] = bfhi(c.x); x3[2] = bflo(c.y); x3[3] = bfhi(c.y); x3[4] = bflo(c.z); x3[5] = bfhi(c.z); x3[6] = bflo(c.w); x3[7] = bfhi(c.w);
            const v2u q = *(const v2u*)(P + (size_t)(m0 - 1) * PW + C_WD + 4 * lane);
            pl[0] = bflo(q.x); pl[1] = bfhi(q.x); pl[2] = bflo(q.y); pl[3] = bfhi(q.y);
        }
#pragma unroll 4
        for (int tt = 0; tt < 16; ++tt) {
            const size_t m = (size_t)(m0 + tt);
            const v4u a = *(const v4u*)(P + m * PW + 8 * lane);
            float x0[8] = {bflo(a.x), bfhi(a.x), bflo(a.y), bfhi(a.y), bflo(a.z), bfhi(a.z), bflo(a.w), bfhi(a.w)};
            float xc[8];
#pragma unroll
            for (int i = 0; i < 8; ++i) { xc[i] = x3[i] * cw[0][i] + x2[i] * cw[1][i] + x1[i] * cw[2][i] + x0[i] * cw[3][i] + cb[i]; x3[i] = x2[i]; x2[i] = x1[i]; x1[i] = x0[i]; }
            v4u o; o.x = pk2(xc[0], xc[1]); o.y = pk2(xc[2], xc[3]); o.z = pk2(xc[4], xc[5]); o.w = pk2(xc[6], xc[7]);
            *(v4u*)(XC + m * 512 + 8 * lane) = o;
            const v2u q = *(const v2u*)(P + m * PW + C_WD + 4 * lane);
            const float cl[4] = {bflo(q.x), bfhi(q.x), bflo(q.y), bfhi(q.y)};
            float al[4];
#pragma unroll
            for (int i = 0; i < 4; ++i) { const float u = cl[i] + (pl[i] - cl[i]) * mu4[i]; pl[i] = cl[i];
                al[i] = (lane < 16) ? tanhf(u) : ((lane < 32) ? u : sigmoidf_(u)); }
            v2u o2; o2.x = pk2(al[0], al[1]); o2.y = pk2(al[2], al[3]);
            *(v2u*)(AL + m * 256 + 4 * lane) = o2;
        }
    }
}
__device__ __forceinline__ void p0_small_weights(Frame& F) {
    const int gt = F.vcu * NWAVES * 64 + F.tid, NT = F.G * NWAVES * 64;
    bf16* WG = (bf16*)(F.ws + FW_WGT); bf16* WL = (bf16*)(F.ws + FW_WLORAT);
    const float* wa = F.in[8]; const float* wi = F.in[10]; const float* w_up = F.in[16]; const float* a_up = F.in[18]; const float* g_up = F.in[19];
    for (int i = gt; i < 4 * 256 * 256; i += NT) { const int kk = i & 255, r = (i >> 8) & 255, pn = i >> 16;
        const int gate = r >> 7, ch = 128 * pn + (r & 127), hh = ch >> 6, j = ch & 63, kin = (pn >> 1) * 256 + kk;
        float v = 0.f; if ((kin >> 6) == hh) v = (gate ? wi : wa)[hh * 4096 + (kin & 63) * 64 + j];
        WG[i] = f2bf(v); }
    { float* WR = (float*)(F.ws + FW_WR); const float* w_grp = F.in[27]; const float* w_exp = F.in[29];
      for (int i = gt; i < 36 * 1024; i += NT) { const int k = i & 1023, e = i >> 10; WR[i] = e < 4 ? w_grp[k * 4 + e] : w_exp[k * 32 + (e - 4)]; } }
    for (int i = gt; i < 1536 * 256; i += NT) { const int kk = i & 255, n = i >> 8; float v = 0.f;
        if (n < 512) { if (kk < 64) v = w_up[kk * 512 + n]; }
        else if (n < 1024) { if (kk >= 64 && kk < 128) v = a_up[(kk - 64) * 512 + n - 512]; }
        else { if (kk >= 128) v = g_up[(kk - 128) * 512 + n - 1024]; }
        WL[i] = f2bf(v); }
}

namespace pg8 {
struct GateOrder : DenseOrder {
    __device__ __forceinline__ const char* a_base(const Gemm& g, const Unit& u) const { return (const char*)g.A + (size_t)u.pm * (BM * 2) * g.lda + (size_t)(u.pn >> 1) * 512; }
};
struct EpiLruGate {
    static constexpr bool PERM = true;
    unsigned char* ws;
    __device__ __forceinline__ void operator()(const f32x4 (&acc)[2][2][4][2], const Unit& u, int wr, int wc, int fr, int fq) const {
        bf16_t* G = (bf16_t*)(ws + WS_LOGA);
        const int row0 = u.pm * BM + wr * 64 + fr, col0 = u.pn * HALF + wc * 32 + 8 * fq;
#pragma unroll
        for (int ai = 0; ai < 2; ++ai)
#pragma unroll
            for (int m = 0; m < 4; ++m) { bf16_t* rowp = G + (size_t)(row0 + ai * HALF + m * 16) * 1024 + col0;
#pragma unroll
                for (int bj = 0; bj < 2; ++bj) { const f32x4 v0 = acc[ai][bj][m][0], v1 = acc[ai][bj][m][1];
                    u32x4 w; w.x = cvt_pk_bf16(v0[0], v0[1]); w.y = cvt_pk_bf16(v0[2], v0[3]); w.z = cvt_pk_bf16(v1[0], v1[1]); w.w = cvt_pk_bf16(v1[2], v1[3]);
                    *(u32x4*)(rowp + bj * 512) = w; } }
    }
};
struct EpiLoraStore {
    static constexpr bool PERM = true;
    unsigned char* out; unsigned char* ws;
    __device__ __forceinline__ void operator()(const f32x4 (&acc)[2][2][4][2], const Unit& u, int wr, int wc, int fr, int fq) const {
        const int row0 = u.pm * BM + wr * 64 + fr;
        bf16_t* LWA = (bf16_t*)(out + DO_LWA); bf16_t* GG = (bf16_t*)(ws + WS_GG);
        bf16_t* base = u.pn < 4 ? LWA : GG; const int ldc = u.pn < 4 ? 1024 : 512; const int col0 = (u.pn < 4 ? u.pn : u.pn - 4) * BM + wc * 32 + 8 * fq;
#pragma unroll
        for (int ai = 0; ai < 2; ++ai)
#pragma unroll
            for (int m = 0; m < 4; ++m) { bf16_t* rowp = base + (size_t)(row0 + ai * HALF + m * 16) * ldc + col0;
#pragma unroll
                for (int bj = 0; bj < 2; ++bj) { const f32x4 v0 = acc[ai][bj][m][0], v1 = acc[ai][bj][m][1];
                    u32x4 w; w.x = cvt_pk_bf16(v0[0], v0[1]); w.y = cvt_pk_bf16(v0[2], v0[3]); w.z = cvt_pk_bf16(v1[0], v1[1]); w.w = cvt_pk_bf16(v1[2], v1[3]);
                    *(u32x4*)(rowp + bj * HALF) = w; } }
    }
};
}
__device__ __forceinline__ void phase_gategemm(Frame& F) {
    {
        pg8::Gemm g{(const bf16*)(F.ws + WS_XC), (const bf16*)(F.ws + FW_WGT), 512, 256, 256};
        pg8::GateOrder S; S.init(NTOK, 1024, F.G, (int)blockIdx.x);
        pg8::EpiLruGate E{F.ws};
        pg8::gemm_phase<pg8::EpiLruGate, pg8::GateOrder>(F.lds + RING_OFF, g, S, E, F.tid);
    }
}
__device__ __forceinline__ void phase_loragemm(Frame& F) {
    {
        pg8::Gemm g{(const bf16*)(F.ws + WS_ALORA), (const bf16*)(F.ws + FW_WLORAT), 256, 256, 256};
        pg8::DenseOrder S; S.init(NTOK, 1536, F.G, (int)blockIdx.x);
        pg8::EpiLoraStore E{(unsigned char*)F.out, F.ws};
        pg8::gemm_phase<pg8::EpiLoraStore, pg8::DenseOrder>(F.lds + RING_OFF, g, S, E, F.tid);
    }
}

typedef float f32x2 __attribute__((ext_vector_type(2)));
__device__ __forceinline__ void rwkv_prepass_unit(Frame& F, int unit, LAS float* wl) {
    int lane = F.lane; asm volatile("" : "+v"(lane));
    const int c = unit & 127, bh = unit >> 7, h = bh & 7, b = bh >> 3, ch = h * 64 + lane;
    const size_t m0 = (size_t)b * T + (size_t)c * 64;
    const bf16* P = (const bf16*)(F.ws + WS_P); const bf16* LWA = (const bf16*)((const unsigned char*)F.out + DO_LWA);
    bf16* OLOC = (bf16*)(F.ws + WS_OLOC); bf16* QHAT = (bf16*)(F.ws + WS_QHAT); float* SB = (float*)(F.ws + WS_SB);
    const float* mu = F.in[14];
    const float mu_r = mu[ch], mu_k = mu[512 + ch], mu_v = mu[1024 + ch];
    const float w0v = F.in[15][ch], a0v = F.in[17][ch], kkv = F.in[20][ch], kav = F.in[21][ch], rkv = F.in[22][ch];
    f32x2 S[64];
#pragma unroll
    for (int k = 0; k < 64; ++k) { S[k].x = (k == lane) ? 1.f : 0.f; S[k].y = 0.f; }
    float pr = 0.f, pk = 0.f, pv = 0.f;
    if (c > 0) { const bf16* row = P + (m0 - 1) * PW; pr = bf2f(row[C_R + ch]); pk = bf2f(row[C_K + ch]); pv = bf2f(row[C_V + ch]); }
#pragma unroll 1
    for (int s8 = 0; s8 < 8; ++s8) {
#pragma unroll 2
        for (int tt = 0; tt < 8; ++tt) {
            const size_t m = m0 + s8 * 8 + tt; const bf16* row = P + m * PW;
            const float cr = bf2f(row[C_R + ch]), ck = bf2f(row[C_K + ch]), cv = bf2f(row[C_V + ch]);
            const float lw = bf2f(LWA[m * 1024 + ch]), la = bf2f(LWA[m * 1024 + 512 + ch]);
            const float r = cr + (pr - cr) * mu_r, kx = ck + (pk - ck) * mu_k, v = cv + (pv - cv) * mu_v;
            pr = cr; pk = ck; pv = cv;
            const float w = -__logf(1.f + __expf(-(w0v + lw))) - 0.5f;
            const float decay = __expf(-__expf(w));
            const float a = 1.f / (1.f + __expf(-(a0v + la)));
            float kk = kx * kkv;
            const float nrm = sqrtf(wave_sum(kk * kk));
            kk = kk / fmaxf(nrm, 1e-12f);
            const float km = kx * (1.f + (a - 1.f) * kav);
            const float sbv = wave_sum(r * km * rkv);
            if (lane == 0) SB[m * 8 + h] = sbv;
            LAS float* q = wl + tt * 384;
            q[lane] = -kk; q[64 + lane] = kk * a; q[128 + lane] = decay; q[192 + lane] = km; q[256 + lane] = r; q[320 + lane] = v;
        }
        LDS_WAIT(); asm volatile("" ::: "memory");
#pragma unroll 1
        for (int tt = 0; tt < 8; ++tt) {
            const LAS float* q = wl + tt * 384;
            const LAS f32x4* q4 = (const LAS f32x4*)q;
            f32x2 sa0 = {0.f, 0.f}, sa1 = {0.f, 0.f}, sa2 = {0.f, 0.f}, sa3 = {0.f, 0.f};
            f32x4 ca[4], na[4];
#pragma unroll
            for (int i = 0; i < 4; ++i) ca[i] = q4[i];
            f32x4 c0[4], c1[4];
#pragma unroll
            for (int g = 0; g < 4; ++g) {
                if (g < 3) {
#pragma unroll
                    for (int i = 0; i < 4; ++i) na[i] = q4[4 * (g + 1) + i];
                } else {
#pragma unroll
                    for (int i = 0; i < 4; ++i) { c0[i] = q4[16 * (i + 1)]; c1[i] = q4[16 * (i + 1) + 1]; }
                }
#pragma unroll
                for (int i = 0; i < 4; ++i) { const int kb = 4 * g + i; const f32x4 al = ca[i];
                    sa0 += S[4 * kb] * al.x; sa1 += S[4 * kb + 1] * al.y; sa2 += S[4 * kb + 2] * al.z; sa3 += S[4 * kb + 3] * al.w; }
                if (g < 3) {
#pragma unroll
                    for (int i = 0; i < 4; ++i) ca[i] = na[i];
                }
            }
            const f32x2 sa = (sa0 + sa1) + (sa2 + sa3);
            f32x2 vv; vv.x = 0.f; vv.y = q[320 + lane];
            f32x2 o0 = {0.f, 0.f}, o1 = {0.f, 0.f}, o2 = {0.f, 0.f}, o3 = {0.f, 0.f};
#pragma unroll
            for (int kb = 0; kb < 16; ++kb) {
                f32x4 n2[4];
                if (kb + 2 < 16) {
#pragma unroll
                    for (int i = 0; i < 4; ++i) n2[i] = q4[16 * (i + 1) + kb + 2];
                }
                const f32x4 be = c0[0], w = c0[1], km = c0[2], rr = c0[3];
                S[4 * kb] = S[4 * kb] * w.x + (sa * be.x + vv * km.x); o0 += S[4 * kb] * rr.x;
                S[4 * kb + 1] = S[4 * kb + 1] * w.y + (sa * be.y + vv * km.y); o1 += S[4 * kb + 1] * rr.y;
                S[4 * kb + 2] = S[4 * kb + 2] * w.z + (sa * be.z + vv * km.z); o2 += S[4 * kb + 2] * rr.z;
                S[4 * kb + 3] = S[4 * kb + 3] * w.w + (sa * be.w + vv * km.w); o3 += S[4 * kb + 3] * rr.w;
#pragma unroll
                for (int i = 0; i < 4; ++i) { c0[i] = c1[i]; if (kb + 2 < 16) c1[i] = n2[i]; }
            }
            const f32x2 o = (o0 + o1) + (o2 + o3);
            const size_t m = m0 + s8 * 8 + tt;
            QHAT[m * 512 + ch] = f2bf(o.x); OLOC[m * 512 + ch] = f2bf(o.y);
        }
        LDS_WAIT(); asm volatile("" ::: "memory");
    }
    int lane2 = lane; asm volatile("" : "+v"(lane2) :: "memory");
    bf16* PC = (bf16*)((unsigned char*)F.out + DO_PC) + (size_t)unit * 4096 + lane2; bf16* QCT = (bf16*)((unsigned char*)F.out + DO_QCT) + (size_t)unit * 4096 + lane2 * 64;
#pragma unroll
    for (int k = 0; k < 64; ++k) PC[k * 64] = f2bf(S[k].x);
#pragma unroll
    for (int k = 0; k < 64; k += 8) { v4u o; o.x = pk2(S[k].y, S[k + 1].y); o.y = pk2(S[k + 2].y, S[k + 3].y); o.z = pk2(S[k + 4].y, S[k + 5].y); o.w = pk2(S[k + 6].y, S[k + 7].y);
        *(v4u*)(QCT + k) = o; }
}
__device__ __forceinline__ void phase_lrulocal(Frame& F, bool dry = false) {
    const int gw = F.vcu * NWAVES + F.wave, NGW = F.G * NWAVES, lane = F.lane;
    {
        const bf16* GT = (const bf16*)(F.ws + WS_LOGA); bf16* GO = dry ? (bf16*)(F.ws + WS_OLOC) : (bf16*)(F.ws + WS_LOGA); const bf16* XC = (const bf16*)(F.ws + WS_XC);
        float* LA = (float*)(F.ws + WS_LRUA); float* LB = (float*)(F.ws + WS_LRUB);
        for (int task = gw; task < 4 * 128 * 8; task += NGW) { const int cg = task & 7, bc = task >> 3, ch = cg * 64 + lane;
            const float bav = F.in[9][ch], biv = F.in[11][ch], sp = -8.f * softplusf_(-F.in[12][ch]);
            const size_t m0 = (size_t)bc * 64; float sl = 0.f, hl = 0.f;
#pragma unroll 1
            for (int t8 = 0; t8 < 64; t8 += 8) {
                bf16 g0[8], g1[8], x8[8];
#pragma unroll
                for (int u = 0; u < 8; ++u) { const size_t m = m0 + t8 + u; g0[u] = GT[m * 1024 + ch]; g1[u] = GT[m * 1024 + 512 + ch]; x8[u] = XC[m * 512 + ch]; }
#pragma unroll
                for (int u = 0; u < 8; ++u) { const size_t m = m0 + t8 + u;
                    const float ra = bf2f(g0[u]) + bav, ia = bf2f(g1[u]) + biv, xc = bf2f(x8[u]);
                    const float r = sigmoidf_(ra), ig = sigmoidf_(ia);
                    const bf16 lab = f2bf(r * sp); const float la = bf2f(lab);
                    const bf16 bbb = f2bf(sqrtf(fmaxf(-expm1f(2.f * la), 0.f)) * (ig * xc)); const float bb = bf2f(bbb);
                    GO[m * 1024 + ch] = lab; GO[m * 1024 + 512 + ch] = bbb;
                    sl += la; hl = __expf(la) * hl + bb; }
            }
            LA[bc * 512 + ch] = sl; LB[bc * 512 + ch] = hl; }
    }
}
__device__ __forceinline__ void phase_rwkvlocal(Frame& F) {
    const int gw = F.vcu * NWAVES + F.wave, NGW = F.G * NWAVES;
    {
        LAS float* wl = (LAS float*)(F.lds + RING_OFF + F.wave * 12288);
        for (int unit = gw; unit < 4096; unit += NGW) rwkv_prepass_unit(F, unit, wl);
    }
}

typedef short bf16x8_t __attribute__((ext_vector_type(8)));
template <int V> __device__ __forceinline__ void rwkv_scan(Frame& F, int bh) {
    constexpr int LDT = 72;
    constexpr int SBUF = 64 * LDT;
    LAS bf16* S0 = (LAS bf16*)(F.lds + RING_OFF);
    const int lane = F.lane, w = F.wave, q = lane >> 4, l15 = lane & 15;
    for (int i = F.tid; i < 2 * SBUF; i += 512) S0[i] = 0;
    __syncthreads();
    if (w < 4) {
        const int tr = w;
        const bf16* PC = (const bf16*)((const unsigned char*)F.out + DO_PC) + (size_t)bh * 128 * 4096 + (16 * tr + l15) * 64 + 8 * q;
        const bf16* QCT = (const bf16*)((const unsigned char*)F.out + DO_QCT) + (size_t)bh * 128 * 4096 + l15 * 64 + 16 * tr + 4 * q;
        const int boff0 = l15 * LDT + 8 * q, woff0 = l15 * LDT + 16 * tr + 4 * q;
        bf16x8_t A[8][2]; v2u Qv[8][4];
#define SCAN_LOAD(s, cc) do { \
        asm volatile("global_load_dwordx4 %0, %1, off" : "=v"(A[s][0]) : "v"(PC + (size_t)(cc) * 4096) : "memory"); \
        asm volatile("global_load_dwordx4 %0, %1, off offset:64" : "=v"(A[s][1]) : "v"(PC + (size_t)(cc) * 4096) : "memory"); \
        asm volatile("global_load_dwordx2 %0, %1, off" : "=v"(Qv[s][0]) : "v"(QCT + (size_t)(cc) * 4096) : "memory"); \
        asm volatile("global_load_dwordx2 %0, %1, off offset:2048" : "=v"(Qv[s][1]) : "v"(QCT + (size_t)(cc) * 4096) : "memory"); \
        asm volatile("global_load_dwordx2 %0, %1, off" : "=v"(Qv[s][2]) : "v"(QCT + (size_t)(cc) * 4096 + 2048) : "memory"); \
        asm volatile("global_load_dwordx2 %0, %1, off offset:2048" : "=v"(Qv[s][3]) : "v"(QCT + (size_t)(cc) * 4096 + 2048) : "memory"); } while (0)
#pragma unroll
        for (int s = 0; s < 8; ++s) SCAN_LOAD(s, s);
        if (V == 0) TSTAMP(F, 22); else TSTAMP(F, 26);
#pragma unroll 1
        for (int c0 = 0; c0 < 128; c0 += 8) {
#pragma unroll
            for (int s = 0; s < 8; ++s) {
                const int c = c0 + s;
                const LAS bf16* Sr = S0 + (s & 1) * SBUF; LAS bf16* Sw = S0 + ((s & 1) ^ 1) * SBUF;
                if (V != 3) asm volatile("s_waitcnt vmcnt(42)" : "+v"(A[s][0]), "+v"(A[s][1]), "+v"(Qv[s][0]), "+v"(Qv[s][1]), "+v"(Qv[s][2]), "+v"(Qv[s][3]) :: "memory");
                pg8::f32x4 acc[4];
#pragma unroll
                for (int t = 0; t < 4; ++t) { acc[t][0] = bflo(Qv[s][t].x); acc[t][1] = bfhi(Qv[s][t].x); acc[t][2] = bflo(Qv[s][t].y); acc[t][3] = bfhi(Qv[s][t].y); }
#pragma unroll
                for (int ks = 0; ks < 2; ++ks)
#pragma unroll
                    for (int t = 0; t < 4; ++t) {
                        if (V != 4) { const bf16x8_t bh_ = *(const LAS bf16x8_t*)(Sr + boff0 + 16 * LDT * t + 32 * ks);
                        acc[t] = __builtin_amdgcn_mfma_f32_16x16x32_bf16(A[s][ks], bh_, acc[t], 0, 0, 0); }
                    }
                if (V != 3) { const int cn = (c + 8 < 128) ? c + 8 : 127; SCAN_LOAD(s, cn); }
#pragma unroll
                for (int t = 0; t < 4; ++t) { v2u oh; oh.x = pg8::cvt_pk_bf16(acc[t][0], acc[t][1]); oh.y = pg8::cvt_pk_bf16(acc[t][2], acc[t][3]);
                    *(LAS v2u*)(Sw + woff0 + 16 * LDT * t) = oh; }
                asm volatile("s_waitcnt lgkmcnt(0)" ::: "memory"); __builtin_amdgcn_s_barrier(); asm volatile("" ::: "memory");
            }
        }
#undef SCAN_LOAD
        if (V == 0) TSTAMP(F, 23); else TSTAMP(F, 27);
        asm volatile("s_waitcnt vmcnt(0)" ::: "memory");
    } else {
        const int t256 = F.tid - 256;
        bf16* HIN = (V == 0 ? (bf16*)((unsigned char*)F.out + DO_HIN) : (bf16*)(F.ws + WS_XC)) + (size_t)bh * 128 * 4096 + (t256 >> 2) * 64 + (t256 & 3) * 16;
        const int hoff = (t256 >> 2) * LDT + (t256 & 3) * 16;
#pragma unroll 1
        for (int c = 0; c < 128; ++c) {
            const LAS bf16* Sr = S0 + (c & 1) * SBUF;
            const v4u x0 = *(const LAS v4u*)(Sr + hoff), x1 = *(const LAS v4u*)(Sr + hoff + 8);
            if (V != 2) { *(v4u*)(HIN + (size_t)c * 4096) = x0; *(v4u*)(HIN + (size_t)c * 4096 + 8) = x1; }
            asm volatile("s_waitcnt lgkmcnt(0)" ::: "memory"); __builtin_amdgcn_s_barrier(); asm volatile("" ::: "memory");
        }
    }
}
__device__ __forceinline__ void phase_scan(Frame& F, int flags) {
    if ((flags & 4) && blockIdx.x >= 36) { TSTAMP_B(F, 36, 24); expert_transposes(F, ((int)blockIdx.x - 36) * NWAVES + F.wave, ((int)F.G - 36) * NWAVES); __syncthreads(); TSTAMP_B(F, 36, 25); }
#ifndef SCAN_VARIANT
#define SCAN_VARIANT 0
#endif
    if ((flags & 2) && blockIdx.x < 32) { rwkv_scan<0>(F, blockIdx.x); if (SCAN_VARIANT) { __syncthreads(); rwkv_scan<SCAN_VARIANT>(F, blockIdx.x); } }
    if ((flags & 1) && blockIdx.x >= 32 && blockIdx.x < 36) {
        const int idx = (blockIdx.x - 32) * 512 + F.tid, b = idx >> 9, ch = idx & 511;
        const float* LA = (const float*)(F.ws + WS_LRUA); const float* LB = (const float*)(F.ws + WS_LRUB); float* LH = (float*)(F.ws + WS_LRUH);
        float h = 0.f;
#pragma unroll 1
        for (int c16 = 0; c16 < 128; c16 += 16) { float a16[16], b16[16];
#pragma unroll
            for (int u = 0; u < 16; ++u) { const int o = (b * 128 + c16 + u) * 512 + ch; a16[u] = LA[o]; b16[u] = LB[o]; }
#pragma unroll
            for (int u = 0; u < 16; ++u) { const int o = (b * 128 + c16 + u) * 512 + ch; LH[o] = h; h = __expf(a16[u]) * h + b16[u]; } }
    }
}

__device__ __forceinline__ void rwkv_post_unit(Frame& F, int unit) {
    int lane = F.lane; asm volatile("" : "+v"(lane));
    const int c = unit & 127, bh = unit >> 7, h = bh & 7, b = bh >> 3, q = lane >> 4, l15 = lane & 15;
    const size_t m0 = (size_t)b * T + (size_t)c * 64;
    const bf16* QHAT = (const bf16*)(F.ws + WS_QHAT); const bf16* OLOC = (const bf16*)(F.ws + WS_OLOC); const bf16* GG = (const bf16*)(F.ws + WS_GG);
    const bf16* HIN = (const bf16*)((const unsigned char*)F.out + DO_HIN) + (size_t)unit * 4096; const bf16* P = (const bf16*)(F.ws + WS_P);
    const float* SB = (const float*)(F.ws + WS_SB); bf16* YMIX = (bf16*)(F.ws + WS_YMIX);
    bf16x8_t Af[4][2];
#pragma unroll
    for (int jt = 0; jt < 4; ++jt)
#pragma unroll
        for (int ks = 0; ks < 2; ++ks) Af[jt][ks] = *(const bf16x8_t*)(HIN + (16 * jt + l15) * 64 + 32 * ks + 8 * q);
    f32x4 lnw[4], lnb[4], muv[4];
#pragma unroll
    for (int jt = 0; jt < 4; ++jt) { const int ch = h * 64 + 16 * jt + 4 * q; lnw[jt] = *(const f32x4*)(F.in[23] + ch); lnb[jt] = *(const f32x4*)(F.in[24] + ch); muv[jt] = *(const f32x4*)(F.in[14] + 1024 + ch); }
#pragma unroll 1
    for (int tt = 0; tt < 4; ++tt) {
        const size_t m = m0 + 16 * tt + l15;
        bf16x8_t Bf[2];
#pragma unroll
        for (int ks = 0; ks < 2; ++ks) Bf[ks] = *(const bf16x8_t*)(QHAT + m * 512 + h * 64 + 32 * ks + 8 * q);
        pg8::f32x4 acc[4];
#pragma unroll
        for (int jt = 0; jt < 4; ++jt) { const v2u o = *(const v2u*)(OLOC + m * 512 + h * 64 + 16 * jt + 4 * q); acc[jt][0] = bflo(o.x); acc[jt][1] = bfhi(o.x); acc[jt][2] = bflo(o.y); acc[jt][3] = bfhi(o.y); }
#pragma unroll
        for (int ks = 0; ks < 2; ++ks)
#pragma unroll
            for (int jt = 0; jt < 4; ++jt) acc[jt] = __builtin_amdgcn_mfma_f32_16x16x32_bf16(Af[jt][ks], Bf[ks], acc[jt], 0, 0, 0);
        float s = 0.f;
#pragma unroll
        for (int jt = 0; jt < 4; ++jt) s += (acc[jt][0] + acc[jt][1]) + (acc[jt][2] + acc[jt][3]);
        s += __shfl_xor(s, 16); s += __shfl_xor(s, 32);
        const float mean = s * (1.f / 64.f);
        float vs = 0.f;
#pragma unroll
        for (int jt = 0; jt < 4; ++jt)
#pragma unroll
            for (int i = 0; i < 4; ++i) { acc[jt][i] -= mean; vs += acc[jt][i] * acc[jt][i]; }
        vs += __shfl_xor(vs, 16); vs += __shfl_xor(vs, 32);
        const float rstd = rsqrtf(vs * (1.f / 64.f) + 64e-5f);
        const float sbv = SB[m * 8 + h];
        const bool first = ((m % T) == 0);
#pragma unroll
        for (int jt = 0; jt < 4; ++jt) { const int ch = h * 64 + 16 * jt + 4 * q;
            const v2u cvq = *(const v2u*)(P + m * PW + C_V + ch); v2u pvq = {0u, 0u}; if (!first) pvq = *(const v2u*)(P + (m - 1) * PW + C_V + ch);
            const v2u gq = *(const v2u*)(GG + m * 512 + ch);
            const float cv[4] = {bflo(cvq.x), bfhi(cvq.x), bflo(cvq.y), bfhi(cvq.y)}, pv[4] = {bflo(pvq.x), bfhi(pvq.x), bflo(pvq.y), bfhi(pvq.y)}, gg[4] = {bflo(gq.x), bfhi(gq.x), bflo(gq.y), bfhi(gq.y)};
            float y[4];
#pragma unroll
            for (int i = 0; i < 4; ++i) { const float v = cv[i] + (pv[i] - cv[i]) * muv[jt][i]; y[i] = (acc[jt][i] * rstd * lnw[jt][i] + lnb[jt][i] + sbv * v) * gg[i]; }
            v2u o; o.x = pk2(y[0], y[1]); o.y = pk2(y[2], y[3]);
            *(v2u*)(YMIX + m * D + 512 + ch) = o; }
    }
}
__device__ __forceinline__ void phase_post(Frame& F, int flags) {
    const int gw = F.vcu * NWAVES + F.wave, NGW = F.G * NWAVES, lane = F.lane;
    if (flags & 2) for (int unit = gw; unit < 4096; unit += NGW) rwkv_post_unit(F, unit);
    if (flags & 1) {
        const bf16* GT = (const bf16*)(F.ws + WS_LOGA); const bf16* P = (const bf16*)(F.ws + WS_P);
        const float* LH = (const float*)(F.ws + WS_LRUH); bf16* YMIX = (bf16*)(F.ws + WS_YMIX); const float* ng = F.in[13];
        for (int task = gw; task < 4 * 128 * 8; task += NGW) { const int cg = task & 7, bc = task >> 3, ch = cg * 64 + lane;
            const size_t m0 = (size_t)bc * 64; float hl = LH[bc * 512 + ch]; const float g = ng[ch];
#pragma unroll 1
            for (int t8 = 0; t8 < 64; t8 += 8) {
                bf16 g0[8], g1[8], p8[8];
#pragma unroll
                for (int u = 0; u < 8; ++u) { const size_t m = m0 + t8 + u; g0[u] = GT[m * 1024 + ch]; g1[u] = GT[m * 1024 + 512 + ch]; p8[u] = P[m * PW + C_GATE + ch]; }
#pragma unroll
                for (int u = 0; u < 8; ++u) { const size_t m = m0 + t8 + u;
                    const float la = bf2f(g0[u]), bb = bf2f(g1[u]); hl = __expf(la) * hl + bb;
                    float y = hl * gelu_tanh(bf2f(p8[u]));
                    const float ss = wave_sum(y * y) * (1.f / 64.f);
                    YMIX[m * D + ch] = f2bf(y * rsqrtf(ss + 1e-6f) * g); }
            }
        }
    }
}

struct Args { const float* in[35]; float* out; unsigned char* ws; int ph_lo, ph_hi, flags, pad; };
__global__ void __launch_bounds__(NWAVES * 64, 2) mk_fwd(Args args) {
    extern __shared__ __attribute__((aligned(16))) unsigned char lds[];
    Frame F;
    F.lds = (LAS unsigned char*)lds;
    F.tid = threadIdx.x; F.lane = F.tid & 63; F.wave = __builtin_amdgcn_readfirstlane(F.tid >> 6);
    F.G = gridDim.x; { const int bx = blockIdx.x; F.vcu = (F.G % 8 == 0) ? (bx % 8) * (F.G / 8) + bx / 8 : bx; }
    F.in = args.in; F.out = args.out; F.ws = args.ws;
    const int lo = args.ph_lo, hi = args.ph_hi;
#define IN(k) (lo <= (k) && (k) < hi)
    const int flags = args.flags;
    for (int u = threadIdx.x; u < (LDS_BYTES - LDSCTL_OFF) / 4; u += NWAVES * 64) ((LAS unsigned*)(F.lds + LDSCTL_OFF))[u] = 0u;
    __syncthreads();
    XcdBarrier bar; bar.bar = (unsigned*)(args.ws + WS_CTL) + CW_BAR; bar.x = 0; bar.st = nullptr;
    if (hi - lo > 1) bar = xcd_barrier_post((unsigned*)(args.ws + WS_CTL) + CW_BAR, (volatile LAS unsigned*)(F.lds + MISC_OFF) + 8);
#define SEAM(k) if (IN(k) && IN((k) + 1)) { xcd_barrier(bar); TSTAMP(F, (k) + 1); }
#ifndef DUP_MASK
#define DUP_MASK 0
#endif
#define PH1(k, call) { int t_ = threadIdx.x; asm volatile("" : "+v"(t_)); F.tid = t_; F.lane = t_ & 63; F.wave = __builtin_amdgcn_readfirstlane(t_ >> 6); call; }
#define PH(k, bit, call) if (IN(k)) { PH1(k, call) if ((DUP_MASK >> (bit)) & 1) { xcd_barrier(bar); PH1(k, call) } }
    TSTAMP(F, 0);
    PH(0, 0, (phase0(F), p0_small_weights(F)))
    SEAM(0)
    PH(1, 1, phase1(F))
    SEAM(1)
    PH(2, 2, phase2(F))
    SEAM(2)
    PH(3, 3, phase_prepA(F))
    SEAM(3)
    PH(4, 4, phase_gategemm(F))
    PH(4, 5, phase_loragemm(F))
    SEAM(4)
    if ((DUP_MASK >> 6) & 1) { if (IN(5)) { PH1(5, phase_lrulocal(F, true)) xcd_barrier(bar); } }
    PH(5, 30, phase_lrulocal(F))
    PH(5, 7, phase_rwkvlocal(F))
    SEAM(5)
    if ((DUP_MASK >> 8) & 1) { if (IN(6)) { PH1(6, phase_scan(F, 6)) xcd_barrier(bar); } }
    PH(6, 30, phase_scan(F, flags | 4))
    SEAM(6)
    PH(7, 9, phase_post(F, flags))
    SEAM(7)
    PH(8, 10, phase_outproj(F))
    SEAM(8)
    if ((DUP_MASK >> 11) & 1) { if (IN(9)) { PH1(9, phase_route(F)) xcd_barrier(bar); if (blockIdx.x == 0 && threadIdx.x < 32) ((int*)(args.ws + WS_CNT))[threadIdx.x * 64] = 0; xcd_barrier(bar); } }
    PH(9, 30, phase_route(F))
    SEAM(9)
    PH(10, 12, phase_m1(F))
    SEAM(10)
    PH(11, 13, phase_m2(F))
    SEAM(11)
    if ((DUP_MASK >> 14) & 1) { if (IN(12)) { PH1(12, phase_final(F, true)) xcd_barrier(bar); } }
    PH(12, 30, phase_final(F))
#undef SEAM
#undef PH
#undef PH1
#undef IN
}

extern "C" void kernel_launch(void* const* d_in, const int* in_sizes, int n_in, void* d_out, int out_size, void* d_ws, size_t ws_size, hipStream_t stream) {
    if (n_in != 35 || out_size != NTOK * D || ws_size < WS_END) { fprintf(stderr, "kernel_launch: unexpected shapes (n_in %d out %d ws %zu)\n", n_in, out_size, ws_size); return; }
    static int grid = 0;
    if (grid == 0) {
        int dev = 0, cus = 0;
        if (hipGetDevice(&dev) != hipSuccess || hipDeviceGetAttribute(&cus, hipDeviceAttributeMultiprocessorCount, dev) != hipSuccess) { grid = -1; return; }
        if (hipFuncSetAttribute((const void*)mk_fwd, hipFuncAttributeMaxDynamicSharedMemorySize, LDS_BYTES) != hipSuccess) { fprintf(stderr, "kernel_launch: hipFuncSetAttribute failed\n"); grid = -1; return; }
        int per_cu = 0;
        if (hipOccupancyMaxActiveBlocksPerMultiprocessor(&per_cu, (const void*)mk_fwd, NWAVES * 64, LDS_BYTES) != hipSuccess || per_cu < 1) { fprintf(stderr, "kernel_launch: occupancy query says %d blocks per CU\n", per_cu); (void)hipGetLastError(); }
        grid = cus;
    }
    if (grid < 0) return;
    const float* const* in = (const float* const*)d_in;
    char* ws = (char*)d_ws; float* out = (float*)d_out;
    Args a{};
    for (int i = 0; i < 35; ++i) a.in[i] = in[i];
    a.out = out; a.ws = (unsigned char*)d_ws;
    hipMemsetAsync(ws + WS_CTL, 0, 1 * MiB, stream);
#define LAUNCH_PH(p) do { a.ph_lo = (p); a.ph_hi = (p) + 1; hipLaunchKernelGGL(mk_fwd, dim3(grid), dim3(NWAVES * 64), LDS_BYTES, stream, a); } while (0)
#ifndef MIX_FLAGS
#define MIX_FLAGS 3
#endif
    a.flags = MIX_FLAGS;
#ifndef N_LAUNCHES
#define N_LAUNCHES 1
#endif
    if (N_LAUNCHES == 1) { a.ph_lo = 0; a.ph_hi = 13; hipLaunchKernelGGL(mk_fwd, dim3(grid), dim3(NWAVES * 64), LDS_BYTES, stream, a); }
    else { for (int p = 0; p < 13; ++p) LAUNCH_PH(p); }
}
```

```cpp
#include <hip/hip_runtime.h>
#include <stdint.h>
#include <cstdio>

#define SCAN_NOLO 1
#ifndef TIMER_A
#define TIMER_A -1
#define TIMER_B -1
#endif
#define TSTAMP(F_, i) do { if (TIMER_A >= 0 && blockIdx.x == 0 && threadIdx.x == 0) ((unsigned long long*)((F_).ws + 8192))[i] = __builtin_amdgcn_s_memrealtime(); } while (0)
#define TSTAMP_B(F_, blk, i) do { if (TIMER_A >= 0 && blockIdx.x == (blk) && threadIdx.x == 0) ((unsigned long long*)((F_).ws + 8192))[i] = __builtin_amdgcn_s_memrealtime(); } while (0)
#define TACCUM(F_, i, t0) do { if (TIMER_A >= 0 && blockIdx.x == 0 && threadIdx.x == 0) ((unsigned long long*)((F_).ws + 8192))[i] += __builtin_amdgcn_s_memrealtime() - (t0); } while (0)
typedef unsigned short bf16;
__device__ __forceinline__ bf16 f2bf(float f) { unsigned u = __float_as_uint(f); return (bf16)((u + 0x7fffu + ((u >> 16) & 1u)) >> 16); }
__device__ __forceinline__ float bf2f(bf16 b) { return __uint_as_float(((unsigned)b) << 16); }

constexpr int NB = 4, T = 8192, D = 1024, NTOK = NB * T;
constexpr int LRU_W = 512, RW = 512, PW = 2816;
constexpr int C_UX = 0, C_GATE = 512, C_R = 1024, C_K = 1536, C_V = 2048, C_WD = 2560, C_AD = 2624, C_GD = 2688;
constexpr int NE = 32, DE = 512;
constexpr size_t MiB = 1u << 20;
constexpr size_t WS_CTL = 0;
constexpr int CW_BAR = 4096;
constexpr size_t WS_CNT = 512 * 1024;
constexpr size_t WS_MOD = 1 * MiB;
constexpr size_t WS_SELW = 1 * MiB + 256 * 1024;
constexpr size_t WS_SEL = 1 * MiB + 512 * 1024;
constexpr size_t FW_WLORAT = 2 * MiB;
constexpr size_t FW_WGT = 3 * MiB;
constexpr size_t FW_WR = 3 * MiB + 512 * 1024;
constexpr size_t FW_WINT = 4 * MiB;
constexpr size_t FW_WOUTT = 10 * MiB;
constexpr size_t WS_LIST = 12 * MiB;
constexpr size_t WS_H = 16 * MiB;
constexpr size_t WS_YMIX = WS_H;
constexpr size_t WS_P = 80 * MiB;
constexpr size_t WS_HID = WS_P;
constexpr size_t WS_YS = 256 * MiB;
constexpr size_t FW_W13T = 416 * MiB;
constexpr size_t FW_W2T = 480 * MiB;
constexpr size_t WS_END = 512 * MiB;

__device__ __forceinline__ float wave_sum(float v) {
    v += __int_as_float(__builtin_amdgcn_update_dpp(0, __float_as_int(v), 0xB1, 0xF, 0xF, true));
    v += __int_as_float(__builtin_amdgcn_update_dpp(0, __float_as_int(v), 0x4E, 0xF, 0xF, true));
    v += __int_as_float(__builtin_amdgcn_update_dpp(0, __float_as_int(v), 0x141, 0xF, 0xF, true));
    v += __int_as_float(__builtin_amdgcn_update_dpp(0, __float_as_int(v), 0x140, 0xF, 0xF, true));
    const int vi = __float_as_int(v);
    const float r0 = __int_as_float(__builtin_amdgcn_readlane(vi, 0)), r1 = __int_as_float(__builtin_amdgcn_readlane(vi, 16));
    const float r2 = __int_as_float(__builtin_amdgcn_readlane(vi, 32)), r3 = __int_as_float(__builtin_amdgcn_readlane(vi, 48));
    return (r0 + r1) + (r2 + r3);
}
__device__ __forceinline__ float sigmoidf_(float x) { return 1.f / (1.f + __expf(-x)); }
__device__ __forceinline__ float softplusf_(float x) { return x > 20.f ? x : log1pf(__expf(x)); }
__device__ __forceinline__ float gelu_tanh(float x) { const float u = 0.7978845608028654f * (x + 0.044715f * x * x * x); return 0.5f * x * (1.f + tanhf(u)); }

namespace pg8 {
#define PG8_LAS __attribute__((address_space(3)))
typedef unsigned short bf16_t;
typedef short bf16x8 __attribute__((ext_vector_type(8)));
typedef float f32x4 __attribute__((ext_vector_type(4)));
typedef unsigned u32x4 __attribute__((ext_vector_type(4)));
constexpr int BM = 256, BK = 64, HALF = 128, HTB = HALF * BK * 2  , STAGE_BYTES = 8 * HTB, NXCD = 8, WGM = 8;

__host__ __device__ __forceinline__ int lds_byte(int r, int c) { const int st = (r >> 4) * 2 + (c >> 5), rr = r & 15, cc = c & 31, ob = rr * 64 + cc * 2; return st * 1024 + (ob ^ (((ob >> 9) & 1) << 5)); }
__host__ __device__ __forceinline__ void stage_rc(int b, int& R, int& C) { const int st = b / 1024, sb = b % 1024, swz = sb ^ (((sb >> 9) & 1) << 5); R = (st >> 1) * 16 + swz / 64; C = (st & 1) * 32 + (swz % 64) / 2; }
__host__ __device__ __forceinline__ int perm32(int rho) { const int n = rho >> 4, i = rho & 15; return 8 * (i >> 2) + 4 * n + (i & 3); }

struct Unit { int pm, pn, e, nrows, row0; };
struct Gemm { const bf16_t* A; const bf16_t* Bt; int lda, ldb, K; };

__device__ __forceinline__ unsigned cvt_pk_bf16(float lo, float hi) { unsigned r; asm volatile("v_cvt_pk_bf16_f32 %0, %1, %2" : "=v"(r) : "v"(lo), "v"(hi)); return r; }

struct DenseOrder {
    static constexpr bool GATHER = false;
    int nM, nN, nwg, G, c;
    __device__ void init(int M, int N, int G_, int c_) { nM = M / BM; nN = N / BM; nwg = nM * nN; G = G_; c = c_; }
    __device__ bool next(int i, Unit& u) const {
        const long L = (long)i * G + c; if (L >= nwg) return false;
        int wgid = (int)L; { const int q = nwg / NXCD, r = nwg % NXCD, xcd = wgid % NXCD, off = wgid / NXCD; wgid = (xcd < r ? xcd * (q + 1) : r * (q + 1) + (xcd - r) * q) + off; }
        const int nig = WGM * nN, gid = wgid / nig, fm = gid * WGM, gsz = (nM - fm) < WGM ? (nM - fm) : WGM;
        u.pm = fm + ((wgid % nig) % gsz); u.pn = (wgid % nig) / gsz; u.e = 0; u.nrows = 256; u.row0 = 0; return true;
    }
    __device__ __forceinline__ const char* a_base(const Gemm& g, const Unit& u) const { return (const char*)g.A + (size_t)u.pm * (BM * 2) * g.lda; }
    __device__ __forceinline__ const char* b_base(const Gemm& g, const Unit& u) const { return (const char*)g.Bt + (size_t)u.pn * (BM * 2) * g.ldb; }
    __device__ __forceinline__ int row(const Unit&, int) const { return 0; }
};

template <class Epi, class Sched>
__device__ __forceinline__ void gemm_phase(PG8_LAS unsigned char* lds, const Gemm g, const Sched& S, const Epi& E, const int tid) {
    const int wid = __builtin_amdgcn_readfirstlane(tid >> 6), lane = tid & 63, wr = wid >> 2, wc = wid & 3, fr = lane & 15, fq = lane >> 4;
    const int K = g.K, nt = K / BK;
    unsigned voffA[2], voffB[2]; int sR[2], sC[2];
#pragma unroll
    for (int i = 0; i < 2; ++i) { int R, C; stage_rc(tid * 16 + i * 8192, R, C); const int Rb = Epi::PERM ? ((R & ~31) + perm32(R & 31)) : R;
        voffA[i] = (unsigned)(R * g.lda + C) * 2u; voffB[i] = (unsigned)(Rb * g.ldb + C) * 2u; sR[i] = R; sC[i] = C; }
    const size_t kstep = (size_t)(BK * 2);
    const size_t hstepA = Sched::GATHER ? 0 : (size_t)HALF * g.lda * 2, hstepB = (size_t)HALF * g.ldb * 2;
    const unsigned ldsw = (unsigned)wid * 1024u;
    const int aoff = lds_byte(wr * 64 + fr, fq * 8), boff = lds_byte(wc * 32 + fr, fq * 8);
    unsigned gA[2][2], gN[2][2];
#define PG8_SA(b, h) (((b) * 2 + (h)) * HTB)
#define PG8_SB(b, h) ((4 + (b) * 2 + (h)) * HTB)
#define PG8_STAGE(bufoff, gbase, voff) do { _Pragma("unroll") for (int _i = 0; _i < 2; ++_i) \
        __builtin_amdgcn_global_load_lds((const unsigned*)((const char*)(gbase) + (voff)[_i]), (PG8_LAS unsigned*)(lds + (bufoff) + ldsw + _i * 8192), 16, 0, 0); } while (0)
#define PG8_STAGE_A(bufoff, kp, h, OFF) do { if constexpr (Sched::GATHER) PG8_STAGE(bufoff, kp, OFF[h]); else PG8_STAGE(bufoff, (kp) + (h) * hstepA, voffA); } while (0)
#define PG8_LDA(dst, b, h) do { _Pragma("unroll") for (int m = 0; m < 4; ++m) _Pragma("unroll") for (int k = 0; k < 2; ++k) dst[m][k] = *(const PG8_LAS bf16x8*)(lds + PG8_SA(b, h) + aoff + m * 2048 + k * 1024); } while (0)
#define PG8_LDB(dst, b, h) do { _Pragma("unroll") for (int n = 0; n < 2; ++n) _Pragma("unroll") for (int k = 0; k < 2; ++k) dst[n][k] = *(const PG8_LAS bf16x8*)(lds + PG8_SB(b, h) + boff + n * 2048 + k * 1024); } while (0)
#define PG8_MMA(ai, bj, At, Bt) do { __builtin_amdgcn_s_setprio(1); _Pragma("unroll") for (int m = 0; m < 4; ++m) _Pragma("unroll") for (int n = 0; n < 2; ++n) _Pragma("unroll") for (int k = 0; k < 2; ++k) \
        acc[ai][bj][m][n] = __builtin_amdgcn_mfma_f32_16x16x32_bf16(Bt[n][k], At[m][k], acc[ai][bj][m][n], 0, 0, 0); __builtin_amdgcn_s_setprio(0); } while (0)
#define PG8_WAIT_V(n) asm volatile("s_waitcnt vmcnt(" #n ")" ::: "memory")
#define PG8_WAIT_L(n) asm volatile("s_waitcnt lgkmcnt(" #n ")" ::: "memory")
#define PG8_BAR __builtin_amdgcn_s_barrier()
#define PG8_SCHED __builtin_amdgcn_sched_barrier(0)
    Unit cur, nxt; int ui = 0;
    if (!S.next(0, cur)) return;
    f32x4 acc[2][2][4][2];
#pragma unroll
    for (int a = 0; a < 2; ++a)
#pragma unroll
        for (int b = 0; b < 2; ++b)
#pragma unroll
            for (int m = 0; m < 4; ++m)
#pragma unroll
                for (int n = 0; n < 2; ++n) acc[a][b][m][n] = (f32x4){0.f, 0.f, 0.f, 0.f};
    bf16x8 At[4][2], B0[2][2], B1[2][2];
    const char* cA = S.a_base(g, cur); const char* cB = S.b_base(g, cur);
    if constexpr (Sched::GATHER) {
#pragma unroll
        for (int h = 0; h < 2; ++h)
#pragma unroll
            for (int i = 0; i < 2; ++i) gA[h][i] = (unsigned)(S.row(cur, h * HALF + sR[i]) * g.lda + sC[i]) * 2u;
    }
    PG8_STAGE(PG8_SB(0, 0), cB, voffB); PG8_STAGE(PG8_SB(0, 1), cB + hstepB, voffB); PG8_STAGE_A(PG8_SA(0, 0), cA, 0, gA); PG8_STAGE_A(PG8_SA(0, 1), cA, 1, gA);
    if (wr == 1) PG8_BAR;
    PG8_WAIT_V(2); PG8_BAR;
    PG8_STAGE(PG8_SB(1, 0), cB + kstep, voffB); PG8_STAGE_A(PG8_SA(1, 0), cA + kstep, 0, gA); PG8_STAGE(PG8_SB(1, 1), cB + hstepB + kstep, voffB);
    PG8_WAIT_V(6); PG8_BAR;
    for (;;) {
        const bool has_next = S.next(ui + 1, nxt);
        const char* nA = has_next ? S.a_base(g, nxt) : cA; const char* nB = has_next ? S.b_base(g, nxt) : cB;
        if constexpr (Sched::GATHER) {
#pragma unroll
            for (int h = 0; h < 2; ++h)
#pragma unroll
                for (int i = 0; i < 2; ++i) gN[h][i] = has_next ? (unsigned)(S.row(nxt, h * HALF + sR[i]) * g.lda + sC[i]) * 2u : gA[h][i];
        }
#pragma unroll 1
        for (int t = 0; t < nt; t += 2) {
            const bool last = (t == nt - 2);
            const char* a1 = cA + (size_t)(t + 1) * kstep;
            const char* a2 = last ? nA : cA + (size_t)(t + 2) * kstep; const char* b2 = last ? nB : cB + (size_t)(t + 2) * kstep;
            const char* a3 = a2 + kstep; const char* b3 = b2 + kstep;
            unsigned o2[2][2];
            if constexpr (Sched::GATHER) {
#pragma unroll
                for (int h = 0; h < 2; ++h)
#pragma unroll
                    for (int i = 0; i < 2; ++i) o2[h][i] = last ? gN[h][i] : gA[h][i];
            }
            PG8_LDB(B0, 0, 0); PG8_LDB(B1, 0, 1); PG8_SCHED; PG8_LDA(At, 0, 0); PG8_STAGE_A(PG8_SA(1, 1), a1, 1, gA);
            PG8_WAIT_V(8); PG8_WAIT_L(0); PG8_BAR; PG8_MMA(0, 0, At, B0); PG8_MMA(0, 1, At, B1); PG8_BAR; PG8_SCHED;
            PG8_LDA(At, 0, 1); PG8_STAGE(PG8_SB(0, 0), b2, voffB); PG8_STAGE(PG8_SB(0, 1), b2 + hstepB, voffB); PG8_STAGE_A(PG8_SA(0, 0), a2, 0, o2);
            PG8_WAIT_V(8); PG8_WAIT_L(0); PG8_BAR; PG8_MMA(1, 0, At, B0); PG8_MMA(1, 1, At, B1); PG8_BAR; PG8_SCHED;
            PG8_LDB(B0, 1, 0); PG8_LDB(B1, 1, 1); PG8_SCHED; PG8_LDA(At, 1, 0); PG8_STAGE_A(PG8_SA(0, 1), a2, 1, o2);
            PG8_WAIT_V(8); PG8_WAIT_L(0); PG8_BAR; PG8_MMA(0, 0, At, B0); PG8_MMA(0, 1, At, B1); PG8_BAR; PG8_SCHED;
            PG8_LDA(At, 1, 1); PG8_STAGE(PG8_SB(1, 0), b3, voffB); PG8_STAGE(PG8_SB(1, 1), b3 + hstepB, voffB); PG8_STAGE_A(PG8_SA(1, 0), a3, 0, o2);
            PG8_WAIT_V(8); PG8_WAIT_L(0); PG8_BAR; PG8_MMA(1, 0, At, B0); PG8_MMA(1, 1, At, B1); PG8_BAR; PG8_SCHED;
        }
        if (wr == 0) PG8_BAR;
        E(acc, cur, wr, wc, fr, fq);
        if (!has_next) break;
#pragma unroll
        for (int a = 0; a < 2; ++a)
#pragma unroll
            for (int b = 0; b < 2; ++b)
#pragma unroll
                for (int m = 0; m < 4; ++m)
#pragma unroll
                    for (int n = 0; n < 2; ++n) acc[a][b][m][n] = (f32x4){0.f, 0.f, 0.f, 0.f};
        cur = nxt; cA = nA; cB = nB; ++ui;
        if constexpr (Sched::GATHER) {
#pragma unroll
            for (int h = 0; h < 2; ++h)
#pragma unroll
                for (int i = 0; i < 2; ++i) gA[h][i] = gN[h][i];
        }
        if (wr == 1) PG8_BAR;
    }
    PG8_WAIT_V(0);
    PG8_BAR;
#undef PG8_SA
#undef PG8_SB
#undef PG8_STAGE
#undef PG8_STAGE_A
#undef PG8_LDA
#undef PG8_LDB
#undef PG8_MMA
#undef PG8_WAIT_V
#undef PG8_WAIT_L
#undef PG8_BAR
#undef PG8_SCHED
}

struct EpiBf16Store {
    static constexpr bool PERM = true;
    bf16_t* O; int ldc;
    __device__ __forceinline__ void operator()(const f32x4 (&acc)[2][2][4][2], const Unit& u, int wr, int wc, int fr, int fq) const {
        const int row0 = u.pm * BM + wr * 64 + fr, col0 = u.pn * BM + wc * 32 + 8 * fq;
#pragma unroll
        for (int ai = 0; ai < 2; ++ai)
#pragma unroll
            for (int m = 0; m < 4; ++m) { bf16_t* rowp = O + (size_t)(row0 + ai * HALF + m * 16) * ldc + col0;
#pragma unroll
                for (int bj = 0; bj < 2; ++bj) { const f32x4 v0 = acc[ai][bj][m][0], v1 = acc[ai][bj][m][1];
                    u32x4 w; w.x = cvt_pk_bf16(v0[0], v0[1]); w.y = cvt_pk_bf16(v0[2], v0[3]); w.z = cvt_pk_bf16(v1[0], v1[1]); w.w = cvt_pk_bf16(v1[2], v1[3]);
                    *(u32x4*)(rowp + bj * HALF) = w; } }
    }
};
}
constexpr int NWAVES = 8;
constexpr int RING_OFF = 0, RING_BYTES = 131072;
constexpr int ROUTER_LDS = 147456;
constexpr int LDSCTL_OFF = ROUTER_LDS, MISC_OFF = LDSCTL_OFF + 320;
constexpr int LDS_TAB_OFF = LDSCTL_OFF + 1024;
constexpr int LDS_BYTES = 155648;

#define GAS __attribute__((address_space(1)))
#define LAS __attribute__((address_space(3)))
typedef unsigned v4u __attribute__((ext_vector_type(4)));
typedef unsigned v2u __attribute__((ext_vector_type(2)));
typedef float f32x4 __attribute__((ext_vector_type(4)));
#define LDS_WAIT() asm volatile("s_waitcnt lgkmcnt(0)" ::: "memory")
#define VM_WAIT() asm volatile("s_waitcnt vmcnt(0)" ::: "memory")
__device__ __forceinline__ unsigned pk2(float lo, float hi) { return (unsigned)f2bf(lo) | ((unsigned)f2bf(hi) << 16); }


struct Frame {
    LAS unsigned char* lds;
    int tid, lane, wave, vcu, G;
    const float* const* in;
    float* out; unsigned char* ws;
};

__device__ __forceinline__ void p0_transpose_item(const float* W, int ldw, bf16* WT, int ldt, int k0, int n0, int row0, LAS float* scr, int lane) {
    {
        f32x4 t[8];
#pragma unroll
        for (int i = 0; i < 8; ++i) t[i] = *(const f32x4*)(W + (size_t)(k0 + 8 * i + (lane >> 3)) * ldw + n0 + 4 * (lane & 7));
#pragma unroll
        for (int i = 0; i < 8; ++i) { LAS float* d = scr + (8 * i + (lane >> 3)) * 33 + 4 * (lane & 7); d[0] = t[i].x; d[1] = t[i].y; d[2] = t[i].z; d[3] = t[i].w; }
    }
    LDS_WAIT(); asm volatile("" ::: "memory");
    const int c = lane & 7;
#pragma unroll
    for (int j = 0; j < 4; ++j) { const int n = (lane >> 3) + 8 * j; const LAS float* s = scr + (8 * c) * 33 + n;
        v4u o; o.x = pk2(s[0 * 33], s[1 * 33]); o.y = pk2(s[2 * 33], s[3 * 33]); o.z = pk2(s[4 * 33], s[5 * 33]); o.w = pk2(s[6 * 33], s[7 * 33]);
        *(v4u*)(WT + (size_t)(row0 + n) * ldt + k0 + 8 * c) = o; }
    LDS_WAIT(); asm volatile("" ::: "memory");
}

__device__ __forceinline__ void p0_mod_task(Frame& F, int task) {
    LAS float* sc = (LAS float*)(F.lds);
    LAS float* red = (LAS float*)(F.lds + 16384);
    const float* c = F.in[1]; const float* w_ada = F.in[2]; const float* b_ada = F.in[3];
    for (int i = F.tid; i < 4096; i += 512) { const float cv = c[i]; sc[i] = cv / (1.f + __expf(-cv)); }
    __syncthreads();
    const int j = task * 64 + F.lane;
    float a0 = 0.f, a1 = 0.f, a2 = 0.f, a3 = 0.f;
    const int kb = F.wave * 128;
#pragma unroll 16
    for (int k = kb; k < kb + 128; ++k) { const float w = w_ada[(size_t)k * 6144 + j]; a0 += sc[k] * w; a1 += sc[1024 + k] * w; a2 += sc[2048 + k] * w; a3 += sc[3072 + k] * w; }
    red[(F.wave * 4 + 0) * 64 + F.lane] = a0; red[(F.wave * 4 + 1) * 64 + F.lane] = a1; red[(F.wave * 4 + 2) * 64 + F.lane] = a2; red[(F.wave * 4 + 3) * 64 + F.lane] = a3;
    __syncthreads();
    if (F.tid < 256) { const int b = F.tid >> 6, l = F.tid & 63; float s = 0.f;
#pragma unroll
        for (int w = 0; w < 8; ++w) s += red[(w * 4 + b) * 64 + l];
        ((float*)(F.ws + WS_MOD))[b * 6144 + task * 64 + l] = s + b_ada[task * 64 + l]; }
    __syncthreads();
}

__device__ __forceinline__ void phase0(Frame& F) {
    if (blockIdx.x < 96) p0_mod_task(F, blockIdx.x);
    LAS float* scr = (LAS float*)(F.lds + RING_OFF + F.wave * 16384);
    const int gw = F.vcu * NWAVES + F.wave, NGW = F.G * NWAVES;
    constexpr int I_IN = (D / 64) * (PW / 32), I_OUT = (D / 64) * (D / 32);
    constexpr int NITEMS = I_IN + I_OUT;
    for (int it = gw; it < NITEMS; it += NGW) {
        int r = it;
        if (r < I_IN) { const int nb = PW / 32, kb = r / nb, n = r % nb; p0_transpose_item(F.in[5], PW, (bf16*)(F.ws + FW_WINT), D, 64 * kb, 32 * n, 32 * n, scr, F.lane); continue; } r -= I_IN;
        { const int nb = D / 32, kb = r / nb, n = r % nb; p0_transpose_item(F.in[25], D, (bf16*)(F.ws + FW_WOUTT), D, 64 * kb, 32 * n, 32 * n, scr, F.lane); }
    }
}
__device__ __forceinline__ void expert_transposes(Frame& F, int wv, int nwv) {
    LAS float* scr = (LAS float*)(F.lds + RING_OFF + F.wave * 16384);
    constexpr int I_E13 = NE * 2 * 256, I_E2 = NE * 256;
    for (int it = wv; it < I_E13 + I_E2; it += nwv) {
        int r = it;
        if (r < I_E13) {
            const int e = r >> 9, which = (r >> 8) & 1, q = r & 255, kb = q >> 4, n = q & 15, n0 = 32 * n;
            const float* W = (which ? F.in[32] : F.in[31]) + (size_t)e * D * DE;
            p0_transpose_item(W, DE, (bf16*)(F.ws + FW_W13T) + (size_t)e * 1024 * 1024, D, 64 * kb, n0, (n0 >> 7) * 256 + which * 128 + (n0 & 127), scr, F.lane); continue; } r -= I_E13;
        {
            const int e = r >> 8, q = r & 255, kb = q >> 5, n = q & 31;
            p0_transpose_item(F.in[33] + (size_t)e * DE * D, D, (bf16*)(F.ws + FW_W2T) + (size_t)e * 1024 * DE, DE, 64 * kb, 32 * n, 32 * n, scr, F.lane); }
    }
}

__device__ __forceinline__ void adaln_row(const float* xrow, const float* g, const float* sh, const float* sc, bf16* orow, int lane) {
    const f32x4* xr = (const f32x4*)xrow + lane;
    f32x4 v[4]; float s = 0.f;
#pragma unroll
    for (int j = 0; j < 4; ++j) { v[j] = xr[64 * j]; s += (v[j].x * v[j].x + v[j].y * v[j].y) + (v[j].z * v[j].z + v[j].w * v[j].w); }
    const float rinv = rsqrtf(wave_sum(s) * (1.f / D) + 1e-6f);
    v2u* o8 = (v2u*)orow + lane;
#pragma unroll
    for (int j = 0; j < 4; ++j) { const f32x4 gg = ((const f32x4*)g)[lane + 64 * j], s1 = ((const f32x4*)sc)[lane + 64 * j], s0 = ((const f32x4*)sh)[lane + 64 * j];
        f32x4 y = v[j] * rinv * gg; y = y * (s1 + 1.f) + s0;
        v2u w; w.x = pk2(y.x, y.y); w.y = pk2(y.z, y.w); o8[64 * j] = w; }
}
__device__ __forceinline__ void phase1(Frame& F) {
    const int gw = F.vcu * NWAVES + F.wave, NGW = F.G * NWAVES;
    const float* mod = (const float*)(F.ws + WS_MOD);
    for (int m = gw; m < NTOK; m += NGW) { const int b = m / T;
        adaln_row(F.in[0] + (size_t)m * D, F.in[4], mod + b * 6144, mod + b * 6144 + 1024, (bf16*)(F.ws + WS_H) + (size_t)m * D, F.lane); }
}
__device__ __forceinline__ void phase2(Frame& F) {
    pg8::Gemm g{(const bf16*)(F.ws + WS_H), (const bf16*)(F.ws + FW_WINT), D, D, D};
    pg8::DenseOrder S; S.init(NTOK, PW, F.G, (int)blockIdx.x);
    pg8::EpiBf16Store E{(bf16*)(F.ws + WS_P), PW};
    pg8::gemm_phase<pg8::EpiBf16Store, pg8::DenseOrder>(F.lds + RING_OFF, g, S, E, F.tid);
}


namespace pg8 {
struct EpiX1F {
    static constexpr bool PERM = false;
    const float* const* in; unsigned char* ws; float* out;
    __device__ __forceinline__ void operator()(const f32x4 (&acc)[2][2][4][2], const Unit& u, int wr, int wc, int fr, int fq) const {
        const float* x = in[0]; const float* mod = (const float*)(ws + WS_MOD);
        const int row0 = u.pm * BM + wr * 64 + fr, col0 = u.pn * BM + wc * 32 + 4 * fq;
        const float* g1 = mod + ((u.pm * BM) / T) * 6144 + 2048;
        f32x4 gv[2][2];
#pragma unroll
        for (int bj = 0; bj < 2; ++bj)
#pragma unroll
            for (int n = 0; n < 2; ++n) gv[bj][n] = *(const f32x4*)(g1 + col0 + bj * HALF + n * 16);
#pragma unroll
        for (int ai = 0; ai < 2; ++ai)
#pragma unroll
            for (int m = 0; m < 4; ++m) { const size_t ro = (size_t)(row0 + ai * HALF + m * 16) * D + col0;
#pragma unroll
                for (int bj = 0; bj < 2; ++bj)
#pragma unroll
                    for (int n = 0; n < 2; ++n) { const f32x4 xv = *(const f32x4*)(x + ro + bj * HALF + n * 16);
                        *(f32x4*)(out + ro + bj * HALF + n * 16) = xv + gv[bj][n] * acc[ai][bj][m][n]; } }
    }
};
template <bool GATH> struct MoeOrder {
    static constexpr bool GATHER = GATH;
    const LAS int* ub; const LAS int* rb; const LAS int* cn; const int* list; int G, c, brows;
    __device__ bool next(int i, Unit& u) const {
        const int L = i * G + c; if (L >= ub[32]) return false;
        int e = 0;
#pragma unroll
        for (int k = 16; k >= 1; k >>= 1) if (ub[e + k] <= L) e += k;
        const int local = L - ub[e], tiles = rb[e + 1] - rb[e], pn = local / tiles, mt = local - pn * tiles;
        u.e = e; u.pn = pn; u.pm = rb[e] + mt; u.row0 = e * NTOK + mt * 256; u.nrows = min(256, cn[e] - mt * 256); return true;
    }
    __device__ __forceinline__ const char* a_base(const Gemm& g, const Unit& u) const { return GATH ? (const char*)g.A : (const char*)g.A + (size_t)u.pm * (BM * 2) * g.lda; }
    __device__ __forceinline__ const char* b_base(const Gemm& g, const Unit& u) const { return (const char*)g.Bt + ((size_t)u.e * brows + (size_t)u.pn * BM) * 2 * g.ldb; }
    __device__ __forceinline__ int row(const Unit& u, int r) const { return r < u.nrows ? (list[u.row0 + r] >> 1) : 0; }
};
struct EpiSwiglu {
    static constexpr bool PERM = true;
    bf16_t* HID;
    __device__ __forceinline__ void operator()(const f32x4 (&acc)[2][2][4][2], const Unit& u, int wr, int wc, int fr, int fq) const {
        const int col0 = u.pn * HALF + wc * 32 + 8 * fq;
#pragma unroll
        for (int ai = 0; ai < 2; ++ai)
#pragma unroll
            for (int m = 0; m < 4; ++m) { const int r = ai * HALF + wr * 64 + m * 16 + fr;
                if (r < u.nrows) { float h[8];
#pragma unroll
                    for (int n = 0; n < 2; ++n)
#pragma unroll
                        for (int i = 0; i < 4; ++i) { const float a = acc[ai][0][m][n][i], b = acc[ai][1][m][n][i]; h[n * 4 + i] = a / (1.f + __expf(-a)) * b; }
                    u32x4 w; w.x = cvt_pk_bf16(h[0], h[1]); w.y = cvt_pk_bf16(h[2], h[3]); w.z = cvt_pk_bf16(h[4], h[5]); w.w = cvt_pk_bf16(h[6], h[7]);
                    *(u32x4*)(HID + (size_t)(u.pm * BM + r) * DE + col0) = w; } }
    }
};
struct EpiYs {
    static constexpr bool PERM = true;
    unsigned char* ws;
    __device__ __forceinline__ void operator()(const f32x4 (&acc)[2][2][4][2], const Unit& u, int wr, int wc, int fr, int fq) const {
        bf16_t* YS = (bf16_t*)(ws + WS_YS); const int* list = (const int*)(ws + WS_LIST); const float* selw = (const float*)(ws + WS_SELW);
        const int col0 = u.pn * BM + wc * 32 + 8 * fq;
#pragma unroll
        for (int ai = 0; ai < 2; ++ai)
#pragma unroll
            for (int m = 0; m < 4; ++m) { const int r = ai * HALF + wr * 64 + m * 16 + fr;
                if (r < u.nrows) { const int li = list[u.row0 + r]; const float w8 = selw[li]; bf16_t* rowp = YS + (size_t)li * D + col0;
#pragma unroll
                    for (int bj = 0; bj < 2; ++bj) { const f32x4 v0 = acc[ai][bj][m][0] * w8, v1 = acc[ai][bj][m][1] * w8;
                        u32x4 w; w.x = cvt_pk_bf16(v0[0], v0[1]); w.y = cvt_pk_bf16(v0[2], v0[3]); w.z = cvt_pk_bf16(v1[0], v1[1]); w.w = cvt_pk_bf16(v1[2], v1[3]);
                        *(u32x4*)(rowp + bj * HALF) = w; } } }
    }
};
}

__device__ __forceinline__ void phase_outproj(Frame& F) {
    pg8::Gemm g{(const bf16*)(F.ws + WS_YMIX), (const bf16*)(F.ws + FW_WOUTT), D, D, D};
    pg8::DenseOrder S; S.init(NTOK, D, F.G, (int)blockIdx.x);
    pg8::EpiX1F E{F.in, F.ws, F.out};
    pg8::gemm_phase<pg8::EpiX1F, pg8::DenseOrder>(F.lds + RING_OFF, g, S, E, F.tid);
}

__device__ __forceinline__ void phase_route(Frame& F) {
    LAS float* wt = (LAS float*)F.lds;
    { const f32x4* WR = (const f32x4*)(F.ws + FW_WR); LAS f32x4* wt4 = (LAS f32x4*)F.lds;
      for (int i = F.tid; i < 36 * 256; i += 512) wt4[i] = WR[i]; }
    __syncthreads();
    const float* mod = (const float*)(F.ws + WS_MOD); const float* g2n = F.in[26];
    int* cnt = (int*)(F.ws + WS_CNT); int* list = (int*)(F.ws + WS_LIST); float* selw = (float*)(F.ws + WS_SELW);
    bf16* H2 = (bf16*)(F.ws + WS_H);
    const int gw = F.vcu * NWAVES + F.wave, NGW = F.G * NWAVES, lane = F.lane;
    LAS int* lcnt = (LAS int*)(F.lds + LDSCTL_OFF + 2048); LAS int* lbase = lcnt + 32; LAS int* tokres = lcnt + 64;
    if (F.tid < 32) lcnt[F.tid] = 0;
    __syncthreads();
    int it = 0;
    for (int m = gw; m < NTOK; m += NGW, ++it) {
        const int b = m / T;
        const f32x4* xr = (const f32x4*)(F.out + (size_t)m * D) + lane;
        f32x4 v[4]; float s = 0.f;
#pragma unroll
        for (int j = 0; j < 4; ++j) { v[j] = xr[64 * j]; s += (v[j].x * v[j].x + v[j].y * v[j].y) + (v[j].z * v[j].z + v[j].w * v[j].w); }
        const float rinv = rsqrtf(wave_sum(s) * (1.f / D) + 1e-6f);
        v2u* o8 = (v2u*)(H2 + (size_t)m * D) + lane;
#pragma unroll
        for (int j = 0; j < 4; ++j) { const f32x4 gg = ((const f32x4*)g2n)[lane + 64 * j], s1 = ((const f32x4*)(mod + b * 6144 + 4096))[lane + 64 * j], s0 = ((const f32x4*)(mod + b * 6144 + 3072))[lane + 64 * j];
            f32x4 y = v[j] * rinv * gg; y = y * (s1 + 1.f) + s0; v[j] = y;
            v2u w; w.x = pk2(y.x, y.y); w.y = pk2(y.z, y.w); o8[64 * j] = w; }
        const float* b_grp = F.in[28]; const float* b_exp = F.in[30];
        int gi = 0; float gm = -3.4e38f, den = 0.f;
#pragma unroll 1
        for (int e = 0; e < 4; ++e) { float p = 0.f;
#pragma unroll
            for (int j = 0; j < 4; ++j) { const f32x4 w = *(const LAS f32x4*)(wt + e * 1024 + lane * 4 + 256 * j); p += (v[j].x * w.x + v[j].y * w.y) + (v[j].z * w.z + v[j].w * w.w); }
            const float gl = wave_sum(p) + b_grp[e];
            if (gl > gm) { den = den * __expf(gm - gl) + 1.f; gm = gl; gi = e; } else den += __expf(gl - gm); }
        gi = __builtin_amdgcn_readfirstlane(gi);
        const float gwt = 1.f / den;
        float v1 = -3.4e38f, v2 = -3.4e38f; int i1 = 0, i2 = 0;
#pragma unroll 1
        for (int ii = 0; ii < 8; ++ii) { const int e = gi * 8 + ii; float p = 0.f;
#pragma unroll
            for (int j = 0; j < 4; ++j) { const f32x4 w = *(const LAS f32x4*)(wt + (4 + e) * 1024 + lane * 4 + 256 * j); p += (v[j].x * w.x + v[j].y * w.y) + (v[j].z * w.z + v[j].w * w.w); }
            const float xx = wave_sum(p) + b_exp[e];
            if (xx > v1) { v2 = v1; i2 = i1; v1 = xx; i1 = ii; } else if (xx > v2) { v2 = xx; i2 = ii; } }
        const float e2 = __expf(v2 - v1), w1 = 1.f / (1.f + e2), w2 = e2 / (1.f + e2);
        if (lane == 0) { const int ea = gi * 8 + i1, eb = gi * 8 + i2;
            selw[m * 2] = w1 * gwt; selw[m * 2 + 1] = w2 * gwt;
            const int ra = atomicAdd((int*)&lcnt[ea], 1), rb2 = atomicAdd((int*)&lcnt[eb], 1);
            tokres[(F.wave * 16 + it) * 2] = ea | (ra << 8); tokres[(F.wave * 16 + it) * 2 + 1] = eb | (rb2 << 8); }
    }
    __syncthreads();
    if (F.tid < 32) { const int c = lcnt[F.tid]; lbase[F.tid] = c ? atomicAdd(&cnt[F.tid * 64], c) : 0; }
    __syncthreads();
    if (lane == 0) { int it = 0;
        for (int m = gw; m < NTOK; m += NGW, ++it) {
            const int a = tokres[(F.wave * 16 + it) * 2], b2 = tokres[(F.wave * 16 + it) * 2 + 1];
            list[(a & 255) * NTOK + lbase[a & 255] + (a >> 8)] = m * 2; list[(b2 & 255) * NTOK + lbase[b2 & 255] + (b2 >> 8)] = m * 2 + 1; } }
    __syncthreads();
}

__device__ __forceinline__ void moe_tables(Frame& F, int npn) {
    LAS int* tab = (LAS int*)(F.lds + LDS_TAB_OFF);
    if (F.tid == 0) { const int* cnt = (const int*)(F.ws + WS_CNT); int ub = 0, rb = 0;
        for (int e = 0; e < 32; ++e) { const int c = __hip_atomic_load(cnt + e * 64, __ATOMIC_RELAXED, __HIP_MEMORY_SCOPE_AGENT); const int tl = (c + 255) >> 8; tab[e] = ub; tab[33 + e] = rb; tab[66 + e] = c; ub += tl * npn; rb += tl; }
        tab[32] = ub; tab[33 + 32] = rb; }
    __syncthreads();
}
__device__ __forceinline__ void phase_m1(Frame& F) {
    moe_tables(F, 4);
    const LAS int* tab = (const LAS int*)(F.lds + LDS_TAB_OFF);
    pg8::Gemm g{(const bf16*)(F.ws + WS_H), (const bf16*)(F.ws + FW_W13T), D, D, D};
    pg8::MoeOrder<true> S{tab, tab + 33, tab + 66, (const int*)(F.ws + WS_LIST), F.G, (int)blockIdx.x, 1024};
    pg8::EpiSwiglu E{(bf16*)(F.ws + WS_HID)};
    pg8::gemm_phase<pg8::EpiSwiglu, pg8::MoeOrder<true>>(F.lds + RING_OFF, g, S, E, F.tid);
}
__device__ __forceinline__ void phase_m2(Frame& F) {
    moe_tables(F, 4);
    const LAS int* tab = (const LAS int*)(F.lds + LDS_TAB_OFF);
    pg8::Gemm g{(const bf16*)(F.ws + WS_HID), (const bf16*)(F.ws + FW_W2T), DE, DE, DE};
    pg8::MoeOrder<false> S{tab, tab + 33, tab + 66, (const int*)(F.ws + WS_LIST), F.G, (int)blockIdx.x, 1024};
    pg8::EpiYs E{F.ws};
    pg8::gemm_phase<pg8::EpiYs, pg8::MoeOrder<false>>(F.lds + RING_OFF, g, S, E, F.tid);
}
__device__ __forceinline__ void phase_final(Frame& F, bool dry = false) {
    const int gw = F.vcu * NWAVES + F.wave, NGW = F.G * NWAVES, lane = F.lane;
    const float* mod = (const float*)(F.ws + WS_MOD); const float* fg = F.in[34]; const bf16* YS = (const bf16*)(F.ws + WS_YS);
    for (int m = gw; m < NTOK; m += NGW) { const int b = m / T;
        f32x4* xr = (f32x4*)(F.out + (size_t)m * D) + lane;
        const v2u* y0 = (const v2u*)(YS + (size_t)(2 * m) * D) + lane; const v2u* y1 = (const v2u*)(YS + (size_t)(2 * m + 1) * D) + lane;
        f32x4 v[4]; float s = 0.f;
#pragma unroll
        for (int j = 0; j < 4; ++j) { const v2u a = y0[64 * j], c = y1[64 * j]; const f32x4 g2 = ((const f32x4*)(mod + b * 6144 + 5120))[lane + 64 * j];
            f32x4 mo; mo.x = __uint_as_float(a.x << 16) + __uint_as_float(c.x << 16); mo.y = __uint_as_float(a.x & 0xffff0000u) + __uint_as_float(c.x & 0xffff0000u);
            mo.z = __uint_as_float(a.y << 16) + __uint_as_float(c.y << 16); mo.w = __uint_as_float(a.y & 0xffff0000u) + __uint_as_float(c.y & 0xffff0000u);
            v[j] = xr[64 * j] + g2 * mo; s += (v[j].x * v[j].x + v[j].y * v[j].y) + (v[j].z * v[j].z + v[j].w * v[j].w); }
        const float rinv = rsqrtf(wave_sum(s) * (1.f / D) + 1e-6f);
        float tdelta = 0.f;
        if (TIMER_A >= 0 && m == 0) { const unsigned long long* ts = (const unsigned long long*)(F.ws + 8192);
            const float us = (float)(TIMER_B == TIMER_A ? ts[TIMER_A] : ts[TIMER_B] - ts[TIMER_A]) * 0.01f; tdelta = sqrtf(32768.f * us * 1e-6f); }
#pragma unroll
        for (int j = 0; j < 4; ++j) (dry ? (f32x4*)(F.ws + WS_P) + (size_t)m * 256 + lane : xr)[64 * j] = v[j] * rinv * ((const f32x4*)fg)[lane + 64 * j] + tdelta;
    }
}
#define XB_TMO      128
#define XB_XCNT(j)  (256  + 64 * (j))
#define XB_XSUB(j)  (1280 + 64 * (j))
#define XB_XGEN(j)  (2304 + 64 * (j))
#define XB_TOP      3328
#define XB_TOPGEN   3392
#define XCD_BAR_WORDS 3456
#define XB_SPIN_CAP (1u << 18)

__device__ __forceinline__ unsigned xb_ld(unsigned* p)              { return __hip_atomic_load(p, __ATOMIC_RELAXED, __HIP_MEMORY_SCOPE_AGENT); }
__device__ __forceinline__ unsigned xb_add(unsigned* p, unsigned v) { return __hip_atomic_fetch_add(p, v, __ATOMIC_RELAXED, __HIP_MEMORY_SCOPE_AGENT); }
__device__ __forceinline__ unsigned xb_xcc_id() { return (unsigned)__builtin_amdgcn_s_getreg((3 << 11) | 20) & 0xFu; }
#define XB_SPIN(cond, bar) do { unsigned _sp = 0; while (cond) { __builtin_amdgcn_s_sleep(1); \
    if ((++_sp & 255u) == 0u) { if (xb_ld(&(bar)[XB_TMO])) break; if (_sp > XB_SPIN_CAP) { atomicAdd(&(bar)[XB_TMO], 1u); break; } } } } while (0)

struct XcdBarrier {
    unsigned* bar; unsigned x;
    volatile LAS unsigned* st;
};

__device__ __forceinline__ XcdBarrier xcd_barrier_post(unsigned* bar, volatile LAS unsigned* st) {
    XcdBarrier b; b.bar = bar; b.x = xb_xcc_id(); b.st = st;
    if (threadIdx.x == 0) (void)xb_add(&bar[XB_XCNT(b.x)], 1u);
    return b;
}
__device__ __forceinline__ void xcd_barrier_complete(unsigned* bar, unsigned x, unsigned& nloc, unsigned& nx) {
    const unsigned G = gridDim.x * gridDim.y * gridDim.z;
    unsigned sum, cnt, mine, sp = 0u;
    for (;;) {
        sum = 0u; cnt = 0u; mine = 0u;
#pragma unroll
        for (unsigned j = 0; j < 16; ++j) { const unsigned c = xb_ld(&bar[XB_XCNT(j)]); sum += c; cnt += (c > 0u) ? 1u : 0u; mine = (j == x) ? c : mine; }
        if (sum == G) break;
        __builtin_amdgcn_s_sleep(1);
        if ((++sp & 255u) == 0u) { if (xb_ld(&bar[XB_TMO])) break; if (sp > XB_SPIN_CAP) { atomicAdd(&bar[XB_TMO], 1u); break; } }
    }
    nloc = mine > 0u ? mine : 1u; nx = cnt > 0u ? cnt : 1u;
}

__device__ __forceinline__ void xcd_barrier(const XcdBarrier& b) {
    asm volatile("s_waitcnt vmcnt(0)" ::: "memory");
    __syncthreads();
    if (threadIdx.x == 0) {
        unsigned* bar = b.bar;
        __builtin_amdgcn_s_waitcnt(0);
        unsigned nloc = b.st[0], nx = b.st[1];
        if (nloc == 0u) { xcd_barrier_complete(bar, b.x, nloc, nx); b.st[0] = nloc; b.st[1] = nx; }
        const unsigned old = xb_add(&bar[XB_XSUB(b.x)], 1u);
        const unsigned gen = old / nloc;
        if (old + 1u == (gen + 1u) * nloc) {
            __builtin_amdgcn_fence(__ATOMIC_RELEASE, "agent");
            asm volatile("s_waitcnt vmcnt(0)" ::: "memory");
            const unsigned og = xb_add(&bar[XB_TOP], 1u);
            const unsigned tg = og / nx;
            if (og + 1u == (tg + 1u) * nx) xb_add(&bar[XB_TOPGEN], 1u);
            else XB_SPIN(xb_ld(&bar[XB_TOPGEN]) == tg, bar);
            __builtin_amdgcn_fence(__ATOMIC_ACQUIRE, "agent");
            xb_add(&bar[XB_XGEN(b.x)], 1u);
            asm volatile("s_waitcnt vmcnt(0)" ::: "memory");
        } else {
            XB_SPIN(xb_ld(&bar[XB_XGEN(b.x)]) == gen, bar);
            __builtin_amdgcn_fence(__ATOMIC_ACQUIRE, "agent");
            asm volatile("s_waitcnt vmcnt(0)" ::: "memory");
        }
    }
    __syncthreads();
}


constexpr size_t WS_XC = WS_H;
constexpr size_t WS_ALORA = WS_H + 32 * MiB;
constexpr size_t WS_LOGA = 256 * MiB;
constexpr size_t WS_OLOC = 320 * MiB;
constexpr size_t WS_QHAT = 352 * MiB;
constexpr size_t WS_GG = 384 * MiB;
constexpr size_t WS_SB = 12 * MiB;
constexpr size_t WS_LRUA = 13 * MiB;
constexpr size_t WS_LRUB = 14 * MiB;
constexpr size_t WS_LRUH = 15 * MiB;
constexpr size_t DO_LWA = 0;
constexpr size_t DO_PC = 64 * MiB;
constexpr size_t DO_QCT = 96 * MiB;
constexpr size_t DO_HIN = 0;

__device__ __forceinline__ float bflo(unsigned u) { return __uint_as_float(u << 16); }
__device__ __forceinline__ float bfhi(unsigned u) { return __uint_as_float(u & 0xffff0000u); }

__device__ __forceinline__ void phase_prepA(Frame& F) {
    const int gw = F.vcu * NWAVES + F.wave, NGW = F.G * NWAVES, lane = F.lane;
    const bf16* P = (const bf16*)(F.ws + WS_P);
    bf16* XC = (bf16*)(F.ws + WS_XC); bf16* AL = (bf16*)(F.ws + WS_ALORA);
    const float* conv_w = F.in[6]; const float* conv_b = F.in[7]; const float* mu = F.in[14];
    float cw[4][8], cb[8];
#pragma unroll
    for (int i = 0; i < 8; ++i) { cb[i] = conv_b[8 * lane + i];
#pragma unroll
        for (int j = 0; j < 4; ++j) cw[j][i] = conv_w[j * 512 + 8 * lane + i]; }
    float mu4[4];
#pragma unroll
    for (int i = 0; i < 4; ++i) mu4[i] = mu[(C_WD - 1024) + 4 * lane + i];
    for (int task = gw; task < NTOK / 16; task += NGW) {
        const int m0 = task * 16, t0 = m0 % T;
        float x1[8], x2[8], x3[8], pl[4];
#pragma unroll
        for (int i = 0; i < 8; ++i) { x1[i] = 0.f; x2[i] = 0.f; x3[i] = 0.f; }
#pragma unroll
        for (int i = 0; i < 4; ++i) pl[i] = 0.f;
        if (t0 > 0) {
            const v4u a = *(const v4u*)(P + (size_t)(m0 - 1) * PW + 8 * lane), b = *(const v4u*)(P + (size_t)(m0 - 2) * PW + 8 * lane), c = *(const v4u*)(P + (size_t)(m0 - 3) * PW + 8 * lane);
            x1[0] = bflo(a.x); x1[1] = bfhi(a.x); x1[2] = bflo(a.y); x1[3] = bfhi(a.y); x1[4] = bflo(a.z); x1[5] = bfhi(a.z); x1[6] = bflo(a.w); x1[7] = bfhi(a.w);
            x2[0] = bflo(b.x); x2[1] = bfhi(b.x); x2[2] = bflo(b.y); x2[3] = bfhi(b.y); x2[4] = bflo(b.z); x2[5] = bfhi(b.z); x2[6] = bflo(b.w); x2[7] = bfhi(b.w);
            x3[0] = bflo(c.x); x3[1] = bfhi(c.x); x3[2] = bflo(c.y); x3[3] = bfhi(c.y); x3[4] = bflo(c.z); x3[5] = bfhi(c.z); x3[6] = bflo(c.w); x3[7] = bfhi(c.w);
            const v2u q = *(const v2u*)(P + (size_t)(m0 - 1) * PW + C_WD + 4 * lane);
            pl[0] = bflo(q.x); pl[1] = bfhi(q.x); pl[2] = bflo(q.y); pl[3] = bfhi(q.y);
        }
#pragma unroll 4
        for (int tt = 0; tt < 16; ++tt) {
            const size_t m = (size_t)(m0 + tt);
            const v4u a = *(const v4u*)(P + m * PW + 8 * lane);
            float x0[8] = {bflo(a.x), bfhi(a.x), bflo(a.y), bfhi(a.y), bflo(a.z), bfhi(a.z), bflo(a.w), bfhi(a.w)};
            float xc[8];
#pragma unroll
            for (int i = 0; i < 8; ++i) { xc[i] = x3[i] * cw[0][i] + x2[i] * cw[1][i] + x1[i] * cw[2][i] + x0[i] * cw[3][i] + cb[i]; x3[i] = x2[i]; x2[i] = x1[i]; x1[i] = x0[i]; }
            v4u o; o.x = pk2(xc[0], xc[1]); o.y = pk2(xc[2], xc[3]); o.z = pk2(xc[4], xc[5]); o.w = pk2(xc[6], xc[7]);
            *(v4u*)(XC + m * 512 + 8 * lane) = o;
            const v2u q = *(const v2u*)(P + m * PW + C_WD + 4 * lane);
            const float cl[4] = {bflo(q.x), bfhi(q.x), bflo(q.y), bfhi(q.y)};
            float al[4];
#pragma unroll
            for (int i = 0; i < 4; ++i) { const float u = cl[i] + (pl[i] - cl[i]) * mu4[i]; pl[i] = cl[i];
                al[i] = (lane < 16) ? tanhf(u) : ((lane < 32) ? u : sigmoidf_(u)); }
            v2u o2; o2.x = pk2(al[0], al[1]); o2.y = pk2(al[2], al[3]);
            *(v2u*)(AL + m * 256 + 4 * lane) = o2;
        }
    }
}
__device__ __forceinline__ void p0_small_weights(Frame& F) {
    const int gt = F.vcu * NWAVES * 64 + F.tid, NT = F.G * NWAVES * 64;
    bf16* WG = (bf16*)(F.ws + FW_WGT); bf16* WL = (bf16*)(F.ws + FW_WLORAT);
    const float* wa = F.in[8]; const float* wi = F.in[10]; const float* w_up = F.in[16]; const float* a_up = F.in[18]; const float* g_up = F.in[19];
    for (int i = gt; i < 4 * 256 * 256; i += NT) { const int kk = i & 255, r = (i >> 8) & 255, pn = i >> 16;
        const int gate = r >> 7, ch = 128 * pn + (r & 127), hh = ch >> 6, j = ch & 63, kin = (pn >> 1) * 256 + kk;
        float v = 0.f; if ((kin >> 6) == hh) v = (gate ? wi : wa)[hh * 4096 + (kin & 63) * 64 + j];
        WG[i] = f2bf(v); }
    { float* WR = (float*)(F.ws + FW_WR); const float* w_grp = F.in[27]; const float* w_exp = F.in[29];
      for (int i = gt; i < 36 * 1024; i += NT) { const int k = i & 1023, e = i >> 10; WR[i] = e < 4 ? w_grp[k * 4 + e] : w_exp[k * 32 + (e - 4)]; } }
    for (int i = gt; i < 1536 * 256; i += NT) { const int kk = i & 255, n = i >> 8; float v = 0.f;
        if (n < 512) { if (kk < 64) v = w_up[kk * 512 + n]; }
        else if (n < 1024) { if (kk >= 64 && kk < 128) v = a_up[(kk - 64) * 512 + n - 512]; }
        else { if (kk >= 128) v = g_up[(kk - 128) * 512 + n - 1024]; }
        WL[i] = f2bf(v); }
}

namespace pg8 {
struct GateOrder : DenseOrder {
    __device__ __forceinline__ const char* a_base(const Gemm& g, const Unit& u) const { return (const char*)g.A + (size_t)u.pm * (BM * 2) * g.lda + (size_t)(u.pn >> 1) * 512; }
};
struct EpiLruGate {
    static constexpr bool PERM = true;
    unsigned char* ws;
    __device__ __forceinline__ void operator()(const f32x4 (&acc)[2][2][4][2], const Unit& u, int wr, int wc, int fr, int fq) const {
        bf16_t* G = (bf16_t*)(ws + WS_LOGA);
        const int row0 = u.pm * BM + wr * 64 + fr, col0 = u.pn * HALF + wc * 32 + 8 * fq;
#pragma unroll
        for (int ai = 0; ai < 2; ++ai)
#pragma unroll
            for (int m = 0; m < 4; ++m) { bf16_t* rowp = G + (size_t)(row0 + ai * HALF + m * 16) * 1024 + col0;
#pragma unroll
                for (int bj = 0; bj < 2; ++bj) { const f32x4 v0 = acc[ai][bj][m][0], v1 = acc[ai][bj][m][1];
                    u32x4 w; w.x = cvt_pk_bf16(v0[0], v0[1]); w.y = cvt_pk_bf16(v0[2], v0[3]); w.z = cvt_pk_bf16(v1[0], v1[1]); w.w = cvt_pk_bf16(v1[2], v1[3]);
                    *(u32x4*)(rowp + bj * 512) = w; } }
    }
};
struct EpiLoraStore {
    static constexpr bool PERM = true;
    unsigned char* out; unsigned char* ws;
    __device__ __forceinline__ void operator()(const f32x4 (&acc)[2][2][4][2], const Unit& u, int wr, int wc, int fr, int fq) const {
        const int row0 = u.pm * BM + wr * 64 + fr;
        bf16_t* LWA = (bf16_t*)(out + DO_LWA); bf16_t* GG = (bf16_t*)(ws + WS_GG);
        bf16_t* base = u.pn < 4 ? LWA : GG; const int ldc = u.pn < 4 ? 1024 : 512; const int col0 = (u.pn < 4 ? u.pn : u.pn - 4) * BM + wc * 32 + 8 * fq;
#pragma unroll
        for (int ai = 0; ai < 2; ++ai)
#pragma unroll
            for (int m = 0; m < 4; ++m) { bf16_t* rowp = base + (size_t)(row0 + ai * HALF + m * 16) * ldc + col0;
#pragma unroll
                for (int bj = 0; bj < 2; ++bj) { const f32x4 v0 = acc[ai][bj][m][0], v1 = acc[ai][bj][m][1];
                    u32x4 w; w.x = cvt_pk_bf16(v0[0], v0[1]); w.y = cvt_pk_bf16(v0[2], v0[3]); w.z = cvt_pk_bf16(v1[0], v1[1]); w.w = cvt_pk_bf16(v1[2], v1[3]);
                    *(u32x4*)(rowp + bj * HALF) = w; } }
    }
};
}
__device__ __forceinline__ void phase_gategemm(Frame& F) {
    {
        pg8::Gemm g{(const bf16*)(F.ws + WS_XC), (const bf16*)(F.ws + FW_WGT), 512, 256, 256};
        pg8::GateOrder S; S.init(NTOK, 1024, F.G, (int)blockIdx.x);
        pg8::EpiLruGate E{F.ws};
        pg8::gemm_phase<pg8::EpiLruGate, pg8::GateOrder>(F.lds + RING_OFF, g, S, E, F.tid);
    }
}
__device__ __forceinline__ void phase_loragemm(Frame& F) {
    {
        pg8::Gemm g{(const bf16*)(F.ws + WS_ALORA), (const bf16*)(F.ws + FW_WLORAT), 256, 256, 256};
        pg8::DenseOrder S; S.init(NTOK, 1536, F.G, (int)blockIdx.x);
        pg8::EpiLoraStore E{(unsigned char*)F.out, F.ws};
        pg8::gemm_phase<pg8::EpiLoraStore, pg8::DenseOrder>(F.lds + RING_OFF, g, S, E, F.tid);
    }
}

typedef float f32x2 __attribute__((ext_vector_type(2)));
__device__ __forceinline__ void rwkv_prepass_unit(Frame& F, int unit, LAS float* wl) {
    int lane = F.lane; asm volatile("" : "+v"(lane));
    const int c = unit & 127, bh = unit >> 7, h = bh & 7, b = bh >> 3, ch = h * 64 + lane;
    const size_t m0 = (size_t)b * T + (size_t)c * 64;
    const bf16* P = (const bf16*)(F.ws + WS_P); const bf16* LWA = (const bf16*)((const unsigned char*)F.out + DO_LWA);
    bf16* OLOC = (bf16*)(F.ws + WS_OLOC); bf16* QHAT = (bf16*)(F.ws + WS_QHAT); float* SB = (float*)(F.ws + WS_SB);
    const float* mu = F.in[14];
    const float mu_r = mu[ch], mu_k = mu[512 + ch], mu_v = mu[1024 + ch];
    const float w0v = F.in[15][ch], a0v = F.in[17][ch], kkv = F.in[20][ch], kav = F.in[21][ch], rkv = F.in[22][ch];
    f32x2 S[64];
#pragma unroll
    for (int k = 0; k < 64; ++k) { S[k].x = (k == lane) ? 1.f : 0.f; S[k].y = 0.f; }
    float pr = 0.f, pk = 0.f, pv = 0.f;
    if (c > 0) { const bf16* row = P + (m0 - 1) * PW; pr = bf2f(row[C_R + ch]); pk = bf2f(row[C_K + ch]); pv = bf2f(row[C_V + ch]); }
#pragma unroll 1
    for (int s8 = 0; s8 < 8; ++s8) {
#pragma unroll 2
        for (int tt = 0; tt < 8; ++tt) {
            const size_t m = m0 + s8 * 8 + tt; const bf16* row = P + m * PW;
            const float cr = bf2f(row[C_R + ch]), ck = bf2f(row[C_K + ch]), cv = bf2f(row[C_V + ch]);
            const float lw = bf2f(LWA[m * 1024 + ch]), la = bf2f(LWA[m * 1024 + 512 + ch]);
            const float r = cr + (pr - cr) * mu_r, kx = ck + (pk - ck) * mu_k, v = cv + (pv - cv) * mu_v;
            pr = cr; pk = ck; pv = cv;
            const float w = -__logf(1.f + __expf(-(w0v + lw))) - 0.5f;
            const float decay = __expf(-__expf(w));
            const float a = 1.f / (1.f + __expf(-(a0v + la)));
            float kk = kx * kkv;
            const float nrm = sqrtf(wave_sum(kk * kk));
            kk = kk / fmaxf(nrm, 1e-12f);
            const float km = kx * (1.f + (a - 1.f) * kav);
            const float sbv = wave_sum(r * km * rkv);
            if (lane == 0) SB[m * 8 + h] = sbv;
            LAS float* q = wl + tt * 384;
            q[lane] = -kk; q[64 + lane] = kk * a; q[128 + lane] = decay; q[192 + lane] = km; q[256 + lane] = r; q[320 + lane] = v;
        }
        LDS_WAIT(); asm volatile("" ::: "memory");
#pragma unroll 1
        for (int tt = 0; tt < 8; ++tt) {
            const LAS float* q = wl + tt * 384;
            const LAS f32x4* q4 = (const LAS f32x4*)q;
            f32x2 sa0 = {0.f, 0.f}, sa1 = {0.f, 0.f}, sa2 = {0.f, 0.f}, sa3 = {0.f, 0.f};
            f32x4 ca[4], na[4];
#pragma unroll
            for (int i = 0; i < 4; ++i) ca[i] = q4[i];
            f32x4 c0[4], c1[4];
#pragma unroll
            for (int g = 0; g < 4; ++g) {
                if (g < 3) {
#pragma unroll
                    for (int i = 0; i < 4; ++i) na[i] = q4[4 * (g + 1) + i];
                } else {
#pragma unroll
                    for (int i = 0; i < 4; ++i) { c0[i] = q4[16 * (i + 1)]; c1[i] = q4[16 * (i + 1) + 1]; }
                }
#pragma unroll
                for (int i = 0; i < 4; ++i) { const int kb = 4 * g + i; const f32x4 al = ca[i];
                    sa0 += S[4 * kb] * al.x; sa1 += S[4 * kb + 1] * al.y; sa2 += S[4 * kb + 2] * al.z; sa3 += S[4 * kb + 3] * al.w; }
                if (g < 3) {
#pragma unroll
                    for (int i = 0; i < 4; ++i) ca[i] = na[i];
                }
            }
            const f32x2 sa = (sa0 + sa1) + (sa2 + sa3);
            f32x2 vv; vv.x = 0.f; vv.y = q[320 + lane];
            f32x2 o0 = {0.f, 0.f}, o1 = {0.f, 0.f}, o2 = {0.f, 0.f}, o3 = {0.f, 0.f};
#pragma unroll
            for (int kb = 0; kb < 16; ++kb) {
                f32x4 n2[4];
                if (kb + 2 < 16) {
#pragma unroll
                    for (int i = 0; i < 4; ++i) n2[i] = q4[16 * (i + 1) + kb + 2];
                }
                const f32x4 be = c0[0], w = c0[1], km = c0[2], rr = c0[3];
                S[4 * kb] = S[4 * kb] * w.x + (sa * be.x + vv * km.x); o0 += S[4 * kb] * rr.x;
                S[4 * kb + 1] = S[4 * kb + 1] * w.y + (sa * be.y + vv * km.y); o1 += S[4 * kb + 1] * rr.y;
                S[4 * kb + 2] = S[4 * kb + 2] * w.z + (sa * be.z + vv * km.z); o2 += S[4 * kb + 2] * rr.z;
                S[4 * kb + 3] = S[4 * kb + 3] * w.w + (sa * be.w + vv * km.w); o3 += S[4 * kb + 3] * rr.w;
#pragma unroll
                for (int i = 0; i < 4; ++i) { c0[i] = c1[i]; if (kb + 2 < 16) c1[i] = n2[i]; }
            }
            const f32x2 o = (o0 + o1) + (o2 + o3);
            const size_t m = m0 + s8 * 8 + tt;
            QHAT[m * 512 + ch] = f2bf(o.x); OLOC[m * 512 + ch] = f2bf(o.y);
        }
        LDS_WAIT(); asm volatile("" ::: "memory");
    }
    int lane2 = lane; asm volatile("" : "+v"(lane2) :: "memory");
    bf16* PC = (bf16*)((unsigned char*)F.out + DO_PC) + (size_t)unit * 4096 + lane2; bf16* QCT = (bf16*)((unsigned char*)F.out + DO_QCT) + (size_t)unit * 4096 + lane2 * 64;
#pragma unroll
    for (int k = 0; k < 64; ++k) PC[k * 64] = f2bf(S[k].x);
#pragma unroll
    for (int k = 0; k < 64; k += 8) { v4u o; o.x = pk2(S[k].y, S[k + 1].y); o.y = pk2(S[k + 2].y, S[k + 3].y); o.z = pk2(S[k + 4].y, S[k + 5].y); o.w = pk2(S[k + 6].y, S[k + 7].y);
        *(v4u*)(QCT + k) = o; }
}
__device__ __forceinline__ void phase_lrulocal(Frame& F, bool dry = false) {
    const int gw = F.vcu * NWAVES + F.wave, NGW = F.G * NWAVES, lane = F.lane;
    {
        const bf16* GT = (const bf16*)(F.ws + WS_LOGA); bf16* GO = dry ? (bf16*)(F.ws + WS_OLOC) : (bf16*)(F.ws + WS_LOGA); const bf16* XC = (const bf16*)(F.ws + WS_XC);
        float* LA = (float*)(F.ws + WS_LRUA); float* LB = (float*)(F.ws + WS_LRUB);
        for (int task = gw; task < 4 * 128 * 8; task += NGW) { const int cg = task & 7, bc = task >> 3, ch = cg * 64 + lane;
            const float bav = F.in[9][ch], biv = F.in[11][ch], sp = -8.f * softplusf_(-F.in[12][ch]);
            const size_t m0 = (size_t)bc * 64; float sl = 0.f, hl = 0.f;
#pragma unroll 1
            for (int t8 = 0; t8 < 64; t8 += 8) {
                bf16 g0[8], g1[8], x8[8];
#pragma unroll
                for (int u = 0; u < 8; ++u) { const size_t m = m0 + t8 + u; g0[u] = GT[m * 1024 + ch]; g1[u] = GT[m * 1024 + 512 + ch]; x8[u] = XC[m * 512 + ch]; }
#pragma unroll
                for (int u = 0; u < 8; ++u) { const size_t m = m0 + t8 + u;
                    const float ra = bf2f(g0[u]) + bav, ia = bf2f(g1[u]) + biv, xc = bf2f(x8[u]);
                    const float r = sigmoidf_(ra), ig = sigmoidf_(ia);
                    const bf16 lab = f2bf(r * sp); const float la = bf2f(lab);
                    const bf16 bbb = f2bf(sqrtf(fmaxf(-expm1f(2.f * la), 0.f)) * (ig * xc)); const float bb = bf2f(bbb);
                    GO[m * 1024 + ch] = lab; GO[m * 1024 + 512 + ch] = bbb;
                    sl += la; hl = __expf(la) * hl + bb; }
            }
            LA[bc * 512 + ch] = sl; LB[bc * 512 + ch] = hl; }
    }
}
__device__ __forceinline__ void phase_rwkvlocal(Frame& F) {
    const int gw = F.vcu * NWAVES + F.wave, NGW = F.G * NWAVES;
    {
        LAS float* wl = (LAS float*)(F.lds + RING_OFF + F.wave * 12288);
        for (int unit = gw; unit < 4096; unit += NGW) rwkv_prepass_unit(F, unit, wl);
    }
}

typedef short bf16x8_t __attribute__((ext_vector_type(8)));
typedef float f32x16 __attribute__((ext_vector_type(16)));
typedef __bf16 bf16x2n_t __attribute__((ext_vector_type(2)));
typedef float f32x2c_t __attribute__((ext_vector_type(2)));
__device__ __forceinline__ unsigned pkbf(float a, float b) { f32x2c_t v = {a, b}; bf16x2n_t r = __builtin_convertvector(v, bf16x2n_t); return __builtin_bit_cast(unsigned, r); }
__device__ __forceinline__ bf16 bf1(float a) { return (bf16)(pkbf(a, 0.f) & 0xffffu); }
constexpr int U_AT = 0, U_RT = 4096, U_BT = 8192, U_KT = 12288, U_BH = 16384, U_KH = 20480, U_VT = 24576, U_LM = 28672, U_G31 = 32768, UNIT_LDS = 33024;
__device__ __forceinline__ int a64(int row, int col) { return row * 128 + (((col >> 3) ^ (row & 7)) << 4) + ((col & 7) << 1); }
__device__ __forceinline__ int a32(int row, int col) { return row * 64 + (((col >> 2) ^ ((row >> 2) & 7)) << 3) + ((col & 3) << 1); }
__device__ __forceinline__ int crow_(int i, int h) { return (i & 3) + 8 * (i >> 2) + 4 * h; }
#define MFMA32(a, b, c) __builtin_amdgcn_mfma_f32_32x32x16_bf16((a), (b), (c), 0, 0, 0)
__device__ __forceinline__ bf16x8_t pack8(const f32x16& x, int s) {
    v4u p; p.x = pkbf(x[8 * s], x[8 * s + 1]); p.y = pkbf(x[8 * s + 2], x[8 * s + 3]); p.z = pkbf(x[8 * s + 4], x[8 * s + 5]); p.w = pkbf(x[8 * s + 6], x[8 * s + 7]);
    return __builtin_bit_cast(bf16x8_t, p); }
__device__ __forceinline__ bf16x8_t ld2x8(const LAS unsigned char* p0, const LAS unsigned char* p1) {
    const v2u lo = *(const LAS v2u*)p0, hi = *(const LAS v2u*)p1; v4u p; p.x = lo.x; p.y = lo.y; p.z = hi.x; p.w = hi.y; return __builtin_bit_cast(bf16x8_t, p); }

__device__ __forceinline__ void phase_rwkvlocal_mfma(Frame& F) {
    int lane = F.lane; asm volatile("" : "+v"(lane));
    const int wave = F.wave, u4 = wave >> 1, wh = wave & 1;
    LAS unsigned char* ub = F.lds + RING_OFF + u4 * UNIT_LDS;
    const bf16* P = (const bf16*)(F.ws + WS_P); const bf16* LWA = (const bf16*)((const unsigned char*)F.out + DO_LWA);
    bf16* OLOC = (bf16*)(F.ws + WS_OLOC); bf16* QHAT = (bf16*)(F.ws + WS_QHAT); float* SB = (float*)(F.ws + WS_SB);
    const float* mu = F.in[14];
    unsigned long long tacc_p = 0, tacc_c = 0;
#pragma unroll 1
    for (int ui = F.vcu; ui < 1024; ui += F.G) {
        const int unit = ui * 4 + u4, c = unit & 127, bhd = unit >> 7, hd = bhd & 7, b = bhd >> 3;
        const size_t m0 = (size_t)b * T + (size_t)c * 64;
        f32x16 S[2][2];
        { int r = lane & 31, h = lane >> 5; asm volatile("" : "+v"(r), "+v"(h));
#pragma unroll
        for (int jt = 0; jt < 2; ++jt)
#pragma unroll
            for (int kt = 0; kt < 2; ++kt)
#pragma unroll
                for (int i = 0; i < 16; ++i) S[jt][kt][i] = (wh == 0 && jt == kt && crow_(i, h) == r) ? 1.f : 0.f;
        }
#pragma unroll 1
        for (int sc = 0; sc < 2; ++sc) {
            const size_t ms = m0 + 32 * sc;
            const unsigned long long tp0 = TIMER_A >= 0 ? __builtin_amdgcn_s_memrealtime() : 0ull;
            {
                int lanep = lane; asm volatile("" : "+v"(lanep));
                const int ch = hd * 64 + lanep;
                const float mu_r = mu[ch], mu_k = mu[512 + ch], mu_v = mu[1024 + ch];
                const float w0v = F.in[15][ch], a0v = F.in[17][ch], kkv = F.in[20][ch], kav = F.in[21][ch], rkv = F.in[22][ch];
                const size_t mb = ms + 16 * wh;
                bf16 p3[3] = {0, 0, 0};
                if ((mb % T) != 0) { const bf16* row = P + (mb - 1) * PW; p3[0] = row[C_R + ch]; p3[1] = row[C_K + ch]; p3[2] = row[C_V + ch]; }
                float cc = 0.f;
                if (wh) {
#pragma unroll 1
                    for (int t8 = 0; t8 < 16; t8 += 8) { bf16 lw8[8];
#pragma unroll
                        for (int t = 0; t < 8; ++t) lw8[t] = LWA[(ms + t8 + t) * 1024 + ch];
#pragma unroll
                        for (int t = 0; t < 8; ++t) { const float w = -__logf(1.f + __expf(-(w0v + bf2f(lw8[t])))) - 0.5f; cc -= __expf(w); } }
                }
                float pr = bf2f(p3[0]), pk = bf2f(p3[1]), pv = bf2f(p3[2]);
                float sbkeep = 0.f, gprev = __expf(cc);
#pragma unroll 1
                for (int t8 = 0; t8 < 16; t8 += 8) {
                    bf16 qr[8], qk[8], qv[8], qw[8], qa[8];
#pragma unroll
                    for (int u = 0; u < 8; ++u) { const size_t m = mb + t8 + u; const bf16* row = P + m * PW;
                        qr[u] = row[C_R + ch]; qk[u] = row[C_K + ch]; qv[u] = row[C_V + ch]; qw[u] = LWA[m * 1024 + ch]; qa[u] = LWA[m * 1024 + 512 + ch]; }
#pragma unroll
                    for (int u = 0; u < 8; ++u) {
                        const int tt = t8 + u, t = 16 * wh + tt;
                        const float cr = bf2f(qr[u]), ck = bf2f(qk[u]), cv = bf2f(qv[u]);
                        const float lw = bf2f(qw[u]), la = bf2f(qa[u]);
                        const float rr = cr + (pr - cr) * mu_r, kx = ck + (pk - ck) * mu_k, v = cv + (pv - cv) * mu_v;
                        pr = cr; pk = ck; pv = cv;
                        const float w = -__logf(1.f + __expf(-(w0v + lw))) - 0.5f;
                        cc -= __expf(w);
                        const float a = __builtin_amdgcn_rcpf(1.f + __expf(-(a0v + la)));
                        float kk = kx * kkv;
                        const float nrm = sqrtf(wave_sum(kk * kk));
                        kk = kk * __builtin_amdgcn_rcpf(fmaxf(nrm, 1e-12f));
                        const float km = kx * (1.f + (a - 1.f) * kav);
                        const float sbv = wave_sum(rr * km * rkv);
                        if (lanep == tt) sbkeep = sbv;
                        const float gp = gprev, g = __expf(cc), ig = __builtin_amdgcn_rcpf(g);
                        gprev = g;
                        const float be = kk * a;
                        *(LAS bf16*)(ub + U_AT + a64(t, lanep)) = bf1(-kk * gp);
                        *(LAS bf16*)(ub + U_RT + a64(t, lanep)) = bf1(rr * g);
                        *(LAS bf16*)(ub + U_BT + a64(t, lanep)) = bf1(be * ig);
                        *(LAS bf16*)(ub + U_KT + a64(t, lanep)) = bf1(km * ig);
                        *(LAS bf16*)(ub + U_BH + a32(lanep, t)) = bf1(be * ig);
                        *(LAS bf16*)(ub + U_KH + a32(lanep, t)) = bf1(km * ig);
                        *(LAS bf16*)(ub + U_VT + a32(lanep, t)) = bf1(v);
                    }
                }
                if (lanep < 16) SB[(mb + lanep) * 8 + hd] = sbkeep;
                if (wh) *(LAS float*)(ub + U_G31 + lanep * 4) = gprev;
            }
            asm volatile("s_waitcnt lgkmcnt(0)" ::: "memory"); __builtin_amdgcn_s_barrier(); asm volatile("" ::: "memory");
            const unsigned long long tp1 = TIMER_A >= 0 ? __builtin_amdgcn_s_memrealtime() : 0ull;
            {
                int r = lane & 31, h = lane >> 5; asm volatile("" : "+v"(r), "+v"(h));
                bf16x8_t fT[2], fAk[2], fRb[2], fRk[2];
                {
                    f32x16 M, MT, R, RT;
#pragma unroll
                    for (int i = 0; i < 16; ++i) { M[i] = 0.f; MT[i] = 0.f; }
#pragma unroll
                    for (int ks = 0; ks < 4; ++ks) { const int o = a64(r, 16 * ks + 8 * h);
                        const bf16x8_t fb = *(const LAS bf16x8_t*)(ub + U_BT + o), fa = *(const LAS bf16x8_t*)(ub + U_AT + o);
                        M = MFMA32(fb, fa, M); MT = MFMA32(fa, fb, MT); }
#pragma unroll
                    for (int i = 0; i < 16; ++i) { const int q = crow_(i, h); M[i] = (q < r) ? M[i] : 0.f; MT[i] = (r < q) ? MT[i] : 0.f;
                        R[i] = M[i] + ((q == r) ? 1.f : 0.f); RT[i] = MT[i] + ((q == r) ? 1.f : 0.f); }
#pragma unroll
                    for (int lvl = 0; lvl < 4; ++lvl) {
                        bf16x8_t pm[2], pmt[2];
#pragma unroll
                        for (int ks = 0; ks < 2; ++ks) { pm[ks] = pack8(M, ks); pmt[ks] = pack8(MT, ks); }
                        f32x16 M2, MT2;
#pragma unroll
                        for (int i = 0; i < 16; ++i) { M2[i] = 0.f; MT2[i] = 0.f; }
#pragma unroll
                        for (int ks = 0; ks < 2; ++ks) { M2 = MFMA32(pmt[ks], pm[ks], M2); MT2 = MFMA32(pm[ks], pmt[ks], MT2); }
                        M = M2; MT = MT2;
                        bf16x8_t pr[2], prt[2];
#pragma unroll
                        for (int ks = 0; ks < 2; ++ks) { pm[ks] = pack8(M, ks); pr[ks] = pack8(R, ks); prt[ks] = pack8(RT, ks); }
#pragma unroll
                        for (int ks = 0; ks < 2; ++ks) { R = MFMA32(prt[ks], pm[ks], R); RT = MFMA32(pm[ks], prt[ks], RT); }
                        (void)pr;
                    }
#pragma unroll
                    for (int ks = 0; ks < 2; ++ks) fT[ks] = pack8(R, ks);
                }
                __builtin_amdgcn_sched_barrier(0);
                {
                    f32x16 Xak, Xrb, Xrk;
#pragma unroll
                    for (int i = 0; i < 16; ++i) { Xak[i] = 0.f; Xrb[i] = 0.f; Xrk[i] = 0.f; }
#pragma unroll
                    for (int ks = 0; ks < 4; ++ks) { const int o = a64(r, 16 * ks + 8 * h);
                        const bf16x8_t fb = *(const LAS bf16x8_t*)(ub + U_BT + o), fk = *(const LAS bf16x8_t*)(ub + U_KT + o);
                        const bf16x8_t fa = *(const LAS bf16x8_t*)(ub + U_AT + o), fr = *(const LAS bf16x8_t*)(ub + U_RT + o);
                        Xak = MFMA32(fk, fa, Xak); Xrb = MFMA32(fb, fr, Xrb); Xrk = MFMA32(fk, fr, Xrk); }
#pragma unroll
                    for (int i = 0; i < 16; ++i) { const int s = crow_(i, h); Xak[i] = (s < r) ? Xak[i] : 0.f; Xrb[i] = (s <= r) ? Xrb[i] : 0.f; Xrk[i] = (s <= r) ? Xrk[i] : 0.f; }
#pragma unroll
                    for (int ks = 0; ks < 2; ++ks) { fAk[ks] = pack8(Xak, ks); fRb[ks] = pack8(Xrb, ks); fRk[ks] = pack8(Xrk, ks); }
                }
#pragma unroll
                for (int jt = 0; jt < 2; ++jt) {
                    __builtin_amdgcn_sched_barrier(0);
                    bf16x8_t sf[2][2], vf[2];
#pragma unroll
                    for (int kt = 0; kt < 2; ++kt)
#pragma unroll
                        for (int ks = 0; ks < 2; ++ks) sf[kt][ks] = pack8(S[jt][kt], ks);
                    if (wh) {
#pragma unroll
                        for (int ks = 0; ks < 2; ++ks) vf[ks] = ld2x8(ub + U_VT + a32(32 * jt + r, 16 * ks + 4 * h), ub + U_VT + a32(32 * jt + r, 16 * ks + 8 + 4 * h));
                    }
                    f32x16 X1, Uu, Oo;
#pragma unroll
                    for (int i = 0; i < 16; ++i) { X1[i] = 0.f; Uu[i] = 0.f; Oo[i] = 0.f; }
#pragma unroll
                    for (int kt = 0; kt < 2; ++kt)
#pragma unroll
                        for (int ks = 0; ks < 2; ++ks) { const int c0 = 32 * kt + 16 * ks + 4 * h;
                            X1 = MFMA32(ld2x8(ub + U_AT + a64(r, c0), ub + U_AT + a64(r, c0 + 8)), sf[kt][ks], X1);
                            Oo = MFMA32(ld2x8(ub + U_RT + a64(r, c0), ub + U_RT + a64(r, c0 + 8)), sf[kt][ks], Oo); }
                    if (wh) {
#pragma unroll
                        for (int ks = 0; ks < 2; ++ks) { X1 = MFMA32(fAk[ks], vf[ks], X1); Oo = MFMA32(fRk[ks], vf[ks], Oo); }
                    }
                    __builtin_amdgcn_sched_barrier(0);
#pragma unroll
                    for (int ks = 0; ks < 2; ++ks) Uu = MFMA32(fT[ks], pack8(X1, ks), Uu);
                    bf16x8_t uf[2];
#pragma unroll
                    for (int ks = 0; ks < 2; ++ks) { uf[ks] = pack8(Uu, ks); Oo = MFMA32(fRb[ks], uf[ks], Oo); }
                    { bf16* dst = (wh ? OLOC : QHAT) + ms * 512 + hd * 64 + 32 * jt + r;
#pragma unroll
                      for (int i = 0; i < 16; ++i) dst[(size_t)crow_(i, h) * 512] = bf1(Oo[i]); }
                    __builtin_amdgcn_sched_barrier(0);
#pragma unroll
                    for (int kt = 0; kt < 2; ++kt) {
#pragma unroll
                        for (int ks = 0; ks < 2; ++ks) { const int k = 32 * kt + r, t0 = 16 * ks + 4 * h;
                            S[jt][kt] = MFMA32(ld2x8(ub + U_BH + a32(k, t0), ub + U_BH + a32(k, t0 + 8)), uf[ks], S[jt][kt]);
                            if (wh) S[jt][kt] = MFMA32(ld2x8(ub + U_KH + a32(k, t0), ub + U_KH + a32(k, t0 + 8)), vf[ks], S[jt][kt]); }
#pragma unroll
                        for (int g = 0; g < 4; ++g) { const f32x4 gg = *(const LAS f32x4*)(ub + U_G31 + (32 * kt + 8 * g + 4 * h) * 4);
                            S[jt][kt][4 * g] *= gg.x; S[jt][kt][4 * g + 1] *= gg.y; S[jt][kt][4 * g + 2] *= gg.z; S[jt][kt][4 * g + 3] *= gg.w; }
                    }
                }
            }
            asm volatile("s_waitcnt lgkmcnt(0)" ::: "memory"); __builtin_amdgcn_s_barrier(); asm volatile("" ::: "memory");
            if (TIMER_A >= 0) { const unsigned long long tp2 = __builtin_amdgcn_s_memrealtime(); tacc_p += tp1 - tp0; tacc_c += tp2 - tp1; }
        }
        int r = lane & 31, h = lane >> 5; asm volatile("" : "+v"(r), "+v"(h));
        if (wh == 0) { bf16* PC = (bf16*)((unsigned char*)F.out + DO_PC) + (size_t)unit * 4096;
#pragma unroll
            for (int jt = 0; jt < 2; ++jt)
#pragma unroll
                for (int kt = 0; kt < 2; ++kt)
#pragma unroll
                    for (int i = 0; i < 16; ++i) PC[(32 * kt + crow_(i, h)) * 64 + 32 * jt + r] = bf1(S[jt][kt][i]);
        } else { bf16* QCT = (bf16*)((unsigned char*)F.out + DO_QCT) + (size_t)unit * 4096;
#pragma unroll
            for (int jt = 0; jt < 2; ++jt)
#pragma unroll
                for (int kt = 0; kt < 2; ++kt)
#pragma unroll
                    for (int g = 0; g < 4; ++g) { v2u o; o.x = pkbf(S[jt][kt][4 * g], S[jt][kt][4 * g + 1]); o.y = pkbf(S[jt][kt][4 * g + 2], S[jt][kt][4 * g + 3]);
                        *(v2u*)(QCT + (32 * jt + r) * 64 + 32 * kt + 8 * g + 4 * h) = o; }
        }
    }
    if (TIMER_A >= 0 && blockIdx.x == 0 && threadIdx.x == 0) { ((unsigned long long*)(F.ws + 8192))[30] = tacc_p; ((unsigned long long*)(F.ws + 8192))[31] = tacc_c; }
}

template <int V> __device__ __forceinline__ void rwkv_scan(Frame& F, int bh) {
    constexpr int LDT = 72;
    constexpr int SBUF = 64 * LDT;
    LAS bf16* S0 = (LAS bf16*)(F.lds + RING_OFF);
    const int lane = F.lane, w = F.wave, q = lane >> 4, l15 = lane & 15;
    for (int i = F.tid; i < 2 * SBUF; i += 512) S0[i] = 0;
    __syncthreads();
    if (w < 4) {
        const int tr = w;
        const bf16* PC = (const bf16*)((const unsigned char*)F.out + DO_PC) + (size_t)bh * 128 * 4096 + (16 * tr + l15) * 64 + 8 * q;
        const bf16* QCT = (const bf16*)((const unsigned char*)F.out + DO_QCT) + (size_t)bh * 128 * 4096 + l15 * 64 + 16 * tr + 4 * q;
        const int boff0 = l15 * LDT + 8 * q, woff0 = l15 * LDT + 16 * tr + 4 * q;
        bf16x8_t A[8][2]; v2u Qv[8][4];
#define SCAN_LOAD(s, cc) do { \
        asm volatile("global_load_dwordx4 %0, %1, off" : "=v"(A[s][0]) : "v"(PC + (size_t)(cc) * 4096) : "memory"); \
        asm volatile("global_load_dwordx4 %0, %1, off offset:64" : "=v"(A[s][1]) : "v"(PC + (size_t)(cc) * 4096) : "memory"); \
        asm volatile("global_load_dwordx2 %0, %1, off" : "=v"(Qv[s][0]) : "v"(QCT + (size_t)(cc) * 4096) : "memory"); \
        asm volatile("global_load_dwordx2 %0, %1, off offset:2048" : "=v"(Qv[s][1]) : "v"(QCT + (size_t)(cc) * 4096) : "memory"); \
        asm volatile("global_load_dwordx2 %0, %1, off" : "=v"(Qv[s][2]) : "v"(QCT + (size_t)(cc) * 4096 + 2048) : "memory"); \
        asm volatile("global_load_dwordx2 %0, %1, off offset:2048" : "=v"(Qv[s][3]) : "v"(QCT + (size_t)(cc) * 4096 + 2048) : "memory"); } while (0)
#pragma unroll
        for (int s = 0; s < 8; ++s) SCAN_LOAD(s, s);
        if (V == 0) TSTAMP(F, 22); else TSTAMP(F, 26);
#pragma unroll 1
        for (int c0 = 0; c0 < 128; c0 += 8) {
#pragma unroll
            for (int s = 0; s < 8; ++s) {
                const int c = c0 + s;
                const LAS bf16* Sr = S0 + (s & 1) * SBUF; LAS bf16* Sw = S0 + ((s & 1) ^ 1) * SBUF;
                if (V != 3) asm volatile("s_waitcnt vmcnt(42)" : "+v"(A[s][0]), "+v"(A[s][1]), "+v"(Qv[s][0]), "+v"(Qv[s][1]), "+v"(Qv[s][2]), "+v"(Qv[s][3]) :: "memory");
                pg8::f32x4 acc[4];
#pragma unroll
                for (int t = 0; t < 4; ++t) { acc[t][0] = bflo(Qv[s][t].x); acc[t][1] = bfhi(Qv[s][t].x); acc[t][2] = bflo(Qv[s][t].y); acc[t][3] = bfhi(Qv[s][t].y); }
#pragma unroll
                for (int ks = 0; ks < 2; ++ks)
#pragma unroll
                    for (int t = 0; t < 4; ++t) {
                        if (V != 4) { const bf16x8_t bh_ = *(const LAS bf16x8_t*)(Sr + boff0 + 16 * LDT * t + 32 * ks);
                        acc[t] = __builtin_amdgcn_mfma_f32_16x16x32_bf16(A[s][ks], bh_, acc[t], 0, 0, 0); }
                    }
                if (V != 3) { const int cn = (c + 8 < 128) ? c + 8 : 127; SCAN_LOAD(s, cn); }
#pragma unroll
                for (int t = 0; t < 4; ++t) { v2u oh; oh.x = pg8::cvt_pk_bf16(acc[t][0], acc[t][1]); oh.y = pg8::cvt_pk_bf16(acc[t][2], acc[t][3]);
                    *(LAS v2u*)(Sw + woff0 + 16 * LDT * t) = oh; }
                asm volatile("s_waitcnt lgkmcnt(0)" ::: "memory"); __builtin_amdgcn_s_barrier(); asm volatile("" ::: "memory");
            }
        }
#undef SCAN_LOAD
        if (V == 0) TSTAMP(F, 23); else TSTAMP(F, 27);
        asm volatile("s_waitcnt vmcnt(0)" ::: "memory");
    } else {
        const int t256 = F.tid - 256;
        bf16* HIN = (V == 0 ? (bf16*)((unsigned char*)F.out + DO_HIN) : (bf16*)(F.ws + WS_XC)) + (size_t)bh * 128 * 4096 + (t256 >> 2) * 64 + (t256 & 3) * 16;
        const int hoff = (t256 >> 2) * LDT + (t256 & 3) * 16;
#pragma unroll 1
        for (int c = 0; c < 128; ++c) {
            const LAS bf16* Sr = S0 + (c & 1) * SBUF;
            const v4u x0 = *(const LAS v4u*)(Sr + hoff), x1 = *(const LAS v4u*)(Sr + hoff + 8);
            if (V != 2) { *(v4u*)(HIN + (size_t)c * 4096) = x0; *(v4u*)(HIN + (size_t)c * 4096 + 8) = x1; }
            asm volatile("s_waitcnt lgkmcnt(0)" ::: "memory"); __builtin_amdgcn_s_barrier(); asm volatile("" ::: "memory");
        }
    }
}
__device__ __forceinline__ void phase_scan(Frame& F, int flags) {
    if ((flags & 4) && blockIdx.x >= 36) { TSTAMP_B(F, 36, 24); expert_transposes(F, ((int)blockIdx.x - 36) * NWAVES + F.wave, ((int)F.G - 36) * NWAVES); __syncthreads(); TSTAMP_B(F, 36, 25); }
#ifndef SCAN_VARIANT
#define SCAN_VARIANT 0
#endif
    if ((flags & 2) && blockIdx.x < 32) { rwkv_scan<0>(F, blockIdx.x); if (SCAN_VARIANT) { __syncthreads(); rwkv_scan<SCAN_VARIANT>(F, blockIdx.x); } }
    if ((flags & 1) && blockIdx.x >= 32 && blockIdx.x < 36) {
        const int idx = (blockIdx.x - 32) * 512 + F.tid, b = idx >> 9, ch = idx & 511;
        const float* LA = (const float*)(F.ws + WS_LRUA); const float* LB = (const float*)(F.ws + WS_LRUB); float* LH = (float*)(F.ws + WS_LRUH);
        float h = 0.f;
#pragma unroll 1
        for (int c16 = 0; c16 < 128; c16 += 16) { float a16[16], b16[16];
#pragma unroll
            for (int u = 0; u < 16; ++u) { const int o = (b * 128 + c16 + u) * 512 + ch; a16[u] = LA[o]; b16[u] = LB[o]; }
#pragma unroll
            for (int u = 0; u < 16; ++u) { const int o = (b * 128 + c16 + u) * 512 + ch; LH[o] = h; h = __expf(a16[u]) * h + b16[u]; } }
    }
}

__device__ __forceinline__ void rwkv_post_unit(Frame& F, int unit) {
    int lane = F.lane; asm volatile("" : "+v"(lane));
    const int c = unit & 127, bh = unit >> 7, h = bh & 7, b = bh >> 3, q = lane >> 4, l15 = lane & 15;
    const size_t m0 = (size_t)b * T + (size_t)c * 64;
    const bf16* QHAT = (const bf16*)(F.ws + WS_QHAT); const bf16* OLOC = (const bf16*)(F.ws + WS_OLOC); const bf16* GG = (const bf16*)(F.ws + WS_GG);
    const bf16* HIN = (const bf16*)((const unsigned char*)F.out + DO_HIN) + (size_t)unit * 4096; const bf16* P = (const bf16*)(F.ws + WS_P);
    const float* SB = (const float*)(F.ws + WS_SB); bf16* YMIX = (bf16*)(F.ws + WS_YMIX);
    bf16x8_t Af[4][2];
#pragma unroll
    for (int jt = 0; jt < 4; ++jt)
#pragma unroll
        for (int ks = 0; ks < 2; ++ks) Af[jt][ks] = *(const bf16x8_t*)(HIN + (16 * jt + l15) * 64 + 32 * ks + 8 * q);
    f32x4 lnw[4], lnb[4], muv[4];
#pragma unroll
    for (int jt = 0; jt < 4; ++jt) { const int ch = h * 64 + 16 * jt + 4 * q; lnw[jt] = *(const f32x4*)(F.in[23] + ch); lnb[jt] = *(const f32x4*)(F.in[24] + ch); muv[jt] = *(const f32x4*)(F.in[14] + 1024 + ch); }
#pragma unroll 1
    for (int tt = 0; tt < 4; ++tt) {
        const size_t m = m0 + 16 * tt + l15;
        bf16x8_t Bf[2];
#pragma unroll
        for (int ks = 0; ks < 2; ++ks) Bf[ks] = *(const bf16x8_t*)(QHAT + m * 512 + h * 64 + 32 * ks + 8 * q);
        pg8::f32x4 acc[4];
#pragma unroll
        for (int jt = 0; jt < 4; ++jt) { const v2u o = *(const v2u*)(OLOC + m * 512 + h * 64 + 16 * jt + 4 * q); acc[jt][0] = bflo(o.x); acc[jt][1] = bfhi(o.x); acc[jt][2] = bflo(o.y); acc[jt][3] = bfhi(o.y); }
#pragma unroll
        for (int ks = 0; ks < 2; ++ks)
#pragma unroll
            for (int jt = 0; jt < 4; ++jt) acc[jt] = __builtin_amdgcn_mfma_f32_16x16x32_bf16(Af[jt][ks], Bf[ks], acc[jt], 0, 0, 0);
        float s = 0.f;
#pragma unroll
        for (int jt = 0; jt < 4; ++jt) s += (acc[jt][0] + acc[jt][1]) + (acc[jt][2] + acc[jt][3]);
        s += __shfl_xor(s, 16); s += __shfl_xor(s, 32);
        const float mean = s * (1.f / 64.f);
        float vs = 0.f;
#pragma unroll
        for (int jt = 0; jt < 4; ++jt)
#pragma unroll
            for (int i = 0; i < 4; ++i) { acc[jt][i] -= mean; vs += acc[jt][i] * acc[jt][i]; }
        vs += __shfl_xor(vs, 16); vs += __shfl_xor(vs, 32);
        const float rstd = rsqrtf(vs * (1.f / 64.f) + 64e-5f);
        const float sbv = SB[m * 8 + h];
        const bool first = ((m % T) == 0);
#pragma unroll
        for (int jt = 0; jt < 4; ++jt) { const int ch = h * 64 + 16 * jt + 4 * q;
            const v2u cvq = *(const v2u*)(P + m * PW + C_V + ch); v2u pvq = {0u, 0u}; if (!first) pvq = *(const v2u*)(P + (m - 1) * PW + C_V + ch);
            const v2u gq = *(const v2u*)(GG + m * 512 + ch);
            const float cv[4] = {bflo(cvq.x), bfhi(cvq.x), bflo(cvq.y), bfhi(cvq.y)}, pv[4] = {bflo(pvq.x), bfhi(pvq.x), bflo(pvq.y), bfhi(pvq.y)}, gg[4] = {bflo(gq.x), bfhi(gq.x), bflo(gq.y), bfhi(gq.y)};
            float y[4];
#pragma unroll
            for (int i = 0; i < 4; ++i) { const float v = cv[i] + (pv[i] - cv[i]) * muv[jt][i]; y[i] = (acc[jt][i] * rstd * lnw[jt][i] + lnb[jt][i] + sbv * v) * gg[i]; }
            v2u o; o.x = pk2(y[0], y[1]); o.y = pk2(y[2], y[3]);
            *(v2u*)(YMIX + m * D + 512 + ch) = o; }
    }
}
__device__ __forceinline__ void phase_post(Frame& F, int flags) {
    const int gw = F.vcu * NWAVES + F.wave, NGW = F.G * NWAVES, lane = F.lane;
    if (flags & 2) for (int unit = gw; unit < 4096; unit += NGW) rwkv_post_unit(F, unit);
    if (flags & 1) {
        const bf16* GT = (const bf16*)(F.ws + WS_LOGA); const bf16* P = (const bf16*)(F.ws + WS_P);
        const float* LH = (const float*)(F.ws + WS_LRUH); bf16* YMIX = (bf16*)(F.ws + WS_YMIX); const float* ng = F.in[13];
        for (int task = gw; task < 4 * 128 * 8; task += NGW) { const int cg = task & 7, bc = task >> 3, ch = cg * 64 + lane;
            const size_t m0 = (size_t)bc * 64; float hl = LH[bc * 512 + ch]; const float g = ng[ch];
#pragma unroll 1
            for (int t8 = 0; t8 < 64; t8 += 8) {
                bf16 g0[8], g1[8], p8[8];
#pragma unroll
                for (int u = 0; u < 8; ++u) { const size_t m = m0 + t8 + u; g0[u] = GT[m * 1024 + ch]; g1[u] = GT[m * 1024 + 512 + ch]; p8[u] = P[m * PW + C_GATE + ch]; }
#pragma unroll
                for (int u = 0; u < 8; ++u) { const size_t m = m0 + t8 + u;
                    const float la = bf2f(g0[u]), bb = bf2f(g1[u]); hl = __expf(la) * hl + bb;
                    float y = hl * gelu_tanh(bf2f(p8[u]));
                    const float ss = wave_sum(y * y) * (1.f / 64.f);
                    YMIX[m * D + ch] = f2bf(y * rsqrtf(ss + 1e-6f) * g); }
            }
        }
    }
}

struct Args { const float* in[35]; float* out; unsigned char* ws; int ph_lo, ph_hi, flags, pad; };
__global__ void __launch_bounds__(NWAVES * 64, 2) mk_fwd(Args args) {
    extern __shared__ __attribute__((aligned(16))) unsigned char lds[];
    Frame F;
    F.lds = (LAS unsigned char*)lds;
    F.tid = threadIdx.x; F.lane = F.tid & 63; F.wave = __builtin_amdgcn_readfirstlane(F.tid >> 6);
    F.G = gridDim.x; { const int bx = blockIdx.x; F.vcu = (F.G % 8 == 0) ? (bx % 8) * (F.G / 8) + bx / 8 : bx; }
    F.in = args.in; F.out = args.out; F.ws = args.ws;
    const int lo = args.ph_lo, hi = args.ph_hi;
#define IN(k) (lo <= (k) && (k) < hi)
    const int flags = args.flags;
    for (int u = threadIdx.x; u < (LDS_BYTES - LDSCTL_OFF) / 4; u += NWAVES * 64) ((LAS unsigned*)(F.lds + LDSCTL_OFF))[u] = 0u;
    __syncthreads();
    XcdBarrier bar; bar.bar = (unsigned*)(args.ws + WS_CTL) + CW_BAR; bar.x = 0; bar.st = nullptr;
    if (hi - lo > 1) bar = xcd_barrier_post((unsigned*)(args.ws + WS_CTL) + CW_BAR, (volatile LAS unsigned*)(F.lds + MISC_OFF) + 8);
#define SEAM(k) if (IN(k) && IN((k) + 1)) { xcd_barrier(bar); TSTAMP(F, (k) + 1); }
#ifndef DUP_MASK
#define DUP_MASK 0
#endif
#define PH1(k, call) { int t_ = threadIdx.x; asm volatile("" : "+v"(t_)); F.tid = t_; F.lane = t_ & 63; F.wave = __builtin_amdgcn_readfirstlane(t_ >> 6); call; }
#define PH(k, bit, call) if (IN(k)) { PH1(k, call) if ((DUP_MASK >> (bit)) & 1) { xcd_barrier(bar); PH1(k, call) } }
    TSTAMP(F, 0);
    PH(0, 0, (phase0(F), p0_small_weights(F)))
    SEAM(0)
    PH(1, 1, phase1(F))
    SEAM(1)
    PH(2, 2, phase2(F))
    SEAM(2)
    PH(3, 3, phase_prepA(F))
    SEAM(3)
    PH(4, 4, phase_gategemm(F))
    PH(4, 5, phase_loragemm(F))
    SEAM(4)
    if ((DUP_MASK >> 6) & 1) { if (IN(5)) { PH1(5, phase_lrulocal(F, true)) xcd_barrier(bar); } }
    PH(5, 30, phase_lrulocal(F))
#ifndef RWKV_MFMA
#define RWKV_MFMA 1
#endif
    if (RWKV_MFMA) { PH(5, 7, phase_rwkvlocal_mfma(F)) } else { PH(5, 7, phase_rwkvlocal(F)) }
    SEAM(5)
    if ((DUP_MASK >> 8) & 1) { if (IN(6)) { PH1(6, phase_scan(F, 6)) xcd_barrier(bar); } }
    PH(6, 30, phase_scan(F, flags | 4))
    SEAM(6)
    PH(7, 9, phase_post(F, flags))
    SEAM(7)
    PH(8, 10, phase_outproj(F))
    SEAM(8)
    if ((DUP_MASK >> 11) & 1) { if (IN(9)) { PH1(9, phase_route(F)) xcd_barrier(bar); if (blockIdx.x == 0 && threadIdx.x < 32) ((int*)(args.ws + WS_CNT))[threadIdx.x * 64] = 0; xcd_barrier(bar); } }
    PH(9, 30, phase_route(F))
    SEAM(9)
    PH(10, 12, phase_m1(F))
    SEAM(10)
    PH(11, 13, phase_m2(F))
    SEAM(11)
    if ((DUP_MASK >> 14) & 1) { if (IN(12)) { PH1(12, phase_final(F, true)) xcd_barrier(bar); } }
    PH(12, 30, phase_final(F))
#undef SEAM
#undef PH
#undef PH1
#undef IN
}

extern "C" void kernel_launch(void* const* d_in, const int* in_sizes, int n_in, void* d_out, int out_size, void* d_ws, size_t ws_size, hipStream_t stream) {
    if (n_in != 35 || out_size != NTOK * D || ws_size < WS_END) { fprintf(stderr, "kernel_launch: unexpected shapes (n_in %d out %d ws %zu)\n", n_in, out_size, ws_size); return; }
    static int grid = 0;
    if (grid == 0) {
        int dev = 0, cus = 0;
        if (hipGetDevice(&dev) != hipSuccess || hipDeviceGetAttribute(&cus, hipDeviceAttributeMultiprocessorCount, dev) != hipSuccess) { grid = -1; return; }
        if (hipFuncSetAttribute((const void*)mk_fwd, hipFuncAttributeMaxDynamicSharedMemorySize, LDS_BYTES) != hipSuccess) { fprintf(stderr, "kernel_launch: hipFuncSetAttribute failed\n"); grid = -1; return; }
        int per_cu = 0;
        if (hipOccupancyMaxActiveBlocksPerMultiprocessor(&per_cu, (const void*)mk_fwd, NWAVES * 64, LDS_BYTES) != hipSuccess || per_cu < 1) { fprintf(stderr, "kernel_launch: occupancy query says %d blocks per CU\n", per_cu); (void)hipGetLastError(); }
        grid = cus;
    }
    if (grid < 0) return;
    const float* const* in = (const float* const*)d_in;
    char* ws = (char*)d_ws; float* out = (float*)d_out;
    Args a{};
    for (int i = 0; i < 35; ++i) a.in[i] = in[i];
    a.out = out; a.ws = (unsigned char*)d_ws;
    hipMemsetAsync(ws + WS_CTL, 0, 1 * MiB, stream);
#define LAUNCH_PH(p) do { a.ph_lo = (p); a.ph_hi = (p) + 1; hipLaunchKernelGGL(mk_fwd, dim3(grid), dim3(NWAVES * 64), LDS_BYTES, stream, a); } while (0)
#ifndef MIX_FLAGS
#define MIX_FLAGS 3
#endif
    a.flags = MIX_FLAGS;
#ifndef N_LAUNCHES
#define N_LAUNCHES 1
#endif
    if (N_LAUNCHES == 1) { a.ph_lo = 0; a.ph_hi = 13; hipLaunchKernelGGL(mk_fwd, dim3(grid), dim3(NWAVES * 64), LDS_BYTES, stream, a); }
    else { for (int p = 0; p < 13; ++p) LAUNCH_PH(p); }
}
```

```cpp
#include <hip/hip_runtime.h>
#include <stdint.h>
#include <cstdio>

#define SCAN_NOLO 1
#ifndef TIMER_A
#define TIMER_A -1
#define TIMER_B -1
#endif
#define TSTAMP(F_, i) do { if (TIMER_A >= 0 && blockIdx.x == 0 && threadIdx.x == 0) ((unsigned long long*)((F_).ws + 8192))[i] = __builtin_amdgcn_s_memrealtime(); } while (0)
#define TSTAMP_B(F_, blk, i) do { if (TIMER_A >= 0 && blockIdx.x == (blk) && threadIdx.x == 0) ((unsigned long long*)((F_).ws + 8192))[i] = __builtin_amdgcn_s_memrealtime(); } while (0)
#define TACCUM(F_, i, t0) do { if (TIMER_A >= 0 && blockIdx.x == 0 && threadIdx.x == 0) ((unsigned long long*)((F_).ws + 8192))[i] += __builtin_amdgcn_s_memrealtime() - (t0); } while (0)
typedef unsigned short bf16;
__device__ __forceinline__ bf16 f2bf(float f) { unsigned u = __float_as_uint(f); return (bf16)((u + 0x7fffu + ((u >> 16) & 1u)) >> 16); }
__device__ __forceinline__ float bf2f(bf16 b) { return __uint_as_float(((unsigned)b) << 16); }

constexpr int NB = 4, T = 8192, D = 1024, NTOK = NB * T;
constexpr int LRU_W = 512, RW = 512, PW = 2816;
constexpr int C_UX = 0, C_GATE = 512, C_R = 1024, C_K = 1536, C_V = 2048, C_WD = 2560, C_AD = 2624, C_GD = 2688;
constexpr int NE = 32, DE = 512;
constexpr size_t MiB = 1u << 20;
constexpr size_t WS_CTL = 0;
constexpr int CW_BAR = 4096;
constexpr size_t WS_CNT = 512 * 1024;
constexpr size_t WS_MOD = 1 * MiB;
constexpr size_t WS_SELW = 1 * MiB + 256 * 1024;
constexpr size_t WS_SEL = 1 * MiB + 512 * 1024;
constexpr size_t FW_WLORAT = 2 * MiB;
constexpr size_t FW_WGT = 3 * MiB;
constexpr size_t FW_WR = 3 * MiB + 512 * 1024;
constexpr size_t FW_WINT = 4 * MiB;
constexpr size_t FW_WOUTT = 10 * MiB;
constexpr size_t WS_LIST = 12 * MiB;
constexpr size_t WS_H = 16 * MiB;
constexpr size_t WS_YMIX = WS_H;
constexpr size_t WS_P = 80 * MiB;
constexpr size_t WS_HID = WS_P;
constexpr size_t WS_YS = 256 * MiB;
constexpr size_t FW_W13T = 416 * MiB;
constexpr size_t FW_W2T = 480 * MiB;
constexpr size_t WS_END = 512 * MiB;

__device__ __forceinline__ float wave_sum(float v) {
    v += __int_as_float(__builtin_amdgcn_update_dpp(0, __float_as_int(v), 0xB1, 0xF, 0xF, true));
    v += __int_as_float(__builtin_amdgcn_update_dpp(0, __float_as_int(v), 0x4E, 0xF, 0xF, true));
    v += __int_as_float(__builtin_amdgcn_update_dpp(0, __float_as_int(v), 0x141, 0xF, 0xF, true));
    v += __int_as_float(__builtin_amdgcn_update_dpp(0, __float_as_int(v), 0x140, 0xF, 0xF, true));
    const int vi = __float_as_int(v);
    const float r0 = __int_as_float(__builtin_amdgcn_readlane(vi, 0)), r1 = __int_as_float(__builtin_amdgcn_readlane(vi, 16));
    const float r2 = __int_as_float(__builtin_amdgcn_readlane(vi, 32)), r3 = __int_as_float(__builtin_amdgcn_readlane(vi, 48));
    return (r0 + r1) + (r2 + r3);
}
__device__ __forceinline__ float fexp(float x) { return __builtin_amdgcn_exp2f(x * 1.44269504089f); }
__device__ __forceinline__ float flog(float x) { return __builtin_amdgcn_logf(x) * 0.69314718056f; }
__device__ __forceinline__ float frcp(float x) { return __builtin_amdgcn_rcpf(x); }
__device__ __forceinline__ float sigmoidf_(float x) { return frcp(1.f + fexp(-x)); }
__device__ __forceinline__ float softplusf_(float x) { return x > 20.f ? x : flog(1.f + fexp(x)); }
__device__ __forceinline__ float ftanh(float u) { return 1.f - 2.f * frcp(1.f + fexp(2.f * u)); }
__device__ __forceinline__ float gelu_tanh(float x) { const float u = 0.7978845608028654f * (x + 0.044715f * x * x * x); return 0.5f * x * (1.f + ftanh(u)); }

namespace pg8 {
#define PG8_LAS __attribute__((address_space(3)))
typedef unsigned short bf16_t;
typedef short bf16x8 __attribute__((ext_vector_type(8)));
typedef float f32x4 __attribute__((ext_vector_type(4)));
typedef unsigned u32x4 __attribute__((ext_vector_type(4)));
constexpr int BM = 256, BK = 64, HALF = 128, HTB = HALF * BK * 2  , STAGE_BYTES = 8 * HTB, NXCD = 8, WGM = 8;

__host__ __device__ __forceinline__ int lds_byte(int r, int c) { const int st = (r >> 4) * 2 + (c >> 5), rr = r & 15, cc = c & 31, ob = rr * 64 + cc * 2; return st * 1024 + (ob ^ (((ob >> 9) & 1) << 5)); }
__host__ __device__ __forceinline__ void stage_rc(int b, int& R, int& C) { const int st = b / 1024, sb = b % 1024, swz = sb ^ (((sb >> 9) & 1) << 5); R = (st >> 1) * 16 + swz / 64; C = (st & 1) * 32 + (swz % 64) / 2; }
__host__ __device__ __forceinline__ int perm32(int rho) { const int n = rho >> 4, i = rho & 15; return 8 * (i >> 2) + 4 * n + (i & 3); }

struct Unit { int pm, pn, e, nrows, row0; };
struct Gemm { const bf16_t* A; const bf16_t* Bt; int lda, ldb, K; };

__device__ __forceinline__ unsigned cvt_pk_bf16(float lo, float hi) { unsigned r; asm volatile("v_cvt_pk_bf16_f32 %0, %1, %2" : "=v"(r) : "v"(lo), "v"(hi)); return r; }

struct DenseOrder {
    static constexpr bool GATHER = false;
    int nM, nN, nwg, G, c;
    __device__ void init(int M, int N, int G_, int c_) { nM = M / BM; nN = N / BM; nwg = nM * nN; G = G_; c = c_; }
    __device__ bool next(int i, Unit& u) const {
        const long L = (long)i * G + c; if (L >= nwg) return false;
        int wgid = (int)L; { const int q = nwg / NXCD, r = nwg % NXCD, xcd = wgid % NXCD, off = wgid / NXCD; wgid = (xcd < r ? xcd * (q + 1) : r * (q + 1) + (xcd - r) * q) + off; }
        const int nig = WGM * nN, gid = wgid / nig, fm = gid * WGM, gsz = (nM - fm) < WGM ? (nM - fm) : WGM;
        u.pm = fm + ((wgid % nig) % gsz); u.pn = (wgid % nig) / gsz; u.e = 0; u.nrows = 256; u.row0 = 0; return true;
    }
    __device__ __forceinline__ const char* a_base(const Gemm& g, const Unit& u) const { return (const char*)g.A + (size_t)u.pm * (BM * 2) * g.lda; }
    __device__ __forceinline__ const char* b_base(const Gemm& g, const Unit& u) const { return (const char*)g.Bt + (size_t)u.pn * (BM * 2) * g.ldb; }
    __device__ __forceinline__ int row(const Unit&, int) const { return 0; }
};

template <class Epi, class Sched>
__device__ __forceinline__ void gemm_phase(PG8_LAS unsigned char* lds, const Gemm g, const Sched& S, const Epi& E, const int tid) {
    const int wid = __builtin_amdgcn_readfirstlane(tid >> 6), lane = tid & 63, wr = wid >> 2, wc = wid & 3, fr = lane & 15, fq = lane >> 4;
    const int K = g.K, nt = K / BK;
    unsigned voffA[2], voffB[2]; int sR[2], sC[2];
#pragma unroll
    for (int i = 0; i < 2; ++i) { int R, C; stage_rc(tid * 16 + i * 8192, R, C); const int Rb = Epi::PERM ? ((R & ~31) + perm32(R & 31)) : R;
        voffA[i] = (unsigned)(R * g.lda + C) * 2u; voffB[i] = (unsigned)(Rb * g.ldb + C) * 2u; sR[i] = R; sC[i] = C; }
    const size_t kstep = (size_t)(BK * 2);
    const size_t hstepA = Sched::GATHER ? 0 : (size_t)HALF * g.lda * 2, hstepB = (size_t)HALF * g.ldb * 2;
    const unsigned ldsw = (unsigned)wid * 1024u;
    const int aoff = lds_byte(wr * 64 + fr, fq * 8), boff = lds_byte(wc * 32 + fr, fq * 8);
    unsigned gA[2][2], gN[2][2];
#define PG8_SA(b, h) (((b) * 2 + (h)) * HTB)
#define PG8_SB(b, h) ((4 + (b) * 2 + (h)) * HTB)
#define PG8_STAGE(bufoff, gbase, voff) do { _Pragma("unroll") for (int _i = 0; _i < 2; ++_i) \
        __builtin_amdgcn_global_load_lds((const unsigned*)((const char*)(gbase) + (voff)[_i]), (PG8_LAS unsigned*)(lds + (bufoff) + ldsw + _i * 8192), 16, 0, 0); } while (0)
#define PG8_STAGE_A(bufoff, kp, h, OFF) do { if constexpr (Sched::GATHER) PG8_STAGE(bufoff, kp, OFF[h]); else PG8_STAGE(bufoff, (kp) + (h) * hstepA, voffA); } while (0)
#define PG8_LDA(dst, b, h) do { _Pragma("unroll") for (int m = 0; m < 4; ++m) _Pragma("unroll") for (int k = 0; k < 2; ++k) dst[m][k] = *(const PG8_LAS bf16x8*)(lds + PG8_SA(b, h) + aoff + m * 2048 + k * 1024); } while (0)
#define PG8_LDB(dst, b, h) do { _Pragma("unroll") for (int n = 0; n < 2; ++n) _Pragma("unroll") for (int k = 0; k < 2; ++k) dst[n][k] = *(const PG8_LAS bf16x8*)(lds + PG8_SB(b, h) + boff + n * 2048 + k * 1024); } while (0)
#define PG8_MMA(ai, bj, At, Bt) do { __builtin_amdgcn_s_setprio(1); _Pragma("unroll") for (int m = 0; m < 4; ++m) _Pragma("unroll") for (int n = 0; n < 2; ++n) _Pragma("unroll") for (int k = 0; k < 2; ++k) \
        acc[ai][bj][m][n] = __builtin_amdgcn_mfma_f32_16x16x32_bf16(Bt[n][k], At[m][k], acc[ai][bj][m][n], 0, 0, 0); __builtin_amdgcn_s_setprio(0); } while (0)
#define PG8_WAIT_V(n) asm volatile("s_waitcnt vmcnt(" #n ")" ::: "memory")
#define PG8_WAIT_L(n) asm volatile("s_waitcnt lgkmcnt(" #n ")" ::: "memory")
#define PG8_BAR __builtin_amdgcn_s_barrier()
#define PG8_SCHED __builtin_amdgcn_sched_barrier(0)
    Unit cur, nxt; int ui = 0;
    if (!S.next(0, cur)) return;
    f32x4 acc[2][2][4][2];
#pragma unroll
    for (int a = 0; a < 2; ++a)
#pragma unroll
        for (int b = 0; b < 2; ++b)
#pragma unroll
            for (int m = 0; m < 4; ++m)
#pragma unroll
                for (int n = 0; n < 2; ++n) acc[a][b][m][n] = (f32x4){0.f, 0.f, 0.f, 0.f};
    bf16x8 At[4][2], B0[2][2], B1[2][2];
    const char* cA = S.a_base(g, cur); const char* cB = S.b_base(g, cur);
    if constexpr (Sched::GATHER) {
#pragma unroll
        for (int h = 0; h < 2; ++h)
#pragma unroll
            for (int i = 0; i < 2; ++i) gA[h][i] = (unsigned)(S.row(cur, h * HALF + sR[i]) * g.lda + sC[i]) * 2u;
    }
    PG8_STAGE(PG8_SB(0, 0), cB, voffB); PG8_STAGE(PG8_SB(0, 1), cB + hstepB, voffB); PG8_STAGE_A(PG8_SA(0, 0), cA, 0, gA); PG8_STAGE_A(PG8_SA(0, 1), cA, 1, gA);
    if (wr == 1) PG8_BAR;
    PG8_WAIT_V(2); PG8_BAR;
    PG8_STAGE(PG8_SB(1, 0), cB + kstep, voffB); PG8_STAGE_A(PG8_SA(1, 0), cA + kstep, 0, gA); PG8_STAGE(PG8_SB(1, 1), cB + hstepB + kstep, voffB);
    PG8_WAIT_V(6); PG8_BAR;
    for (;;) {
        const bool has_next = S.next(ui + 1, nxt);
        const char* nA = has_next ? S.a_base(g, nxt) : cA; const char* nB = has_next ? S.b_base(g, nxt) : cB;
        if constexpr (Sched::GATHER) {
#pragma unroll
            for (int h = 0; h < 2; ++h)
#pragma unroll
                for (int i = 0; i < 2; ++i) gN[h][i] = has_next ? (unsigned)(S.row(nxt, h * HALF + sR[i]) * g.lda + sC[i]) * 2u : gA[h][i];
        }
#pragma unroll 1
        for (int t = 0; t < nt; t += 2) {
            const bool last = (t == nt - 2);
            const char* a1 = cA + (size_t)(t + 1) * kstep;
            const char* a2 = last ? nA : cA + (size_t)(t + 2) * kstep; const char* b2 = last ? nB : cB + (size_t)(t + 2) * kstep;
            const char* a3 = a2 + kstep; const char* b3 = b2 + kstep;
            unsigned o2[2][2];
            if constexpr (Sched::GATHER) {
#pragma unroll
                for (int h = 0; h < 2; ++h)
#pragma unroll
                    for (int i = 0; i < 2; ++i) o2[h][i] = last ? gN[h][i] : gA[h][i];
            }
            PG8_LDB(B0, 0, 0); PG8_LDB(B1, 0, 1); PG8_SCHED; PG8_LDA(At, 0, 0); PG8_STAGE_A(PG8_SA(1, 1), a1, 1, gA);
            PG8_WAIT_V(8); PG8_WAIT_L(0); PG8_BAR; PG8_MMA(0, 0, At, B0); PG8_MMA(0, 1, At, B1); PG8_BAR; PG8_SCHED;
            PG8_LDA(At, 0, 1); PG8_STAGE(PG8_SB(0, 0), b2, voffB); PG8_STAGE(PG8_SB(0, 1), b2 + hstepB, voffB); PG8_STAGE_A(PG8_SA(0, 0), a2, 0, o2);
            PG8_WAIT_V(8); PG8_WAIT_L(0); PG8_BAR; PG8_MMA(1, 0, At, B0); PG8_MMA(1, 1, At, B1); PG8_BAR; PG8_SCHED;
            PG8_LDB(B0, 1, 0); PG8_LDB(B1, 1, 1); PG8_SCHED; PG8_LDA(At, 1, 0); PG8_STAGE_A(PG8_SA(0, 1), a2, 1, o2);
            PG8_WAIT_V(8); PG8_WAIT_L(0); PG8_BAR; PG8_MMA(0, 0, At, B0); PG8_MMA(0, 1, At, B1); PG8_BAR; PG8_SCHED;
            PG8_LDA(At, 1, 1); PG8_STAGE(PG8_SB(1, 0), b3, voffB); PG8_STAGE(PG8_SB(1, 1), b3 + hstepB, voffB); PG8_STAGE_A(PG8_SA(1, 0), a3, 0, o2);
            PG8_WAIT_V(8); PG8_WAIT_L(0); PG8_BAR; PG8_MMA(1, 0, At, B0); PG8_MMA(1, 1, At, B1); PG8_BAR; PG8_SCHED;
        }
        if (wr == 0) PG8_BAR;
        E(acc, cur, wr, wc, fr, fq);
        if (!has_next) break;
#pragma unroll
        for (int a = 0; a < 2; ++a)
#pragma unroll
            for (int b = 0; b < 2; ++b)
#pragma unroll
                for (int m = 0; m < 4; ++m)
#pragma unroll
                    for (int n = 0; n < 2; ++n) acc[a][b][m][n] = (f32x4){0.f, 0.f, 0.f, 0.f};
        cur = nxt; cA = nA; cB = nB; ++ui;
        if constexpr (Sched::GATHER) {
#pragma unroll
            for (int h = 0; h < 2; ++h)
#pragma unroll
                for (int i = 0; i < 2; ++i) gA[h][i] = gN[h][i];
        }
        if (wr == 1) PG8_BAR;
    }
    PG8_WAIT_V(0);
    PG8_BAR;
#undef PG8_SA
#undef PG8_SB
#undef PG8_STAGE
#undef PG8_STAGE_A
#undef PG8_LDA
#undef PG8_LDB
#undef PG8_MMA
#undef PG8_WAIT_V
#undef PG8_WAIT_L
#undef PG8_BAR
#undef PG8_SCHED
}

struct EpiBf16Store {
    static constexpr bool PERM = true;
    bf16_t* O; int ldc;
    __device__ __forceinline__ void operator()(const f32x4 (&acc)[2][2][4][2], const Unit& u, int wr, int wc, int fr, int fq) const {
        const int row0 = u.pm * BM + wr * 64 + fr, col0 = u.pn * BM + wc * 32 + 8 * fq;
#pragma unroll
        for (int ai = 0; ai < 2; ++ai)
#pragma unroll
            for (int m = 0; m < 4; ++m) { bf16_t* rowp = O + (size_t)(row0 + ai * HALF + m * 16) * ldc + col0;
#pragma unroll
                for (int bj = 0; bj < 2; ++bj) { const f32x4 v0 = acc[ai][bj][m][0], v1 = acc[ai][bj][m][1];
                    u32x4 w; w.x = cvt_pk_bf16(v0[0], v0[1]); w.y = cvt_pk_bf16(v0[2], v0[3]); w.z = cvt_pk_bf16(v1[0], v1[1]); w.w = cvt_pk_bf16(v1[2], v1[3]);
                    *(u32x4*)(rowp + bj * HALF) = w; } }
    }
};
}
constexpr int NWAVES = 8;
constexpr int RING_OFF = 0, RING_BYTES = 131072;
constexpr int ROUTER_LDS = 147456;
constexpr int LDSCTL_OFF = ROUTER_LDS, MISC_OFF = LDSCTL_OFF + 320;
constexpr int LDS_TAB_OFF = LDSCTL_OFF + 1024;
constexpr int LDS_BYTES = 155648;

#define GAS __attribute__((address_space(1)))
#define LAS __attribute__((address_space(3)))
typedef unsigned v4u __attribute__((ext_vector_type(4)));
typedef unsigned v2u __attribute__((ext_vector_type(2)));
typedef float f32x4 __attribute__((ext_vector_type(4)));
#define LDS_WAIT() asm volatile("s_waitcnt lgkmcnt(0)" ::: "memory")
#define VM_WAIT() asm volatile("s_waitcnt vmcnt(0)" ::: "memory")
__device__ __forceinline__ unsigned pk2(float lo, float hi) { return (unsigned)f2bf(lo) | ((unsigned)f2bf(hi) << 16); }


struct Frame {
    LAS unsigned char* lds;
    int tid, lane, wave, vcu, G;
    const float* const* in;
    float* out; unsigned char* ws;
};

__device__ __forceinline__ void p0_transpose_item(const float* W, int ldw, bf16* WT, int ldt, int k0, int n0, int row0, LAS float* scr, int lane) {
    {
        f32x4 t[8];
#pragma unroll
        for (int i = 0; i < 8; ++i) t[i] = *(const f32x4*)(W + (size_t)(k0 + 8 * i + (lane >> 3)) * ldw + n0 + 4 * (lane & 7));
#pragma unroll
        for (int i = 0; i < 8; ++i) { LAS float* d = scr + (8 * i + (lane >> 3)) * 33 + 4 * (lane & 7); d[0] = t[i].x; d[1] = t[i].y; d[2] = t[i].z; d[3] = t[i].w; }
    }
    LDS_WAIT(); asm volatile("" ::: "memory");
    const int c = lane & 7;
#pragma unroll
    for (int j = 0; j < 4; ++j) { const int n = (lane >> 3) + 8 * j; const LAS float* s = scr + (8 * c) * 33 + n;
        v4u o; o.x = pk2(s[0 * 33], s[1 * 33]); o.y = pk2(s[2 * 33], s[3 * 33]); o.z = pk2(s[4 * 33], s[5 * 33]); o.w = pk2(s[6 * 33], s[7 * 33]);
        *(v4u*)(WT + (size_t)(row0 + n) * ldt + k0 + 8 * c) = o; }
    LDS_WAIT(); asm volatile("" ::: "memory");
}

__device__ __forceinline__ void p0_mod_task(Frame& F, int task) {
    LAS float* sc = (LAS float*)(F.lds);
    LAS float* red = (LAS float*)(F.lds + 16384);
    const float* c = F.in[1]; const float* w_ada = F.in[2]; const float* b_ada = F.in[3];
    for (int i = F.tid; i < 4096; i += 512) { const float cv = c[i]; sc[i] = cv / (1.f + __expf(-cv)); }
    __syncthreads();
    const int j = task * 64 + F.lane;
    float a0 = 0.f, a1 = 0.f, a2 = 0.f, a3 = 0.f;
    const int kb = F.wave * 128;
#pragma unroll 16
    for (int k = kb; k < kb + 128; ++k) { const float w = w_ada[(size_t)k * 6144 + j]; a0 += sc[k] * w; a1 += sc[1024 + k] * w; a2 += sc[2048 + k] * w; a3 += sc[3072 + k] * w; }
    red[(F.wave * 4 + 0) * 64 + F.lane] = a0; red[(F.wave * 4 + 1) * 64 + F.lane] = a1; red[(F.wave * 4 + 2) * 64 + F.lane] = a2; red[(F.wave * 4 + 3) * 64 + F.lane] = a3;
    __syncthreads();
    if (F.tid < 256) { const int b = F.tid >> 6, l = F.tid & 63; float s = 0.f;
#pragma unroll
        for (int w = 0; w < 8; ++w) s += red[(w * 4 + b) * 64 + l];
        ((float*)(F.ws + WS_MOD))[b * 6144 + task * 64 + l] = s + b_ada[task * 64 + l]; }
    __syncthreads();
}

__device__ __forceinline__ void phase0(Frame& F) {
    if (blockIdx.x < 96) p0_mod_task(F, blockIdx.x);
    LAS float* scr = (LAS float*)(F.lds + RING_OFF + F.wave * 16384);
    const int gw = F.vcu * NWAVES + F.wave, NGW = F.G * NWAVES;
    constexpr int I_IN = (D / 64) * (PW / 32), I_OUT = (D / 64) * (D / 32);
    constexpr int NITEMS = I_IN + I_OUT;
    for (int it = gw; it < NITEMS; it += NGW) {
        int r = it;
        if (r < I_IN) { const int nb = PW / 32, kb = r / nb, n = r % nb; p0_transpose_item(F.in[5], PW, (bf16*)(F.ws + FW_WINT), D, 64 * kb, 32 * n, 32 * n, scr, F.lane); continue; } r -= I_IN;
        { const int nb = D / 32, kb = r / nb, n = r % nb; p0_transpose_item(F.in[25], D, (bf16*)(F.ws + FW_WOUTT), D, 64 * kb, 32 * n, 32 * n, scr, F.lane); }
    }
}
__device__ __forceinline__ void expert_transposes(Frame& F, int wv, int nwv) {
    LAS float* scr = (LAS float*)(F.lds + RING_OFF + F.wave * 16384);
    constexpr int I_E13 = NE * 2 * 256, I_E2 = NE * 256;
    for (int it = wv; it < I_E13 + I_E2; it += nwv) {
        int r = it;
        if (r < I_E13) {
            const int e = r >> 9, which = (r >> 8) & 1, q = r & 255, kb = q >> 4, n = q & 15, n0 = 32 * n;
            const float* W = (which ? F.in[32] : F.in[31]) + (size_t)e * D * DE;
            p0_transpose_item(W, DE, (bf16*)(F.ws + FW_W13T) + (size_t)e * 1024 * 1024, D, 64 * kb, n0, (n0 >> 7) * 256 + which * 128 + (n0 & 127), scr, F.lane); continue; } r -= I_E13;
        {
            const int e = r >> 8, q = r & 255, kb = q >> 5, n = q & 31;
            p0_transpose_item(F.in[33] + (size_t)e * DE * D, D, (bf16*)(F.ws + FW_W2T) + (size_t)e * 1024 * DE, DE, 64 * kb, 32 * n, 32 * n, scr, F.lane); }
    }
}

__device__ __forceinline__ void adaln_row(const float* xrow, const float* g, const float* sh, const float* sc, bf16* orow, int lane) {
    const f32x4* xr = (const f32x4*)xrow + lane;
    f32x4 v[4]; float s = 0.f;
#pragma unroll
    for (int j = 0; j < 4; ++j) { v[j] = xr[64 * j]; s += (v[j].x * v[j].x + v[j].y * v[j].y) + (v[j].z * v[j].z + v[j].w * v[j].w); }
    const float rinv = rsqrtf(wave_sum(s) * (1.f / D) + 1e-6f);
    v2u* o8 = (v2u*)orow + lane;
#pragma unroll
    for (int j = 0; j < 4; ++j) { const f32x4 gg = ((const f32x4*)g)[lane + 64 * j], s1 = ((const f32x4*)sc)[lane + 64 * j], s0 = ((const f32x4*)sh)[lane + 64 * j];
        f32x4 y = v[j] * rinv * gg; y = y * (s1 + 1.f) + s0;
        v2u w; w.x = pk2(y.x, y.y); w.y = pk2(y.z, y.w); o8[64 * j] = w; }
}
__device__ __forceinline__ void phase1(Frame& F) {
    const int gw = F.vcu * NWAVES + F.wave, NGW = F.G * NWAVES;
    const float* mod = (const float*)(F.ws + WS_MOD);
    for (int m = gw; m < NTOK; m += NGW) { const int b = m / T;
        adaln_row(F.in[0] + (size_t)m * D, F.in[4], mod + b * 6144, mod + b * 6144 + 1024, (bf16*)(F.ws + WS_H) + (size_t)m * D, F.lane); }
}
__device__ __forceinline__ void phase2(Frame& F) {
    pg8::Gemm g{(const bf16*)(F.ws + WS_H), (const bf16*)(F.ws + FW_WINT), D, D, D};
    pg8::DenseOrder S; S.init(NTOK, PW, F.G, (int)blockIdx.x);
    pg8::EpiBf16Store E{(bf16*)(F.ws + WS_P), PW};
    pg8::gemm_phase<pg8::EpiBf16Store, pg8::DenseOrder>(F.lds + RING_OFF, g, S, E, F.tid);
}


namespace pg8 {
struct EpiX1F {
    static constexpr bool PERM = false;
    const float* const* in; unsigned char* ws; float* out;
    __device__ __forceinline__ void operator()(const f32x4 (&acc)[2][2][4][2], const Unit& u, int wr, int wc, int fr, int fq) const {
        const float* x = in[0]; const float* mod = (const float*)(ws + WS_MOD);
        const int row0 = u.pm * BM + wr * 64 + fr, col0 = u.pn * BM + wc * 32 + 4 * fq;
        const float* g1 = mod + ((u.pm * BM) / T) * 6144 + 2048;
        f32x4 gv[2][2];
#pragma unroll
        for (int bj = 0; bj < 2; ++bj)
#pragma unroll
            for (int n = 0; n < 2; ++n) gv[bj][n] = *(const f32x4*)(g1 + col0 + bj * HALF + n * 16);
#pragma unroll
        for (int ai = 0; ai < 2; ++ai)
#pragma unroll
            for (int m = 0; m < 4; ++m) { const size_t ro = (size_t)(row0 + ai * HALF + m * 16) * D + col0;
#pragma unroll
                for (int bj = 0; bj < 2; ++bj)
#pragma unroll
                    for (int n = 0; n < 2; ++n) { const f32x4 xv = *(const f32x4*)(x + ro + bj * HALF + n * 16);
                        *(f32x4*)(out + ro + bj * HALF + n * 16) = xv + gv[bj][n] * acc[ai][bj][m][n]; } }
    }
};
template <bool GATH> struct MoeOrder {
    static constexpr bool GATHER = GATH;
    const LAS int* ub; const LAS int* rb; const LAS int* cn; const int* list; int G, c, brows;
    __device__ bool next(int i, Unit& u) const {
        const int L = i * G + c; if (L >= ub[32]) return false;
        int e = 0;
#pragma unroll
        for (int k = 16; k >= 1; k >>= 1) if (ub[e + k] <= L) e += k;
        const int local = L - ub[e], tiles = rb[e + 1] - rb[e], pn = local / tiles, mt = local - pn * tiles;
        u.e = e; u.pn = pn; u.pm = rb[e] + mt; u.row0 = e * NTOK + mt * 256; u.nrows = min(256, cn[e] - mt * 256); return true;
    }
    __device__ __forceinline__ const char* a_base(const Gemm& g, const Unit& u) const { return GATH ? (const char*)g.A : (const char*)g.A + (size_t)u.pm * (BM * 2) * g.lda; }
    __device__ __forceinline__ const char* b_base(const Gemm& g, const Unit& u) const { return (const char*)g.Bt + ((size_t)u.e * brows + (size_t)u.pn * BM) * 2 * g.ldb; }
    __device__ __forceinline__ int row(const Unit& u, int r) const { return r < u.nrows ? (list[u.row0 + r] >> 1) : 0; }
};
struct EpiSwiglu {
    static constexpr bool PERM = true;
    bf16_t* HID;
    __device__ __forceinline__ void operator()(const f32x4 (&acc)[2][2][4][2], const Unit& u, int wr, int wc, int fr, int fq) const {
        const int col0 = u.pn * HALF + wc * 32 + 8 * fq;
#pragma unroll
        for (int ai = 0; ai < 2; ++ai)
#pragma unroll
            for (int m = 0; m < 4; ++m) { const int r = ai * HALF + wr * 64 + m * 16 + fr;
                if (r < u.nrows) { float h[8];
#pragma unroll
                    for (int n = 0; n < 2; ++n)
#pragma unroll
                        for (int i = 0; i < 4; ++i) { const float a = acc[ai][0][m][n][i], b = acc[ai][1][m][n][i]; h[n * 4 + i] = a * frcp(1.f + fexp(-a)) * b; }
                    u32x4 w; w.x = cvt_pk_bf16(h[0], h[1]); w.y = cvt_pk_bf16(h[2], h[3]); w.z = cvt_pk_bf16(h[4], h[5]); w.w = cvt_pk_bf16(h[6], h[7]);
                    *(u32x4*)(HID + (size_t)(u.pm * BM + r) * DE + col0) = w; } }
    }
};
struct EpiYs {
    static constexpr bool PERM = true;
    unsigned char* ws;
    __device__ __forceinline__ void operator()(const f32x4 (&acc)[2][2][4][2], const Unit& u, int wr, int wc, int fr, int fq) const {
        bf16_t* YS = (bf16_t*)(ws + WS_YS); const int* list = (const int*)(ws + WS_LIST); const float* selw = (const float*)(ws + WS_SELW);
        const int col0 = u.pn * BM + wc * 32 + 8 * fq;
#pragma unroll
        for (int ai = 0; ai < 2; ++ai)
#pragma unroll
            for (int m = 0; m < 4; ++m) { const int r = ai * HALF + wr * 64 + m * 16 + fr;
                if (r < u.nrows) { const int li = list[u.row0 + r]; const float w8 = selw[li]; bf16_t* rowp = YS + (size_t)li * D + col0;
#pragma unroll
                    for (int bj = 0; bj < 2; ++bj) { const f32x4 v0 = acc[ai][bj][m][0] * w8, v1 = acc[ai][bj][m][1] * w8;
                        u32x4 w; w.x = cvt_pk_bf16(v0[0], v0[1]); w.y = cvt_pk_bf16(v0[2], v0[3]); w.z = cvt_pk_bf16(v1[0], v1[1]); w.w = cvt_pk_bf16(v1[2], v1[3]);
                        *(u32x4*)(rowp + bj * HALF) = w; } } }
    }
};
}

__device__ __forceinline__ void phase_outproj(Frame& F) {
    pg8::Gemm g{(const bf16*)(F.ws + WS_YMIX), (const bf16*)(F.ws + FW_WOUTT), D, D, D};
    pg8::DenseOrder S; S.init(NTOK, D, F.G, (int)blockIdx.x);
    pg8::EpiX1F E{F.in, F.ws, F.out};
    pg8::gemm_phase<pg8::EpiX1F, pg8::DenseOrder>(F.lds + RING_OFF, g, S, E, F.tid);
}

__device__ __forceinline__ void phase_route(Frame& F) {
    LAS float* wt = (LAS float*)F.lds;
    { const f32x4* WR = (const f32x4*)(F.ws + FW_WR); LAS f32x4* wt4 = (LAS f32x4*)F.lds;
      for (int i = F.tid; i < 36 * 256; i += 512) wt4[i] = WR[i]; }
    __syncthreads();
    const float* mod = (const float*)(F.ws + WS_MOD); const float* g2n = F.in[26];
    int* cnt = (int*)(F.ws + WS_CNT); int* list = (int*)(F.ws + WS_LIST); float* selw = (float*)(F.ws + WS_SELW);
    bf16* H2 = (bf16*)(F.ws + WS_H);
    const int gw = F.vcu * NWAVES + F.wave, NGW = F.G * NWAVES, lane = F.lane;
    LAS int* lcnt = (LAS int*)(F.lds + LDSCTL_OFF + 2048); LAS int* lbase = lcnt + 32; LAS int* tokres = lcnt + 64;
    if (F.tid < 32) lcnt[F.tid] = 0;
    __syncthreads();
    int it = 0;
    for (int m = gw; m < NTOK; m += NGW, ++it) {
        const int b = m / T;
        const f32x4* xr = (const f32x4*)(F.out + (size_t)m * D) + lane;
        f32x4 v[4]; float s = 0.f;
#pragma unroll
        for (int j = 0; j < 4; ++j) { v[j] = xr[64 * j]; s += (v[j].x * v[j].x + v[j].y * v[j].y) + (v[j].z * v[j].z + v[j].w * v[j].w); }
        const float rinv = rsqrtf(wave_sum(s) * (1.f / D) + 1e-6f);
        v2u* o8 = (v2u*)(H2 + (size_t)m * D) + lane;
#pragma unroll
        for (int j = 0; j < 4; ++j) { const f32x4 gg = ((const f32x4*)g2n)[lane + 64 * j], s1 = ((const f32x4*)(mod + b * 6144 + 4096))[lane + 64 * j], s0 = ((const f32x4*)(mod + b * 6144 + 3072))[lane + 64 * j];
            f32x4 y = v[j] * rinv * gg; y = y * (s1 + 1.f) + s0; v[j] = y;
            v2u w; w.x = pk2(y.x, y.y); w.y = pk2(y.z, y.w); o8[64 * j] = w; }
        const float* b_grp = F.in[28]; const float* b_exp = F.in[30];
        int gi = 0; float gm = -3.4e38f, den = 0.f;
#pragma unroll 1
        for (int e = 0; e < 4; ++e) { float p = 0.f;
#pragma unroll
            for (int j = 0; j < 4; ++j) { const f32x4 w = *(const LAS f32x4*)(wt + e * 1024 + lane * 4 + 256 * j); p += (v[j].x * w.x + v[j].y * w.y) + (v[j].z * w.z + v[j].w * w.w); }
            const float gl = wave_sum(p) + b_grp[e];
            if (gl > gm) { den = den * __expf(gm - gl) + 1.f; gm = gl; gi = e; } else den += __expf(gl - gm); }
        gi = __builtin_amdgcn_readfirstlane(gi);
        const float gwt = 1.f / den;
        float v1 = -3.4e38f, v2 = -3.4e38f; int i1 = 0, i2 = 0;
#pragma unroll 1
        for (int ii = 0; ii < 8; ++ii) { const int e = gi * 8 + ii; float p = 0.f;
#pragma unroll
            for (int j = 0; j < 4; ++j) { const f32x4 w = *(const LAS f32x4*)(wt + (4 + e) * 1024 + lane * 4 + 256 * j); p += (v[j].x * w.x + v[j].y * w.y) + (v[j].z * w.z + v[j].w * w.w); }
            const float xx = wave_sum(p) + b_exp[e];
            if (xx > v1) { v2 = v1; i2 = i1; v1 = xx; i1 = ii; } else if (xx > v2) { v2 = xx; i2 = ii; } }
        const float e2 = __expf(v2 - v1), w1 = 1.f / (1.f + e2), w2 = e2 / (1.f + e2);
        if (lane == 0) { const int ea = gi * 8 + i1, eb = gi * 8 + i2;
            selw[m * 2] = w1 * gwt; selw[m * 2 + 1] = w2 * gwt;
            const int ra = atomicAdd((int*)&lcnt[ea], 1), rb2 = atomicAdd((int*)&lcnt[eb], 1);
            tokres[(F.wave * 16 + it) * 2] = ea | (ra << 8); tokres[(F.wave * 16 + it) * 2 + 1] = eb | (rb2 << 8); }
    }
    __syncthreads();
    if (F.tid < 32) { const int c = lcnt[F.tid]; lbase[F.tid] = c ? atomicAdd(&cnt[F.tid * 64], c) : 0; }
    __syncthreads();
    if (lane == 0) { int it = 0;
        for (int m = gw; m < NTOK; m += NGW, ++it) {
            const int a = tokres[(F.wave * 16 + it) * 2], b2 = tokres[(F.wave * 16 + it) * 2 + 1];
            list[(a & 255) * NTOK + lbase[a & 255] + (a >> 8)] = m * 2; list[(b2 & 255) * NTOK + lbase[b2 & 255] + (b2 >> 8)] = m * 2 + 1; } }
    __syncthreads();
}

__device__ __forceinline__ void moe_tables(Frame& F, int npn) {
    LAS int* tab = (LAS int*)(F.lds + LDS_TAB_OFF);
    if (F.tid == 0) { const int* cnt = (const int*)(F.ws + WS_CNT); int ub = 0, rb = 0;
        for (int e = 0; e < 32; ++e) { const int c = __hip_atomic_load(cnt + e * 64, __ATOMIC_RELAXED, __HIP_MEMORY_SCOPE_AGENT); const int tl = (c + 255) >> 8; tab[e] = ub; tab[33 + e] = rb; tab[66 + e] = c; ub += tl * npn; rb += tl; }
        tab[32] = ub; tab[33 + 32] = rb; }
    __syncthreads();
}
__device__ __forceinline__ void phase_m1(Frame& F) {
    moe_tables(F, 4);
    const LAS int* tab = (const LAS int*)(F.lds + LDS_TAB_OFF);
    pg8::Gemm g{(const bf16*)(F.ws + WS_H), (const bf16*)(F.ws + FW_W13T), D, D, D};
    pg8::MoeOrder<true> S{tab, tab + 33, tab + 66, (const int*)(F.ws + WS_LIST), F.G, (int)blockIdx.x, 1024};
    pg8::EpiSwiglu E{(bf16*)(F.ws + WS_HID)};
    pg8::gemm_phase<pg8::EpiSwiglu, pg8::MoeOrder<true>>(F.lds + RING_OFF, g, S, E, F.tid);
}
__device__ __forceinline__ void phase_m2(Frame& F) {
    moe_tables(F, 4);
    const LAS int* tab = (const LAS int*)(F.lds + LDS_TAB_OFF);
    pg8::Gemm g{(const bf16*)(F.ws + WS_HID), (const bf16*)(F.ws + FW_W2T), DE, DE, DE};
    pg8::MoeOrder<false> S{tab, tab + 33, tab + 66, (const int*)(F.ws + WS_LIST), F.G, (int)blockIdx.x, 1024};
    pg8::EpiYs E{F.ws};
    pg8::gemm_phase<pg8::EpiYs, pg8::MoeOrder<false>>(F.lds + RING_OFF, g, S, E, F.tid);
}
__device__ __forceinline__ void phase_final(Frame& F, bool dry = false) {
    const int gw = F.vcu * NWAVES + F.wave, NGW = F.G * NWAVES, lane = F.lane;
    const float* mod = (const float*)(F.ws + WS_MOD); const float* fg = F.in[34]; const bf16* YS = (const bf16*)(F.ws + WS_YS);
    for (int m = gw; m < NTOK; m += NGW) { const int b = m / T;
        f32x4* xr = (f32x4*)(F.out + (size_t)m * D) + lane;
        const v2u* y0 = (const v2u*)(YS + (size_t)(2 * m) * D) + lane; const v2u* y1 = (const v2u*)(YS + (size_t)(2 * m + 1) * D) + lane;
        f32x4 v[4]; float s = 0.f;
#pragma unroll
        for (int j = 0; j < 4; ++j) { const v2u a = y0[64 * j], c = y1[64 * j]; const f32x4 g2 = ((const f32x4*)(mod + b * 6144 + 5120))[lane + 64 * j];
            f32x4 mo; mo.x = __uint_as_float(a.x << 16) + __uint_as_float(c.x << 16); mo.y = __uint_as_float(a.x & 0xffff0000u) + __uint_as_float(c.x & 0xffff0000u);
            mo.z = __uint_as_float(a.y << 16) + __uint_as_float(c.y << 16); mo.w = __uint_as_float(a.y & 0xffff0000u) + __uint_as_float(c.y & 0xffff0000u);
            v[j] = xr[64 * j] + g2 * mo; s += (v[j].x * v[j].x + v[j].y * v[j].y) + (v[j].z * v[j].z + v[j].w * v[j].w); }
        const float rinv = rsqrtf(wave_sum(s) * (1.f / D) + 1e-6f);
        float tdelta = 0.f;
        if (TIMER_A >= 0 && m == 0) { const unsigned long long* ts = (const unsigned long long*)(F.ws + 8192);
            const float us = (float)(TIMER_B == TIMER_A ? ts[TIMER_A] : ts[TIMER_B] - ts[TIMER_A]) * 0.01f; tdelta = sqrtf(32768.f * us * 1e-6f); }
#pragma unroll
        for (int j = 0; j < 4; ++j) (dry ? (f32x4*)(F.ws + WS_P) + (size_t)m * 256 + lane : xr)[64 * j] = v[j] * rinv * ((const f32x4*)fg)[lane + 64 * j] + tdelta;
    }
}
#define XB_TMO      128
#define XB_XCNT(j)  (256  + 64 * (j))
#define XB_XSUB(j)  (1280 + 64 * (j))
#define XB_XGEN(j)  (2304 + 64 * (j))
#define XB_TOP      3328
#define XB_TOPGEN   3392
#define XCD_BAR_WORDS 3456
#define XB_SPIN_CAP (1u << 18)

__device__ __forceinline__ unsigned xb_ld(unsigned* p)              { return __hip_atomic_load(p, __ATOMIC_RELAXED, __HIP_MEMORY_SCOPE_AGENT); }
__device__ __forceinline__ unsigned xb_add(unsigned* p, unsigned v) { return __hip_atomic_fetch_add(p, v, __ATOMIC_RELAXED, __HIP_MEMORY_SCOPE_AGENT); }
__device__ __forceinline__ unsigned xb_xcc_id() { return (unsigned)__builtin_amdgcn_s_getreg((3 << 11) | 20) & 0xFu; }
#define XB_SPIN(cond, bar) do { unsigned _sp = 0; while (cond) { __builtin_amdgcn_s_sleep(1); \
    if ((++_sp & 255u) == 0u) { if (xb_ld(&(bar)[XB_TMO])) break; if (_sp > XB_SPIN_CAP) { atomicAdd(&(bar)[XB_TMO], 1u); break; } } } } while (0)

struct XcdBarrier {
    unsigned* bar; unsigned x;
    volatile LAS unsigned* st;
};

__device__ __forceinline__ XcdBarrier xcd_barrier_post(unsigned* bar, volatile LAS unsigned* st) {
    XcdBarrier b; b.bar = bar; b.x = xb_xcc_id(); b.st = st;
    if (threadIdx.x == 0) (void)xb_add(&bar[XB_XCNT(b.x)], 1u);
    return b;
}
__device__ __forceinline__ void xcd_barrier_complete(unsigned* bar, unsigned x, unsigned& nloc, unsigned& nx) {
    const unsigned G = gridDim.x * gridDim.y * gridDim.z;
    unsigned sum, cnt, mine, sp = 0u;
    for (;;) {
        sum = 0u; cnt = 0u; mine = 0u;
#pragma unroll
        for (unsigned j = 0; j < 16; ++j) { const unsigned c = xb_ld(&bar[XB_XCNT(j)]); sum += c; cnt += (c > 0u) ? 1u : 0u; mine = (j == x) ? c : mine; }
        if (sum == G) break;
        __builtin_amdgcn_s_sleep(1);
        if ((++sp & 255u) == 0u) { if (xb_ld(&bar[XB_TMO])) break; if (sp > XB_SPIN_CAP) { atomicAdd(&bar[XB_TMO], 1u); break; } }
    }
    nloc = mine > 0u ? mine : 1u; nx = cnt > 0u ? cnt : 1u;
}

__device__ __forceinline__ void xcd_barrier(const XcdBarrier& b) {
    asm volatile("s_waitcnt vmcnt(0)" ::: "memory");
    __syncthreads();
    if (threadIdx.x == 0) {
        unsigned* bar = b.bar;
        __builtin_amdgcn_s_waitcnt(0);
        unsigned nloc = b.st[0], nx = b.st[1];
        if (nloc == 0u) { xcd_barrier_complete(bar, b.x, nloc, nx); b.st[0] = nloc; b.st[1] = nx; }
        const unsigned old = xb_add(&bar[XB_XSUB(b.x)], 1u);
        const unsigned gen = old / nloc;
        if (old + 1u == (gen + 1u) * nloc) {
            __builtin_amdgcn_fence(__ATOMIC_RELEASE, "agent");
            asm volatile("s_waitcnt vmcnt(0)" ::: "memory");
            const unsigned og = xb_add(&bar[XB_TOP], 1u);
            const unsigned tg = og / nx;
            if (og + 1u == (tg + 1u) * nx) xb_add(&bar[XB_TOPGEN], 1u);
            else XB_SPIN(xb_ld(&bar[XB_TOPGEN]) == tg, bar);
            __builtin_amdgcn_fence(__ATOMIC_ACQUIRE, "agent");
            xb_add(&bar[XB_XGEN(b.x)], 1u);
            asm volatile("s_waitcnt vmcnt(0)" ::: "memory");
        } else {
            XB_SPIN(xb_ld(&bar[XB_XGEN(b.x)]) == gen, bar);
            __builtin_amdgcn_fence(__ATOMIC_ACQUIRE, "agent");
            asm volatile("s_waitcnt vmcnt(0)" ::: "memory");
        }
    }
    __syncthreads();
}


constexpr size_t WS_XC = WS_H;
constexpr size_t WS_ALORA = WS_H + 32 * MiB;
constexpr size_t WS_LOGA = 256 * MiB;
constexpr size_t WS_OLOC = 320 * MiB;
constexpr size_t WS_QHAT = 352 * MiB;
constexpr size_t WS_GG = 384 * MiB;
constexpr size_t WS_SB = 12 * MiB;
constexpr size_t WS_LRUA = 13 * MiB;
constexpr size_t WS_LRUB = 14 * MiB;
constexpr size_t WS_LRUH = 15 * MiB;
constexpr size_t DO_LWA = 0;
constexpr size_t DO_PC = 64 * MiB;
constexpr size_t DO_QCT = 96 * MiB;
constexpr size_t DO_HIN = 0;

__device__ __forceinline__ float bflo(unsigned u) { return __uint_as_float(u << 16); }
__device__ __forceinline__ float bfhi(unsigned u) { return __uint_as_float(u & 0xffff0000u); }

__device__ __forceinline__ void phase_prepA(Frame& F) {
    const int gw = F.vcu * NWAVES + F.wave, NGW = F.G * NWAVES, lane = F.lane;
    const bf16* P = (const bf16*)(F.ws + WS_P);
    bf16* XC = (bf16*)(F.ws + WS_XC); bf16* AL = (bf16*)(F.ws + WS_ALORA);
    const float* conv_w = F.in[6]; const float* conv_b = F.in[7]; const float* mu = F.in[14];
    float cw[4][8], cb[8];
#pragma unroll
    for (int i = 0; i < 8; ++i) { cb[i] = conv_b[8 * lane + i];
#pragma unroll
        for (int j = 0; j < 4; ++j) cw[j][i] = conv_w[j * 512 + 8 * lane + i]; }
    float mu4[4];
#pragma unroll
    for (int i = 0; i < 4; ++i) mu4[i] = mu[(C_WD - 1024) + 4 * lane + i];
    for (int task = gw; task < NTOK / 16; task += NGW) {
        const int m0 = task * 16, t0 = m0 % T;
        float x1[8], x2[8], x3[8], pl[4];
#pragma unroll
        for (int i = 0; i < 8; ++i) { x1[i] = 0.f; x2[i] = 0.f; x3[i] = 0.f; }
#pragma unroll
        for (int i = 0; i < 4; ++i) pl[i] = 0.f;
        if (t0 > 0) {
            const v4u a = *(const v4u*)(P + (size_t)(m0 - 1) * PW + 8 * lane), b = *(const v4u*)(P + (size_t)(m0 - 2) * PW + 8 * lane), c = *(const v4u*)(P + (size_t)(m0 - 3) * PW + 8 * lane);
            x1[0] = bflo(a.x); x1[1] = bfhi(a.x); x1[2] = bflo(a.y); x1[3] = bfhi(a.y); x1[4] = bflo(a.z); x1[5] = bfhi(a.z); x1[6] = bflo(a.w); x1[7] = bfhi(a.w);
            x2[0] = bflo(b.x); x2[1] = bfhi(b.x); x2[2] = bflo(b.y); x2[3] = bfhi(b.y); x2[4] = bflo(b.z); x2[5] = bfhi(b.z); x2[6] = bflo(b.w); x2[7] = bfhi(b.w);
            x3[0] = bflo(c.x); x3[1] = bfhi(c.x); x3[2] = bflo(c.y); x3[3] = bfhi(c.y); x3[4] = bflo(c.z); x3[5] = bfhi(c.z); x3[6] = bflo(c.w); x3[7] = bfhi(c.w);
            const v2u q = *(const v2u*)(P + (size_t)(m0 - 1) * PW + C_WD + 4 * lane);
            pl[0] = bflo(q.x); pl[1] = bfhi(q.x); pl[2] = bflo(q.y); pl[3] = bfhi(q.y);
        }
#pragma unroll 4
        for (int tt = 0; tt < 16; ++tt) {
            const size_t m = (size_t)(m0 + tt);
            const v4u a = *(const v4u*)(P + m * PW + 8 * lane);
            float x0[8] = {bflo(a.x), bfhi(a.x), bflo(a.y), bfhi(a.y), bflo(a.z), bfhi(a.z), bflo(a.w), bfhi(a.w)};
            float xc[8];
#pragma unroll
            for (int i = 0; i < 8; ++i) { xc[i] = x3[i] * cw[0][i] + x2[i] * cw[1][i] + x1[i] * cw[2][i] + x0[i] * cw[3][i] + cb[i]; x3[i] = x2[i]; x2[i] = x1[i]; x1[i] = x0[i]; }
            v4u o; o.x = pk2(xc[0], xc[1]); o.y = pk2(xc[2], xc[3]); o.z = pk2(xc[4], xc[5]); o.w = pk2(xc[6], xc[7]);
            *(v4u*)(XC + m * 512 + 8 * lane) = o;
            const v2u q = *(const v2u*)(P + m * PW + C_WD + 4 * lane);
            const float cl[4] = {bflo(q.x), bfhi(q.x), bflo(q.y), bfhi(q.y)};
            float al[4];
#pragma unroll
            for (int i = 0; i < 4; ++i) { const float u = cl[i] + (pl[i] - cl[i]) * mu4[i]; pl[i] = cl[i];
                al[i] = (lane < 16) ? ftanh(u) : ((lane < 32) ? u : sigmoidf_(u)); }
            v2u o2; o2.x = pk2(al[0], al[1]); o2.y = pk2(al[2], al[3]);
            *(v2u*)(AL + m * 256 + 4 * lane) = o2;
        }
    }
}
__device__ __forceinline__ void p0_small_weights(Frame& F) {
    const int gt = F.vcu * NWAVES * 64 + F.tid, NT = F.G * NWAVES * 64;
    bf16* WG = (bf16*)(F.ws + FW_WGT); bf16* WL = (bf16*)(F.ws + FW_WLORAT);
    const float* wa = F.in[8]; const float* wi = F.in[10]; const float* w_up = F.in[16]; const float* a_up = F.in[18]; const float* g_up = F.in[19];
    for (int i = gt; i < 4 * 256 * 256; i += NT) { const int kk = i & 255, r = (i >> 8) & 255, pn = i >> 16;
        const int gate = r >> 7, ch = 128 * pn + (r & 127), hh = ch >> 6, j = ch & 63, kin = (pn >> 1) * 256 + kk;
        float v = 0.f; if ((kin >> 6) == hh) v = (gate ? wi : wa)[hh * 4096 + (kin & 63) * 64 + j];
        WG[i] = f2bf(v); }
    { float* WR = (float*)(F.ws + FW_WR); const float* w_grp = F.in[27]; const float* w_exp = F.in[29];
      for (int i = gt; i < 36 * 1024; i += NT) { const int k = i & 1023, e = i >> 10; WR[i] = e < 4 ? w_grp[k * 4 + e] : w_exp[k * 32 + (e - 4)]; } }
    for (int i = gt; i < 1536 * 256; i += NT) { const int kk = i & 255, n = i >> 8; float v = 0.f;
        if (n < 512) { if (kk < 64) v = w_up[kk * 512 + n]; }
        else if (n < 1024) { if (kk >= 64 && kk < 128) v = a_up[(kk - 64) * 512 + n - 512]; }
        else { if (kk >= 128) v = g_up[(kk - 128) * 512 + n - 1024]; }
        WL[i] = f2bf(v); }
}

namespace pg8 {
struct GateOrder : DenseOrder {
    __device__ __forceinline__ const char* a_base(const Gemm& g, const Unit& u) const { return (const char*)g.A + (size_t)u.pm * (BM * 2) * g.lda + (size_t)(u.pn >> 1) * 512; }
};
struct EpiLruGate {
    static constexpr bool PERM = true;
    unsigned char* ws;
    __device__ __forceinline__ void operator()(const f32x4 (&acc)[2][2][4][2], const Unit& u, int wr, int wc, int fr, int fq) const {
        bf16_t* G = (bf16_t*)(ws + WS_LOGA);
        const int row0 = u.pm * BM + wr * 64 + fr, col0 = u.pn * HALF + wc * 32 + 8 * fq;
#pragma unroll
        for (int ai = 0; ai < 2; ++ai)
#pragma unroll
            for (int m = 0; m < 4; ++m) { bf16_t* rowp = G + (size_t)(row0 + ai * HALF + m * 16) * 1024 + col0;
#pragma unroll
                for (int bj = 0; bj < 2; ++bj) { const f32x4 v0 = acc[ai][bj][m][0], v1 = acc[ai][bj][m][1];
                    u32x4 w; w.x = cvt_pk_bf16(v0[0], v0[1]); w.y = cvt_pk_bf16(v0[2], v0[3]); w.z = cvt_pk_bf16(v1[0], v1[1]); w.w = cvt_pk_bf16(v1[2], v1[3]);
                    *(u32x4*)(rowp + bj * 512) = w; } }
    }
};
struct EpiLoraStore {
    static constexpr bool PERM = true;
    unsigned char* out; unsigned char* ws;
    __device__ __forceinline__ void operator()(const f32x4 (&acc)[2][2][4][2], const Unit& u, int wr, int wc, int fr, int fq) const {
        const int row0 = u.pm * BM + wr * 64 + fr;
        bf16_t* LWA = (bf16_t*)(out + DO_LWA); bf16_t* GG = (bf16_t*)(ws + WS_GG);
        bf16_t* base = u.pn < 4 ? LWA : GG; const int ldc = u.pn < 4 ? 1024 : 512; const int col0 = (u.pn < 4 ? u.pn : u.pn - 4) * BM + wc * 32 + 8 * fq;
#pragma unroll
        for (int ai = 0; ai < 2; ++ai)
#pragma unroll
            for (int m = 0; m < 4; ++m) { bf16_t* rowp = base + (size_t)(row0 + ai * HALF + m * 16) * ldc + col0;
#pragma unroll
                for (int bj = 0; bj < 2; ++bj) { const f32x4 v0 = acc[ai][bj][m][0], v1 = acc[ai][bj][m][1];
                    u32x4 w; w.x = cvt_pk_bf16(v0[0], v0[1]); w.y = cvt_pk_bf16(v0[2], v0[3]); w.z = cvt_pk_bf16(v1[0], v1[1]); w.w = cvt_pk_bf16(v1[2], v1[3]);
                    *(u32x4*)(rowp + bj * HALF) = w; } }
    }
};
}
__device__ __forceinline__ void phase_gategemm(Frame& F) {
    {
        pg8::Gemm g{(const bf16*)(F.ws + WS_XC), (const bf16*)(F.ws + FW_WGT), 512, 256, 256};
        pg8::GateOrder S; S.init(NTOK, 1024, F.G, (int)blockIdx.x);
        pg8::EpiLruGate E{F.ws};
        pg8::gemm_phase<pg8::EpiLruGate, pg8::GateOrder>(F.lds + RING_OFF, g, S, E, F.tid);
    }
}
__device__ __forceinline__ void phase_loragemm(Frame& F) {
    {
        pg8::Gemm g{(const bf16*)(F.ws + WS_ALORA), (const bf16*)(F.ws + FW_WLORAT), 256, 256, 256};
        pg8::DenseOrder S; S.init(NTOK, 1536, F.G, (int)blockIdx.x);
        pg8::EpiLoraStore E{(unsigned char*)F.out, F.ws};
        pg8::gemm_phase<pg8::EpiLoraStore, pg8::DenseOrder>(F.lds + RING_OFF, g, S, E, F.tid);
    }
}

typedef float f32x2 __attribute__((ext_vector_type(2)));
__device__ __forceinline__ void rwkv_prepass_unit(Frame& F, int unit, LAS float* wl) {
    int lane = F.lane; asm volatile("" : "+v"(lane));
    const int c = unit & 127, bh = unit >> 7, h = bh & 7, b = bh >> 3, ch = h * 64 + lane;
    const size_t m0 = (size_t)b * T + (size_t)c * 64;
    const bf16* P = (const bf16*)(F.ws + WS_P); const bf16* LWA = (const bf16*)((const unsigned char*)F.out + DO_LWA);
    bf16* OLOC = (bf16*)(F.ws + WS_OLOC); bf16* QHAT = (bf16*)(F.ws + WS_QHAT); float* SB = (float*)(F.ws + WS_SB);
    const float* mu = F.in[14];
    const float mu_r = mu[ch], mu_k = mu[512 + ch], mu_v = mu[1024 + ch];
    const float w0v = F.in[15][ch], a0v = F.in[17][ch], kkv = F.in[20][ch], kav = F.in[21][ch], rkv = F.in[22][ch];
    f32x2 S[64];
#pragma unroll
    for (int k = 0; k < 64; ++k) { S[k].x = (k == lane) ? 1.f : 0.f; S[k].y = 0.f; }
    float pr = 0.f, pk = 0.f, pv = 0.f;
    if (c > 0) { const bf16* row = P + (m0 - 1) * PW; pr = bf2f(row[C_R + ch]); pk = bf2f(row[C_K + ch]); pv = bf2f(row[C_V + ch]); }
#pragma unroll 1
    for (int s8 = 0; s8 < 8; ++s8) {
#pragma unroll 2
        for (int tt = 0; tt < 8; ++tt) {
            const size_t m = m0 + s8 * 8 + tt; const bf16* row = P + m * PW;
            const float cr = bf2f(row[C_R + ch]), ck = bf2f(row[C_K + ch]), cv = bf2f(row[C_V + ch]);
            const float lw = bf2f(LWA[m * 1024 + ch]), la = bf2f(LWA[m * 1024 + 512 + ch]);
            const float r = cr + (pr - cr) * mu_r, kx = ck + (pk - ck) * mu_k, v = cv + (pv - cv) * mu_v;
            pr = cr; pk = ck; pv = cv;
            const float w = -__logf(1.f + __expf(-(w0v + lw))) - 0.5f;
            const float decay = __expf(-__expf(w));
            const float a = 1.f / (1.f + __expf(-(a0v + la)));
            float kk = kx * kkv;
            const float nrm = sqrtf(wave_sum(kk * kk));
            kk = kk / fmaxf(nrm, 1e-12f);
            const float km = kx * (1.f + (a - 1.f) * kav);
            const float sbv = wave_sum(r * km * rkv);
            if (lane == 0) SB[m * 8 + h] = sbv;
            LAS float* q = wl + tt * 384;
            q[lane] = -kk; q[64 + lane] = kk * a; q[128 + lane] = decay; q[192 + lane] = km; q[256 + lane] = r; q[320 + lane] = v;
        }
        LDS_WAIT(); asm volatile("" ::: "memory");
#pragma unroll 1
        for (int tt = 0; tt < 8; ++tt) {
            const LAS float* q = wl + tt * 384;
            const LAS f32x4* q4 = (const LAS f32x4*)q;
            f32x2 sa0 = {0.f, 0.f}, sa1 = {0.f, 0.f}, sa2 = {0.f, 0.f}, sa3 = {0.f, 0.f};
            f32x4 ca[4], na[4];
#pragma unroll
            for (int i = 0; i < 4; ++i) ca[i] = q4[i];
            f32x4 c0[4], c1[4];
#pragma unroll
            for (int g = 0; g < 4; ++g) {
                if (g < 3) {
#pragma unroll
                    for (int i = 0; i < 4; ++i) na[i] = q4[4 * (g + 1) + i];
                } else {
#pragma unroll
                    for (int i = 0; i < 4; ++i) { c0[i] = q4[16 * (i + 1)]; c1[i] = q4[16 * (i + 1) + 1]; }
                }
#pragma unroll
                for (int i = 0; i < 4; ++i) { const int kb = 4 * g + i; const f32x4 al = ca[i];
                    sa0 += S[4 * kb] * al.x; sa1 += S[4 * kb + 1] * al.y; sa2 += S[4 * kb + 2] * al.z; sa3 += S[4 * kb + 3] * al.w; }
                if (g < 3) {
#pragma unroll
                    for (int i = 0; i < 4; ++i) ca[i] = na[i];
                }
            }
            const f32x2 sa = (sa0 + sa1) + (sa2 + sa3);
            f32x2 vv; vv.x = 0.f; vv.y = q[320 + lane];
            f32x2 o0 = {0.f, 0.f}, o1 = {0.f, 0.f}, o2 = {0.f, 0.f}, o3 = {0.f, 0.f};
#pragma unroll
            for (int kb = 0; kb < 16; ++kb) {
                f32x4 n2[4];
                if (kb + 2 < 16) {
#pragma unroll
                    for (int i = 0; i < 4; ++i) n2[i] = q4[16 * (i + 1) + kb + 2];
                }
                const f32x4 be = c0[0], w = c0[1], km = c0[2], rr = c0[3];
                S[4 * kb] = S[4 * kb] * w.x + (sa * be.x + vv * km.x); o0 += S[4 * kb] * rr.x;
                S[4 * kb + 1] = S[4 * kb + 1] * w.y + (sa * be.y + vv * km.y); o1 += S[4 * kb + 1] * rr.y;
                S[4 * kb + 2] = S[4 * kb + 2] * w.z + (sa * be.z + vv * km.z); o2 += S[4 * kb + 2] * rr.z;
                S[4 * kb + 3] = S[4 * kb + 3] * w.w + (sa * be.w + vv * km.w); o3 += S[4 * kb + 3] * rr.w;
#pragma unroll
                for (int i = 0; i < 4; ++i) { c0[i] = c1[i]; if (kb + 2 < 16) c1[i] = n2[i]; }
            }
            const f32x2 o = (o0 + o1) + (o2 + o3);
            const size_t m = m0 + s8 * 8 + tt;
            QHAT[m * 512 + ch] = f2bf(o.x); OLOC[m * 512 + ch] = f2bf(o.y);
        }
        LDS_WAIT(); asm volatile("" ::: "memory");
    }
    int lane2 = lane; asm volatile("" : "+v"(lane2) :: "memory");
    bf16* PC = (bf16*)((unsigned char*)F.out + DO_PC) + (size_t)unit * 4096 + lane2; bf16* QCT = (bf16*)((unsigned char*)F.out + DO_QCT) + (size_t)unit * 4096 + lane2 * 64;
#pragma unroll
    for (int k = 0; k < 64; ++k) PC[k * 64] = f2bf(S[k].x);
#pragma unroll
    for (int k = 0; k < 64; k += 8) { v4u o; o.x = pk2(S[k].y, S[k + 1].y); o.y = pk2(S[k + 2].y, S[k + 3].y); o.z = pk2(S[k + 4].y, S[k + 5].y); o.w = pk2(S[k + 6].y, S[k + 7].y);
        *(v4u*)(QCT + k) = o; }
}
__device__ __forceinline__ void phase_lrulocal(Frame& F, bool dry = false) {
    const int gw = F.vcu * NWAVES + F.wave, NGW = F.G * NWAVES, lane = F.lane;
    {
        const bf16* GT = (const bf16*)(F.ws + WS_LOGA); bf16* GO = dry ? (bf16*)(F.ws + WS_OLOC) : (bf16*)(F.ws + WS_LOGA); const bf16* XC = (const bf16*)(F.ws + WS_XC);
        float* LA = (float*)(F.ws + WS_LRUA); float* LB = (float*)(F.ws + WS_LRUB);
        for (int task = gw; task < 4 * 128 * 8; task += NGW) { const int cg = task & 7, bc = task >> 3, ch = cg * 64 + lane;
            const float bav = F.in[9][ch], biv = F.in[11][ch], sp = -8.f * softplusf_(-F.in[12][ch]);
            const size_t m0 = (size_t)bc * 64; float sl = 0.f, hl = 0.f;
#pragma unroll 1
            for (int t8 = 0; t8 < 64; t8 += 8) {
                bf16 g0[8], g1[8], x8[8];
#pragma unroll
                for (int u = 0; u < 8; ++u) { const size_t m = m0 + t8 + u; g0[u] = GT[m * 1024 + ch]; g1[u] = GT[m * 1024 + 512 + ch]; x8[u] = XC[m * 512 + ch]; }
#pragma unroll
                for (int u = 0; u < 8; ++u) { const size_t m = m0 + t8 + u;
                    const float ra = bf2f(g0[u]) + bav, ia = bf2f(g1[u]) + biv, xc = bf2f(x8[u]);
                    const float r = sigmoidf_(ra), ig = sigmoidf_(ia);
                    const bf16 lab = f2bf(r * sp); const float la = bf2f(lab);
                    const bf16 bbb = f2bf(__builtin_amdgcn_sqrtf(fmaxf(1.f - fexp(2.f * la), 0.f)) * (ig * xc)); const float bb = bf2f(bbb);
                    GO[m * 1024 + ch] = lab; GO[m * 1024 + 512 + ch] = bbb;
                    sl += la; hl = fexp(la) * hl + bb; }
            }
            LA[bc * 512 + ch] = sl; LB[bc * 512 + ch] = hl; }
    }
}
__device__ __forceinline__ void phase_rwkvlocal(Frame& F) {
    const int gw = F.vcu * NWAVES + F.wave, NGW = F.G * NWAVES;
    {
        LAS float* wl = (LAS float*)(F.lds + RING_OFF + F.wave * 12288);
        for (int unit = gw; unit < 4096; unit += NGW) rwkv_prepass_unit(F, unit, wl);
    }
}

typedef short bf16x8_t __attribute__((ext_vector_type(8)));
typedef float f32x16 __attribute__((ext_vector_type(16)));
typedef __bf16 bf16x2n_t __attribute__((ext_vector_type(2)));
typedef float f32x2c_t __attribute__((ext_vector_type(2)));
__device__ __forceinline__ unsigned pkbf(float a, float b) { f32x2c_t v = {a, b}; bf16x2n_t r = __builtin_convertvector(v, bf16x2n_t); return __builtin_bit_cast(unsigned, r); }
__device__ __forceinline__ bf16 bf1(float a) { return (bf16)(pkbf(a, 0.f) & 0xffffu); }
constexpr int U_AT = 0, U_RT = 4096, U_BT = 8192, U_KT = 12288, U_BH = 16384, U_KH = 20480, U_VT = 24576, U_LM = 28672, U_G31 = 32768, UNIT_LDS = 33024;
__device__ __forceinline__ int a64(int row, int col) { return row * 128 + (((col >> 3) ^ (row & 7)) << 4) + ((col & 7) << 1); }
__device__ __forceinline__ int a32(int row, int col) { return row * 64 + (((col >> 2) ^ ((row >> 2) & 7)) << 3) + ((col & 3) << 1); }
__device__ __forceinline__ int crow_(int i, int h) { return (i & 3) + 8 * (i >> 2) + 4 * h; }
#define MFMA32(a, b, c) __builtin_amdgcn_mfma_f32_32x32x16_bf16((a), (b), (c), 0, 0, 0)
__device__ __forceinline__ bf16x8_t pack8(const f32x16& x, int s) {
    v4u p; p.x = pkbf(x[8 * s], x[8 * s + 1]); p.y = pkbf(x[8 * s + 2], x[8 * s + 3]); p.z = pkbf(x[8 * s + 4], x[8 * s + 5]); p.w = pkbf(x[8 * s + 6], x[8 * s + 7]);
    return __builtin_bit_cast(bf16x8_t, p); }
__device__ __forceinline__ bf16x8_t ld2x8(const LAS unsigned char* p0, const LAS unsigned char* p1) {
    const v2u lo = *(const LAS v2u*)p0, hi = *(const LAS v2u*)p1; v4u p; p.x = lo.x; p.y = lo.y; p.z = hi.x; p.w = hi.y; return __builtin_bit_cast(bf16x8_t, p); }

__device__ __forceinline__ void phase_rwkvlocal_mfma(Frame& F) {
    int lane = F.lane; asm volatile("" : "+v"(lane));
    const int wave = F.wave, u4 = wave >> 1, wh = wave & 1;
    LAS unsigned char* ub = F.lds + RING_OFF + u4 * UNIT_LDS;
    const bf16* P = (const bf16*)(F.ws + WS_P); const bf16* LWA = (const bf16*)((const unsigned char*)F.out + DO_LWA);
    bf16* OLOC = (bf16*)(F.ws + WS_OLOC); bf16* QHAT = (bf16*)(F.ws + WS_QHAT); float* SB = (float*)(F.ws + WS_SB);
    const float* mu = F.in[14];
    unsigned long long tacc_p = 0, tacc_c = 0;
#pragma unroll 1
    for (int ui = F.vcu; ui < 256; ui += F.G) {
        const int unit = ui * 4 + u4, c = unit & 31, bhd = unit >> 5, hd = bhd & 7, b = bhd >> 3;
        const size_t m0 = (size_t)b * T + (size_t)c * 256;
        f32x16 S[2][2];
        { int r = lane & 31, h = lane >> 5; asm volatile("" : "+v"(r), "+v"(h));
#pragma unroll
        for (int jt = 0; jt < 2; ++jt)
#pragma unroll
            for (int kt = 0; kt < 2; ++kt)
#pragma unroll
                for (int i = 0; i < 16; ++i) S[jt][kt][i] = (wh == 0 && jt == kt && crow_(i, h) == r) ? 1.f : 0.f;
        }
#pragma unroll 1
        for (int sc = 0; sc < 8; ++sc) {
            const size_t ms = m0 + 32 * sc;
            const unsigned long long tp0 = TIMER_A >= 0 ? __builtin_amdgcn_s_memrealtime() : 0ull;
            {
                int lanep = lane; asm volatile("" : "+v"(lanep));
                const int ch = hd * 64 + lanep;
                const float mu_r = mu[ch], mu_k = mu[512 + ch], mu_v = mu[1024 + ch];
                const float w0v = F.in[15][ch], a0v = F.in[17][ch], kkv = F.in[20][ch], kav = F.in[21][ch], rkv = F.in[22][ch];
                const size_t mb = ms + 16 * wh;
                bf16 p3[3] = {0, 0, 0};
                if ((mb % T) != 0) { const bf16* row = P + (mb - 1) * PW; p3[0] = row[C_R + ch]; p3[1] = row[C_K + ch]; p3[2] = row[C_V + ch]; }
                float cc = 0.f;
                if (wh) {
#pragma unroll 1
                    for (int t8 = 0; t8 < 16; t8 += 8) { bf16 lw8[8];
#pragma unroll
                        for (int t = 0; t < 8; ++t) lw8[t] = LWA[(ms + t8 + t) * 1024 + ch];
#pragma unroll
                        for (int t = 0; t < 8; ++t) { const float w = -flog(1.f + fexp(-(w0v + bf2f(lw8[t])))) - 0.5f; cc -= fexp(w); } }
                }
                float pr = bf2f(p3[0]), pk = bf2f(p3[1]), pv = bf2f(p3[2]);
                float sbkeep = 0.f, gprev = fexp(cc);
#pragma unroll 1
                for (int t8 = 0; t8 < 16; t8 += 8) {
                    bf16 qr[8], qk[8], qv[8], qw[8], qa[8];
#pragma unroll
                    for (int u = 0; u < 8; ++u) { const size_t m = mb + t8 + u; const bf16* row = P + m * PW;
                        qr[u] = row[C_R + ch]; qk[u] = row[C_K + ch]; qv[u] = row[C_V + ch]; qw[u] = LWA[m * 1024 + ch]; qa[u] = LWA[m * 1024 + 512 + ch]; }
#pragma unroll
                    for (int u = 0; u < 8; ++u) {
                        const int tt = t8 + u, t = 16 * wh + tt;
                        const float cr = bf2f(qr[u]), ck = bf2f(qk[u]), cv = bf2f(qv[u]);
                        const float lw = bf2f(qw[u]), la = bf2f(qa[u]);
                        const float rr = cr + (pr - cr) * mu_r, kx = ck + (pk - ck) * mu_k, v = cv + (pv - cv) * mu_v;
                        pr = cr; pk = ck; pv = cv;
                        const float w = -flog(1.f + fexp(-(w0v + lw))) - 0.5f;
                        cc -= fexp(w);
                        const float a = frcp(1.f + fexp(-(a0v + la)));
                        float kk = kx * kkv;
                        const float nrm = __builtin_amdgcn_sqrtf(wave_sum(kk * kk));
                        kk = kk * __builtin_amdgcn_rcpf(fmaxf(nrm, 1e-12f));
                        const float km = kx * (1.f + (a - 1.f) * kav);
                        const float sbv = wave_sum(rr * km * rkv);
                        if (lanep == tt) sbkeep = sbv;
                        const float gp = gprev, g = fexp(cc), ig = frcp(g);
                        gprev = g;
                        const float be = kk * a;
                        *(LAS bf16*)(ub + U_AT + a64(t, lanep)) = bf1(-kk * gp);
                        *(LAS bf16*)(ub + U_RT + a64(t, lanep)) = bf1(rr * g);
                        *(LAS bf16*)(ub + U_BT + a64(t, lanep)) = bf1(be * ig);
                        *(LAS bf16*)(ub + U_KT + a64(t, lanep)) = bf1(km * ig);
                        *(LAS bf16*)(ub + U_BH + a32(lanep, t)) = bf1(be * ig);
                        *(LAS bf16*)(ub + U_KH + a32(lanep, t)) = bf1(km * ig);
                        *(LAS bf16*)(ub + U_VT + a32(lanep, t)) = bf1(v);
                    }
                }
                if (lanep < 16) SB[(mb + lanep) * 8 + hd] = sbkeep;
                if (wh) *(LAS float*)(ub + U_G31 + lanep * 4) = gprev;
            }
            asm volatile("s_waitcnt lgkmcnt(0)" ::: "memory"); __builtin_amdgcn_s_barrier(); asm volatile("" ::: "memory");
            const unsigned long long tp1 = TIMER_A >= 0 ? __builtin_amdgcn_s_memrealtime() : 0ull;
            {
                int r = lane & 31, h = lane >> 5; asm volatile("" : "+v"(r), "+v"(h));
                bf16x8_t fT[2], fAk[2], fRb[2], fRk[2];
                {
                    f32x16 M, MT, R, RT;
#pragma unroll
                    for (int i = 0; i < 16; ++i) { M[i] = 0.f; MT[i] = 0.f; }
#pragma unroll
                    for (int ks = 0; ks < 4; ++ks) { const int o = a64(r, 16 * ks + 8 * h);
                        const bf16x8_t fb = *(const LAS bf16x8_t*)(ub + U_BT + o), fa = *(const LAS bf16x8_t*)(ub + U_AT + o);
                        M = MFMA32(fb, fa, M); MT = MFMA32(fa, fb, MT); }
#pragma unroll
                    for (int i = 0; i < 16; ++i) { const int q = crow_(i, h); M[i] = (q < r) ? M[i] : 0.f; MT[i] = (r < q) ? MT[i] : 0.f;
                        R[i] = M[i] + ((q == r) ? 1.f : 0.f); RT[i] = MT[i] + ((q == r) ? 1.f : 0.f); }
#pragma unroll
                    for (int lvl = 0; lvl < 4; ++lvl) {
                        bf16x8_t pm[2], pmt[2];
#pragma unroll
                        for (int ks = 0; ks < 2; ++ks) { pm[ks] = pack8(M, ks); pmt[ks] = pack8(MT, ks); }
                        f32x16 M2, MT2;
#pragma unroll
                        for (int i = 0; i < 16; ++i) { M2[i] = 0.f; MT2[i] = 0.f; }
#pragma unroll
                        for (int ks = 0; ks < 2; ++ks) { M2 = MFMA32(pmt[ks], pm[ks], M2); MT2 = MFMA32(pm[ks], pmt[ks], MT2); }
                        M = M2; MT = MT2;
                        bf16x8_t pr[2], prt[2];
#pragma unroll
                        for (int ks = 0; ks < 2; ++ks) { pm[ks] = pack8(M, ks); pr[ks] = pack8(R, ks); prt[ks] = pack8(RT, ks); }
#pragma unroll
                        for (int ks = 0; ks < 2; ++ks) { R = MFMA32(prt[ks], pm[ks], R); RT = MFMA32(pm[ks], prt[ks], RT); }
                        (void)pr;
                    }
#pragma unroll
                    for (int ks = 0; ks < 2; ++ks) fT[ks] = pack8(R, ks);
                }
                __builtin_amdgcn_sched_barrier(0);
                {
                    f32x16 Xak, Xrb, Xrk;
#pragma unroll
                    for (int i = 0; i < 16; ++i) { Xak[i] = 0.f; Xrb[i] = 0.f; Xrk[i] = 0.f; }
#pragma unroll
                    for (int ks = 0; ks < 4; ++ks) { const int o = a64(r, 16 * ks + 8 * h);
                        const bf16x8_t fb = *(const LAS bf16x8_t*)(ub + U_BT + o), fk = *(const LAS bf16x8_t*)(ub + U_KT + o);
                        const bf16x8_t fa = *(const LAS bf16x8_t*)(ub + U_AT + o), fr = *(const LAS bf16x8_t*)(ub + U_RT + o);
                        Xak = MFMA32(fk, fa, Xak); Xrb = MFMA32(fb, fr, Xrb); Xrk = MFMA32(fk, fr, Xrk); }
#pragma unroll
                    for (int i = 0; i < 16; ++i) { const int s = crow_(i, h); Xak[i] = (s < r) ? Xak[i] : 0.f; Xrb[i] = (s <= r) ? Xrb[i] : 0.f; Xrk[i] = (s <= r) ? Xrk[i] : 0.f; }
#pragma unroll
                    for (int ks = 0; ks < 2; ++ks) { fAk[ks] = pack8(Xak, ks); fRb[ks] = pack8(Xrb, ks); fRk[ks] = pack8(Xrk, ks); }
                }
#pragma unroll
                for (int jt = 0; jt < 2; ++jt) {
                    __builtin_amdgcn_sched_barrier(0);
                    bf16x8_t sf[2][2], vf[2];
#pragma unroll
                    for (int kt = 0; kt < 2; ++kt)
#pragma unroll
                        for (int ks = 0; ks < 2; ++ks) sf[kt][ks] = pack8(S[jt][kt], ks);
                    if (wh) {
#pragma unroll
                        for (int ks = 0; ks < 2; ++ks) vf[ks] = ld2x8(ub + U_VT + a32(32 * jt + r, 16 * ks + 4 * h), ub + U_VT + a32(32 * jt + r, 16 * ks + 8 + 4 * h));
                    }
                    f32x16 X1, Uu, Oo;
#pragma unroll
                    for (int i = 0; i < 16; ++i) { X1[i] = 0.f; Uu[i] = 0.f; Oo[i] = 0.f; }
#pragma unroll
                    for (int kt = 0; kt < 2; ++kt)
#pragma unroll
                        for (int ks = 0; ks < 2; ++ks) { const int c0 = 32 * kt + 16 * ks + 4 * h;
                            X1 = MFMA32(ld2x8(ub + U_AT + a64(r, c0), ub + U_AT + a64(r, c0 + 8)), sf[kt][ks], X1);
                            Oo = MFMA32(ld2x8(ub + U_RT + a64(r, c0), ub + U_RT + a64(r, c0 + 8)), sf[kt][ks], Oo); }
                    if (wh) {
#pragma unroll
                        for (int ks = 0; ks < 2; ++ks) { X1 = MFMA32(fAk[ks], vf[ks], X1); Oo = MFMA32(fRk[ks], vf[ks], Oo); }
                    }
                    __builtin_amdgcn_sched_barrier(0);
#pragma unroll
                    for (int ks = 0; ks < 2; ++ks) Uu = MFMA32(fT[ks], pack8(X1, ks), Uu);
                    bf16x8_t uf[2];
#pragma unroll
                    for (int ks = 0; ks < 2; ++ks) { uf[ks] = pack8(Uu, ks); Oo = MFMA32(fRb[ks], uf[ks], Oo); }
                    { bf16* dst = (wh ? OLOC : QHAT) + ms * 512 + hd * 64 + 32 * jt + r;
#pragma unroll
                      for (int i = 0; i < 16; ++i) dst[(size_t)crow_(i, h) * 512] = bf1(Oo[i]); }
                    __builtin_amdgcn_sched_barrier(0);
#pragma unroll
                    for (int kt = 0; kt < 2; ++kt) {
#pragma unroll
                        for (int ks = 0; ks < 2; ++ks) { const int k = 32 * kt + r, t0 = 16 * ks + 4 * h;
                            S[jt][kt] = MFMA32(ld2x8(ub + U_BH + a32(k, t0), ub + U_BH + a32(k, t0 + 8)), uf[ks], S[jt][kt]);
                            if (wh) S[jt][kt] = MFMA32(ld2x8(ub + U_KH + a32(k, t0), ub + U_KH + a32(k, t0 + 8)), vf[ks], S[jt][kt]); }
#pragma unroll
                        for (int g = 0; g < 4; ++g) { const f32x4 gg = *(const LAS f32x4*)(ub + U_G31 + (32 * kt + 8 * g + 4 * h) * 4);
                            S[jt][kt][4 * g] *= gg.x; S[jt][kt][4 * g + 1] *= gg.y; S[jt][kt][4 * g + 2] *= gg.z; S[jt][kt][4 * g + 3] *= gg.w; }
                    }
                }
            }
            asm volatile("s_waitcnt lgkmcnt(0)" ::: "memory"); __builtin_amdgcn_s_barrier(); asm volatile("" ::: "memory");
            if (TIMER_A >= 0) { const unsigned long long tp2 = __builtin_amdgcn_s_memrealtime(); tacc_p += tp1 - tp0; tacc_c += tp2 - tp1; }
        }
        int r = lane & 31, h = lane >> 5; asm volatile("" : "+v"(r), "+v"(h));
        if (wh == 0) { bf16* PC = (bf16*)((unsigned char*)F.out + DO_PC) + (size_t)unit * 4096;
#pragma unroll
            for (int jt = 0; jt < 2; ++jt)
#pragma unroll
                for (int kt = 0; kt < 2; ++kt)
#pragma unroll
                    for (int i = 0; i < 16; ++i) PC[(32 * kt + crow_(i, h)) * 64 + 32 * jt + r] = bf1(S[jt][kt][i]);
        } else { bf16* QCT = (bf16*)((unsigned char*)F.out + DO_QCT) + (size_t)unit * 4096;
#pragma unroll
            for (int jt = 0; jt < 2; ++jt)
#pragma unroll
                for (int kt = 0; kt < 2; ++kt)
#pragma unroll
                    for (int g = 0; g < 4; ++g) { v2u o; o.x = pkbf(S[jt][kt][4 * g], S[jt][kt][4 * g + 1]); o.y = pkbf(S[jt][kt][4 * g + 2], S[jt][kt][4 * g + 3]);
                        *(v2u*)(QCT + (32 * jt + r) * 64 + 32 * kt + 8 * g + 4 * h) = o; }
        }
    }
    if (TIMER_A >= 0 && blockIdx.x == 0 && threadIdx.x == 0) { ((unsigned long long*)(F.ws + 8192))[30] = tacc_p; ((unsigned long long*)(F.ws + 8192))[31] = tacc_c; }
}

template <int V> __device__ __forceinline__ void rwkv_scan(Frame& F, int bh) {
    constexpr int LDT = 72;
    constexpr int SBUF = 64 * LDT;
    LAS bf16* S0 = (LAS bf16*)(F.lds + RING_OFF);
    const int lane = F.lane, w = F.wave, q = lane >> 4, l15 = lane & 15;
    for (int i = F.tid; i < 2 * SBUF; i += 512) S0[i] = 0;
    __syncthreads();
    if (w < 4) {
        const int tr = w;
        const bf16* PC = (const bf16*)((const unsigned char*)F.out + DO_PC) + (size_t)bh * 32 * 4096 + (16 * tr + l15) * 64 + 8 * q;
        const bf16* QCT = (const bf16*)((const unsigned char*)F.out + DO_QCT) + (size_t)bh * 32 * 4096 + l15 * 64 + 16 * tr + 4 * q;
        const int boff0 = l15 * LDT + 8 * q, woff0 = l15 * LDT + 16 * tr + 4 * q;
        bf16x8_t A[8][2]; v2u Qv[8][4];
#define SCAN_LOAD(s, cc) do { \
        asm volatile("global_load_dwordx4 %0, %1, off" : "=v"(A[s][0]) : "v"(PC + (size_t)(cc) * 4096) : "memory"); \
        asm volatile("global_load_dwordx4 %0, %1, off offset:64" : "=v"(A[s][1]) : "v"(PC + (size_t)(cc) * 4096) : "memory"); \
        asm volatile("global_load_dwordx2 %0, %1, off" : "=v"(Qv[s][0]) : "v"(QCT + (size_t)(cc) * 4096) : "memory"); \
        asm volatile("global_load_dwordx2 %0, %1, off offset:2048" : "=v"(Qv[s][1]) : "v"(QCT + (size_t)(cc) * 4096) : "memory"); \
        asm volatile("global_load_dwordx2 %0, %1, off" : "=v"(Qv[s][2]) : "v"(QCT + (size_t)(cc) * 4096 + 2048) : "memory"); \
        asm volatile("global_load_dwordx2 %0, %1, off offset:2048" : "=v"(Qv[s][3]) : "v"(QCT + (size_t)(cc) * 4096 + 2048) : "memory"); } while (0)
#pragma unroll
        for (int s = 0; s < 8; ++s) SCAN_LOAD(s, s);
        if (V == 0) TSTAMP(F, 22); else TSTAMP(F, 26);
#pragma unroll 1
        for (int c0 = 0; c0 < 32; c0 += 8) {
#pragma unroll
            for (int s = 0; s < 8; ++s) {
                const int c = c0 + s;
                const LAS bf16* Sr = S0 + (s & 1) * SBUF; LAS bf16* Sw = S0 + ((s & 1) ^ 1) * SBUF;
                if (V != 3) asm volatile("s_waitcnt vmcnt(42)" : "+v"(A[s][0]), "+v"(A[s][1]), "+v"(Qv[s][0]), "+v"(Qv[s][1]), "+v"(Qv[s][2]), "+v"(Qv[s][3]) :: "memory");
                pg8::f32x4 acc[4];
#pragma unroll
                for (int t = 0; t < 4; ++t) { acc[t][0] = bflo(Qv[s][t].x); acc[t][1] = bfhi(Qv[s][t].x); acc[t][2] = bflo(Qv[s][t].y); acc[t][3] = bfhi(Qv[s][t].y); }
#pragma unroll
                for (int ks = 0; ks < 2; ++ks)
#pragma unroll
                    for (int t = 0; t < 4; ++t) {
                        if (V != 4) { const bf16x8_t bh_ = *(const LAS bf16x8_t*)(Sr + boff0 + 16 * LDT * t + 32 * ks);
                        acc[t] = __builtin_amdgcn_mfma_f32_16x16x32_bf16(A[s][ks], bh_, acc[t], 0, 0, 0); }
                    }
                if (V != 3) { const int cn = (c + 8 < 32) ? c + 8 : 31; SCAN_LOAD(s, cn); }
#pragma unroll
                for (int t = 0; t < 4; ++t) { v2u oh; oh.x = pg8::cvt_pk_bf16(acc[t][0], acc[t][1]); oh.y = pg8::cvt_pk_bf16(acc[t][2], acc[t][3]);
                    *(LAS v2u*)(Sw + woff0 + 16 * LDT * t) = oh; }
                asm volatile("s_waitcnt lgkmcnt(0)" ::: "memory"); __builtin_amdgcn_s_barrier(); asm volatile("" ::: "memory");
            }
        }
#undef SCAN_LOAD
        if (V == 0) TSTAMP(F, 23); else TSTAMP(F, 27);
        asm volatile("s_waitcnt vmcnt(0)" ::: "memory");
    } else {
        const int t256 = F.tid - 256;
        bf16* HIN = (V == 0 ? (bf16*)((unsigned char*)F.out + DO_HIN) : (bf16*)(F.ws + WS_XC)) + (size_t)bh * 32 * 4096 + (t256 >> 2) * 64 + (t256 & 3) * 16;
        const int hoff = (t256 >> 2) * LDT + (t256 & 3) * 16;
#pragma unroll 1
        for (int c = 0; c < 32; ++c) {
            const LAS bf16* Sr = S0 + (c & 1) * SBUF;
            const v4u x0 = *(const LAS v4u*)(Sr + hoff), x1 = *(const LAS v4u*)(Sr + hoff + 8);
            if (V != 2) { *(v4u*)(HIN + (size_t)c * 4096) = x0; *(v4u*)(HIN + (size_t)c * 4096 + 8) = x1; }
            asm volatile("s_waitcnt lgkmcnt(0)" ::: "memory"); __builtin_amdgcn_s_barrier(); asm volatile("" ::: "memory");
        }
    }
}
__device__ __forceinline__ void phase_scan(Frame& F, int flags) {
    if ((flags & 4) && blockIdx.x >= 36) { TSTAMP_B(F, 36, 24); expert_transposes(F, ((int)blockIdx.x - 36) * NWAVES + F.wave, ((int)F.G - 36) * NWAVES); __syncthreads(); TSTAMP_B(F, 36, 25); }
#ifndef SCAN_VARIANT
#define SCAN_VARIANT 0
#endif
    if ((flags & 2) && blockIdx.x < 32) { rwkv_scan<0>(F, blockIdx.x); if (SCAN_VARIANT) { __syncthreads(); rwkv_scan<SCAN_VARIANT>(F, blockIdx.x); } }
    if ((flags & 1) && blockIdx.x >= 32 && blockIdx.x < 36) {
        const int idx = (blockIdx.x - 32) * 512 + F.tid, b = idx >> 9, ch = idx & 511;
        const float* LA = (const float*)(F.ws + WS_LRUA); const float* LB = (const float*)(F.ws + WS_LRUB); float* LH = (float*)(F.ws + WS_LRUH);
        float h = 0.f;
#pragma unroll 1
        for (int c16 = 0; c16 < 128; c16 += 16) { float a16[16], b16[16];
#pragma unroll
            for (int u = 0; u < 16; ++u) { const int o = (b * 128 + c16 + u) * 512 + ch; a16[u] = LA[o]; b16[u] = LB[o]; }
#pragma unroll
            for (int u = 0; u < 16; ++u) { const int o = (b * 128 + c16 + u) * 512 + ch; LH[o] = h; h = fexp(a16[u]) * h + b16[u]; } }
    }
}

__device__ __forceinline__ void rwkv_post_unit(Frame& F, int unit) {
    int lane = F.lane; asm volatile("" : "+v"(lane));
    const int c = unit & 127, bh = unit >> 7, h = bh & 7, b = bh >> 3, q = lane >> 4, l15 = lane & 15;
    const size_t m0 = (size_t)b * T + (size_t)c * 64;
    const bf16* QHAT = (const bf16*)(F.ws + WS_QHAT); const bf16* OLOC = (const bf16*)(F.ws + WS_OLOC); const bf16* GG = (const bf16*)(F.ws + WS_GG);
    const bf16* HIN = (const bf16*)((const unsigned char*)F.out + DO_HIN) + (size_t)(bh * 32 + (c >> 2)) * 4096; const bf16* P = (const bf16*)(F.ws + WS_P);
    const float* SB = (const float*)(F.ws + WS_SB); bf16* YMIX = (bf16*)(F.ws + WS_YMIX);
    bf16x8_t Af[4][2];
#pragma unroll
    for (int jt = 0; jt < 4; ++jt)
#pragma unroll
        for (int ks = 0; ks < 2; ++ks) Af[jt][ks] = *(const bf16x8_t*)(HIN + (16 * jt + l15) * 64 + 32 * ks + 8 * q);
    f32x4 lnw[4], lnb[4], muv[4];
#pragma unroll
    for (int jt = 0; jt < 4; ++jt) { const int ch = h * 64 + 16 * jt + 4 * q; lnw[jt] = *(const f32x4*)(F.in[23] + ch); lnb[jt] = *(const f32x4*)(F.in[24] + ch); muv[jt] = *(const f32x4*)(F.in[14] + 1024 + ch); }
#pragma unroll 1
    for (int tt = 0; tt < 4; ++tt) {
        const size_t m = m0 + 16 * tt + l15;
        bf16x8_t Bf[2];
#pragma unroll
        for (int ks = 0; ks < 2; ++ks) Bf[ks] = *(const bf16x8_t*)(QHAT + m * 512 + h * 64 + 32 * ks + 8 * q);
        pg8::f32x4 acc[4];
#pragma unroll
        for (int jt = 0; jt < 4; ++jt) { const v2u o = *(const v2u*)(OLOC + m * 512 + h * 64 + 16 * jt + 4 * q); acc[jt][0] = bflo(o.x); acc[jt][1] = bfhi(o.x); acc[jt][2] = bflo(o.y); acc[jt][3] = bfhi(o.y); }
#pragma unroll
        for (int ks = 0; ks < 2; ++ks)
#pragma unroll
            for (int jt = 0; jt < 4; ++jt) acc[jt] = __builtin_amdgcn_mfma_f32_16x16x32_bf16(Af[jt][ks], Bf[ks], acc[jt], 0, 0, 0);
        float s = 0.f;
#pragma unroll
        for (int jt = 0; jt < 4; ++jt) s += (acc[jt][0] + acc[jt][1]) + (acc[jt][2] + acc[jt][3]);
        s += __shfl_xor(s, 16); s += __shfl_xor(s, 32);
        const float mean = s * (1.f / 64.f);
        float vs = 0.f;
#pragma unroll
        for (int jt = 0; jt < 4; ++jt)
#pragma unroll
            for (int i = 0; i < 4; ++i) { acc[jt][i] -= mean; vs += acc[jt][i] * acc[jt][i]; }
        vs += __shfl_xor(vs, 16); vs += __shfl_xor(vs, 32);
        const float rstd = rsqrtf(vs * (1.f / 64.f) + 64e-5f);
        const float sbv = SB[m * 8 + h];
        const bool first = ((m % T) == 0);
#pragma unroll
        for (int jt = 0; jt < 4; ++jt) { const int ch = h * 64 + 16 * jt + 4 * q;
            const v2u cvq = *(const v2u*)(P + m * PW + C_V + ch); v2u pvq = {0u, 0u}; if (!first) pvq = *(const v2u*)(P + (m - 1) * PW + C_V + ch);
            const v2u gq = *(const v2u*)(GG + m * 512 + ch);
            const float cv[4] = {bflo(cvq.x), bfhi(cvq.x), bflo(cvq.y), bfhi(cvq.y)}, pv[4] = {bflo(pvq.x), bfhi(pvq.x), bflo(pvq.y), bfhi(pvq.y)}, gg[4] = {bflo(gq.x), bfhi(gq.x), bflo(gq.y), bfhi(gq.y)};
            float y[4];
#pragma unroll
            for (int i = 0; i < 4; ++i) { const float v = cv[i] + (pv[i] - cv[i]) * muv[jt][i]; y[i] = (acc[jt][i] * rstd * lnw[jt][i] + lnb[jt][i] + sbv * v) * gg[i]; }
            v2u o; o.x = pk2(y[0], y[1]); o.y = pk2(y[2], y[3]);
            *(v2u*)(YMIX + m * D + 512 + ch) = o; }
    }
}
__device__ __forceinline__ void phase_post(Frame& F, int flags) {
    const int gw = F.vcu * NWAVES + F.wave, NGW = F.G * NWAVES, lane = F.lane;
    if (flags & 2) for (int unit = gw; unit < 4096; unit += NGW) rwkv_post_unit(F, unit);
    if (flags & 1) {
        const bf16* GT = (const bf16*)(F.ws + WS_LOGA); const bf16* P = (const bf16*)(F.ws + WS_P);
        const float* LH = (const float*)(F.ws + WS_LRUH); bf16* YMIX = (bf16*)(F.ws + WS_YMIX); const float* ng = F.in[13];
        for (int task = gw; task < 4 * 128 * 8; task += NGW) { const int cg = task & 7, bc = task >> 3, ch = cg * 64 + lane;
            const size_t m0 = (size_t)bc * 64; float hl = LH[bc * 512 + ch]; const float g = ng[ch];
#pragma unroll 1
            for (int t8 = 0; t8 < 64; t8 += 8) {
                bf16 g0[8], g1[8], p8[8];
#pragma unroll
                for (int u = 0; u < 8; ++u) { const size_t m = m0 + t8 + u; g0[u] = GT[m * 1024 + ch]; g1[u] = GT[m * 1024 + 512 + ch]; p8[u] = P[m * PW + C_GATE + ch]; }
#pragma unroll
                for (int u = 0; u < 8; ++u) { const size_t m = m0 + t8 + u;
                    const float la = bf2f(g0[u]), bb = bf2f(g1[u]); hl = fexp(la) * hl + bb;
                    float y = hl * gelu_tanh(bf2f(p8[u]));
                    const float ss = wave_sum(y * y) * (1.f / 64.f);
                    YMIX[m * D + ch] = f2bf(y * rsqrtf(ss + 1e-6f) * g); }
            }
        }
    }
}

struct Args { const float* in[35]; float* out; unsigned char* ws; int ph_lo, ph_hi, flags, pad; };
__global__ void __launch_bounds__(NWAVES * 64, 2) mk_fwd(Args args) {
    extern __shared__ __attribute__((aligned(16))) unsigned char lds[];
    Frame F;
    F.lds = (LAS unsigned char*)lds;
    F.tid = threadIdx.x; F.lane = F.tid & 63; F.wave = __builtin_amdgcn_readfirstlane(F.tid >> 6);
    F.G = gridDim.x; { const int bx = blockIdx.x; F.vcu = (F.G % 8 == 0) ? (bx % 8) * (F.G / 8) + bx / 8 : bx; }
    F.in = args.in; F.out = args.out; F.ws = args.ws;
    const int lo = args.ph_lo, hi = args.ph_hi;
#define IN(k) (lo <= (k) && (k) < hi)
    const int flags = args.flags;
    for (int u = threadIdx.x; u < (LDS_BYTES - LDSCTL_OFF) / 4; u += NWAVES * 64) ((LAS unsigned*)(F.lds + LDSCTL_OFF))[u] = 0u;
    __syncthreads();
    XcdBarrier bar; bar.bar = (unsigned*)(args.ws + WS_CTL) + CW_BAR; bar.x = 0; bar.st = nullptr;
    if (hi - lo > 1) bar = xcd_barrier_post((unsigned*)(args.ws + WS_CTL) + CW_BAR, (volatile LAS unsigned*)(F.lds + MISC_OFF) + 8);
#define SEAM(k) if (IN(k) && IN((k) + 1)) { xcd_barrier(bar); TSTAMP(F, (k) + 1); }
#ifndef DUP_MASK
#define DUP_MASK 0
#endif
#define PH1(k, call) { int t_ = threadIdx.x; asm volatile("" : "+v"(t_)); F.tid = t_; F.lane = t_ & 63; F.wave = __builtin_amdgcn_readfirstlane(t_ >> 6); call; }
#define PH(k, bit, call) if (IN(k)) { PH1(k, call) if ((DUP_MASK >> (bit)) & 1) { xcd_barrier(bar); PH1(k, call) } }
    TSTAMP(F, 0);
    PH(0, 0, (phase0(F), p0_small_weights(F)))
    SEAM(0)
    PH(1, 1, phase1(F))
    SEAM(1)
    PH(2, 2, phase2(F))
    SEAM(2)
    PH(3, 3, phase_prepA(F))
    SEAM(3)
    PH(4, 4, phase_gategemm(F))
    PH(4, 5, phase_loragemm(F))
    SEAM(4)
    if ((DUP_MASK >> 6) & 1) { if (IN(5)) { PH1(5, phase_lrulocal(F, true)) xcd_barrier(bar); } }
    PH(5, 30, phase_lrulocal(F))
#ifndef RWKV_MFMA
#define RWKV_MFMA 1
#endif
    if (RWKV_MFMA) { PH(5, 7, phase_rwkvlocal_mfma(F)) } else { PH(5, 7, phase_rwkvlocal(F)) }
    SEAM(5)
    if ((DUP_MASK >> 8) & 1) { if (IN(6)) { PH1(6, phase_scan(F, 6)) xcd_barrier(bar); } }
    PH(6, 30, phase_scan(F, flags | 4))
    SEAM(6)
    PH(7, 9, phase_post(F, flags))
    SEAM(7)
    PH(8, 10, phase_outproj(F))
    SEAM(8)
    if ((DUP_MASK >> 11) & 1) { if (IN(9)) { PH1(9, phase_route(F)) xcd_barrier(bar); if (blockIdx.x == 0 && threadIdx.x < 32) ((int*)(args.ws + WS_CNT))[threadIdx.x * 64] = 0; xcd_barrier(bar); } }
    PH(9, 30, phase_route(F))
    SEAM(9)
    PH(10, 12, phase_m1(F))
    SEAM(10)
    PH(11, 13, phase_m2(F))
    SEAM(11)
    if ((DUP_MASK >> 14) & 1) { if (IN(12)) { PH1(12, phase_final(F, true)) xcd_barrier(bar); } }
    PH(12, 30, phase_final(F))
#undef SEAM
#undef PH
#undef PH1
#undef IN
}

extern "C" void kernel_launch(void* const* d_in, const int* in_sizes, int n_in, void* d_out, int out_size, void* d_ws, size_t ws_size, hipStream_t stream) {
    if (n_in != 35 || out_size != NTOK * D || ws_size < WS_END) { fprintf(stderr, "kernel_launch: unexpected shapes (n_in %d out %d ws %zu)\n", n_in, out_size, ws_size); return; }
    static int grid = 0;
    if (grid == 0) {
        int dev = 0, cus = 0;
        if (hipGetDevice(&dev) != hipSuccess || hipDeviceGetAttribute(&cus, hipDeviceAttributeMultiprocessorCount, dev) != hipSuccess) { grid = -1; return; }
        if (hipFuncSetAttribute((const void*)mk_fwd, hipFuncAttributeMaxDynamicSharedMemorySize, LDS_BYTES) != hipSuccess) { fprintf(stderr, "kernel_launch: hipFuncSetAttribute failed\n"); grid = -1; return; }
        int per_cu = 0;
        if (hipOccupancyMaxActiveBlocksPerMultiprocessor(&per_cu, (const void*)mk_fwd, NWAVES * 64, LDS_BYTES) != hipSuccess || per_cu < 1) { fprintf(stderr, "kernel_launch: occupancy query says %d blocks per CU\n", per_cu); (void)hipGetLastError(); }
        grid = cus;
    }
    if (grid < 0) return;
    const float* const* in = (const float* const*)d_in;
    char* ws = (char*)d_ws; float* out = (float*)d_out;
    Args a{};
    for (int i = 0; i < 35; ++i) a.in[i] = in[i];
    a.out = out; a.ws = (unsigned char*)d_ws;
    hipMemsetAsync(ws + WS_CTL, 0, 1 * MiB, stream);
#define LAUNCH_PH(p) do { a.ph_lo = (p); a.ph_hi = (p) + 1; hipLaunchKernelGGL(mk_fwd, dim3(grid), dim3(NWAVES * 64), LDS_BYTES, stream, a); } while (0)
#ifndef MIX_FLAGS
#define MIX_FLAGS 3
#endif
    a.flags = MIX_FLAGS;
#ifndef N_LAUNCHES
#define N_LAUNCHES 1
#endif
    if (N_LAUNCHES == 1) { a.ph_lo = 0; a.ph_hi = 13; hipLaunchKernelGGL(mk_fwd, dim3(grid), dim3(NWAVES * 64), LDS_BYTES, stream, a); }
    else { for (int p = 0; p < 13; ++p) LAUNCH_PH(p); }
}
```

```cpp
#include <hip/hip_runtime.h>
#include <stdint.h>
#include <cstdio>

#define SCAN_NOLO 1
#ifndef TIMER_A
#define TIMER_A -1
#define TIMER_B -1
#endif
#define TSTAMP(F_, i) do { if (TIMER_A >= 0 && blockIdx.x == 0 && threadIdx.x == 0) ((unsigned long long*)((F_).ws + 8192))[i] = __builtin_amdgcn_s_memrealtime(); } while (0)
#define TSTAMP_B(F_, blk, i) do { if (TIMER_A >= 0 && blockIdx.x == (blk) && threadIdx.x == 0) ((unsigned long long*)((F_).ws + 8192))[i] = __builtin_amdgcn_s_memrealtime(); } while (0)
#define TACCUM(F_, i, t0) do { if (TIMER_A >= 0 && blockIdx.x == 0 && threadIdx.x == 0) ((unsigned long long*)((F_).ws + 8192))[i] += __builtin_amdgcn_s_memrealtime() - (t0); } while (0)
typedef unsigned short bf16;
__device__ __forceinline__ bf16 f2bf(float f) { unsigned u = __float_as_uint(f); return (bf16)((u + 0x7fffu + ((u >> 16) & 1u)) >> 16); }
__device__ __forceinline__ float bf2f(bf16 b) { return __uint_as_float(((unsigned)b) << 16); }

constexpr int NB = 4, T = 8192, D = 1024, NTOK = NB * T;
constexpr int LRU_W = 512, RW = 512, PW = 2816;
constexpr int C_UX = 0, C_GATE = 512, C_R = 1024, C_K = 1536, C_V = 2048, C_WD = 2560, C_AD = 2624, C_GD = 2688;
constexpr int NE = 32, DE = 512;
constexpr size_t MiB = 1u << 20;
constexpr size_t WS_CTL = 0;
constexpr int CW_BAR = 4096;
constexpr size_t WS_CNT = 512 * 1024;
constexpr size_t WS_MOD = 1 * MiB;
constexpr size_t WS_SELW = 384 * MiB;
constexpr size_t WS_SEL = 1 * MiB + 512 * 1024;
constexpr size_t FW_WLORAT = 2 * MiB;
constexpr size_t FW_WGT = 3 * MiB;
constexpr size_t FW_WR = 3 * MiB + 512 * 1024;
constexpr size_t FW_WINT = 4 * MiB;
constexpr size_t FW_WOUTT = 10 * MiB;
constexpr size_t WS_LIST = 12 * MiB;
constexpr size_t WS_H = 16 * MiB;
constexpr size_t WS_YMIX = WS_H;
constexpr size_t WS_P = 80 * MiB;
constexpr size_t WS_HID = WS_P;
constexpr size_t WS_YS = 256 * MiB;
constexpr size_t FW_W13T = 416 * MiB;
constexpr size_t FW_W2T = 480 * MiB;
constexpr size_t WS_END = 512 * MiB;

__device__ __forceinline__ float wave_sum(float v) {
    v += __int_as_float(__builtin_amdgcn_update_dpp(0, __float_as_int(v), 0xB1, 0xF, 0xF, true));
    v += __int_as_float(__builtin_amdgcn_update_dpp(0, __float_as_int(v), 0x4E, 0xF, 0xF, true));
    v += __int_as_float(__builtin_amdgcn_update_dpp(0, __float_as_int(v), 0x141, 0xF, 0xF, true));
    v += __int_as_float(__builtin_amdgcn_update_dpp(0, __float_as_int(v), 0x140, 0xF, 0xF, true));
    const int vi = __float_as_int(v);
    const float r0 = __int_as_float(__builtin_amdgcn_readlane(vi, 0)), r1 = __int_as_float(__builtin_amdgcn_readlane(vi, 16));
    const float r2 = __int_as_float(__builtin_amdgcn_readlane(vi, 32)), r3 = __int_as_float(__builtin_amdgcn_readlane(vi, 48));
    return (r0 + r1) + (r2 + r3);
}
__device__ __forceinline__ float fexp(float x) { return __builtin_amdgcn_exp2f(x * 1.44269504089f); }
__device__ __forceinline__ float flog(float x) { return __builtin_amdgcn_logf(x) * 0.69314718056f; }
__device__ __forceinline__ float frcp(float x) { return __builtin_amdgcn_rcpf(x); }
__device__ __forceinline__ float sigmoidf_(float x) { return frcp(1.f + fexp(-x)); }
__device__ __forceinline__ float softplusf_(float x) { return x > 20.f ? x : flog(1.f + fexp(x)); }
__device__ __forceinline__ float ftanh(float u) { return 1.f - 2.f * frcp(1.f + fexp(2.f * u)); }
__device__ __forceinline__ float gelu_tanh(float x) { const float u = 0.7978845608028654f * (x + 0.044715f * x * x * x); return 0.5f * x * (1.f + ftanh(u)); }

namespace pg8 {
#define PG8_LAS __attribute__((address_space(3)))
typedef unsigned short bf16_t;
typedef short bf16x8 __attribute__((ext_vector_type(8)));
typedef float f32x4 __attribute__((ext_vector_type(4)));
typedef unsigned u32x4 __attribute__((ext_vector_type(4)));
constexpr int BM = 256, BK = 64, HALF = 128, HTB = HALF * BK * 2  , STAGE_BYTES = 8 * HTB, NXCD = 8, WGM = 8;

__host__ __device__ __forceinline__ int lds_byte(int r, int c) { const int st = (r >> 4) * 2 + (c >> 5), rr = r & 15, cc = c & 31, ob = rr * 64 + cc * 2; return st * 1024 + (ob ^ (((ob >> 9) & 1) << 5)); }
__host__ __device__ __forceinline__ void stage_rc(int b, int& R, int& C) { const int st = b / 1024, sb = b % 1024, swz = sb ^ (((sb >> 9) & 1) << 5); R = (st >> 1) * 16 + swz / 64; C = (st & 1) * 32 + (swz % 64) / 2; }
__host__ __device__ __forceinline__ int perm32(int rho) { const int n = rho >> 4, i = rho & 15; return 8 * (i >> 2) + 4 * n + (i & 3); }

struct Unit { int pm, pn, e, nrows, row0; };
struct Gemm { const bf16_t* A; const bf16_t* Bt; int lda, ldb, K; };

__device__ __forceinline__ unsigned cvt_pk_bf16(float lo, float hi) { unsigned r; asm volatile("v_cvt_pk_bf16_f32 %0, %1, %2" : "=v"(r) : "v"(lo), "v"(hi)); return r; }

struct DenseOrder {
    static constexpr bool GATHER = false;
    int nM, nN, nwg, G, c;
    __device__ void init(int M, int N, int G_, int c_) { nM = M / BM; nN = N / BM; nwg = nM * nN; G = G_; c = c_; }
    __device__ bool next(int i, Unit& u) const {
        const long L = (long)i * G + c; if (L >= nwg) return false;
        int wgid = (int)L; { const int q = nwg / NXCD, r = nwg % NXCD, xcd = wgid % NXCD, off = wgid / NXCD; wgid = (xcd < r ? xcd * (q + 1) : r * (q + 1) + (xcd - r) * q) + off; }
        const int nig = WGM * nN, gid = wgid / nig, fm = gid * WGM, gsz = (nM - fm) < WGM ? (nM - fm) : WGM;
        u.pm = fm + ((wgid % nig) % gsz); u.pn = (wgid % nig) / gsz; u.e = 0; u.nrows = 256; u.row0 = 0; return true;
    }
    __device__ __forceinline__ const char* a_base(const Gemm& g, const Unit& u) const { return (const char*)g.A + (size_t)u.pm * (BM * 2) * g.lda; }
    __device__ __forceinline__ const char* b_base(const Gemm& g, const Unit& u) const { return (const char*)g.Bt + (size_t)u.pn * (BM * 2) * g.ldb; }
    __device__ __forceinline__ int row(const Unit&, int) const { return 0; }
};

template <class Epi, class Sched>
__device__ __forceinline__ void gemm_phase(PG8_LAS unsigned char* lds, const Gemm g, const Sched& S, const Epi& E, const int tid) {
    const int wid = __builtin_amdgcn_readfirstlane(tid >> 6), lane = tid & 63, wr = wid >> 2, wc = wid & 3, fr = lane & 15, fq = lane >> 4;
    const int K = g.K, nt = K / BK;
    unsigned voffA[2], voffB[2]; int sR[2], sC[2];
#pragma unroll
    for (int i = 0; i < 2; ++i) { int R, C; stage_rc(tid * 16 + i * 8192, R, C); const int Rb = Epi::PERM ? ((R & ~31) + perm32(R & 31)) : R;
        voffA[i] = (unsigned)(R * g.lda + C) * 2u; voffB[i] = (unsigned)(Rb * g.ldb + C) * 2u; sR[i] = R; sC[i] = C; }
    const size_t kstep = (size_t)(BK * 2);
    const size_t hstepA = Sched::GATHER ? 0 : (size_t)HALF * g.lda * 2, hstepB = (size_t)HALF * g.ldb * 2;
    const unsigned ldsw = (unsigned)wid * 1024u;
    const int aoff = lds_byte(wr * 64 + fr, fq * 8), boff = lds_byte(wc * 32 + fr, fq * 8);
    unsigned gA[2][2], gN[2][2];
#define PG8_SA(b, h) (((b) * 2 + (h)) * HTB)
#define PG8_SB(b, h) ((4 + (b) * 2 + (h)) * HTB)
#define PG8_STAGE(bufoff, gbase, voff) do { _Pragma("unroll") for (int _i = 0; _i < 2; ++_i) \
        __builtin_amdgcn_global_load_lds((const unsigned*)((const char*)(gbase) + (voff)[_i]), (PG8_LAS unsigned*)(lds + (bufoff) + ldsw + _i * 8192), 16, 0, 0); } while (0)
#define PG8_STAGE_A(bufoff, kp, h, OFF) do { if constexpr (Sched::GATHER) PG8_STAGE(bufoff, kp, OFF[h]); else PG8_STAGE(bufoff, (kp) + (h) * hstepA, voffA); } while (0)
#define PG8_LDA(dst, b, h) do { _Pragma("unroll") for (int m = 0; m < 4; ++m) _Pragma("unroll") for (int k = 0; k < 2; ++k) dst[m][k] = *(const PG8_LAS bf16x8*)(lds + PG8_SA(b, h) + aoff + m * 2048 + k * 1024); } while (0)
#define PG8_LDB(dst, b, h) do { _Pragma("unroll") for (int n = 0; n < 2; ++n) _Pragma("unroll") for (int k = 0; k < 2; ++k) dst[n][k] = *(const PG8_LAS bf16x8*)(lds + PG8_SB(b, h) + boff + n * 2048 + k * 1024); } while (0)
#define PG8_MMA(ai, bj, At, Bt) do { __builtin_amdgcn_s_setprio(1); _Pragma("unroll") for (int m = 0; m < 4; ++m) _Pragma("unroll") for (int n = 0; n < 2; ++n) _Pragma("unroll") for (int k = 0; k < 2; ++k) \
        acc[ai][bj][m][n] = __builtin_amdgcn_mfma_f32_16x16x32_bf16(Bt[n][k], At[m][k], acc[ai][bj][m][n], 0, 0, 0); __builtin_amdgcn_s_setprio(0); } while (0)
#define PG8_WAIT_V(n) asm volatile("s_waitcnt vmcnt(" #n ")" ::: "memory")
#define PG8_WAIT_L(n) asm volatile("s_waitcnt lgkmcnt(" #n ")" ::: "memory")
#define PG8_BAR __builtin_amdgcn_s_barrier()
#define PG8_SCHED __builtin_amdgcn_sched_barrier(0)
    Unit cur, nxt; int ui = 0;
    if (!S.next(0, cur)) return;
    f32x4 acc[2][2][4][2];
#pragma unroll
    for (int a = 0; a < 2; ++a)
#pragma unroll
        for (int b = 0; b < 2; ++b)
#pragma unroll
            for (int m = 0; m < 4; ++m)
#pragma unroll
                for (int n = 0; n < 2; ++n) acc[a][b][m][n] = (f32x4){0.f, 0.f, 0.f, 0.f};
    bf16x8 At[4][2], B0[2][2], B1[2][2];
    const char* cA = S.a_base(g, cur); const char* cB = S.b_base(g, cur);
    if constexpr (Sched::GATHER) {
#pragma unroll
        for (int h = 0; h < 2; ++h)
#pragma unroll
            for (int i = 0; i < 2; ++i) gA[h][i] = (unsigned)(S.row(cur, h * HALF + sR[i]) * g.lda + sC[i]) * 2u;
    }
    PG8_STAGE(PG8_SB(0, 0), cB, voffB); PG8_STAGE(PG8_SB(0, 1), cB + hstepB, voffB); PG8_STAGE_A(PG8_SA(0, 0), cA, 0, gA); PG8_STAGE_A(PG8_SA(0, 1), cA, 1, gA);
    if (wr == 1) PG8_BAR;
    PG8_WAIT_V(2); PG8_BAR;
    PG8_STAGE(PG8_SB(1, 0), cB + kstep, voffB); PG8_STAGE_A(PG8_SA(1, 0), cA + kstep, 0, gA); PG8_STAGE(PG8_SB(1, 1), cB + hstepB + kstep, voffB);
    PG8_WAIT_V(6); PG8_BAR;
    for (;;) {
        const bool has_next = S.next(ui + 1, nxt);
        const char* nA = has_next ? S.a_base(g, nxt) : cA; const char* nB = has_next ? S.b_base(g, nxt) : cB;
        if constexpr (Sched::GATHER) {
#pragma unroll
            for (int h = 0; h < 2; ++h)
#pragma unroll
                for (int i = 0; i < 2; ++i) gN[h][i] = has_next ? (unsigned)(S.row(nxt, h * HALF + sR[i]) * g.lda + sC[i]) * 2u : gA[h][i];
        }
#pragma unroll 1
        for (int t = 0; t < nt; t += 2) {
            const bool last = (t == nt - 2);
            const char* a1 = cA + (size_t)(t + 1) * kstep;
            const char* a2 = last ? nA : cA + (size_t)(t + 2) * kstep; const char* b2 = last ? nB : cB + (size_t)(t + 2) * kstep;
            const char* a3 = a2 + kstep; const char* b3 = b2 + kstep;
            unsigned o2[2][2];
            if constexpr (Sched::GATHER) {
#pragma unroll
                for (int h = 0; h < 2; ++h)
#pragma unroll
                    for (int i = 0; i < 2; ++i) o2[h][i] = last ? gN[h][i] : gA[h][i];
            }
            PG8_LDB(B0, 0, 0); PG8_LDB(B1, 0, 1); PG8_SCHED; PG8_LDA(At, 0, 0); PG8_STAGE_A(PG8_SA(1, 1), a1, 1, gA);
            PG8_WAIT_V(8); PG8_WAIT_L(0); PG8_BAR; PG8_MMA(0, 0, At, B0); PG8_MMA(0, 1, At, B1); PG8_BAR; PG8_SCHED;
            PG8_LDA(At, 0, 1); PG8_STAGE(PG8_SB(0, 0), b2, voffB); PG8_STAGE(PG8_SB(0, 1), b2 + hstepB, voffB); PG8_STAGE_A(PG8_SA(0, 0), a2, 0, o2);
            PG8_WAIT_V(8); PG8_WAIT_L(0); PG8_BAR; PG8_MMA(1, 0, At, B0); PG8_MMA(1, 1, At, B1); PG8_BAR; PG8_SCHED;
            PG8_LDB(B0, 1, 0); PG8_LDB(B1, 1, 1); PG8_SCHED; PG8_LDA(At, 1, 0); PG8_STAGE_A(PG8_SA(0, 1), a2, 1, o2);
            PG8_WAIT_V(8); PG8_WAIT_L(0); PG8_BAR; PG8_MMA(0, 0, At, B0); PG8_MMA(0, 1, At, B1); PG8_BAR; PG8_SCHED;
            PG8_LDA(At, 1, 1); PG8_STAGE(PG8_SB(1, 0), b3, voffB); PG8_STAGE(PG8_SB(1, 1), b3 + hstepB, voffB); PG8_STAGE_A(PG8_SA(1, 0), a3, 0, o2);
            PG8_WAIT_V(8); PG8_WAIT_L(0); PG8_BAR; PG8_MMA(1, 0, At, B0); PG8_MMA(1, 1, At, B1); PG8_BAR; PG8_SCHED;
        }
        if (wr == 0) PG8_BAR;
        E(acc, cur, wr, wc, fr, fq);
        if (!has_next) break;
#pragma unroll
        for (int a = 0; a < 2; ++a)
#pragma unroll
            for (int b = 0; b < 2; ++b)
#pragma unroll
                for (int m = 0; m < 4; ++m)
#pragma unroll
                    for (int n = 0; n < 2; ++n) acc[a][b][m][n] = (f32x4){0.f, 0.f, 0.f, 0.f};
        cur = nxt; cA = nA; cB = nB; ++ui;
        if constexpr (Sched::GATHER) {
#pragma unroll
            for (int h = 0; h < 2; ++h)
#pragma unroll
                for (int i = 0; i < 2; ++i) gA[h][i] = gN[h][i];
        }
        if (wr == 1) PG8_BAR;
    }
    PG8_WAIT_V(0);
    PG8_BAR;
#undef PG8_SA
#undef PG8_SB
#undef PG8_STAGE
#undef PG8_STAGE_A
#undef PG8_LDA
#undef PG8_LDB
#undef PG8_MMA
#undef PG8_WAIT_V
#undef PG8_WAIT_L
#undef PG8_BAR
#undef PG8_SCHED
}

struct EpiBf16Store {
    static constexpr bool PERM = true;
    bf16_t* O; int ldc;
    __device__ __forceinline__ void operator()(const f32x4 (&acc)[2][2][4][2], const Unit& u, int wr, int wc, int fr, int fq) const {
        const int row0 = u.pm * BM + wr * 64 + fr, col0 = u.pn * BM + wc * 32 + 8 * fq;
#pragma unroll
        for (int ai = 0; ai < 2; ++ai)
#pragma unroll
            for (int m = 0; m < 4; ++m) { bf16_t* rowp = O + (size_t)(row0 + ai * HALF + m * 16) * ldc + col0;
#pragma unroll
                for (int bj = 0; bj < 2; ++bj) { const f32x4 v0 = acc[ai][bj][m][0], v1 = acc[ai][bj][m][1];
                    u32x4 w; w.x = cvt_pk_bf16(v0[0], v0[1]); w.y = cvt_pk_bf16(v0[2], v0[3]); w.z = cvt_pk_bf16(v1[0], v1[1]); w.w = cvt_pk_bf16(v1[2], v1[3]);
                    *(u32x4*)(rowp + bj * HALF) = w; } }
    }
};
}
constexpr int NWAVES = 8;
constexpr int RING_OFF = 0, RING_BYTES = 131072;
constexpr int ROUTER_LDS = 147456;
constexpr int LDSCTL_OFF = ROUTER_LDS, MISC_OFF = LDSCTL_OFF + 320;
constexpr int LDS_TAB_OFF = LDSCTL_OFF + 1024;
constexpr int LDS_BYTES = 155648;

#define GAS __attribute__((address_space(1)))
#define LAS __attribute__((address_space(3)))
typedef unsigned v4u __attribute__((ext_vector_type(4)));
typedef unsigned v2u __attribute__((ext_vector_type(2)));
typedef float f32x4 __attribute__((ext_vector_type(4)));
#define LDS_WAIT() asm volatile("s_waitcnt lgkmcnt(0)" ::: "memory")
#define VM_WAIT() asm volatile("s_waitcnt vmcnt(0)" ::: "memory")
__device__ __forceinline__ unsigned pk2(float lo, float hi) { return (unsigned)f2bf(lo) | ((unsigned)f2bf(hi) << 16); }


struct Frame {
    LAS unsigned char* lds;
    int tid, lane, wave, vcu, G;
    const float* const* in;
    float* out; unsigned char* ws;
};

__device__ __forceinline__ void p0_transpose_item(const float* W, int ldw, bf16* WT, int ldt, int k0, int n0, int row0, LAS float* scr, int lane) {
    {
        f32x4 t[8];
#pragma unroll
        for (int i = 0; i < 8; ++i) t[i] = *(const f32x4*)(W + (size_t)(k0 + 8 * i + (lane >> 3)) * ldw + n0 + 4 * (lane & 7));
#pragma unroll
        for (int i = 0; i < 8; ++i) { LAS float* d = scr + (8 * i + (lane >> 3)) * 33 + 4 * (lane & 7); d[0] = t[i].x; d[1] = t[i].y; d[2] = t[i].z; d[3] = t[i].w; }
    }
    LDS_WAIT(); asm volatile("" ::: "memory");
    const int c = lane & 7;
#pragma unroll
    for (int j = 0; j < 4; ++j) { const int n = (lane >> 3) + 8 * j; const LAS float* s = scr + (8 * c) * 33 + n;
        v4u o; o.x = pk2(s[0 * 33], s[1 * 33]); o.y = pk2(s[2 * 33], s[3 * 33]); o.z = pk2(s[4 * 33], s[5 * 33]); o.w = pk2(s[6 * 33], s[7 * 33]);
        *(v4u*)(WT + (size_t)(row0 + n) * ldt + k0 + 8 * c) = o; }
    LDS_WAIT(); asm volatile("" ::: "memory");
}

__device__ __forceinline__ void p0_mod_task(Frame& F, int task) {
    LAS float* sc = (LAS float*)(F.lds);
    LAS float* red = (LAS float*)(F.lds + 16384);
    const float* c = F.in[1]; const float* w_ada = F.in[2]; const float* b_ada = F.in[3];
    for (int i = F.tid; i < 4096; i += 512) { const float cv = c[i]; sc[i] = cv / (1.f + __expf(-cv)); }
    __syncthreads();
    const int j = task * 64 + F.lane;
    float a0 = 0.f, a1 = 0.f, a2 = 0.f, a3 = 0.f;
    const int kb = F.wave * 128;
#pragma unroll 16
    for (int k = kb; k < kb + 128; ++k) { const float w = w_ada[(size_t)k * 6144 + j]; a0 += sc[k] * w; a1 += sc[1024 + k] * w; a2 += sc[2048 + k] * w; a3 += sc[3072 + k] * w; }
    red[(F.wave * 4 + 0) * 64 + F.lane] = a0; red[(F.wave * 4 + 1) * 64 + F.lane] = a1; red[(F.wave * 4 + 2) * 64 + F.lane] = a2; red[(F.wave * 4 + 3) * 64 + F.lane] = a3;
    __syncthreads();
    if (F.tid < 256) { const int b = F.tid >> 6, l = F.tid & 63; float s = 0.f;
#pragma unroll
        for (int w = 0; w < 8; ++w) s += red[(w * 4 + b) * 64 + l];
        ((float*)(F.ws + WS_MOD))[b * 6144 + task * 64 + l] = s + b_ada[task * 64 + l]; }
    __syncthreads();
}

__device__ __forceinline__ void phase0(Frame& F) {
    if (blockIdx.x < 96) p0_mod_task(F, blockIdx.x);
    LAS float* scr = (LAS float*)(F.lds + RING_OFF + F.wave * 16384);
    const int gw = F.vcu * NWAVES + F.wave, NGW = F.G * NWAVES;
    constexpr int I_IN = (D / 64) * (PW / 32), I_OUT = (D / 64) * (D / 32);
    constexpr int NITEMS = I_IN + I_OUT;
    for (int it = gw; it < NITEMS; it += NGW) {
        int r = it;
        if (r < I_IN) { const int nb = PW / 32, kb = r / nb, n = r % nb; p0_transpose_item(F.in[5], PW, (bf16*)(F.ws + FW_WINT), D, 64 * kb, 32 * n, 32 * n, scr, F.lane); continue; } r -= I_IN;
        { const int nb = D / 32, kb = r / nb, n = r % nb; p0_transpose_item(F.in[25], D, (bf16*)(F.ws + FW_WOUTT), D, 64 * kb, 32 * n, 32 * n, scr, F.lane); }
    }
}
__device__ __forceinline__ void expert_transposes(Frame& F, int wv, int nwv) {
    LAS float* scr = (LAS float*)(F.lds + RING_OFF + F.wave * 16384);
    constexpr int I_E13 = NE * 2 * 256, I_E2 = NE * 256;
    for (int it = wv; it < I_E13 + I_E2; it += nwv) {
        int r = it;
        if (r < I_E13) {
            const int e = r >> 9, which = (r >> 8) & 1, q = r & 255, kb = q >> 4, n = q & 15, n0 = 32 * n;
            const float* W = (which ? F.in[32] : F.in[31]) + (size_t)e * D * DE;
            p0_transpose_item(W, DE, (bf16*)(F.ws + FW_W13T) + (size_t)e * 1024 * 1024, D, 64 * kb, n0, (n0 >> 7) * 256 + which * 128 + (n0 & 127), scr, F.lane); continue; } r -= I_E13;
        {
            const int e = r >> 8, q = r & 255, kb = q >> 5, n = q & 31;
            p0_transpose_item(F.in[33] + (size_t)e * DE * D, D, (bf16*)(F.ws + FW_W2T) + (size_t)e * 1024 * DE, DE, 64 * kb, 32 * n, 32 * n, scr, F.lane); }
    }
}

__device__ __forceinline__ void adaln_row(const float* xrow, const float* g, const float* sh, const float* sc, bf16* orow, int lane) {
    const f32x4* xr = (const f32x4*)xrow + lane;
    f32x4 v[4]; float s = 0.f;
#pragma unroll
    for (int j = 0; j < 4; ++j) { v[j] = xr[64 * j]; s += (v[j].x * v[j].x + v[j].y * v[j].y) + (v[j].z * v[j].z + v[j].w * v[j].w); }
    const float rinv = rsqrtf(wave_sum(s) * (1.f / D) + 1e-6f);
    v2u* o8 = (v2u*)orow + lane;
#pragma unroll
    for (int j = 0; j < 4; ++j) { const f32x4 gg = ((const f32x4*)g)[lane + 64 * j], s1 = ((const f32x4*)sc)[lane + 64 * j], s0 = ((const f32x4*)sh)[lane + 64 * j];
        f32x4 y = v[j] * rinv * gg; y = y * (s1 + 1.f) + s0;
        v2u w; w.x = pk2(y.x, y.y); w.y = pk2(y.z, y.w); o8[64 * j] = w; }
}
__device__ __forceinline__ void phase1(Frame& F) {
    const int gw = F.vcu * NWAVES + F.wave, NGW = F.G * NWAVES;
    const float* mod = (const float*)(F.ws + WS_MOD);
    for (int m = gw; m < NTOK; m += NGW) { const int b = m / T;
        adaln_row(F.in[0] + (size_t)m * D, F.in[4], mod + b * 6144, mod + b * 6144 + 1024, (bf16*)(F.ws + WS_H) + (size_t)m * D, F.lane); }
}
__device__ __forceinline__ void phase2(Frame& F) {
    pg8::Gemm g{(const bf16*)(F.ws + WS_H), (const bf16*)(F.ws + FW_WINT), D, D, D};
    pg8::DenseOrder S; S.init(NTOK, PW, F.G, (int)blockIdx.x);
    pg8::EpiBf16Store E{(bf16*)(F.ws + WS_P), PW};
    pg8::gemm_phase<pg8::EpiBf16Store, pg8::DenseOrder>(F.lds + RING_OFF, g, S, E, F.tid);
}


namespace pg8 {
struct EpiX1F {
    static constexpr bool PERM = false;
    const float* const* in; unsigned char* ws; float* out;
    __device__ __forceinline__ void operator()(const f32x4 (&acc)[2][2][4][2], const Unit& u, int wr, int wc, int fr, int fq) const {
        const float* x = in[0]; const float* mod = (const float*)(ws + WS_MOD);
        const int row0 = u.pm * BM + wr * 64 + fr, col0 = u.pn * BM + wc * 32 + 4 * fq;
        const float* g1 = mod + ((u.pm * BM) / T) * 6144 + 2048;
        f32x4 gv[2][2];
#pragma unroll
        for (int bj = 0; bj < 2; ++bj)
#pragma unroll
            for (int n = 0; n < 2; ++n) gv[bj][n] = *(const f32x4*)(g1 + col0 + bj * HALF + n * 16);
#pragma unroll
        for (int ai = 0; ai < 2; ++ai)
#pragma unroll
            for (int m = 0; m < 4; ++m) { const size_t ro = (size_t)(row0 + ai * HALF + m * 16) * D + col0;
#pragma unroll
                for (int bj = 0; bj < 2; ++bj)
#pragma unroll
                    for (int n = 0; n < 2; ++n) { const f32x4 xv = *(const f32x4*)(x + ro + bj * HALF + n * 16);
                        *(f32x4*)(out + ro + bj * HALF + n * 16) = xv + gv[bj][n] * acc[ai][bj][m][n]; } }
    }
};
template <bool GATH> struct MoeOrder {
    static constexpr bool GATHER = GATH;
    const LAS int* ub; const LAS int* rb; const LAS int* cn; const int* list; int G, c, brows;
    __device__ bool next(int i, Unit& u) const {
        int e, local;
        if ((G & 7) == 0) {
            const int x = c & 7, L = i * (G >> 3) + (c >> 3); const LAS int* xb = ub + 98 + x * 5;
            if (L >= xb[4]) return false;
            int j = 0;
#pragma unroll
            for (int k = 2; k >= 1; k >>= 1) if (xb[j + k] <= L) j += k;
            e = x + 8 * j; local = L - xb[j];
        } else {
            const int L = i * G + c; if (L >= ub[32]) return false;
            e = 0;
#pragma unroll
            for (int k = 16; k >= 1; k >>= 1) if (ub[e + k] <= L) e += k;
            local = L - ub[e];
        }
        const int tiles = rb[e + 1] - rb[e], pn = local / tiles, mt = local - pn * tiles;
        u.e = e; u.pn = pn; u.pm = rb[e] + mt; u.row0 = e * NTOK + mt * 256; u.nrows = min(256, cn[e] - mt * 256); return true;
    }
    __device__ __forceinline__ const char* a_base(const Gemm& g, const Unit& u) const { return GATH ? (const char*)g.A : (const char*)g.A + (size_t)u.pm * (BM * 2) * g.lda; }
    __device__ __forceinline__ const char* b_base(const Gemm& g, const Unit& u) const { return (const char*)g.Bt + ((size_t)u.e * brows + (size_t)u.pn * BM) * 2 * g.ldb; }
    __device__ __forceinline__ int row(const Unit& u, int r) const { return r < u.nrows ? (list[u.row0 + r] >> 1) : 0; }
};
struct EpiSwiglu {
    static constexpr bool PERM = true;
    bf16_t* HID;
    __device__ __forceinline__ void operator()(const f32x4 (&acc)[2][2][4][2], const Unit& u, int wr, int wc, int fr, int fq) const {
        const int col0 = u.pn * HALF + wc * 32 + 8 * fq;
#pragma unroll
        for (int ai = 0; ai < 2; ++ai)
#pragma unroll
            for (int m = 0; m < 4; ++m) { const int r = ai * HALF + wr * 64 + m * 16 + fr;
                if (r < u.nrows) { float h[8];
#pragma unroll
                    for (int n = 0; n < 2; ++n)
#pragma unroll
                        for (int i = 0; i < 4; ++i) { const float a = acc[ai][0][m][n][i], b = acc[ai][1][m][n][i]; h[n * 4 + i] = a * frcp(1.f + fexp(-a)) * b; }
                    u32x4 w; w.x = cvt_pk_bf16(h[0], h[1]); w.y = cvt_pk_bf16(h[2], h[3]); w.z = cvt_pk_bf16(h[4], h[5]); w.w = cvt_pk_bf16(h[6], h[7]);
                    *(u32x4*)(HID + (size_t)(u.pm * BM + r) * DE + col0) = w; } }
    }
};
struct EpiYs {
    static constexpr bool PERM = true;
    unsigned char* ws;
    __device__ __forceinline__ void operator()(const f32x4 (&acc)[2][2][4][2], const Unit& u, int wr, int wc, int fr, int fq) const {
        bf16_t* YS = (bf16_t*)(ws + WS_YS); const int* list = (const int*)(ws + WS_LIST); const float* selw = (const float*)(ws + WS_SELW);
        const int col0 = u.pn * BM + wc * 32 + 8 * fq;
#pragma unroll
        for (int ai = 0; ai < 2; ++ai)
#pragma unroll
            for (int m = 0; m < 4; ++m) { const int r = ai * HALF + wr * 64 + m * 16 + fr;
                if (r < u.nrows) { const int li = list[u.row0 + r]; const float w8 = selw[u.row0 + r]; bf16_t* rowp = YS + (size_t)li * D + col0;
#pragma unroll
                    for (int bj = 0; bj < 2; ++bj) { const f32x4 v0 = acc[ai][bj][m][0] * w8, v1 = acc[ai][bj][m][1] * w8;
                        u32x4 w; w.x = cvt_pk_bf16(v0[0], v0[1]); w.y = cvt_pk_bf16(v0[2], v0[3]); w.z = cvt_pk_bf16(v1[0], v1[1]); w.w = cvt_pk_bf16(v1[2], v1[3]);
                        *(u32x4*)(rowp + bj * HALF) = w; } } }
    }
};
}

__device__ __forceinline__ void phase_outproj(Frame& F) {
    pg8::Gemm g{(const bf16*)(F.ws + WS_YMIX), (const bf16*)(F.ws + FW_WOUTT), D, D, D};
    pg8::DenseOrder S; S.init(NTOK, D, F.G, (int)blockIdx.x);
    pg8::EpiX1F E{F.in, F.ws, F.out};
    pg8::gemm_phase<pg8::EpiX1F, pg8::DenseOrder>(F.lds + RING_OFF, g, S, E, F.tid);
}

__device__ __forceinline__ void phase_route(Frame& F) {
    TSTAMP(F, 40);
    LAS float* wt = (LAS float*)F.lds;
    { const f32x4* WR = (const f32x4*)(F.ws + FW_WR); LAS f32x4* wt4 = (LAS f32x4*)F.lds;
      for (int i = F.tid; i < 36 * 256; i += 512) wt4[i] = WR[i]; }
    __syncthreads();
    const float* mod = (const float*)(F.ws + WS_MOD); const float* g2n = F.in[26];
    int* cnt = (int*)(F.ws + WS_CNT); int* list = (int*)(F.ws + WS_LIST); float* selw = (float*)(F.ws + WS_SELW);
    bf16* H2 = (bf16*)(F.ws + WS_H);
    const int gw = F.vcu * NWAVES + F.wave, NGW = F.G * NWAVES, lane = F.lane;
    LAS int* lcnt = (LAS int*)(F.lds + LDSCTL_OFF + 2048); LAS int* lbase = lcnt + 32; LAS int* tokres = lcnt + 64; LAS float* tokw = (LAS float*)(tokres + 256);
    if (F.tid < 32) lcnt[F.tid] = 0;
    __syncthreads();
    int it = 0;
    unsigned long long ta_[4] = {0, 0, 0, 0};
    TSTAMP(F, 41);
    f32x4 vn[4];
#pragma unroll
    for (int j = 0; j < 4; ++j) vn[j] = ((const f32x4*)(F.out + (size_t)gw * D) + lane)[64 * j];
    f32x4 ggr[4], s1r[4], s0r[4]; int bcur = -1;
#pragma unroll
    for (int j = 0; j < 4; ++j) ggr[j] = ((const f32x4*)g2n)[lane + 64 * j];
    for (int m = gw; m < NTOK; m += NGW, ++it) {
        const int b = m / T;
        if (b != bcur) { bcur = b;
#pragma unroll
            for (int j = 0; j < 4; ++j) { s1r[j] = ((const f32x4*)(mod + b * 6144 + 4096))[lane + 64 * j] + 1.f; s0r[j] = ((const f32x4*)(mod + b * 6144 + 3072))[lane + 64 * j]; } }
        const unsigned long long tr0 = TIMER_A >= 0 ? __builtin_amdgcn_s_memrealtime() : 0ull;
        f32x4 v[4]; float s = 0.f;
#pragma unroll
        for (int j = 0; j < 4; ++j) { v[j] = vn[j]; s += (v[j].x * v[j].x + v[j].y * v[j].y) + (v[j].z * v[j].z + v[j].w * v[j].w); }
        if (m + NGW < NTOK) {
#pragma unroll
            for (int j = 0; j < 4; ++j) vn[j] = ((const f32x4*)(F.out + (size_t)(m + NGW) * D) + lane)[64 * j];
        }
        const float rinv = rsqrtf(wave_sum(s) * (1.f / D) + 1e-6f);
        v2u* o8 = (v2u*)(H2 + (size_t)m * D) + lane;
#pragma unroll
        for (int j = 0; j < 4; ++j) { f32x4 y = v[j] * rinv * ggr[j]; y = y * s1r[j] + s0r[j]; v[j] = y;
            v2u w; w.x = pk2(y.x, y.y); w.y = pk2(y.z, y.w); o8[64 * j] = w; }
        const unsigned long long tr1 = TIMER_A >= 0 ? __builtin_amdgcn_s_memrealtime() : 0ull;
        float pg[4] = {0.f, 0.f, 0.f, 0.f};
#pragma unroll
        for (int j = 0; j < 4; ++j)
#pragma unroll
            for (int e = 0; e < 4; ++e) { const f32x4 w = *(const LAS f32x4*)(wt + e * 1024 + lane * 4 + 256 * j); pg[e] += (v[j].x * w.x + v[j].y * w.y) + (v[j].z * w.z + v[j].w * w.w); }
        const f32x4 bg = *(const f32x4*)F.in[28];
        const float g0 = wave_sum(pg[0]) + bg.x, g1 = wave_sum(pg[1]) + bg.y, g2 = wave_sum(pg[2]) + bg.z, g3 = wave_sum(pg[3]) + bg.w;
        float gm = g0; int gi = 0;
        if (g1 > gm) { gm = g1; gi = 1; } if (g2 > gm) { gm = g2; gi = 2; } if (g3 > gm) { gm = g3; gi = 3; }
        const float gwt = frcp(fexp(g0 - gm) + fexp(g1 - gm) + fexp(g2 - gm) + fexp(g3 - gm));
        gi = __builtin_amdgcn_readfirstlane(gi);
        const unsigned long long tr2 = TIMER_A >= 0 ? __builtin_amdgcn_s_memrealtime() : 0ull;
        const LAS float* we = wt + (4 + gi * 8) * 1024 + lane * 4;
        const f32x4 be0 = *(const f32x4*)(F.in[30] + gi * 8), be1 = *(const f32x4*)(F.in[30] + gi * 8 + 4);
        float xe[8];
#pragma unroll
        for (int hf = 0; hf < 2; ++hf) { float pe[4] = {0.f, 0.f, 0.f, 0.f};
#pragma unroll
            for (int j = 0; j < 4; ++j)
#pragma unroll
                for (int e = 0; e < 4; ++e) { const f32x4 w = *(const LAS f32x4*)(we + (hf * 4 + e) * 1024 + 256 * j); pe[e] += (v[j].x * w.x + v[j].y * w.y) + (v[j].z * w.z + v[j].w * w.w); }
#pragma unroll
            for (int e = 0; e < 4; ++e) xe[hf * 4 + e] = wave_sum(pe[e]); }
        xe[0] += be0.x; xe[1] += be0.y; xe[2] += be0.z; xe[3] += be0.w; xe[4] += be1.x; xe[5] += be1.y; xe[6] += be1.z; xe[7] += be1.w;
        const unsigned long long tr3 = TIMER_A >= 0 ? __builtin_amdgcn_s_memrealtime() : 0ull;
        float v1 = xe[0], v2 = -3.4e38f; int i1 = 0, i2 = 0;
#pragma unroll
        for (int ii = 1; ii < 8; ++ii) { const float xx = xe[ii]; const bool a1 = xx > v1, a2 = xx > v2;
            v2 = a1 ? v1 : (a2 ? xx : v2); i2 = a1 ? i1 : (a2 ? ii : i2); v1 = a1 ? xx : v1; i1 = a1 ? ii : i1; }
        const float e2 = fexp(v2 - v1), w1 = frcp(1.f + e2), w2 = e2 * w1;
        if (lane == 0) { const int ea = gi * 8 + i1, eb = gi * 8 + i2;
            tokw[(F.wave * 16 + it) * 2] = w1 * gwt; tokw[(F.wave * 16 + it) * 2 + 1] = w2 * gwt;
            const int ra = atomicAdd((int*)&lcnt[ea], 1), rb2 = atomicAdd((int*)&lcnt[eb], 1);
            tokres[(F.wave * 16 + it) * 2] = ea | (ra << 8); tokres[(F.wave * 16 + it) * 2 + 1] = eb | (rb2 << 8); }
        if (TIMER_A >= 0) { const unsigned long long tr4 = __builtin_amdgcn_s_memrealtime(); ta_[0] += tr1 - tr0; ta_[1] += tr2 - tr1; ta_[2] += tr3 - tr2; ta_[3] += tr4 - tr3; }
    }
    if (TIMER_A >= 0 && blockIdx.x == 0 && threadIdx.x == 0) { for (int q = 0; q < 4; ++q) ((unsigned long long*)(F.ws + 8192))[45 + q] = ta_[q]; }
    TSTAMP(F, 42);
    __syncthreads();
    if (F.tid < 32) { const int c = lcnt[F.tid]; lbase[F.tid] = c ? atomicAdd(&cnt[F.tid * 64], c) : 0; }
    __syncthreads();
    if (lane < 16) { const int m = gw + lane * NGW;
        if (m < NTOK) { const int a = tokres[(F.wave * 16 + lane) * 2], b2 = tokres[(F.wave * 16 + lane) * 2 + 1];
            const int pa = (a & 255) * NTOK + lbase[a & 255] + (a >> 8), pb = (b2 & 255) * NTOK + lbase[b2 & 255] + (b2 >> 8);
            list[pa] = m * 2; list[pb] = m * 2 + 1; selw[pa] = tokw[(F.wave * 16 + lane) * 2]; selw[pb] = tokw[(F.wave * 16 + lane) * 2 + 1]; } }
    __syncthreads();
}

__device__ __forceinline__ void moe_tables(Frame& F, int npn) {
    LAS int* tab = (LAS int*)(F.lds + LDS_TAB_OFF);
    if (F.tid == 0) { const int* cnt = (const int*)(F.ws + WS_CNT); int ub = 0, rb = 0;
        for (int e = 0; e < 32; ++e) { const int c = __hip_atomic_load(cnt + e * 64, __ATOMIC_RELAXED, __HIP_MEMORY_SCOPE_AGENT); const int tl = (c + 255) >> 8; tab[e] = ub; tab[33 + e] = rb; tab[66 + e] = c; ub += tl * npn; rb += tl; }
        tab[32] = ub; tab[33 + 32] = rb;
        for (int x = 0; x < 8; ++x) { int s = 0; for (int j = 0; j < 4; ++j) { tab[98 + x * 5 + j] = s; s += tab[x + 8 * j + 1] - tab[x + 8 * j]; } tab[98 + x * 5 + 4] = s; } }
    __syncthreads();
}
__device__ __forceinline__ void phase_m1(Frame& F) {
    moe_tables(F, 4);
    const LAS int* tab = (const LAS int*)(F.lds + LDS_TAB_OFF);
    pg8::Gemm g{(const bf16*)(F.ws + WS_H), (const bf16*)(F.ws + FW_W13T), D, D, D};
    pg8::MoeOrder<true> S{tab, tab + 33, tab + 66, (const int*)(F.ws + WS_LIST), F.G, (int)blockIdx.x, 1024};
    pg8::EpiSwiglu E{(bf16*)(F.ws + WS_HID)};
    pg8::gemm_phase<pg8::EpiSwiglu, pg8::MoeOrder<true>>(F.lds + RING_OFF, g, S, E, F.tid);
}
__device__ __forceinline__ void phase_m2(Frame& F) {
    moe_tables(F, 4);
    const LAS int* tab = (const LAS int*)(F.lds + LDS_TAB_OFF);
    pg8::Gemm g{(const bf16*)(F.ws + WS_HID), (const bf16*)(F.ws + FW_W2T), DE, DE, DE};
    pg8::MoeOrder<false> S{tab, tab + 33, tab + 66, (const int*)(F.ws + WS_LIST), F.G, (int)blockIdx.x, 1024};
    pg8::EpiYs E{F.ws};
    pg8::gemm_phase<pg8::EpiYs, pg8::MoeOrder<false>>(F.lds + RING_OFF, g, S, E, F.tid);
}
__device__ __forceinline__ void phase_final(Frame& F, bool dry = false) {
    const int gw = F.vcu * NWAVES + F.wave, NGW = F.G * NWAVES, lane = F.lane;
    const float* mod = (const float*)(F.ws + WS_MOD); const float* fg = F.in[34]; const bf16* YS = (const bf16*)(F.ws + WS_YS);
    for (int m = gw; m < NTOK; m += NGW) { const int b = m / T;
        f32x4* xr = (f32x4*)(F.out + (size_t)m * D) + lane;
        const v2u* y0 = (const v2u*)(YS + (size_t)(2 * m) * D) + lane; const v2u* y1 = (const v2u*)(YS + (size_t)(2 * m + 1) * D) + lane;
        f32x4 v[4]; float s = 0.f;
#pragma unroll
        for (int j = 0; j < 4; ++j) { const v2u a = y0[64 * j], c = y1[64 * j]; const f32x4 g2 = ((const f32x4*)(mod + b * 6144 + 5120))[lane + 64 * j];
            f32x4 mo; mo.x = __uint_as_float(a.x << 16) + __uint_as_float(c.x << 16); mo.y = __uint_as_float(a.x & 0xffff0000u) + __uint_as_float(c.x & 0xffff0000u);
            mo.z = __uint_as_float(a.y << 16) + __uint_as_float(c.y << 16); mo.w = __uint_as_float(a.y & 0xffff0000u) + __uint_as_float(c.y & 0xffff0000u);
            v[j] = xr[64 * j] + g2 * mo; s += (v[j].x * v[j].x + v[j].y * v[j].y) + (v[j].z * v[j].z + v[j].w * v[j].w); }
        const float rinv = rsqrtf(wave_sum(s) * (1.f / D) + 1e-6f);
        float tdelta = 0.f;
        if (TIMER_A >= 0 && m == 0) { const unsigned long long* ts = (const unsigned long long*)(F.ws + 8192);
            const float us = (float)(TIMER_B == TIMER_A ? ts[TIMER_A] : ts[TIMER_B] - ts[TIMER_A]) * 0.01f; tdelta = sqrtf(32768.f * us * 1e-6f); }
#pragma unroll
        for (int j = 0; j < 4; ++j) (dry ? (f32x4*)(F.ws + WS_P) + (size_t)m * 256 + lane : xr)[64 * j] = v[j] * rinv * ((const f32x4*)fg)[lane + 64 * j] + tdelta;
    }
}
#define XB_TMO      128
#define XB_XCNT(j)  (256  + 64 * (j))
#define XB_XSUB(j)  (1280 + 64 * (j))
#define XB_XGEN(j)  (2304 + 64 * (j))
#define XB_TOP      3328
#define XB_TOPGEN   3392
#define XCD_BAR_WORDS 3456
#define XB_SPIN_CAP (1u << 18)

__device__ __forceinline__ unsigned xb_ld(unsigned* p)              { return __hip_atomic_load(p, __ATOMIC_RELAXED, __HIP_MEMORY_SCOPE_AGENT); }
__device__ __forceinline__ unsigned xb_add(unsigned* p, unsigned v) { return __hip_atomic_fetch_add(p, v, __ATOMIC_RELAXED, __HIP_MEMORY_SCOPE_AGENT); }
__device__ __forceinline__ unsigned xb_xcc_id() { return (unsigned)__builtin_amdgcn_s_getreg((3 << 11) | 20) & 0xFu; }
#define XB_SPIN(cond, bar) do { unsigned _sp = 0; while (cond) { __builtin_amdgcn_s_sleep(1); \
    if ((++_sp & 255u) == 0u) { if (xb_ld(&(bar)[XB_TMO])) break; if (_sp > XB_SPIN_CAP) { atomicAdd(&(bar)[XB_TMO], 1u); break; } } } } while (0)

struct XcdBarrier {
    unsigned* bar; unsigned x;
    volatile LAS unsigned* st;
};

__device__ __forceinline__ XcdBarrier xcd_barrier_post(unsigned* bar, volatile LAS unsigned* st) {
    XcdBarrier b; b.bar = bar; b.x = xb_xcc_id(); b.st = st;
    if (threadIdx.x == 0) (void)xb_add(&bar[XB_XCNT(b.x)], 1u);
    return b;
}
__device__ __forceinline__ void xcd_barrier_complete(unsigned* bar, unsigned x, unsigned& nloc, unsigned& nx) {
    const unsigned G = gridDim.x * gridDim.y * gridDim.z;
    unsigned sum, cnt, mine, sp = 0u;
    for (;;) {
        sum = 0u; cnt = 0u; mine = 0u;
#pragma unroll
        for (unsigned j = 0; j < 16; ++j) { const unsigned c = xb_ld(&bar[XB_XCNT(j)]); sum += c; cnt += (c > 0u) ? 1u : 0u; mine = (j == x) ? c : mine; }
        if (sum == G) break;
        __builtin_amdgcn_s_sleep(1);
        if ((++sp & 255u) == 0u) { if (xb_ld(&bar[XB_TMO])) break; if (sp > XB_SPIN_CAP) { atomicAdd(&bar[XB_TMO], 1u); break; } }
    }
    nloc = mine > 0u ? mine : 1u; nx = cnt > 0u ? cnt : 1u;
}

__device__ __forceinline__ void xcd_barrier(const XcdBarrier& b) {
    asm volatile("s_waitcnt vmcnt(0)" ::: "memory");
    __syncthreads();
    if (threadIdx.x == 0) {
        unsigned* bar = b.bar;
        __builtin_amdgcn_s_waitcnt(0);
        unsigned nloc = b.st[0], nx = b.st[1];
        if (nloc == 0u) { xcd_barrier_complete(bar, b.x, nloc, nx); b.st[0] = nloc; b.st[1] = nx; }
        const unsigned old = xb_add(&bar[XB_XSUB(b.x)], 1u);
        const unsigned gen = old / nloc;
        if (old + 1u == (gen + 1u) * nloc) {
            __builtin_amdgcn_fence(__ATOMIC_RELEASE, "agent");
            asm volatile("s_waitcnt vmcnt(0)" ::: "memory");
            const unsigned og = xb_add(&bar[XB_TOP], 1u);
            const unsigned tg = og / nx;
            if (og + 1u == (tg + 1u) * nx) xb_add(&bar[XB_TOPGEN], 1u);
            else XB_SPIN(xb_ld(&bar[XB_TOPGEN]) == tg, bar);
            __builtin_amdgcn_fence(__ATOMIC_ACQUIRE, "agent");
            xb_add(&bar[XB_XGEN(b.x)], 1u);
            asm volatile("s_waitcnt vmcnt(0)" ::: "memory");
        } else {
            XB_SPIN(xb_ld(&bar[XB_XGEN(b.x)]) == gen, bar);
            __builtin_amdgcn_fence(__ATOMIC_ACQUIRE, "agent");
            asm volatile("s_waitcnt vmcnt(0)" ::: "memory");
        }
    }
    __syncthreads();
}


constexpr size_t WS_XC = WS_H;
constexpr size_t WS_ALORA = WS_H + 32 * MiB;
constexpr size_t WS_LOGA = 256 * MiB;
constexpr size_t WS_OLOC = 320 * MiB;
constexpr size_t WS_QHAT = 352 * MiB;
constexpr size_t WS_GG = 384 * MiB;
constexpr size_t WS_SB = 12 * MiB;
constexpr size_t WS_LRUA = 13 * MiB;
constexpr size_t WS_LRUB = 14 * MiB;
constexpr size_t WS_LRUH = 15 * MiB;
constexpr size_t DO_LWA = 0;
constexpr size_t DO_PC = 64 * MiB;
constexpr size_t DO_QCT = 96 * MiB;
constexpr size_t DO_HIN = 0;

__device__ __forceinline__ float bflo(unsigned u) { return __uint_as_float(u << 16); }
__device__ __forceinline__ float bfhi(unsigned u) { return __uint_as_float(u & 0xffff0000u); }

__device__ __forceinline__ void phase_prepA(Frame& F) {
    const int gw = F.vcu * NWAVES + F.wave, NGW = F.G * NWAVES, lane = F.lane;
    const bf16* P = (const bf16*)(F.ws + WS_P);
    bf16* XC = (bf16*)(F.ws + WS_XC); bf16* AL = (bf16*)(F.ws + WS_ALORA);
    const float* conv_w = F.in[6]; const float* conv_b = F.in[7]; const float* mu = F.in[14];
    float cw[4][8], cb[8];
#pragma unroll
    for (int i = 0; i < 8; ++i) { cb[i] = conv_b[8 * lane + i];
#pragma unroll
        for (int j = 0; j < 4; ++j) cw[j][i] = conv_w[j * 512 + 8 * lane + i]; }
    float mu4[4];
#pragma unroll
    for (int i = 0; i < 4; ++i) mu4[i] = mu[(C_WD - 1024) + 4 * lane + i];
    for (int task = gw; task < NTOK / 16; task += NGW) {
        const int m0 = task * 16, t0 = m0 % T;
        float x1[8], x2[8], x3[8], pl[4];
#pragma unroll
        for (int i = 0; i < 8; ++i) { x1[i] = 0.f; x2[i] = 0.f; x3[i] = 0.f; }
#pragma unroll
        for (int i = 0; i < 4; ++i) pl[i] = 0.f;
        if (t0 > 0) {
            const v4u a = *(const v4u*)(P + (size_t)(m0 - 1) * PW + 8 * lane), b = *(const v4u*)(P + (size_t)(m0 - 2) * PW + 8 * lane), c = *(const v4u*)(P + (size_t)(m0 - 3) * PW + 8 * lane);
            x1[0] = bflo(a.x); x1[1] = bfhi(a.x); x1[2] = bflo(a.y); x1[3] = bfhi(a.y); x1[4] = bflo(a.z); x1[5] = bfhi(a.z); x1[6] = bflo(a.w); x1[7] = bfhi(a.w);
            x2[0] = bflo(b.x); x2[1] = bfhi(b.x); x2[2] = bflo(b.y); x2[3] = bfhi(b.y); x2[4] = bflo(b.z); x2[5] = bfhi(b.z); x2[6] = bflo(b.w); x2[7] = bfhi(b.w);
            x3[0] = bflo(c.x); x3[1] = bfhi(c.x); x3[2] = bflo(c.y); x3[3] = bfhi(c.y); x3[4] = bflo(c.z); x3[5] = bfhi(c.z); x3[6] = bflo(c.w); x3[7] = bfhi(c.w);
            const v2u q = *(const v2u*)(P + (size_t)(m0 - 1) * PW + C_WD + 4 * lane);
            pl[0] = bflo(q.x); pl[1] = bfhi(q.x); pl[2] = bflo(q.y); pl[3] = bfhi(q.y);
        }
#pragma unroll 4
        for (int tt = 0; tt < 16; ++tt) {
            const size_t m = (size_t)(m0 + tt);
            const v4u a = *(const v4u*)(P + m * PW + 8 * lane);
            float x0[8] = {bflo(a.x), bfhi(a.x), bflo(a.y), bfhi(a.y), bflo(a.z), bfhi(a.z), bflo(a.w), bfhi(a.w)};
            float xc[8];
#pragma unroll
            for (int i = 0; i < 8; ++i) { xc[i] = x3[i] * cw[0][i] + x2[i] * cw[1][i] + x1[i] * cw[2][i] + x0[i] * cw[3][i] + cb[i]; x3[i] = x2[i]; x2[i] = x1[i]; x1[i] = x0[i]; }
            v4u o; o.x = pk2(xc[0], xc[1]); o.y = pk2(xc[2], xc[3]); o.z = pk2(xc[4], xc[5]); o.w = pk2(xc[6], xc[7]);
            *(v4u*)(XC + m * 512 + 8 * lane) = o;
            const v2u q = *(const v2u*)(P + m * PW + C_WD + 4 * lane);
            const float cl[4] = {bflo(q.x), bfhi(q.x), bflo(q.y), bfhi(q.y)};
            float al[4];
#pragma unroll
            for (int i = 0; i < 4; ++i) { const float u = cl[i] + (pl[i] - cl[i]) * mu4[i]; pl[i] = cl[i];
                al[i] = (lane < 16) ? ftanh(u) : ((lane < 32) ? u : sigmoidf_(u)); }
            v2u o2; o2.x = pk2(al[0], al[1]); o2.y = pk2(al[2], al[3]);
            *(v2u*)(AL + m * 256 + 4 * lane) = o2;
        }
    }
}
__device__ __forceinline__ void p0_small_weights(Frame& F) {
    const int gt = F.vcu * NWAVES * 64 + F.tid, NT = F.G * NWAVES * 64;
    bf16* WG = (bf16*)(F.ws + FW_WGT); bf16* WL = (bf16*)(F.ws + FW_WLORAT);
    const float* wa = F.in[8]; const float* wi = F.in[10]; const float* w_up = F.in[16]; const float* a_up = F.in[18]; const float* g_up = F.in[19];
    for (int i = gt; i < 4 * 256 * 256; i += NT) { const int kk = i & 255, r = (i >> 8) & 255, pn = i >> 16;
        const int gate = r >> 7, ch = 128 * pn + (r & 127), hh = ch >> 6, j = ch & 63, kin = (pn >> 1) * 256 + kk;
        float v = 0.f; if ((kin >> 6) == hh) v = (gate ? wi : wa)[hh * 4096 + (kin & 63) * 64 + j];
        WG[i] = f2bf(v); }
    { float* WR = (float*)(F.ws + FW_WR); const float* w_grp = F.in[27]; const float* w_exp = F.in[29];
      for (int i = gt; i < 36 * 1024; i += NT) { const int k = i & 1023, e = i >> 10; WR[i] = e < 4 ? w_grp[k * 4 + e] : w_exp[k * 32 + (e - 4)]; } }
    for (int i = gt; i < 1536 * 256; i += NT) { const int kk = i & 255, n = i >> 8; float v = 0.f;
        if (n < 512) { if (kk < 64) v = w_up[kk * 512 + n]; }
        else if (n < 1024) { if (kk >= 64 && kk < 128) v = a_up[(kk - 64) * 512 + n - 512]; }
        else { if (kk >= 128) v = g_up[(kk - 128) * 512 + n - 1024]; }
        WL[i] = f2bf(v); }
}

namespace pg8 {
struct GateOrder : DenseOrder {
    __device__ __forceinline__ const char* a_base(const Gemm& g, const Unit& u) const { return (const char*)g.A + (size_t)u.pm * (BM * 2) * g.lda + (size_t)(u.pn >> 1) * 512; }
};
struct EpiLruGate {
    static constexpr bool PERM = true;
    unsigned char* ws;
    __device__ __forceinline__ void operator()(const f32x4 (&acc)[2][2][4][2], const Unit& u, int wr, int wc, int fr, int fq) const {
        bf16_t* G = (bf16_t*)(ws + WS_LOGA);
        const int row0 = u.pm * BM + wr * 64 + fr, col0 = u.pn * HALF + wc * 32 + 8 * fq;
#pragma unroll
        for (int ai = 0; ai < 2; ++ai)
#pragma unroll
            for (int m = 0; m < 4; ++m) { bf16_t* rowp = G + (size_t)(row0 + ai * HALF + m * 16) * 1024 + col0;
#pragma unroll
                for (int bj = 0; bj < 2; ++bj) { const f32x4 v0 = acc[ai][bj][m][0], v1 = acc[ai][bj][m][1];
                    u32x4 w; w.x = cvt_pk_bf16(v0[0], v0[1]); w.y = cvt_pk_bf16(v0[2], v0[3]); w.z = cvt_pk_bf16(v1[0], v1[1]); w.w = cvt_pk_bf16(v1[2], v1[3]);
                    *(u32x4*)(rowp + bj * 512) = w; } }
    }
};
struct EpiLoraStore {
    static constexpr bool PERM = true;
    unsigned char* out; unsigned char* ws;
    __device__ __forceinline__ void operator()(const f32x4 (&acc)[2][2][4][2], const Unit& u, int wr, int wc, int fr, int fq) const {
        const int row0 = u.pm * BM + wr * 64 + fr;
        bf16_t* LWA = (bf16_t*)(out + DO_LWA); bf16_t* GG = (bf16_t*)(ws + WS_GG);
        bf16_t* base = u.pn < 4 ? LWA : GG; const int ldc = u.pn < 4 ? 1024 : 512; const int col0 = (u.pn < 4 ? u.pn : u.pn - 4) * BM + wc * 32 + 8 * fq;
#pragma unroll
        for (int ai = 0; ai < 2; ++ai)
#pragma unroll
            for (int m = 0; m < 4; ++m) { bf16_t* rowp = base + (size_t)(row0 + ai * HALF + m * 16) * ldc + col0;
#pragma unroll
                for (int bj = 0; bj < 2; ++bj) { const f32x4 v0 = acc[ai][bj][m][0], v1 = acc[ai][bj][m][1];
                    u32x4 w; w.x = cvt_pk_bf16(v0[0], v0[1]); w.y = cvt_pk_bf16(v0[2], v0[3]); w.z = cvt_pk_bf16(v1[0], v1[1]); w.w = cvt_pk_bf16(v1[2], v1[3]);
                    *(u32x4*)(rowp + bj * HALF) = w; } }
    }
};
}
__device__ __forceinline__ void phase_gategemm(Frame& F) {
    {
        pg8::Gemm g{(const bf16*)(F.ws + WS_XC), (const bf16*)(F.ws + FW_WGT), 512, 256, 256};
        pg8::GateOrder S; S.init(NTOK, 1024, F.G, (int)blockIdx.x);
        pg8::EpiLruGate E{F.ws};
        pg8::gemm_phase<pg8::EpiLruGate, pg8::GateOrder>(F.lds + RING_OFF, g, S, E, F.tid);
    }
}
__device__ __forceinline__ void phase_loragemm(Frame& F) {
    {
        pg8::Gemm g{(const bf16*)(F.ws + WS_ALORA), (const bf16*)(F.ws + FW_WLORAT), 256, 256, 256};
        pg8::DenseOrder S; S.init(NTOK, 1536, F.G, (int)blockIdx.x);
        pg8::EpiLoraStore E{(unsigned char*)F.out, F.ws};
        pg8::gemm_phase<pg8::EpiLoraStore, pg8::DenseOrder>(F.lds + RING_OFF, g, S, E, F.tid);
    }
}

typedef float f32x2 __attribute__((ext_vector_type(2)));
__device__ __forceinline__ void rwkv_prepass_unit(Frame& F, int unit, LAS float* wl) {
    int lane = F.lane; asm volatile("" : "+v"(lane));
    const int c = unit & 127, bh = unit >> 7, h = bh & 7, b = bh >> 3, ch = h * 64 + lane;
    const size_t m0 = (size_t)b * T + (size_t)c * 64;
    const bf16* P = (const bf16*)(F.ws + WS_P); const bf16* LWA = (const bf16*)((const unsigned char*)F.out + DO_LWA);
    bf16* OLOC = (bf16*)(F.ws + WS_OLOC); bf16* QHAT = (bf16*)(F.ws + WS_QHAT); float* SB = (float*)(F.ws + WS_SB);
    const float* mu = F.in[14];
    const float mu_r = mu[ch], mu_k = mu[512 + ch], mu_v = mu[1024 + ch];
    const float w0v = F.in[15][ch], a0v = F.in[17][ch], kkv = F.in[20][ch], kav = F.in[21][ch], rkv = F.in[22][ch];
    f32x2 S[64];
#pragma unroll
    for (int k = 0; k < 64; ++k) { S[k].x = (k == lane) ? 1.f : 0.f; S[k].y = 0.f; }
    float pr = 0.f, pk = 0.f, pv = 0.f;
    if (c > 0) { const bf16* row = P + (m0 - 1) * PW; pr = bf2f(row[C_R + ch]); pk = bf2f(row[C_K + ch]); pv = bf2f(row[C_V + ch]); }
#pragma unroll 1
    for (int s8 = 0; s8 < 8; ++s8) {
#pragma unroll 2
        for (int tt = 0; tt < 8; ++tt) {
            const size_t m = m0 + s8 * 8 + tt; const bf16* row = P + m * PW;
            const float cr = bf2f(row[C_R + ch]), ck = bf2f(row[C_K + ch]), cv = bf2f(row[C_V + ch]);
            const float lw = bf2f(LWA[m * 1024 + ch]), la = bf2f(LWA[m * 1024 + 512 + ch]);
            const float r = cr + (pr - cr) * mu_r, kx = ck + (pk - ck) * mu_k, v = cv + (pv - cv) * mu_v;
            pr = cr; pk = ck; pv = cv;
            const float w = -__logf(1.f + __expf(-(w0v + lw))) - 0.5f;
            const float decay = __expf(-__expf(w));
            const float a = 1.f / (1.f + __expf(-(a0v + la)));
            float kk = kx * kkv;
            const float nrm = sqrtf(wave_sum(kk * kk));
            kk = kk / fmaxf(nrm, 1e-12f);
            const float km = kx * (1.f + (a - 1.f) * kav);
            const float sbv = wave_sum(r * km * rkv);
            if (lane == 0) SB[m * 8 + h] = sbv;
            LAS float* q = wl + tt * 384;
            q[lane] = -kk; q[64 + lane] = kk * a; q[128 + lane] = decay; q[192 + lane] = km; q[256 + lane] = r; q[320 + lane] = v;
        }
        LDS_WAIT(); asm volatile("" ::: "memory");
#pragma unroll 1
        for (int tt = 0; tt < 8; ++tt) {
            const LAS float* q = wl + tt * 384;
            const LAS f32x4* q4 = (const LAS f32x4*)q;
            f32x2 sa0 = {0.f, 0.f}, sa1 = {0.f, 0.f}, sa2 = {0.f, 0.f}, sa3 = {0.f, 0.f};
            f32x4 ca[4], na[4];
#pragma unroll
            for (int i = 0; i < 4; ++i) ca[i] = q4[i];
            f32x4 c0[4], c1[4];
#pragma unroll
            for (int g = 0; g < 4; ++g) {
                if (g < 3) {
#pragma unroll
                    for (int i = 0; i < 4; ++i) na[i] = q4[4 * (g + 1) + i];
                } else {
#pragma unroll
                    for (int i = 0; i < 4; ++i) { c0[i] = q4[16 * (i + 1)]; c1[i] = q4[16 * (i + 1) + 1]; }
                }
#pragma unroll
                for (int i = 0; i < 4; ++i) { const int kb = 4 * g + i; const f32x4 al = ca[i];
                    sa0 += S[4 * kb] * al.x; sa1 += S[4 * kb + 1] * al.y; sa2 += S[4 * kb + 2] * al.z; sa3 += S[4 * kb + 3] * al.w; }
                if (g < 3) {
#pragma unroll
                    for (int i = 0; i < 4; ++i) ca[i] = na[i];
                }
            }
            const f32x2 sa = (sa0 + sa1) + (sa2 + sa3);
            f32x2 vv; vv.x = 0.f; vv.y = q[320 + lane];
            f32x2 o0 = {0.f, 0.f}, o1 = {0.f, 0.f}, o2 = {0.f, 0.f}, o3 = {0.f, 0.f};
#pragma unroll
            for (int kb = 0; kb < 16; ++kb) {
                f32x4 n2[4];
                if (kb + 2 < 16) {
#pragma unroll
                    for (int i = 0; i < 4; ++i) n2[i] = q4[16 * (i + 1) + kb + 2];
                }
                const f32x4 be = c0[0], w = c0[1], km = c0[2], rr = c0[3];
                S[4 * kb] = S[4 * kb] * w.x + (sa * be.x + vv * km.x); o0 += S[4 * kb] * rr.x;
                S[4 * kb + 1] = S[4 * kb + 1] * w.y + (sa * be.y + vv * km.y); o1 += S[4 * kb + 1] * rr.y;
                S[4 * kb + 2] = S[4 * kb + 2] * w.z + (sa * be.z + vv * km.z); o2 += S[4 * kb + 2] * rr.z;
                S[4 * kb + 3] = S[4 * kb + 3] * w.w + (sa * be.w + vv * km.w); o3 += S[4 * kb + 3] * rr.w;
#pragma unroll
                for (int i = 0; i < 4; ++i) { c0[i] = c1[i]; if (kb + 2 < 16) c1[i] = n2[i]; }
            }
            const f32x2 o = (o0 + o1) + (o2 + o3);
            const size_t m = m0 + s8 * 8 + tt;
            QHAT[m * 512 + ch] = f2bf(o.x); OLOC[m * 512 + ch] = f2bf(o.y);
        }
        LDS_WAIT(); asm volatile("" ::: "memory");
    }
    int lane2 = lane; asm volatile("" : "+v"(lane2) :: "memory");
    bf16* PC = (bf16*)((unsigned char*)F.out + DO_PC) + (size_t)unit * 4096 + lane2; bf16* QCT = (bf16*)((unsigned char*)F.out + DO_QCT) + (size_t)unit * 4096 + lane2 * 64;
#pragma unroll
    for (int k = 0; k < 64; ++k) PC[k * 64] = f2bf(S[k].x);
#pragma unroll
    for (int k = 0; k < 64; k += 8) { v4u o; o.x = pk2(S[k].y, S[k + 1].y); o.y = pk2(S[k + 2].y, S[k + 3].y); o.z = pk2(S[k + 4].y, S[k + 5].y); o.w = pk2(S[k + 6].y, S[k + 7].y);
        *(v4u*)(QCT + k) = o; }
}
__device__ __forceinline__ void phase_lrulocal(Frame& F, bool dry = false) {
    const int gw = F.vcu * NWAVES + F.wave, NGW = F.G * NWAVES, lane = F.lane;
    {
        const bf16* GT = (const bf16*)(F.ws + WS_LOGA); bf16* GO = dry ? (bf16*)(F.ws + WS_OLOC) : (bf16*)(F.ws + WS_LOGA); const bf16* XC = (const bf16*)(F.ws + WS_XC);
        float* LA = (float*)(F.ws + WS_LRUA); float* LB = (float*)(F.ws + WS_LRUB);
        for (int task = gw; task < 4 * 128 * 8; task += NGW) { const int cg = task & 7, bc = task >> 3, ch = cg * 64 + lane;
            const float bav = F.in[9][ch], biv = F.in[11][ch], sp = -8.f * softplusf_(-F.in[12][ch]);
            const size_t m0 = (size_t)bc * 64; float sl = 0.f, hl = 0.f;
#pragma unroll 1
            for (int t8 = 0; t8 < 64; t8 += 8) {
                bf16 g0[8], g1[8], x8[8];
#pragma unroll
                for (int u = 0; u < 8; ++u) { const size_t m = m0 + t8 + u; g0[u] = GT[m * 1024 + ch]; g1[u] = GT[m * 1024 + 512 + ch]; x8[u] = XC[m * 512 + ch]; }
#pragma unroll
                for (int u = 0; u < 8; ++u) { const size_t m = m0 + t8 + u;
                    const float ra = bf2f(g0[u]) + bav, ia = bf2f(g1[u]) + biv, xc = bf2f(x8[u]);
                    const float r = sigmoidf_(ra), ig = sigmoidf_(ia);
                    const bf16 lab = f2bf(r * sp); const float la = bf2f(lab);
                    const bf16 bbb = f2bf(__builtin_amdgcn_sqrtf(fmaxf(1.f - fexp(2.f * la), 0.f)) * (ig * xc)); const float bb = bf2f(bbb);
                    GO[m * 1024 + ch] = lab; GO[m * 1024 + 512 + ch] = bbb;
                    sl += la; hl = fexp(la) * hl + bb; }
            }
            LA[bc * 512 + ch] = sl; LB[bc * 512 + ch] = hl; }
    }
}
__device__ __forceinline__ void phase_rwkvlocal(Frame& F) {
    const int gw = F.vcu * NWAVES + F.wave, NGW = F.G * NWAVES;
    {
        LAS float* wl = (LAS float*)(F.lds + RING_OFF + F.wave * 12288);
        for (int unit = gw; unit < 4096; unit += NGW) rwkv_prepass_unit(F, unit, wl);
    }
}

typedef short bf16x8_t __attribute__((ext_vector_type(8)));
typedef float f32x16 __attribute__((ext_vector_type(16)));
typedef __bf16 bf16x2n_t __attribute__((ext_vector_type(2)));
typedef float f32x2c_t __attribute__((ext_vector_type(2)));
__device__ __forceinline__ unsigned pkbf(float a, float b) { f32x2c_t v = {a, b}; bf16x2n_t r = __builtin_convertvector(v, bf16x2n_t); return __builtin_bit_cast(unsigned, r); }
__device__ __forceinline__ bf16 bf1(float a) { return (bf16)(pkbf(a, 0.f) & 0xffffu); }
constexpr int U_AT = 0, U_RT = 4096, U_BT = 8192, U_KT = 12288, U_BH = 16384, U_KH = 20480, U_VT = 24576, U_LM = 28672, U_G31 = 32768, UNIT_LDS = 33024;
__device__ __forceinline__ int a64(int row, int col) { return row * 128 + (((col >> 3) ^ (row & 7)) << 4) + ((col & 7) << 1); }
__device__ __forceinline__ int a32(int row, int col) { return row * 64 + (((col >> 2) ^ ((row >> 2) & 7)) << 3) + ((col & 3) << 1); }
__device__ __forceinline__ int crow_(int i, int h) { return (i & 3) + 8 * (i >> 2) + 4 * h; }
#define MFMA32(a, b, c) __builtin_amdgcn_mfma_f32_32x32x16_bf16((a), (b), (c), 0, 0, 0)
__device__ __forceinline__ bf16x8_t pack8(const f32x16& x, int s) {
    v4u p; p.x = pkbf(x[8 * s], x[8 * s + 1]); p.y = pkbf(x[8 * s + 2], x[8 * s + 3]); p.z = pkbf(x[8 * s + 4], x[8 * s + 5]); p.w = pkbf(x[8 * s + 6], x[8 * s + 7]);
    return __builtin_bit_cast(bf16x8_t, p); }
__device__ __forceinline__ bf16x8_t ld2x8(const LAS unsigned char* p0, const LAS unsigned char* p1) {
    const v2u lo = *(const LAS v2u*)p0, hi = *(const LAS v2u*)p1; v4u p; p.x = lo.x; p.y = lo.y; p.z = hi.x; p.w = hi.y; return __builtin_bit_cast(bf16x8_t, p); }

__device__ __forceinline__ void phase_rwkvlocal_mfma(Frame& F) {
    int lane = F.lane; asm volatile("" : "+v"(lane));
    const int wave = F.wave, u4 = wave >> 1, wh = wave & 1;
    LAS unsigned char* ub = F.lds + RING_OFF + u4 * UNIT_LDS;
    const bf16* P = (const bf16*)(F.ws + WS_P); const bf16* LWA = (const bf16*)((const unsigned char*)F.out + DO_LWA);
    bf16* OLOC = (bf16*)(F.ws + WS_OLOC); bf16* QHAT = (bf16*)(F.ws + WS_QHAT); float* SB = (float*)(F.ws + WS_SB);
    const float* mu = F.in[14];
    unsigned long long tacc_p = 0, tacc_c = 0;
#pragma unroll 1
    for (int ui = F.vcu; ui < 256; ui += F.G) {
        const int unit = ui * 4 + u4, c = unit & 31, bhd = unit >> 5, hd = bhd & 7, b = bhd >> 3;
        const size_t m0 = (size_t)b * T + (size_t)c * 256;
        f32x16 S[2][2];
        { int r = lane & 31, h = lane >> 5; asm volatile("" : "+v"(r), "+v"(h));
#pragma unroll
        for (int jt = 0; jt < 2; ++jt)
#pragma unroll
            for (int kt = 0; kt < 2; ++kt)
#pragma unroll
                for (int i = 0; i < 16; ++i) S[jt][kt][i] = (wh == 0 && jt == kt && crow_(i, h) == r) ? 1.f : 0.f;
        }
#pragma unroll 1
        for (int sc = 0; sc < 8; ++sc) {
            const size_t ms = m0 + 32 * sc;
            const unsigned long long tp0 = TIMER_A >= 0 ? __builtin_amdgcn_s_memrealtime() : 0ull;
            {
                int lanep = lane; asm volatile("" : "+v"(lanep));
                const int ch = hd * 64 + lanep;
                const float mu_r = mu[ch], mu_k = mu[512 + ch], mu_v = mu[1024 + ch];
                const float w0v = F.in[15][ch], a0v = F.in[17][ch], kkv = F.in[20][ch], kav = F.in[21][ch], rkv = F.in[22][ch];
                const size_t mb = ms + 16 * wh;
                bf16 p3[3] = {0, 0, 0};
                if ((mb % T) != 0) { const bf16* row = P + (mb - 1) * PW; p3[0] = row[C_R + ch]; p3[1] = row[C_K + ch]; p3[2] = row[C_V + ch]; }
                float cc = 0.f;
                if (wh) {
                    bf16 lw16[16];
#pragma unroll
                    for (int t = 0; t < 16; ++t) lw16[t] = LWA[(ms + t) * 1024 + ch];
#pragma unroll
                    for (int t = 0; t < 16; ++t) { const float w = -flog(1.f + fexp(-(w0v + bf2f(lw16[t])))) - 0.5f; cc -= fexp(w); }
                }
                float pr = bf2f(p3[0]), pk = bf2f(p3[1]), pv = bf2f(p3[2]);
                float sbkeep = 0.f, gprev = fexp(cc);
                {
                    constexpr int t8 = 0;
                    bf16 qr[16], qk[16], qv[16], qw[16], qa[16];
#pragma unroll
                    for (int u = 0; u < 16; ++u) { const size_t m = mb + t8 + u; const bf16* row = P + m * PW;
                        qr[u] = row[C_R + ch]; qk[u] = row[C_K + ch]; qv[u] = row[C_V + ch]; qw[u] = LWA[m * 1024 + ch]; qa[u] = LWA[m * 1024 + 512 + ch]; }
#pragma unroll
                    for (int u = 0; u < 16; ++u) {
                        const int tt = t8 + u, t = 16 * wh + tt;
                        const float cr = bf2f(qr[u]), ck = bf2f(qk[u]), cv = bf2f(qv[u]);
                        const float lw = bf2f(qw[u]), la = bf2f(qa[u]);
                        const float rr = cr + (pr - cr) * mu_r, kx = ck + (pk - ck) * mu_k, v = cv + (pv - cv) * mu_v;
                        pr = cr; pk = ck; pv = cv;
                        const float w = -flog(1.f + fexp(-(w0v + lw))) - 0.5f;
                        cc -= fexp(w);
                        const float a = frcp(1.f + fexp(-(a0v + la)));
                        float kk = kx * kkv;
                        const float nrm = __builtin_amdgcn_sqrtf(wave_sum(kk * kk));
                        kk = kk * __builtin_amdgcn_rcpf(fmaxf(nrm, 1e-12f));
                        const float km = kx * (1.f + (a - 1.f) * kav);
                        const float sbv = wave_sum(rr * km * rkv);
                        if (lanep == tt) sbkeep = sbv;
                        const float gp = gprev, g = fexp(cc), ig = frcp(g);
                        gprev = g;
                        const float be = kk * a;
                        *(LAS bf16*)(ub + U_AT + a64(t, lanep)) = bf1(-kk * gp);
                        *(LAS bf16*)(ub + U_RT + a64(t, lanep)) = bf1(rr * g);
                        *(LAS bf16*)(ub + U_BT + a64(t, lanep)) = bf1(be * ig);
                        *(LAS bf16*)(ub + U_KT + a64(t, lanep)) = bf1(km * ig);
                        *(LAS bf16*)(ub + U_BH + a32(lanep, t)) = bf1(be * ig);
                        *(LAS bf16*)(ub + U_KH + a32(lanep, t)) = bf1(km * ig);
                        *(LAS bf16*)(ub + U_VT + a32(lanep, t)) = bf1(v);
                    }
                }
                if (lanep < 16) SB[(mb + lanep) * 8 + hd] = sbkeep;
                if (wh) *(LAS float*)(ub + U_G31 + lanep * 4) = gprev;
            }
            asm volatile("s_waitcnt lgkmcnt(0)" ::: "memory"); __builtin_amdgcn_s_barrier(); asm volatile("" ::: "memory");
            const unsigned long long tp1 = TIMER_A >= 0 ? __builtin_amdgcn_s_memrealtime() : 0ull;
            {
                int r = lane & 31, h = lane >> 5; asm volatile("" : "+v"(r), "+v"(h));
                bf16x8_t fT[2], fAk[2], fRb[2], fRk[2];
                {
                    f32x16 M, MT, R, RT;
#pragma unroll
                    for (int i = 0; i < 16; ++i) { M[i] = 0.f; MT[i] = 0.f; }
#pragma unroll
                    for (int ks = 0; ks < 4; ++ks) { const int o = a64(r, 16 * ks + 8 * h);
                        const bf16x8_t fb = *(const LAS bf16x8_t*)(ub + U_BT + o), fa = *(const LAS bf16x8_t*)(ub + U_AT + o);
                        M = MFMA32(fb, fa, M); MT = MFMA32(fa, fb, MT); }
#pragma unroll
                    for (int i = 0; i < 16; ++i) { const int q = crow_(i, h); M[i] = (q < r) ? M[i] : 0.f; MT[i] = (r < q) ? MT[i] : 0.f;
                        R[i] = M[i] + ((q == r) ? 1.f : 0.f); RT[i] = MT[i] + ((q == r) ? 1.f : 0.f); }
#pragma unroll
                    for (int lvl = 0; lvl < 4; ++lvl) {
                        bf16x8_t pm[2], pmt[2];
#pragma unroll
                        for (int ks = 0; ks < 2; ++ks) { pm[ks] = pack8(M, ks); pmt[ks] = pack8(MT, ks); }
                        f32x16 M2, MT2;
#pragma unroll
                        for (int i = 0; i < 16; ++i) { M2[i] = 0.f; MT2[i] = 0.f; }
#pragma unroll
                        for (int ks = 0; ks < 2; ++ks) { M2 = MFMA32(pmt[ks], pm[ks], M2); MT2 = MFMA32(pm[ks], pmt[ks], MT2); }
                        M = M2; MT = MT2;
                        bf16x8_t pr[2], prt[2];
#pragma unroll
                        for (int ks = 0; ks < 2; ++ks) { pm[ks] = pack8(M, ks); pr[ks] = pack8(R, ks); prt[ks] = pack8(RT, ks); }
#pragma unroll
                        for (int ks = 0; ks < 2; ++ks) { R = MFMA32(prt[ks], pm[ks], R); RT = MFMA32(pm[ks], prt[ks], RT); }
                        (void)pr;
                    }
#pragma unroll
                    for (int ks = 0; ks < 2; ++ks) fT[ks] = pack8(R, ks);
                }
                __builtin_amdgcn_sched_barrier(0);
                {
                    f32x16 Xak, Xrb, Xrk;
#pragma unroll
                    for (int i = 0; i < 16; ++i) { Xak[i] = 0.f; Xrb[i] = 0.f; Xrk[i] = 0.f; }
#pragma unroll
                    for (int ks = 0; ks < 4; ++ks) { const int o = a64(r, 16 * ks + 8 * h);
                        const bf16x8_t fb = *(const LAS bf16x8_t*)(ub + U_BT + o), fk = *(const LAS bf16x8_t*)(ub + U_KT + o);
                        const bf16x8_t fa = *(const LAS bf16x8_t*)(ub + U_AT + o), fr = *(const LAS bf16x8_t*)(ub + U_RT + o);
                        Xak = MFMA32(fk, fa, Xak); Xrb = MFMA32(fb, fr, Xrb); Xrk = MFMA32(fk, fr, Xrk); }
#pragma unroll
                    for (int i = 0; i < 16; ++i) { const int s = crow_(i, h); Xak[i] = (s < r) ? Xak[i] : 0.f; Xrb[i] = (s <= r) ? Xrb[i] : 0.f; Xrk[i] = (s <= r) ? Xrk[i] : 0.f; }
#pragma unroll
                    for (int ks = 0; ks < 2; ++ks) { fAk[ks] = pack8(Xak, ks); fRb[ks] = pack8(Xrb, ks); fRk[ks] = pack8(Xrk, ks); }
                }
#pragma unroll
                for (int jt = 0; jt < 2; ++jt) {
                    __builtin_amdgcn_sched_barrier(0);
                    bf16x8_t sf[2][2], vf[2];
#pragma unroll
                    for (int kt = 0; kt < 2; ++kt)
#pragma unroll
                        for (int ks = 0; ks < 2; ++ks) sf[kt][ks] = pack8(S[jt][kt], ks);
                    if (wh) {
#pragma unroll
                        for (int ks = 0; ks < 2; ++ks) vf[ks] = ld2x8(ub + U_VT + a32(32 * jt + r, 16 * ks + 4 * h), ub + U_VT + a32(32 * jt + r, 16 * ks + 8 + 4 * h));
                    }
                    f32x16 X1, Uu, Oo;
#pragma unroll
                    for (int i = 0; i < 16; ++i) { X1[i] = 0.f; Uu[i] = 0.f; Oo[i] = 0.f; }
#pragma unroll
                    for (int kt = 0; kt < 2; ++kt)
#pragma unroll
                        for (int ks = 0; ks < 2; ++ks) { const int c0 = 32 * kt + 16 * ks + 4 * h;
                            X1 = MFMA32(ld2x8(ub + U_AT + a64(r, c0), ub + U_AT + a64(r, c0 + 8)), sf[kt][ks], X1);
                            Oo = MFMA32(ld2x8(ub + U_RT + a64(r, c0), ub + U_RT + a64(r, c0 + 8)), sf[kt][ks], Oo); }
                    if (wh) {
#pragma unroll
                        for (int ks = 0; ks < 2; ++ks) { X1 = MFMA32(fAk[ks], vf[ks], X1); Oo = MFMA32(fRk[ks], vf[ks], Oo); }
                    }
                    __builtin_amdgcn_sched_barrier(0);
#pragma unroll
                    for (int ks = 0; ks < 2; ++ks) Uu = MFMA32(fT[ks], pack8(X1, ks), Uu);
                    bf16x8_t uf[2];
#pragma unroll
                    for (int ks = 0; ks < 2; ++ks) { uf[ks] = pack8(Uu, ks); Oo = MFMA32(fRb[ks], uf[ks], Oo); }
                    { bf16* dst = (wh ? OLOC : QHAT) + ms * 512 + hd * 64 + 32 * jt + r;
#pragma unroll
                      for (int i = 0; i < 16; ++i) dst[(size_t)crow_(i, h) * 512] = bf1(Oo[i]); }
                    __builtin_amdgcn_sched_barrier(0);
#pragma unroll
                    for (int kt = 0; kt < 2; ++kt) {
#pragma unroll
                        for (int ks = 0; ks < 2; ++ks) { const int k = 32 * kt + r, t0 = 16 * ks + 4 * h;
                            S[jt][kt] = MFMA32(ld2x8(ub + U_BH + a32(k, t0), ub + U_BH + a32(k, t0 + 8)), uf[ks], S[jt][kt]);
                            if (wh) S[jt][kt] = MFMA32(ld2x8(ub + U_KH + a32(k, t0), ub + U_KH + a32(k, t0 + 8)), vf[ks], S[jt][kt]); }
#pragma unroll
                        for (int g = 0; g < 4; ++g) { const f32x4 gg = *(const LAS f32x4*)(ub + U_G31 + (32 * kt + 8 * g + 4 * h) * 4);
                            S[jt][kt][4 * g] *= gg.x; S[jt][kt][4 * g + 1] *= gg.y; S[jt][kt][4 * g + 2] *= gg.z; S[jt][kt][4 * g + 3] *= gg.w; }
                    }
                }
            }
            asm volatile("s_waitcnt lgkmcnt(0)" ::: "memory"); __builtin_amdgcn_s_barrier(); asm volatile("" ::: "memory");
            if (TIMER_A >= 0) { const unsigned long long tp2 = __builtin_amdgcn_s_memrealtime(); tacc_p += tp1 - tp0; tacc_c += tp2 - tp1; }
        }
        int r = lane & 31, h = lane >> 5; asm volatile("" : "+v"(r), "+v"(h));
        if (wh == 0) { bf16* PC = (bf16*)((unsigned char*)F.out + DO_PC) + (size_t)unit * 4096;
#pragma unroll
            for (int jt = 0; jt < 2; ++jt)
#pragma unroll
                for (int kt = 0; kt < 2; ++kt)
#pragma unroll
                    for (int i = 0; i < 16; ++i) PC[(32 * kt + crow_(i, h)) * 64 + 32 * jt + r] = bf1(S[jt][kt][i]);
        } else { bf16* QCT = (bf16*)((unsigned char*)F.out + DO_QCT) + (size_t)unit * 4096;
#pragma unroll
            for (int jt = 0; jt < 2; ++jt)
#pragma unroll
                for (int kt = 0; kt < 2; ++kt)
#pragma unroll
                    for (int g = 0; g < 4; ++g) { v2u o; o.x = pkbf(S[jt][kt][4 * g], S[jt][kt][4 * g + 1]); o.y = pkbf(S[jt][kt][4 * g + 2], S[jt][kt][4 * g + 3]);
                        *(v2u*)(QCT + (32 * jt + r) * 64 + 32 * kt + 8 * g + 4 * h) = o; }
        }
    }
    if (TIMER_A >= 0 && blockIdx.x == 0 && threadIdx.x == 0) { ((unsigned long long*)(F.ws + 8192))[30] = tacc_p; ((unsigned long long*)(F.ws + 8192))[31] = tacc_c; }
}

template <int V> __device__ __forceinline__ void rwkv_scan(Frame& F, int bh) {
    constexpr int LDT = 72;
    constexpr int SBUF = 64 * LDT;
    LAS bf16* S0 = (LAS bf16*)(F.lds + RING_OFF);
    const int lane = F.lane, w = F.wave, q = lane >> 4, l15 = lane & 15;
    for (int i = F.tid; i < 2 * SBUF; i += 512) S0[i] = 0;
    __syncthreads();
    if (w < 4) {
        const int tr = w;
        const bf16* PC = (const bf16*)((const unsigned char*)F.out + DO_PC) + (size_t)bh * 32 * 4096 + (16 * tr + l15) * 64 + 8 * q;
        const bf16* QCT = (const bf16*)((const unsigned char*)F.out + DO_QCT) + (size_t)bh * 32 * 4096 + l15 * 64 + 16 * tr + 4 * q;
        const int boff0 = l15 * LDT + 8 * q, woff0 = l15 * LDT + 16 * tr + 4 * q;
        bf16x8_t A[8][2]; v2u Qv[8][4];
#define SCAN_LOAD(s, cc) do { \
        asm volatile("global_load_dwordx4 %0, %1, off" : "=v"(A[s][0]) : "v"(PC + (size_t)(cc) * 4096) : "memory"); \
        asm volatile("global_load_dwordx4 %0, %1, off offset:64" : "=v"(A[s][1]) : "v"(PC + (size_t)(cc) * 4096) : "memory"); \
        asm volatile("global_load_dwordx2 %0, %1, off" : "=v"(Qv[s][0]) : "v"(QCT + (size_t)(cc) * 4096) : "memory"); \
        asm volatile("global_load_dwordx2 %0, %1, off offset:2048" : "=v"(Qv[s][1]) : "v"(QCT + (size_t)(cc) * 4096) : "memory"); \
        asm volatile("global_load_dwordx2 %0, %1, off" : "=v"(Qv[s][2]) : "v"(QCT + (size_t)(cc) * 4096 + 2048) : "memory"); \
        asm volatile("global_load_dwordx2 %0, %1, off offset:2048" : "=v"(Qv[s][3]) : "v"(QCT + (size_t)(cc) * 4096 + 2048) : "memory"); } while (0)
#pragma unroll
        for (int s = 0; s < 8; ++s) SCAN_LOAD(s, s);
        if (V == 0) TSTAMP(F, 22); else TSTAMP(F, 26);
#pragma unroll 1
        for (int c0 = 0; c0 < 32; c0 += 8) {
#pragma unroll
            for (int s = 0; s < 8; ++s) {
                const int c = c0 + s;
                const LAS bf16* Sr = S0 + (s & 1) * SBUF; LAS bf16* Sw = S0 + ((s & 1) ^ 1) * SBUF;
                if (V != 3) asm volatile("s_waitcnt vmcnt(42)" : "+v"(A[s][0]), "+v"(A[s][1]), "+v"(Qv[s][0]), "+v"(Qv[s][1]), "+v"(Qv[s][2]), "+v"(Qv[s][3]) :: "memory");
                pg8::f32x4 acc[4];
#pragma unroll
                for (int t = 0; t < 4; ++t) { acc[t][0] = bflo(Qv[s][t].x); acc[t][1] = bfhi(Qv[s][t].x); acc[t][2] = bflo(Qv[s][t].y); acc[t][3] = bfhi(Qv[s][t].y); }
#pragma unroll
                for (int ks = 0; ks < 2; ++ks)
#pragma unroll
                    for (int t = 0; t < 4; ++t) {
                        if (V != 4) { const bf16x8_t bh_ = *(const LAS bf16x8_t*)(Sr + boff0 + 16 * LDT * t + 32 * ks);
                        acc[t] = __builtin_amdgcn_mfma_f32_16x16x32_bf16(A[s][ks], bh_, acc[t], 0, 0, 0); }
                    }
                if (V != 3) { const int cn = (c + 8 < 32) ? c + 8 : 31; SCAN_LOAD(s, cn); }
#pragma unroll
                for (int t = 0; t < 4; ++t) { v2u oh; oh.x = pg8::cvt_pk_bf16(acc[t][0], acc[t][1]); oh.y = pg8::cvt_pk_bf16(acc[t][2], acc[t][3]);
                    *(LAS v2u*)(Sw + woff0 + 16 * LDT * t) = oh; }
                asm volatile("s_waitcnt lgkmcnt(0)" ::: "memory"); __builtin_amdgcn_s_barrier(); asm volatile("" ::: "memory");
            }
        }
#undef SCAN_LOAD
        if (V == 0) TSTAMP(F, 23); else TSTAMP(F, 27);
        asm volatile("s_waitcnt vmcnt(0)" ::: "memory");
    } else {
        const int t256 = F.tid - 256;
        bf16* HIN = (V == 0 ? (bf16*)((unsigned char*)F.out + DO_HIN) : (bf16*)(F.ws + WS_XC)) + (size_t)bh * 32 * 4096 + (t256 >> 2) * 64 + (t256 & 3) * 16;
        const int hoff = (t256 >> 2) * LDT + (t256 & 3) * 16;
#pragma unroll 1
        for (int c = 0; c < 32; ++c) {
            const LAS bf16* Sr = S0 + (c & 1) * SBUF;
            const v4u x0 = *(const LAS v4u*)(Sr + hoff), x1 = *(const LAS v4u*)(Sr + hoff + 8);
            if (V != 2) { *(v4u*)(HIN + (size_t)c * 4096) = x0; *(v4u*)(HIN + (size_t)c * 4096 + 8) = x1; }
            asm volatile("s_waitcnt lgkmcnt(0)" ::: "memory"); __builtin_amdgcn_s_barrier(); asm volatile("" ::: "memory");
        }
    }
}
__device__ __forceinline__ void phase_scan(Frame& F, int flags) {
    if ((flags & 4) && blockIdx.x >= 36) { TSTAMP_B(F, 36, 24); expert_transposes(F, ((int)blockIdx.x - 36) * NWAVES + F.wave, ((int)F.G - 36) * NWAVES); __syncthreads(); TSTAMP_B(F, 36, 25); }
#ifndef SCAN_VARIANT
#define SCAN_VARIANT 0
#endif
    if ((flags & 2) && blockIdx.x < 32) { rwkv_scan<0>(F, blockIdx.x); if (SCAN_VARIANT) { __syncthreads(); rwkv_scan<SCAN_VARIANT>(F, blockIdx.x); } }
    if ((flags & 1) && blockIdx.x >= 32 && blockIdx.x < 36) {
        const int idx = (blockIdx.x - 32) * 512 + F.tid, b = idx >> 9, ch = idx & 511;
        const float* LA = (const float*)(F.ws + WS_LRUA); const float* LB = (const float*)(F.ws + WS_LRUB); float* LH = (float*)(F.ws + WS_LRUH);
        float h = 0.f;
#pragma unroll 1
        for (int c16 = 0; c16 < 128; c16 += 16) { float a16[16], b16[16];
#pragma unroll
            for (int u = 0; u < 16; ++u) { const int o = (b * 128 + c16 + u) * 512 + ch; a16[u] = LA[o]; b16[u] = LB[o]; }
#pragma unroll
            for (int u = 0; u < 16; ++u) { const int o = (b * 128 + c16 + u) * 512 + ch; LH[o] = h; h = fexp(a16[u]) * h + b16[u]; } }
    }
}

__device__ __forceinline__ void rwkv_post_unit(Frame& F, int unit) {
    int lane = F.lane; asm volatile("" : "+v"(lane));
    const int c = unit & 127, bh = unit >> 7, h = bh & 7, b = bh >> 3, q = lane >> 4, l15 = lane & 15;
    const size_t m0 = (size_t)b * T + (size_t)c * 64;
    const bf16* QHAT = (const bf16*)(F.ws + WS_QHAT); const bf16* OLOC = (const bf16*)(F.ws + WS_OLOC); const bf16* GG = (const bf16*)(F.ws + WS_GG);
    const bf16* HIN = (const bf16*)((const unsigned char*)F.out + DO_HIN) + (size_t)(bh * 32 + (c >> 2)) * 4096; const bf16* P = (const bf16*)(F.ws + WS_P);
    const float* SB = (const float*)(F.ws + WS_SB); bf16* YMIX = (bf16*)(F.ws + WS_YMIX);
    bf16x8_t Af[4][2];
#pragma unroll
    for (int jt = 0; jt < 4; ++jt)
#pragma unroll
        for (int ks = 0; ks < 2; ++ks) Af[jt][ks] = *(const bf16x8_t*)(HIN + (16 * jt + l15) * 64 + 32 * ks + 8 * q);
    f32x4 lnw[4], lnb[4], muv[4];
#pragma unroll
    for (int jt = 0; jt < 4; ++jt) { const int ch = h * 64 + 16 * jt + 4 * q; lnw[jt] = *(const f32x4*)(F.in[23] + ch); lnb[jt] = *(const f32x4*)(F.in[24] + ch); muv[jt] = *(const f32x4*)(F.in[14] + 1024 + ch); }
#pragma unroll 1
    for (int tt = 0; tt < 4; ++tt) {
        const size_t m = m0 + 16 * tt + l15;
        bf16x8_t Bf[2];
#pragma unroll
        for (int ks = 0; ks < 2; ++ks) Bf[ks] = *(const bf16x8_t*)(QHAT + m * 512 + h * 64 + 32 * ks + 8 * q);
        pg8::f32x4 acc[4];
#pragma unroll
        for (int jt = 0; jt < 4; ++jt) { const v2u o = *(const v2u*)(OLOC + m * 512 + h * 64 + 16 * jt + 4 * q); acc[jt][0] = bflo(o.x); acc[jt][1] = bfhi(o.x); acc[jt][2] = bflo(o.y); acc[jt][3] = bfhi(o.y); }
#pragma unroll
        for (int ks = 0; ks < 2; ++ks)
#pragma unroll
            for (int jt = 0; jt < 4; ++jt) acc[jt] = __builtin_amdgcn_mfma_f32_16x16x32_bf16(Af[jt][ks], Bf[ks], acc[jt], 0, 0, 0);
        float s = 0.f;
#pragma unroll
        for (int jt = 0; jt < 4; ++jt) s += (acc[jt][0] + acc[jt][1]) + (acc[jt][2] + acc[jt][3]);
        s += __shfl_xor(s, 16); s += __shfl_xor(s, 32);
        const float mean = s * (1.f / 64.f);
        float vs = 0.f;
#pragma unroll
        for (int jt = 0; jt < 4; ++jt)
#pragma unroll
            for (int i = 0; i < 4; ++i) { acc[jt][i] -= mean; vs += acc[jt][i] * acc[jt][i]; }
        vs += __shfl_xor(vs, 16); vs += __shfl_xor(vs, 32);
        const float rstd = rsqrtf(vs * (1.f / 64.f) + 64e-5f);
        const float sbv = SB[m * 8 + h];
        const bool first = ((m % T) == 0);
#pragma unroll
        for (int jt = 0; jt < 4; ++jt) { const int ch = h * 64 + 16 * jt + 4 * q;
            const v2u cvq = *(const v2u*)(P + m * PW + C_V + ch); v2u pvq = {0u, 0u}; if (!first) pvq = *(const v2u*)(P + (m - 1) * PW + C_V + ch);
            const v2u gq = *(const v2u*)(GG + m * 512 + ch);
            const float cv[4] = {bflo(cvq.x), bfhi(cvq.x), bflo(cvq.y), bfhi(cvq.y)}, pv[4] = {bflo(pvq.x), bfhi(pvq.x), bflo(pvq.y), bfhi(pvq.y)}, gg[4] = {bflo(gq.x), bfhi(gq.x), bflo(gq.y), bfhi(gq.y)};
            float y[4];
#pragma unroll
            for (int i = 0; i < 4; ++i) { const float v = cv[i] + (pv[i] - cv[i]) * muv[jt][i]; y[i] = (acc[jt][i] * rstd * lnw[jt][i] + lnb[jt][i] + sbv * v) * gg[i]; }
            v2u o; o.x = pk2(y[0], y[1]); o.y = pk2(y[2], y[3]);
            *(v2u*)(YMIX + m * D + 512 + ch) = o; }
    }
}
__device__ __forceinline__ void phase_post(Frame& F, int flags) {
    const int gw = F.vcu * NWAVES + F.wave, NGW = F.G * NWAVES, lane = F.lane;
    if (flags & 2) for (int unit = gw; unit < 4096; unit += NGW) rwkv_post_unit(F, unit);
    if (flags & 1) {
        const bf16* GT = (const bf16*)(F.ws + WS_LOGA); const bf16* P = (const bf16*)(F.ws + WS_P);
        const float* LH = (const float*)(F.ws + WS_LRUH); bf16* YMIX = (bf16*)(F.ws + WS_YMIX); const float* ng = F.in[13];
        for (int task = gw; task < 4 * 128 * 8; task += NGW) { const int cg = task & 7, bc = task >> 3, ch = cg * 64 + lane;
            const size_t m0 = (size_t)bc * 64; float hl = LH[bc * 512 + ch]; const float g = ng[ch];
#pragma unroll 1
            for (int t8 = 0; t8 < 64; t8 += 8) {
                bf16 g0[8], g1[8], p8[8];
#pragma unroll
                for (int u = 0; u < 8; ++u) { const size_t m = m0 + t8 + u; g0[u] = GT[m * 1024 + ch]; g1[u] = GT[m * 1024 + 512 + ch]; p8[u] = P[m * PW + C_GATE + ch]; }
#pragma unroll
                for (int u = 0; u < 8; ++u) { const size_t m = m0 + t8 + u;
                    const float la = bf2f(g0[u]), bb = bf2f(g1[u]); hl = fexp(la) * hl + bb;
                    float y = hl * gelu_tanh(bf2f(p8[u]));
                    const float ss = wave_sum(y * y) * (1.f / 64.f);
                    YMIX[m * D + ch] = f2bf(y * rsqrtf(ss + 1e-6f) * g); }
            }
        }
    }
}

struct Args { const float* in[35]; float* out; unsigned char* ws; int ph_lo, ph_hi, flags, pad; };
__global__ void __launch_bounds__(NWAVES * 64, 2) mk_fwd(Args args) {
    extern __shared__ __attribute__((aligned(16))) unsigned char lds[];
    Frame F;
    F.lds = (LAS unsigned char*)lds;
    F.tid = threadIdx.x; F.lane = F.tid & 63; F.wave = __builtin_amdgcn_readfirstlane(F.tid >> 6);
    F.G = gridDim.x; { const int bx = blockIdx.x; F.vcu = (F.G % 8 == 0) ? (bx % 8) * (F.G / 8) + bx / 8 : bx; }
    F.in = args.in; F.out = args.out; F.ws = args.ws;
    const int lo = args.ph_lo, hi = args.ph_hi;
#define IN(k) (lo <= (k) && (k) < hi)
    const int flags = args.flags;
    for (int u = threadIdx.x; u < (LDS_BYTES - LDSCTL_OFF) / 4; u += NWAVES * 64) ((LAS unsigned*)(F.lds + LDSCTL_OFF))[u] = 0u;
    __syncthreads();
    XcdBarrier bar; bar.bar = (unsigned*)(args.ws + WS_CTL) + CW_BAR; bar.x = 0; bar.st = nullptr;
    if (hi - lo > 1) bar = xcd_barrier_post((unsigned*)(args.ws + WS_CTL) + CW_BAR, (volatile LAS unsigned*)(F.lds + MISC_OFF) + 8);
#define SEAM(k) if (IN(k) && IN((k) + 1)) { xcd_barrier(bar); TSTAMP(F, (k) + 1); }
#ifndef DUP_MASK
#define DUP_MASK 0
#endif
#define PH1(k, call) { int t_ = threadIdx.x; asm volatile("" : "+v"(t_)); F.tid = t_; F.lane = t_ & 63; F.wave = __builtin_amdgcn_readfirstlane(t_ >> 6); call; }
#define PH(k, bit, call) if (IN(k)) { PH1(k, call) if ((DUP_MASK >> (bit)) & 1) { xcd_barrier(bar); PH1(k, call) } }
    TSTAMP(F, 0);
    PH(0, 0, (phase0(F), p0_small_weights(F)))
    SEAM(0)
    PH(1, 1, phase1(F))
    SEAM(1)
    PH(2, 2, phase2(F))
    SEAM(2)
    PH(3, 3, phase_prepA(F))
    SEAM(3)
    PH(4, 4, phase_gategemm(F))
    PH(4, 5, phase_loragemm(F))
    SEAM(4)
    if ((DUP_MASK >> 6) & 1) { if (IN(5)) { PH1(5, phase_lrulocal(F, true)) xcd_barrier(bar); } }
    PH(5, 30, phase_lrulocal(F))
#ifndef RWKV_MFMA
#define RWKV_MFMA 1
#endif
    if (RWKV_MFMA) { PH(5, 7, phase_rwkvlocal_mfma(F)) } else { PH(5, 7, phase_rwkvlocal(F)) }
    SEAM(5)
    if ((DUP_MASK >> 8) & 1) { if (IN(6)) { PH1(6, phase_scan(F, 6)) xcd_barrier(bar); } }
    PH(6, 30, phase_scan(F, flags | 4))
    SEAM(6)
    PH(7, 9, phase_post(F, flags))
    SEAM(7)
    PH(8, 10, phase_outproj(F))
    SEAM(8)
    if ((DUP_MASK >> 11) & 1) { if (IN(9)) { PH1(9, phase_route(F)) xcd_barrier(bar); if (blockIdx.x == 0 && threadIdx.x < 32) ((int*)(args.ws + WS_CNT))[threadIdx.x * 64] = 0; xcd_barrier(bar); } }
    PH(9, 30, phase_route(F))
    SEAM(9)
    PH(10, 12, phase_m1(F))
    SEAM(10)
    PH(11, 13, phase_m2(F))
    SEAM(11)
    if ((DUP_MASK >> 14) & 1) { if (IN(12)) { PH1(12, phase_final(F, true)) xcd_barrier(bar); } }
    PH(12, 30, phase_final(F))
#undef SEAM
#undef PH
#undef PH1
#undef IN
}

extern "C" void kernel_launch(void* const* d_in, const int* in_sizes, int n_in, void* d_out, int out_size, void* d_ws, size_t ws_size, hipStream_t stream) {
    if (n_in != 35 || out_size != NTOK * D || ws_size < WS_END) { fprintf(stderr, "kernel_launch: unexpected shapes (n_in %d out %d ws %zu)\n", n_in, out_size, ws_size); return; }
    static int grid = 0;
    if (grid == 0) {
        int dev = 0, cus = 0;
        if (hipGetDevice(&dev) != hipSuccess || hipDeviceGetAttribute(&cus, hipDeviceAttributeMultiprocessorCount, dev) != hipSuccess) { grid = -1; return; }
        if (hipFuncSetAttribute((const void*)mk_fwd, hipFuncAttributeMaxDynamicSharedMemorySize, LDS_BYTES) != hipSuccess) { fprintf(stderr, "kernel_launch: hipFuncSetAttribute failed\n"); grid = -1; return; }
        int per_cu = 0;
        if (hipOccupancyMaxActiveBlocksPerMultiprocessor(&per_cu, (const void*)mk_fwd, NWAVES * 64, LDS_BYTES) != hipSuccess || per_cu < 1) { fprintf(stderr, "kernel_launch: occupancy query says %d blocks per CU\n", per_cu); (void)hipGetLastError(); }
        grid = cus;
    }
    if (grid < 0) return;
    const float* const* in = (const float* const*)d_in;
    char* ws = (char*)d_ws; float* out = (float*)d_out;
    Args a{};
    for (int i = 0; i < 35; ++i) a.in[i] = in[i];
    a.out = out; a.ws = (unsigned char*)d_ws;
    hipMemsetAsync(ws + WS_CTL, 0, 1 * MiB, stream);
#define LAUNCH_PH(p) do { a.ph_lo = (p); a.ph_hi = (p) + 1; hipLaunchKernelGGL(mk_fwd, dim3(grid), dim3(NWAVES * 64), LDS_BYTES, stream, a); } while (0)
#ifndef MIX_FLAGS
#define MIX_FLAGS 3
#endif
    a.flags = MIX_FLAGS;
#ifndef N_LAUNCHES
#define N_LAUNCHES 1
#endif
    if (N_LAUNCHES == 1) { a.ph_lo = 0; a.ph_hi = 13; hipLaunchKernelGGL(mk_fwd, dim3(grid), dim3(NWAVES * 64), LDS_BYTES, stream, a); }
    else { for (int p = 0; p < 13; ++p) LAUNCH_PH(p); }
}
```

```cpp
#include <hip/hip_runtime.h>
#include <stdint.h>
#include <cstdio>

#define SCAN_NOLO 1
#ifndef TIMER_A
#define TIMER_A -1
#define TIMER_B -1
#endif
#define TSTAMP(F_, i) do { if (TIMER_A >= 0 && blockIdx.x == 0 && threadIdx.x == 0) ((unsigned long long*)((F_).ws + 8192))[i] = __builtin_amdgcn_s_memrealtime(); } while (0)
#define TSTAMP_B(F_, blk, i) do { if (TIMER_A >= 0 && blockIdx.x == (blk) && threadIdx.x == 0) ((unsigned long long*)((F_).ws + 8192))[i] = __builtin_amdgcn_s_memrealtime(); } while (0)
#define TACCUM(F_, i, t0) do { if (TIMER_A >= 0 && blockIdx.x == 0 && threadIdx.x == 0) ((unsigned long long*)((F_).ws + 8192))[i] += __builtin_amdgcn_s_memrealtime() - (t0); } while (0)
typedef unsigned short bf16;
__device__ __forceinline__ bf16 f2bf(float f) { unsigned u = __float_as_uint(f); return (bf16)((u + 0x7fffu + ((u >> 16) & 1u)) >> 16); }
__device__ __forceinline__ float bf2f(bf16 b) { return __uint_as_float(((unsigned)b) << 16); }
__device__ __forceinline__ float bflo(unsigned u) { return __uint_as_float(u << 16); }
__device__ __forceinline__ float bfhi(unsigned u) { return __uint_as_float(u & 0xffff0000u); }

constexpr int NB = 4, T = 8192, D = 1024, NTOK = NB * T;
constexpr int LRU_W = 512, RW = 512, PW = 2816;
constexpr int C_UX = 0, C_GATE = 512, C_R = 1024, C_K = 1536, C_V = 2048, C_WD = 2560, C_AD = 2624, C_GD = 2688;
constexpr int NE = 32, DE = 512;
constexpr size_t MiB = 1u << 20;
constexpr size_t WS_CTL = 0;
constexpr int CW_BAR = 4096;
constexpr size_t WS_CNT = 32 * 1024;
constexpr size_t WS_MOD = 1 * MiB;
constexpr size_t WS_SELW = 384 * MiB;
constexpr size_t WS_SEL = 1 * MiB + 512 * 1024;
constexpr size_t FW_WLORAT = 2 * MiB;
constexpr size_t FW_WGT = 3 * MiB;
constexpr size_t FW_WR = 3 * MiB + 512 * 1024;
constexpr size_t FW_WINT = 4 * MiB;
constexpr size_t FW_WOUTT = 10 * MiB;
constexpr size_t WS_LIST = 12 * MiB;
constexpr size_t WS_H = 16 * MiB;
constexpr size_t WS_YMIX = WS_H;
constexpr size_t WS_P = 80 * MiB;
constexpr size_t WS_HID = WS_P;
constexpr size_t WS_Y = 152 * MiB;
constexpr size_t WS_YS = 256 * MiB;
constexpr size_t FW_W13T = 416 * MiB;
constexpr size_t FW_W2T = 480 * MiB;
constexpr size_t WS_END = 512 * MiB;

__device__ __forceinline__ float wave_sum(float v) {
    v += __int_as_float(__builtin_amdgcn_update_dpp(0, __float_as_int(v), 0xB1, 0xF, 0xF, true));
    v += __int_as_float(__builtin_amdgcn_update_dpp(0, __float_as_int(v), 0x4E, 0xF, 0xF, true));
    v += __int_as_float(__builtin_amdgcn_update_dpp(0, __float_as_int(v), 0x141, 0xF, 0xF, true));
    v += __int_as_float(__builtin_amdgcn_update_dpp(0, __float_as_int(v), 0x140, 0xF, 0xF, true));
    const int vi = __float_as_int(v);
    const float r0 = __int_as_float(__builtin_amdgcn_readlane(vi, 0)), r1 = __int_as_float(__builtin_amdgcn_readlane(vi, 16));
    const float r2 = __int_as_float(__builtin_amdgcn_readlane(vi, 32)), r3 = __int_as_float(__builtin_amdgcn_readlane(vi, 48));
    return (r0 + r1) + (r2 + r3);
}
__device__ __forceinline__ float fexp(float x) { return __builtin_amdgcn_exp2f(x * 1.44269504089f); }
__device__ __forceinline__ float flog(float x) { return __builtin_amdgcn_logf(x) * 0.69314718056f; }
__device__ __forceinline__ float frcp(float x) { return __builtin_amdgcn_rcpf(x); }
__device__ __forceinline__ float sigmoidf_(float x) { return frcp(1.f + fexp(-x)); }
__device__ __forceinline__ float softplusf_(float x) { return x > 20.f ? x : flog(1.f + fexp(x)); }
__device__ __forceinline__ float ftanh(float u) { return 1.f - 2.f * frcp(1.f + fexp(2.f * u)); }
__device__ __forceinline__ float gelu_tanh(float x) { const float u = 0.7978845608028654f * (x + 0.044715f * x * x * x); return 0.5f * x * (1.f + ftanh(u)); }

namespace pg8 {
#define PG8_LAS __attribute__((address_space(3)))
typedef unsigned short bf16_t;
typedef short bf16x8 __attribute__((ext_vector_type(8)));
typedef float f32x4 __attribute__((ext_vector_type(4)));
typedef unsigned u32x4 __attribute__((ext_vector_type(4)));
constexpr int BM = 256, BK = 64, HALF = 128, HTB = HALF * BK * 2  , STAGE_BYTES = 8 * HTB, NXCD = 8, WGM = 8;

__host__ __device__ __forceinline__ int lds_byte(int r, int c) { const int st = (r >> 4) * 2 + (c >> 5), rr = r & 15, cc = c & 31, ob = rr * 64 + cc * 2; return st * 1024 + (ob ^ (((ob >> 9) & 1) << 5)); }
__host__ __device__ __forceinline__ void stage_rc(int b, int& R, int& C) { const int st = b / 1024, sb = b % 1024, swz = sb ^ (((sb >> 9) & 1) << 5); R = (st >> 1) * 16 + swz / 64; C = (st & 1) * 32 + (swz % 64) / 2; }
__host__ __device__ __forceinline__ int perm32(int rho) { const int n = rho >> 4, i = rho & 15; return 8 * (i >> 2) + 4 * n + (i & 3); }

struct Unit { int pm, pn, e, nrows, row0; };
struct Gemm { const bf16_t* A; const bf16_t* Bt; int lda, ldb, K; };

__device__ __forceinline__ unsigned cvt_pk_bf16(float lo, float hi) { unsigned r; asm volatile("v_cvt_pk_bf16_f32 %0, %1, %2" : "=v"(r) : "v"(lo), "v"(hi)); return r; }

struct DenseOrder {
    static constexpr bool GATHER = false;
    int nM, nN, nwg, G, c;
    __device__ void init(int M, int N, int G_, int c_) { nM = M / BM; nN = N / BM; nwg = nM * nN; G = G_; c = c_; }
    __device__ bool next(int i, Unit& u) const {
        const long L = (long)i * G + c; if (L >= nwg) return false;
        int wgid = (int)L; { const int q = nwg / NXCD, r = nwg % NXCD, xcd = wgid % NXCD, off = wgid / NXCD; wgid = (xcd < r ? xcd * (q + 1) : r * (q + 1) + (xcd - r) * q) + off; }
        const int nig = WGM * nN, gid = wgid / nig, fm = gid * WGM, gsz = (nM - fm) < WGM ? (nM - fm) : WGM;
        u.pm = fm + ((wgid % nig) % gsz); u.pn = (wgid % nig) / gsz; u.e = 0; u.nrows = 256; u.row0 = 0; return true;
    }
    __device__ __forceinline__ const char* a_base(const Gemm& g, const Unit& u) const { return (const char*)g.A + (size_t)u.pm * (BM * 2) * g.lda; }
    __device__ __forceinline__ const char* b_base(const Gemm& g, const Unit& u) const { return (const char*)g.Bt + (size_t)u.pn * (BM * 2) * g.ldb; }
    __device__ __forceinline__ int row(const Unit&, int) const { return 0; }
};

template <class Epi, class Sched>
__device__ __forceinline__ void gemm_phase(PG8_LAS unsigned char* lds, const Gemm g, const Sched& S, const Epi& E, const int tid) {
    const int wid = __builtin_amdgcn_readfirstlane(tid >> 6), lane = tid & 63, wr = wid >> 2, wc = wid & 3, fr = lane & 15, fq = lane >> 4;
    const int K = g.K, nt = K / BK;
    unsigned voffA[2], voffB[2]; int sR[2], sC[2];
#pragma unroll
    for (int i = 0; i < 2; ++i) { int R, C; stage_rc(tid * 16 + i * 8192, R, C); const int Rb = Epi::PERM ? ((R & ~31) + perm32(R & 31)) : R;
        voffA[i] = (unsigned)(R * g.lda + C) * 2u; voffB[i] = (unsigned)(Rb * g.ldb + C) * 2u; sR[i] = R; sC[i] = C; }
    const size_t kstep = (size_t)(BK * 2);
    const size_t hstepA = Sched::GATHER ? 0 : (size_t)HALF * g.lda * 2, hstepB = (size_t)HALF * g.ldb * 2;
    const unsigned ldsw = (unsigned)wid * 1024u;
    const int aoff = lds_byte(wr * 64 + fr, fq * 8), boff = lds_byte(wc * 32 + fr, fq * 8);
    unsigned gA[2][2], gN[2][2];
#define PG8_SA(b, h) (((b) * 2 + (h)) * HTB)
#define PG8_SB(b, h) ((4 + (b) * 2 + (h)) * HTB)
#define PG8_STAGE(bufoff, gbase, voff) do { _Pragma("unroll") for (int _i = 0; _i < 2; ++_i) \
        __builtin_amdgcn_global_load_lds((const unsigned*)((const char*)(gbase) + (voff)[_i]), (PG8_LAS unsigned*)(lds + (bufoff) + ldsw + _i * 8192), 16, 0, 0); } while (0)
#define PG8_STAGE_A(bufoff, kp, h, OFF) do { if constexpr (Sched::GATHER) PG8_STAGE(bufoff, kp, OFF[h]); else PG8_STAGE(bufoff, (kp) + (h) * hstepA, voffA); } while (0)
#define PG8_LDA(dst, b, h) do { _Pragma("unroll") for (int m = 0; m < 4; ++m) _Pragma("unroll") for (int k = 0; k < 2; ++k) dst[m][k] = *(const PG8_LAS bf16x8*)(lds + PG8_SA(b, h) + aoff + m * 2048 + k * 1024); } while (0)
#define PG8_LDB(dst, b, h) do { _Pragma("unroll") for (int n = 0; n < 2; ++n) _Pragma("unroll") for (int k = 0; k < 2; ++k) dst[n][k] = *(const PG8_LAS bf16x8*)(lds + PG8_SB(b, h) + boff + n * 2048 + k * 1024); } while (0)
#define PG8_MMA(ai, bj, At, Bt) do { __builtin_amdgcn_s_setprio(1); _Pragma("unroll") for (int m = 0; m < 4; ++m) _Pragma("unroll") for (int n = 0; n < 2; ++n) _Pragma("unroll") for (int k = 0; k < 2; ++k) \
        acc[ai][bj][m][n] = __builtin_amdgcn_mfma_f32_16x16x32_bf16(Bt[n][k], At[m][k], acc[ai][bj][m][n], 0, 0, 0); __builtin_amdgcn_s_setprio(0); } while (0)
#define PG8_WAIT_V(n) asm volatile("s_waitcnt vmcnt(" #n ")" ::: "memory")
#define PG8_WAIT_L(n) asm volatile("s_waitcnt lgkmcnt(" #n ")" ::: "memory")
#define PG8_BAR __builtin_amdgcn_s_barrier()
#define PG8_SCHED __builtin_amdgcn_sched_barrier(0)
    Unit cur, nxt; int ui = 0;
    if (!S.next(0, cur)) return;
    f32x4 acc[2][2][4][2];
#pragma unroll
    for (int a = 0; a < 2; ++a)
#pragma unroll
        for (int b = 0; b < 2; ++b)
#pragma unroll
            for (int m = 0; m < 4; ++m)
#pragma unroll
                for (int n = 0; n < 2; ++n) acc[a][b][m][n] = (f32x4){0.f, 0.f, 0.f, 0.f};
    bf16x8 At[4][2], B0[2][2], B1[2][2];
    const char* cA = S.a_base(g, cur); const char* cB = S.b_base(g, cur);
    if constexpr (Sched::GATHER) {
#pragma unroll
        for (int h = 0; h < 2; ++h)
#pragma unroll
            for (int i = 0; i < 2; ++i) gA[h][i] = (unsigned)(S.row(cur, h * HALF + sR[i]) * g.lda + sC[i]) * 2u;
    }
    PG8_STAGE(PG8_SB(0, 0), cB, voffB); PG8_STAGE(PG8_SB(0, 1), cB + hstepB, voffB); PG8_STAGE_A(PG8_SA(0, 0), cA, 0, gA); PG8_STAGE_A(PG8_SA(0, 1), cA, 1, gA);
    if (wr == 1) PG8_BAR;
    PG8_WAIT_V(2); PG8_BAR;
    PG8_STAGE(PG8_SB(1, 0), cB + kstep, voffB); PG8_STAGE_A(PG8_SA(1, 0), cA + kstep, 0, gA); PG8_STAGE(PG8_SB(1, 1), cB + hstepB + kstep, voffB);
    PG8_WAIT_V(6); PG8_BAR;
    for (;;) {
        const bool has_next = S.next(ui + 1, nxt);
        const char* nA = has_next ? S.a_base(g, nxt) : cA; const char* nB = has_next ? S.b_base(g, nxt) : cB;
        if constexpr (Sched::GATHER) {
#pragma unroll
            for (int h = 0; h < 2; ++h)
#pragma unroll
                for (int i = 0; i < 2; ++i) gN[h][i] = has_next ? (unsigned)(S.row(nxt, h * HALF + sR[i]) * g.lda + sC[i]) * 2u : gA[h][i];
        }
#pragma unroll 1
        for (int t = 0; t < nt; t += 2) {
            const bool last = (t == nt - 2);
            const char* a1 = cA + (size_t)(t + 1) * kstep;
            const char* a2 = last ? nA : cA + (size_t)(t + 2) * kstep; const char* b2 = last ? nB : cB + (size_t)(t + 2) * kstep;
            const char* a3 = a2 + kstep; const char* b3 = b2 + kstep;
            unsigned o2[2][2];
            if constexpr (Sched::GATHER) {
#pragma unroll
                for (int h = 0; h < 2; ++h)
#pragma unroll
                    for (int i = 0; i < 2; ++i) o2[h][i] = last ? gN[h][i] : gA[h][i];
            }
            PG8_LDB(B0, 0, 0); PG8_LDB(B1, 0, 1); PG8_SCHED; PG8_LDA(At, 0, 0); PG8_STAGE_A(PG8_SA(1, 1), a1, 1, gA);
            PG8_WAIT_V(8); PG8_WAIT_L(0); PG8_BAR; PG8_MMA(0, 0, At, B0); PG8_MMA(0, 1, At, B1); PG8_BAR; PG8_SCHED;
            PG8_LDA(At, 0, 1); PG8_STAGE(PG8_SB(0, 0), b2, voffB); PG8_STAGE(PG8_SB(0, 1), b2 + hstepB, voffB); PG8_STAGE_A(PG8_SA(0, 0), a2, 0, o2);
            PG8_WAIT_V(8); PG8_WAIT_L(0); PG8_BAR; PG8_MMA(1, 0, At, B0); PG8_MMA(1, 1, At, B1); PG8_BAR; PG8_SCHED;
            PG8_LDB(B0, 1, 0); PG8_LDB(B1, 1, 1); PG8_SCHED; PG8_LDA(At, 1, 0); PG8_STAGE_A(PG8_SA(0, 1), a2, 1, o2);
            PG8_WAIT_V(8); PG8_WAIT_L(0); PG8_BAR; PG8_MMA(0, 0, At, B0); PG8_MMA(0, 1, At, B1); PG8_BAR; PG8_SCHED;
            PG8_LDA(At, 1, 1); PG8_STAGE(PG8_SB(1, 0), b3, voffB); PG8_STAGE(PG8_SB(1, 1), b3 + hstepB, voffB); PG8_STAGE_A(PG8_SA(1, 0), a3, 0, o2);
            PG8_WAIT_V(8); PG8_WAIT_L(0); PG8_BAR; PG8_MMA(1, 0, At, B0); PG8_MMA(1, 1, At, B1); PG8_BAR; PG8_SCHED;
        }
        if (wr == 0) PG8_BAR;
        E(acc, cur, wr, wc, fr, fq);
        if (!has_next) break;
#pragma unroll
        for (int a = 0; a < 2; ++a)
#pragma unroll
            for (int b = 0; b < 2; ++b)
#pragma unroll
                for (int m = 0; m < 4; ++m)
#pragma unroll
                    for (int n = 0; n < 2; ++n) acc[a][b][m][n] = (f32x4){0.f, 0.f, 0.f, 0.f};
        cur = nxt; cA = nA; cB = nB; ++ui;
        if constexpr (Sched::GATHER) {
#pragma unroll
            for (int h = 0; h < 2; ++h)
#pragma unroll
                for (int i = 0; i < 2; ++i) gA[h][i] = gN[h][i];
        }
        if (wr == 1) PG8_BAR;
    }
    PG8_WAIT_V(0);
    PG8_BAR;
#undef PG8_SA
#undef PG8_SB
#undef PG8_STAGE
#undef PG8_STAGE_A
#undef PG8_LDA
#undef PG8_LDB
#undef PG8_MMA
#undef PG8_WAIT_V
#undef PG8_WAIT_L
#undef PG8_BAR
#undef PG8_SCHED
}

struct EpiBf16Store {
    static constexpr bool PERM = true;
    bf16_t* O; int ldc;
    __device__ __forceinline__ void operator()(const f32x4 (&acc)[2][2][4][2], const Unit& u, int wr, int wc, int fr, int fq) const {
        const int row0 = u.pm * BM + wr * 64 + fr, col0 = u.pn * BM + wc * 32 + 8 * fq;
#pragma unroll
        for (int ai = 0; ai < 2; ++ai)
#pragma unroll
            for (int m = 0; m < 4; ++m) { bf16_t* rowp = O + (size_t)(row0 + ai * HALF + m * 16) * ldc + col0;
#pragma unroll
                for (int bj = 0; bj < 2; ++bj) { const f32x4 v0 = acc[ai][bj][m][0], v1 = acc[ai][bj][m][1];
                    u32x4 w; w.x = cvt_pk_bf16(v0[0], v0[1]); w.y = cvt_pk_bf16(v0[2], v0[3]); w.z = cvt_pk_bf16(v1[0], v1[1]); w.w = cvt_pk_bf16(v1[2], v1[3]);
                    *(u32x4*)(rowp + bj * HALF) = w; } }
    }
};
}
constexpr int NWAVES = 8;
constexpr int RING_OFF = 0, RING_BYTES = 131072;
constexpr int ROUTER_LDS = 147456;
constexpr int LDSCTL_OFF = ROUTER_LDS, MISC_OFF = LDSCTL_OFF + 320;
constexpr int LDS_TAB_OFF = LDSCTL_OFF + 1024;
constexpr int LDS_BYTES = 155648;

#define GAS __attribute__((address_space(1)))
#define LAS __attribute__((address_space(3)))
typedef unsigned v4u __attribute__((ext_vector_type(4)));
typedef unsigned v2u __attribute__((ext_vector_type(2)));
typedef float f32x4 __attribute__((ext_vector_type(4)));
#define LDS_WAIT() asm volatile("s_waitcnt lgkmcnt(0)" ::: "memory")
#define VM_WAIT() asm volatile("s_waitcnt vmcnt(0)" ::: "memory")
__device__ __forceinline__ unsigned pk2(float lo, float hi) { return (unsigned)f2bf(lo) | ((unsigned)f2bf(hi) << 16); }


struct Frame {
    LAS unsigned char* lds;
    int tid, lane, wave, vcu, G;
    const float* const* in;
    float* out; unsigned char* ws;
};

__device__ __forceinline__ void p0_transpose_item(const float* W, int ldw, bf16* WT, int ldt, int k0, int n0, int row0, LAS float* scr, int lane) {
    {
        f32x4 t[8];
#pragma unroll
        for (int i = 0; i < 8; ++i) t[i] = *(const f32x4*)(W + (size_t)(k0 + 8 * i + (lane >> 3)) * ldw + n0 + 4 * (lane & 7));
#pragma unroll
        for (int i = 0; i < 8; ++i) { LAS float* d = scr + (8 * i + (lane >> 3)) * 33 + 4 * (lane & 7); d[0] = t[i].x; d[1] = t[i].y; d[2] = t[i].z; d[3] = t[i].w; }
    }
    LDS_WAIT(); asm volatile("" ::: "memory");
    const int c = lane & 7;
#pragma unroll
    for (int j = 0; j < 4; ++j) { const int n = (lane >> 3) + 8 * j; const LAS float* s = scr + (8 * c) * 33 + n;
        v4u o; o.x = pk2(s[0 * 33], s[1 * 33]); o.y = pk2(s[2 * 33], s[3 * 33]); o.z = pk2(s[4 * 33], s[5 * 33]); o.w = pk2(s[6 * 33], s[7 * 33]);
        *(v4u*)(WT + (size_t)(row0 + n) * ldt + k0 + 8 * c) = o; }
    LDS_WAIT(); asm volatile("" ::: "memory");
}

__device__ __forceinline__ void p0_mod_task(Frame& F, int task) {
    LAS float* sc = (LAS float*)(F.lds);
    LAS float* red = (LAS float*)(F.lds + 16384);
    const float* c = F.in[1]; const float* w_ada = F.in[2]; const float* b_ada = F.in[3];
    for (int i = F.tid; i < 4096; i += 512) { const float cv = c[i]; sc[i] = cv / (1.f + __expf(-cv)); }
    __syncthreads();
    const int j = task * 32 + (F.lane & 31);
    float a0 = 0.f, a1 = 0.f, a2 = 0.f, a3 = 0.f;
    const int kb = F.wave * 128 + (F.lane >> 5) * 64;
#pragma unroll 16
    for (int k = kb; k < kb + 64; ++k) { const float w = w_ada[(size_t)k * 6144 + j]; a0 += sc[k] * w; a1 += sc[1024 + k] * w; a2 += sc[2048 + k] * w; a3 += sc[3072 + k] * w; }
    red[(F.wave * 4 + 0) * 64 + F.lane] = a0; red[(F.wave * 4 + 1) * 64 + F.lane] = a1; red[(F.wave * 4 + 2) * 64 + F.lane] = a2; red[(F.wave * 4 + 3) * 64 + F.lane] = a3;
    __syncthreads();
    if (F.tid < 128) { const int b = F.tid >> 5, l = F.tid & 31; float s = 0.f;
#pragma unroll
        for (int w = 0; w < 8; ++w) s += red[(w * 4 + b) * 64 + l] + red[(w * 4 + b) * 64 + 32 + l];
        ((float*)(F.ws + WS_MOD))[b * 6144 + task * 32 + l] = s + b_ada[task * 32 + l]; }
    __syncthreads();
}

__device__ __forceinline__ void phase0(Frame& F) {
    if (blockIdx.x < 192) p0_mod_task(F, blockIdx.x);
    LAS float* scr = (LAS float*)(F.lds + RING_OFF + F.wave * 16384);
    const int gw = F.vcu * NWAVES + F.wave, NGW = F.G * NWAVES;
    constexpr int I_IN = (D / 64) * (PW / 32), I_OUT = (D / 64) * (D / 32);
    constexpr int NITEMS = I_IN + I_OUT;
    for (int it = gw; it < NITEMS; it += NGW) {
        int r = it;
        if (r < I_IN) { const int nb = PW / 32, kb = r / nb, n = r % nb; p0_transpose_item(F.in[5], PW, (bf16*)(F.ws + FW_WINT), D, 64 * kb, 32 * n, 32 * n, scr, F.lane); continue; } r -= I_IN;
        { const int nb = D / 32, kb = r / nb, n = r % nb; p0_transpose_item(F.in[25], D, (bf16*)(F.ws + FW_WOUTT), D, 64 * kb, 32 * n, 32 * n, scr, F.lane); }
    }
}
__device__ __forceinline__ void expert_transposes(Frame& F, int wv, int nwv) {
    LAS float* scr = (LAS float*)(F.lds + RING_OFF + F.wave * 16384);
    constexpr int I_E13 = NE * 2 * 256, I_E2 = NE * 256;
    for (int it = wv; it < I_E13 + I_E2; it += nwv) {
        int r = it;
        if (r < I_E13) {
            const int e = r >> 9, which = (r >> 8) & 1, q = r & 255, kb = q >> 4, n = q & 15, n0 = 32 * n;
            const float* W = (which ? F.in[32] : F.in[31]) + (size_t)e * D * DE;
            p0_transpose_item(W, DE, (bf16*)(F.ws + FW_W13T) + (size_t)e * 1024 * 1024, D, 64 * kb, n0, (n0 >> 7) * 256 + which * 128 + (n0 & 127), scr, F.lane); continue; } r -= I_E13;
        {
            const int e = r >> 8, q = r & 255, kb = q >> 5, n = q & 31;
            p0_transpose_item(F.in[33] + (size_t)e * DE * D, D, (bf16*)(F.ws + FW_W2T) + (size_t)e * 1024 * DE, DE, 64 * kb, 32 * n, 32 * n, scr, F.lane); }
    }
}

__device__ __forceinline__ void adaln_row(const float* xrow, const float* g, const float* sh, const float* sc, bf16* orow, int lane) {
    const f32x4* xr = (const f32x4*)xrow + lane;
    f32x4 v[4]; float s = 0.f;
#pragma unroll
    for (int j = 0; j < 4; ++j) { v[j] = xr[64 * j]; s += (v[j].x * v[j].x + v[j].y * v[j].y) + (v[j].z * v[j].z + v[j].w * v[j].w); }
    const float rinv = rsqrtf(wave_sum(s) * (1.f / D) + 1e-6f);
    v2u* o8 = (v2u*)orow + lane;
#pragma unroll
    for (int j = 0; j < 4; ++j) { const f32x4 gg = ((const f32x4*)g)[lane + 64 * j], s1 = ((const f32x4*)sc)[lane + 64 * j], s0 = ((const f32x4*)sh)[lane + 64 * j];
        f32x4 y = v[j] * rinv * gg; y = y * (s1 + 1.f) + s0;
        v2u w; w.x = pk2(y.x, y.y); w.y = pk2(y.z, y.w); o8[64 * j] = w; }
}
__device__ __forceinline__ void phase1(Frame& F) {
    const int gw = F.vcu * NWAVES + F.wave, NGW = F.G * NWAVES;
    const float* mod = (const float*)(F.ws + WS_MOD);
    for (int m = gw; m < NTOK; m += NGW) { const int b = m / T;
        adaln_row(F.in[0] + (size_t)m * D, F.in[4], mod + b * 6144, mod + b * 6144 + 1024, (bf16*)(F.ws + WS_H) + (size_t)m * D, F.lane); }
}
__device__ __forceinline__ void phase2(Frame& F) {
    pg8::Gemm g{(const bf16*)(F.ws + WS_H), (const bf16*)(F.ws + FW_WINT), D, D, D};
    pg8::DenseOrder S; S.init(NTOK, PW, F.G, (int)blockIdx.x);
    pg8::EpiBf16Store E{(bf16*)(F.ws + WS_P), PW};
    pg8::gemm_phase<pg8::EpiBf16Store, pg8::DenseOrder>(F.lds + RING_OFF, g, S, E, F.tid);
}


namespace pg8 {
struct EpiX1F {
    static constexpr bool PERM = true;
    const float* const* in; unsigned char* ws; float* out;
    __device__ __forceinline__ void operator()(const f32x4 (&acc)[2][2][4][2], const Unit& u, int wr, int wc, int fr, int fq) const {
        const float* mod = (const float*)(ws + WS_MOD); bf16_t* Y = (bf16_t*)(ws + WS_Y);
        const int row0 = u.pm * BM + wr * 64 + fr, col0 = u.pn * BM + wc * 32 + 8 * fq;
        const float* g1 = mod + ((u.pm * BM) / T) * 6144 + 2048;
        f32x4 gv[2][2];
#pragma unroll
        for (int bj = 0; bj < 2; ++bj)
#pragma unroll
            for (int n = 0; n < 2; ++n) gv[bj][n] = *(const f32x4*)(g1 + col0 + bj * HALF + n * 4);
#pragma unroll
        for (int ai = 0; ai < 2; ++ai)
#pragma unroll
            for (int m = 0; m < 4; ++m) { bf16_t* rowp = Y + (size_t)(row0 + ai * HALF + m * 16) * D + col0;
#pragma unroll
                for (int bj = 0; bj < 2; ++bj) { const f32x4 v0 = acc[ai][bj][m][0] * gv[bj][0], v1 = acc[ai][bj][m][1] * gv[bj][1];
                    u32x4 w; w.x = cvt_pk_bf16(v0[0], v0[1]); w.y = cvt_pk_bf16(v0[2], v0[3]); w.z = cvt_pk_bf16(v1[0], v1[1]); w.w = cvt_pk_bf16(v1[2], v1[3]);
                    *(u32x4*)(rowp + bj * HALF) = w; } }
    }
};
template <bool GATH> struct MoeOrder {
    static constexpr bool GATHER = GATH;
    const LAS int* ub; const LAS int* rb; const LAS int* cn; const int* list; int G, c, brows;
    __device__ bool next(int i, Unit& u) const {
        int e, local;
        if ((G & 7) == 0) {
            const int x = c & 7, L = i * (G >> 3) + (c >> 3); const LAS int* xb = ub + 98 + x * 5;
            if (L >= xb[4]) return false;
            int j = 0;
#pragma unroll
            for (int k = 2; k >= 1; k >>= 1) if (xb[j + k] <= L) j += k;
            e = x + 8 * j; local = L - xb[j];
        } else {
            const int L = i * G + c; if (L >= ub[32]) return false;
            e = 0;
#pragma unroll
            for (int k = 16; k >= 1; k >>= 1) if (ub[e + k] <= L) e += k;
            local = L - ub[e];
        }
        const int tiles = rb[e + 1] - rb[e], pn = local / tiles, mt = local - pn * tiles;
        u.e = e; u.pn = pn; u.pm = rb[e] + mt; u.row0 = e * NTOK + mt * 256; u.nrows = min(256, cn[e] - mt * 256); return true;
    }
    __device__ __forceinline__ const char* a_base(const Gemm& g, const Unit& u) const { return GATH ? (const char*)g.A : (const char*)g.A + (size_t)u.pm * (BM * 2) * g.lda; }
    __device__ __forceinline__ const char* b_base(const Gemm& g, const Unit& u) const { return (const char*)g.Bt + ((size_t)u.e * brows + (size_t)u.pn * BM) * 2 * g.ldb; }
    __device__ __forceinline__ int row(const Unit& u, int r) const { return r < u.nrows ? (list[u.row0 + r] >> 1) : 0; }
};
struct EpiSwiglu {
    static constexpr bool PERM = true;
    bf16_t* HID;
    __device__ __forceinline__ void operator()(const f32x4 (&acc)[2][2][4][2], const Unit& u, int wr, int wc, int fr, int fq) const {
        const int col0 = u.pn * HALF + wc * 32 + 8 * fq;
#pragma unroll
        for (int ai = 0; ai < 2; ++ai)
#pragma unroll
            for (int m = 0; m < 4; ++m) { const int r = ai * HALF + wr * 64 + m * 16 + fr;
                if (r < u.nrows) { float h[8];
#pragma unroll
                    for (int n = 0; n < 2; ++n)
#pragma unroll
                        for (int i = 0; i < 4; ++i) { const float a = acc[ai][0][m][n][i], b = acc[ai][1][m][n][i]; h[n * 4 + i] = a * frcp(1.f + fexp(-a)) * b; }
                    u32x4 w; w.x = cvt_pk_bf16(h[0], h[1]); w.y = cvt_pk_bf16(h[2], h[3]); w.z = cvt_pk_bf16(h[4], h[5]); w.w = cvt_pk_bf16(h[6], h[7]);
                    *(u32x4*)(HID + (size_t)(u.pm * BM + r) * DE + col0) = w; } }
    }
};
struct EpiYs {
    static constexpr bool PERM = true;
    unsigned char* ws;
    __device__ __forceinline__ void operator()(const f32x4 (&acc)[2][2][4][2], const Unit& u, int wr, int wc, int fr, int fq) const {
        bf16_t* YS = (bf16_t*)(ws + WS_YS); const int* list = (const int*)(ws + WS_LIST); const float* selw = (const float*)(ws + WS_SELW);
        const int col0 = u.pn * BM + wc * 32 + 8 * fq;
#pragma unroll
        for (int ai = 0; ai < 2; ++ai)
#pragma unroll
            for (int m = 0; m < 4; ++m) { const int r = ai * HALF + wr * 64 + m * 16 + fr;
                if (r < u.nrows) { const int li = list[u.row0 + r]; const float w8 = selw[u.row0 + r]; bf16_t* rowp = YS + (size_t)li * D + col0;
#pragma unroll
                    for (int bj = 0; bj < 2; ++bj) { const f32x4 v0 = acc[ai][bj][m][0] * w8, v1 = acc[ai][bj][m][1] * w8;
                        u32x4 w; w.x = cvt_pk_bf16(v0[0], v0[1]); w.y = cvt_pk_bf16(v0[2], v0[3]); w.z = cvt_pk_bf16(v1[0], v1[1]); w.w = cvt_pk_bf16(v1[2], v1[3]);
                        *(u32x4*)(rowp + bj * HALF) = w; } } }
    }
};
}

__device__ __forceinline__ void phase_outproj(Frame& F) {
    pg8::Gemm g{(const bf16*)(F.ws + WS_YMIX), (const bf16*)(F.ws + FW_WOUTT), D, D, D};
    pg8::DenseOrder S; S.init(NTOK, D, F.G, (int)blockIdx.x);
    pg8::EpiX1F E{F.in, F.ws, F.out};
    pg8::gemm_phase<pg8::EpiX1F, pg8::DenseOrder>(F.lds + RING_OFF, g, S, E, F.tid);
}

__device__ __forceinline__ void phase_route(Frame& F) {
    TSTAMP(F, 40);
    LAS float* wt = (LAS float*)F.lds;
    { const f32x4* WR = (const f32x4*)(F.ws + FW_WR); LAS f32x4* wt4 = (LAS f32x4*)F.lds;
      for (int i = F.tid; i < 36 * 256; i += 512) wt4[i] = WR[i]; }
    __syncthreads();
    const float* mod = (const float*)(F.ws + WS_MOD); const float* g2n = F.in[26];
    int* cnt = (int*)(F.ws + WS_CNT); int* list = (int*)(F.ws + WS_LIST); float* selw = (float*)(F.ws + WS_SELW);
    bf16* H2 = (bf16*)(F.ws + WS_H);
    const int gw = F.vcu * NWAVES + F.wave, NGW = F.G * NWAVES, lane = F.lane;
    LAS int* lcnt = (LAS int*)(F.lds + LDSCTL_OFF + 2048); LAS int* lbase = lcnt + 32; LAS int* tokres = lcnt + 64; LAS float* tokw = (LAS float*)(tokres + 256);
    if (F.tid < 32) lcnt[F.tid] = 0;
    __syncthreads();
    int it = 0;
    unsigned long long ta_[4] = {0, 0, 0, 0};
    TSTAMP(F, 41);
    const float* xin = F.in[0]; const bf16* Yb = (const bf16*)(F.ws + WS_Y);
    f32x4 vn[4]; v2u yn[4];
#pragma unroll
    for (int j = 0; j < 4; ++j) { vn[j] = ((const f32x4*)(xin + (size_t)gw * D) + lane)[64 * j]; yn[j] = ((const v2u*)(Yb + (size_t)gw * D) + lane)[64 * j]; }
    f32x4 ggr[4], s1r[4], s0r[4]; int bcur = -1;
#pragma unroll
    for (int j = 0; j < 4; ++j) ggr[j] = ((const f32x4*)g2n)[lane + 64 * j];
    for (int m = gw; m < NTOK; m += NGW, ++it) {
        const int b = m / T;
        if (b != bcur) { bcur = b;
#pragma unroll
            for (int j = 0; j < 4; ++j) { s1r[j] = ((const f32x4*)(mod + b * 6144 + 4096))[lane + 64 * j] + 1.f; s0r[j] = ((const f32x4*)(mod + b * 6144 + 3072))[lane + 64 * j]; } }
        const unsigned long long tr0 = TIMER_A >= 0 ? __builtin_amdgcn_s_memrealtime() : 0ull;
        f32x4 v[4]; float s = 0.f;
#pragma unroll
        for (int j = 0; j < 4; ++j) { v[j] = vn[j]; v[j].x += bflo(yn[j].x); v[j].y += bfhi(yn[j].x); v[j].z += bflo(yn[j].y); v[j].w += bfhi(yn[j].y);
            s += (v[j].x * v[j].x + v[j].y * v[j].y) + (v[j].z * v[j].z + v[j].w * v[j].w); }
        if (m + NGW < NTOK) {
#pragma unroll
            for (int j = 0; j < 4; ++j) { vn[j] = ((const f32x4*)(xin + (size_t)(m + NGW) * D) + lane)[64 * j]; yn[j] = ((const v2u*)(Yb + (size_t)(m + NGW) * D) + lane)[64 * j]; }
        }
        const float rinv = rsqrtf(wave_sum(s) * (1.f / D) + 1e-6f);
        v2u* o8 = (v2u*)(H2 + (size_t)m * D) + lane;
#pragma unroll
        for (int j = 0; j < 4; ++j) { f32x4 y = v[j] * rinv * ggr[j]; y = y * s1r[j] + s0r[j]; v[j] = y;
            v2u w; w.x = pk2(y.x, y.y); w.y = pk2(y.z, y.w); o8[64 * j] = w; }
        const unsigned long long tr1 = TIMER_A >= 0 ? __builtin_amdgcn_s_memrealtime() : 0ull;
        float pg[4] = {0.f, 0.f, 0.f, 0.f};
#pragma unroll
        for (int j = 0; j < 4; ++j)
#pragma unroll
            for (int e = 0; e < 4; ++e) { const f32x4 w = *(const LAS f32x4*)(wt + e * 1024 + lane * 4 + 256 * j); pg[e] += (v[j].x * w.x + v[j].y * w.y) + (v[j].z * w.z + v[j].w * w.w); }
        const f32x4 bg = *(const f32x4*)F.in[28];
        const float g0 = wave_sum(pg[0]) + bg.x, g1 = wave_sum(pg[1]) + bg.y, g2 = wave_sum(pg[2]) + bg.z, g3 = wave_sum(pg[3]) + bg.w;
        float gm = g0; int gi = 0;
        if (g1 > gm) { gm = g1; gi = 1; } if (g2 > gm) { gm = g2; gi = 2; } if (g3 > gm) { gm = g3; gi = 3; }
        const float gwt = frcp(fexp(g0 - gm) + fexp(g1 - gm) + fexp(g2 - gm) + fexp(g3 - gm));
        gi = __builtin_amdgcn_readfirstlane(gi);
        const unsigned long long tr2 = TIMER_A >= 0 ? __builtin_amdgcn_s_memrealtime() : 0ull;
        const LAS float* we = wt + (4 + gi * 8) * 1024 + lane * 4;
        const f32x4 be0 = *(const f32x4*)(F.in[30] + gi * 8), be1 = *(const f32x4*)(F.in[30] + gi * 8 + 4);
        float xe[8];
#pragma unroll
        for (int hf = 0; hf < 2; ++hf) { float pe[4] = {0.f, 0.f, 0.f, 0.f};
#pragma unroll
            for (int j = 0; j < 4; ++j)
#pragma unroll
                for (int e = 0; e < 4; ++e) { const f32x4 w = *(const LAS f32x4*)(we + (hf * 4 + e) * 1024 + 256 * j); pe[e] += (v[j].x * w.x + v[j].y * w.y) + (v[j].z * w.z + v[j].w * w.w); }
#pragma unroll
            for (int e = 0; e < 4; ++e) xe[hf * 4 + e] = wave_sum(pe[e]); }
        xe[0] += be0.x; xe[1] += be0.y; xe[2] += be0.z; xe[3] += be0.w; xe[4] += be1.x; xe[5] += be1.y; xe[6] += be1.z; xe[7] += be1.w;
        const unsigned long long tr3 = TIMER_A >= 0 ? __builtin_amdgcn_s_memrealtime() : 0ull;
        float v1 = xe[0], v2 = -3.4e38f; int i1 = 0, i2 = 0;
#pragma unroll
        for (int ii = 1; ii < 8; ++ii) { const float xx = xe[ii]; const bool a1 = xx > v1, a2 = xx > v2;
            v2 = a1 ? v1 : (a2 ? xx : v2); i2 = a1 ? i1 : (a2 ? ii : i2); v1 = a1 ? xx : v1; i1 = a1 ? ii : i1; }
        const float e2 = fexp(v2 - v1), w1 = frcp(1.f + e2), w2 = e2 * w1;
        if (lane == 0) { const int ea = gi * 8 + i1, eb = gi * 8 + i2;
            tokw[(F.wave * 16 + it) * 2] = w1 * gwt; tokw[(F.wave * 16 + it) * 2 + 1] = w2 * gwt;
            const int ra = atomicAdd((int*)&lcnt[ea], 1), rb2 = atomicAdd((int*)&lcnt[eb], 1);
            tokres[(F.wave * 16 + it) * 2] = ea | (ra << 8); tokres[(F.wave * 16 + it) * 2 + 1] = eb | (rb2 << 8); }
        if (TIMER_A >= 0) { const unsigned long long tr4 = __builtin_amdgcn_s_memrealtime(); ta_[0] += tr1 - tr0; ta_[1] += tr2 - tr1; ta_[2] += tr3 - tr2; ta_[3] += tr4 - tr3; }
    }
    if (TIMER_A >= 0 && blockIdx.x == 0 && threadIdx.x == 0) { for (int q = 0; q < 4; ++q) ((unsigned long long*)(F.ws + 8192))[45 + q] = ta_[q]; }
    TSTAMP(F, 42);
    __syncthreads();
    if (F.tid < 32) { const int c = lcnt[F.tid]; lbase[F.tid] = c ? atomicAdd(&cnt[F.tid * 64], c) : 0; }
    __syncthreads();
    if (lane < 16) { const int m = gw + lane * NGW;
        if (m < NTOK) { const int a = tokres[(F.wave * 16 + lane) * 2], b2 = tokres[(F.wave * 16 + lane) * 2 + 1];
            const int pa = (a & 255) * NTOK + lbase[a & 255] + (a >> 8), pb = (b2 & 255) * NTOK + lbase[b2 & 255] + (b2 >> 8);
            list[pa] = m * 2; list[pb] = m * 2 + 1; selw[pa] = tokw[(F.wave * 16 + lane) * 2]; selw[pb] = tokw[(F.wave * 16 + lane) * 2 + 1]; } }
    __syncthreads();
}

__device__ __forceinline__ void moe_tables(Frame& F, int npn) {
    LAS int* tab = (LAS int*)(F.lds + LDS_TAB_OFF);
    if (F.tid == 0) { const int* cnt = (const int*)(F.ws + WS_CNT); int ub = 0, rb = 0;
        for (int e = 0; e < 32; ++e) { const int c = __hip_atomic_load(cnt + e * 64, __ATOMIC_RELAXED, __HIP_MEMORY_SCOPE_AGENT); const int tl = (c + 255) >> 8; tab[e] = ub; tab[33 + e] = rb; tab[66 + e] = c; ub += tl * npn; rb += tl; }
        tab[32] = ub; tab[33 + 32] = rb;
        for (int x = 0; x < 8; ++x) { int s = 0; for (int j = 0; j < 4; ++j) { tab[98 + x * 5 + j] = s; s += tab[x + 8 * j + 1] - tab[x + 8 * j]; } tab[98 + x * 5 + 4] = s; } }
    __syncthreads();
}
__device__ __forceinline__ void phase_m1(Frame& F) {
    moe_tables(F, 4);
    const LAS int* tab = (const LAS int*)(F.lds + LDS_TAB_OFF);
    pg8::Gemm g{(const bf16*)(F.ws + WS_H), (const bf16*)(F.ws + FW_W13T), D, D, D};
    pg8::MoeOrder<true> S{tab, tab + 33, tab + 66, (const int*)(F.ws + WS_LIST), F.G, (int)blockIdx.x, 1024};
    pg8::EpiSwiglu E{(bf16*)(F.ws + WS_HID)};
    pg8::gemm_phase<pg8::EpiSwiglu, pg8::MoeOrder<true>>(F.lds + RING_OFF, g, S, E, F.tid);
}
__device__ __forceinline__ void phase_m2(Frame& F) {
    moe_tables(F, 4);
    const LAS int* tab = (const LAS int*)(F.lds + LDS_TAB_OFF);
    pg8::Gemm g{(const bf16*)(F.ws + WS_HID), (const bf16*)(F.ws + FW_W2T), DE, DE, DE};
    pg8::MoeOrder<false> S{tab, tab + 33, tab + 66, (const int*)(F.ws + WS_LIST), F.G, (int)blockIdx.x, 1024};
    pg8::EpiYs E{F.ws};
    pg8::gemm_phase<pg8::EpiYs, pg8::MoeOrder<false>>(F.lds + RING_OFF, g, S, E, F.tid);
}
__device__ __forceinline__ void phase_final(Frame& F, bool dry = false) {
    const int gw = F.vcu * NWAVES + F.wave, NGW = F.G * NWAVES, lane = F.lane;
    const float* mod = (const float*)(F.ws + WS_MOD); const float* fg = F.in[34]; const bf16* YS = (const bf16*)(F.ws + WS_YS);
    const float* xin = F.in[0]; const bf16* Yb = (const bf16*)(F.ws + WS_Y);
    for (int m = gw; m < NTOK; m += NGW) { const int b = m / T;
        f32x4* xr = (f32x4*)(F.out + (size_t)m * D) + lane; const f32x4* xi = (const f32x4*)(xin + (size_t)m * D) + lane; const v2u* yb = (const v2u*)(Yb + (size_t)m * D) + lane;
        const v2u* y0 = (const v2u*)(YS + (size_t)(2 * m) * D) + lane; const v2u* y1 = (const v2u*)(YS + (size_t)(2 * m + 1) * D) + lane;
        f32x4 v[4]; float s = 0.f;
#pragma unroll
        for (int j = 0; j < 4; ++j) { const v2u a = y0[64 * j], c = y1[64 * j], yy = yb[64 * j]; const f32x4 g2 = ((const f32x4*)(mod + b * 6144 + 5120))[lane + 64 * j];
            f32x4 mo; mo.x = bflo(a.x) + bflo(c.x); mo.y = bfhi(a.x) + bfhi(c.x); mo.z = bflo(a.y) + bflo(c.y); mo.w = bfhi(a.y) + bfhi(c.y);
            f32x4 x1 = xi[64 * j]; x1.x += bflo(yy.x); x1.y += bfhi(yy.x); x1.z += bflo(yy.y); x1.w += bfhi(yy.y);
            v[j] = x1 + g2 * mo; s += (v[j].x * v[j].x + v[j].y * v[j].y) + (v[j].z * v[j].z + v[j].w * v[j].w); }
        const float rinv = rsqrtf(wave_sum(s) * (1.f / D) + 1e-6f);
        float tdelta = 0.f;
        if (TIMER_A >= 0 && m == 0) { const unsigned long long* ts = (const unsigned long long*)(F.ws + 8192);
            const float us = (float)(TIMER_B == TIMER_A ? ts[TIMER_A] : ts[TIMER_B] - ts[TIMER_A]) * 0.01f; tdelta = sqrtf(32768.f * us * 1e-6f); }
#pragma unroll
        for (int j = 0; j < 4; ++j) xr[64 * j] = v[j] * rinv * ((const f32x4*)fg)[lane + 64 * j] + tdelta;
    }
}
#define XB_TMO      128
#define XB_XCNT(j)  (256  + 64 * (j))
#define XB_XSUB(j)  (1280 + 64 * (j))
#define XB_XGEN(j)  (2304 + 64 * (j))
#define XB_TOP      3328
#define XB_TOPGEN   3392
#define XCD_BAR_WORDS 3456
#define XB_SPIN_CAP (1u << 18)

__device__ __forceinline__ unsigned xb_ld(unsigned* p)              { return __hip_atomic_load(p, __ATOMIC_RELAXED, __HIP_MEMORY_SCOPE_AGENT); }
__device__ __forceinline__ unsigned xb_add(unsigned* p, unsigned v) { return __hip_atomic_fetch_add(p, v, __ATOMIC_RELAXED, __HIP_MEMORY_SCOPE_AGENT); }
__device__ __forceinline__ unsigned xb_xcc_id() { return (unsigned)__builtin_amdgcn_s_getreg((3 << 11) | 20) & 0xFu; }
#define XB_SPIN(cond, bar) do { unsigned _sp = 0; while (cond) { __builtin_amdgcn_s_sleep(1); \
    if ((++_sp & 255u) == 0u) { if (xb_ld(&(bar)[XB_TMO])) break; if (_sp > XB_SPIN_CAP) { atomicAdd(&(bar)[XB_TMO], 1u); break; } } } } while (0)

struct XcdBarrier {
    unsigned* bar; unsigned x;
    volatile LAS unsigned* st;
};

__device__ __forceinline__ XcdBarrier xcd_barrier_post(unsigned* bar, volatile LAS unsigned* st) {
    XcdBarrier b; b.bar = bar; b.x = xb_xcc_id(); b.st = st;
    if (threadIdx.x == 0) (void)xb_add(&bar[XB_XCNT(b.x)], 1u);
    return b;
}
__device__ __forceinline__ void xcd_barrier_complete(unsigned* bar, unsigned x, unsigned& nloc, unsigned& nx) {
    const unsigned G = gridDim.x * gridDim.y * gridDim.z;
    unsigned sum, cnt, mine, sp = 0u;
    for (;;) {
        sum = 0u; cnt = 0u; mine = 0u;
#pragma unroll
        for (unsigned j = 0; j < 16; ++j) { const unsigned c = xb_ld(&bar[XB_XCNT(j)]); sum += c; cnt += (c > 0u) ? 1u : 0u; mine = (j == x) ? c : mine; }
        if (sum == G) break;
        __builtin_amdgcn_s_sleep(1);
        if ((++sp & 255u) == 0u) { if (xb_ld(&bar[XB_TMO])) break; if (sp > XB_SPIN_CAP) { atomicAdd(&bar[XB_TMO], 1u); break; } }
    }
    nloc = mine > 0u ? mine : 1u; nx = cnt > 0u ? cnt : 1u;
}

__device__ __forceinline__ void xcd_barrier(const XcdBarrier& b) {
    asm volatile("s_waitcnt vmcnt(0)" ::: "memory");
    __syncthreads();
    if (threadIdx.x == 0) {
        unsigned* bar = b.bar;
        __builtin_amdgcn_s_waitcnt(0);
        unsigned nloc = b.st[0], nx = b.st[1];
        if (nloc == 0u) { xcd_barrier_complete(bar, b.x, nloc, nx); b.st[0] = nloc; b.st[1] = nx; }
        const unsigned old = xb_add(&bar[XB_XSUB(b.x)], 1u);
        const unsigned gen = old / nloc;
        if (old + 1u == (gen + 1u) * nloc) {
            __builtin_amdgcn_fence(__ATOMIC_RELEASE, "agent");
            asm volatile("s_waitcnt vmcnt(0)" ::: "memory");
            const unsigned og = xb_add(&bar[XB_TOP], 1u);
            const unsigned tg = og / nx;
            if (og + 1u == (tg + 1u) * nx) xb_add(&bar[XB_TOPGEN], 1u);
            else XB_SPIN(xb_ld(&bar[XB_TOPGEN]) == tg, bar);
            __builtin_amdgcn_fence(__ATOMIC_ACQUIRE, "agent");
            xb_add(&bar[XB_XGEN(b.x)], 1u);
            asm volatile("s_waitcnt vmcnt(0)" ::: "memory");
        } else {
            XB_SPIN(xb_ld(&bar[XB_XGEN(b.x)]) == gen, bar);
            __builtin_amdgcn_fence(__ATOMIC_ACQUIRE, "agent");
            asm volatile("s_waitcnt vmcnt(0)" ::: "memory");
        }
    }
    __syncthreads();
}


constexpr size_t WS_XC = WS_H;
constexpr size_t WS_ALORA = WS_H + 32 * MiB;
constexpr size_t WS_LOGA = 256 * MiB;
constexpr size_t WS_OLOC = 320 * MiB;
constexpr size_t WS_QHAT = 352 * MiB;
constexpr size_t WS_GG = 384 * MiB;
constexpr size_t WS_SB = 12 * MiB;
constexpr size_t WS_LRUA = 13 * MiB;
constexpr size_t WS_LRUB = 14 * MiB;
constexpr size_t WS_LRUH = 15 * MiB;
constexpr size_t DO_LWA = 0;
constexpr size_t DO_PC = 64 * MiB;
constexpr size_t DO_QCT = 96 * MiB;
constexpr size_t DO_HIN = 0;


__device__ __forceinline__ void phase_prepA(Frame& F) {
    const int gw = F.vcu * NWAVES + F.wave, NGW = F.G * NWAVES, lane = F.lane;
    const bf16* P = (const bf16*)(F.ws + WS_P);
    bf16* XC = (bf16*)(F.ws + WS_XC); bf16* AL = (bf16*)(F.ws + WS_ALORA);
    const float* conv_w = F.in[6]; const float* conv_b = F.in[7]; const float* mu = F.in[14];
    float cw[4][8], cb[8];
#pragma unroll
    for (int i = 0; i < 8; ++i) { cb[i] = conv_b[8 * lane + i];
#pragma unroll
        for (int j = 0; j < 4; ++j) cw[j][i] = conv_w[j * 512 + 8 * lane + i]; }
    float mu4[4];
#pragma unroll
    for (int i = 0; i < 4; ++i) mu4[i] = mu[(C_WD - 1024) + 4 * lane + i];
    for (int task = gw; task < NTOK / 16; task += NGW) {
        const int m0 = task * 16, t0 = m0 % T;
        float x1[8], x2[8], x3[8], pl[4];
#pragma unroll
        for (int i = 0; i < 8; ++i) { x1[i] = 0.f; x2[i] = 0.f; x3[i] = 0.f; }
#pragma unroll
        for (int i = 0; i < 4; ++i) pl[i] = 0.f;
        if (t0 > 0) {
            const v4u a = *(const v4u*)(P + (size_t)(m0 - 1) * PW + 8 * lane), b = *(const v4u*)(P + (size_t)(m0 - 2) * PW + 8 * lane), c = *(const v4u*)(P + (size_t)(m0 - 3) * PW + 8 * lane);
            x1[0] = bflo(a.x); x1[1] = bfhi(a.x); x1[2] = bflo(a.y); x1[3] = bfhi(a.y); x1[4] = bflo(a.z); x1[5] = bfhi(a.z); x1[6] = bflo(a.w); x1[7] = bfhi(a.w);
            x2[0] = bflo(b.x); x2[1] = bfhi(b.x); x2[2] = bflo(b.y); x2[3] = bfhi(b.y); x2[4] = bflo(b.z); x2[5] = bfhi(b.z); x2[6] = bflo(b.w); x2[7] = bfhi(b.w);
            x3[0] = bflo(c.x); x3[1] = bfhi(c.x); x3[2] = bflo(c.y); x3[3] = bfhi(c.y); x3[4] = bflo(c.z); x3[5] = bfhi(c.z); x3[6] = bflo(c.w); x3[7] = bfhi(c.w);
            const v2u q = *(const v2u*)(P + (size_t)(m0 - 1) * PW + C_WD + 4 * lane);
            pl[0] = bflo(q.x); pl[1] = bfhi(q.x); pl[2] = bflo(q.y); pl[3] = bfhi(q.y);
        }
#pragma unroll 4
        for (int tt = 0; tt < 16; ++tt) {
            const size_t m = (size_t)(m0 + tt);
            const v4u a = *(const v4u*)(P + m * PW + 8 * lane);
            float x0[8] = {bflo(a.x), bfhi(a.x), bflo(a.y), bfhi(a.y), bflo(a.z), bfhi(a.z), bflo(a.w), bfhi(a.w)};
            float xc[8];
#pragma unroll
            for (int i = 0; i < 8; ++i) { xc[i] = x3[i] * cw[0][i] + x2[i] * cw[1][i] + x1[i] * cw[2][i] + x0[i] * cw[3][i] + cb[i]; x3[i] = x2[i]; x2[i] = x1[i]; x1[i] = x0[i]; }
            v4u o; o.x = pk2(xc[0], xc[1]); o.y = pk2(xc[2], xc[3]); o.z = pk2(xc[4], xc[5]); o.w = pk2(xc[6], xc[7]);
            *(v4u*)(XC + m * 512 + 8 * lane) = o;
            const v2u q = *(const v2u*)(P + m * PW + C_WD + 4 * lane);
            const float cl[4] = {bflo(q.x), bfhi(q.x), bflo(q.y), bfhi(q.y)};
            float al[4];
#pragma unroll
            for (int i = 0; i < 4; ++i) { const float u = cl[i] + (pl[i] - cl[i]) * mu4[i]; pl[i] = cl[i];
                al[i] = (lane < 16) ? ftanh(u) : ((lane < 32) ? u : sigmoidf_(u)); }
            v2u o2; o2.x = pk2(al[0], al[1]); o2.y = pk2(al[2], al[3]);
            *(v2u*)(AL + m * 256 + 4 * lane) = o2;
        }
    }
}
__device__ __forceinline__ void p0_small_weights(Frame& F) {
    const int gt = F.vcu * NWAVES * 64 + F.tid, NT = F.G * NWAVES * 64;
    bf16* WG = (bf16*)(F.ws + FW_WGT); bf16* WL = (bf16*)(F.ws + FW_WLORAT);
    const float* wa = F.in[8]; const float* wi = F.in[10]; const float* w_up = F.in[16]; const float* a_up = F.in[18]; const float* g_up = F.in[19];
    for (int i = gt; i < 4 * 256 * 128; i += NT) { const int kk = i & 127, r = (i >> 7) & 255, pn = i >> 15;
        const int gate = r >> 7, ch = 128 * pn + (r & 127), hh = ch >> 6, j = ch & 63, kin = 128 * pn + kk;
        float v = 0.f; if ((kin >> 6) == hh) v = (gate ? wi : wa)[hh * 4096 + (kin & 63) * 64 + j];
        WG[i] = f2bf(v); }
    { float* WR = (float*)(F.ws + FW_WR); const float* w_grp = F.in[27]; const float* w_exp = F.in[29];
      for (int i = gt; i < 36 * 1024; i += NT) { const int k = i & 1023, e = i >> 10; WR[i] = e < 4 ? w_grp[k * 4 + e] : w_exp[k * 32 + (e - 4)]; } }
    for (int i = gt; i < 1536 * 128; i += NT) { const int kk = i & 127, n = i >> 7; float v = 0.f;
        if (n < 512) { if (kk < 64) v = w_up[kk * 512 + n]; }
        else if (n < 1024) { if (kk >= 64) v = a_up[(kk - 64) * 512 + n - 512]; }
        else v = g_up[kk * 512 + n - 1024];
        WL[i] = f2bf(v); }
}

namespace pg8 {
struct GateOrder : DenseOrder {
    __device__ __forceinline__ const char* a_base(const Gemm& g, const Unit& u) const { return (const char*)g.A + (size_t)u.pm * (BM * 2) * g.lda + (size_t)u.pn * 256; }
};
struct LoraOrder : DenseOrder {
    __device__ __forceinline__ const char* a_base(const Gemm& g, const Unit& u) const { return (const char*)g.A + (size_t)u.pm * (BM * 2) * g.lda + (u.pn >= 4 ? 256 : 0); }
};
struct EpiLruGate {
    static constexpr bool PERM = true;
    unsigned char* ws;
    __device__ __forceinline__ void operator()(const f32x4 (&acc)[2][2][4][2], const Unit& u, int wr, int wc, int fr, int fq) const {
        bf16_t* G = (bf16_t*)(ws + WS_LOGA);
        const int row0 = u.pm * BM + wr * 64 + fr, col0 = u.pn * HALF + wc * 32 + 8 * fq;
#pragma unroll
        for (int ai = 0; ai < 2; ++ai)
#pragma unroll
            for (int m = 0; m < 4; ++m) { bf16_t* rowp = G + (size_t)(row0 + ai * HALF + m * 16) * 1024 + col0;
#pragma unroll
                for (int bj = 0; bj < 2; ++bj) { const f32x4 v0 = acc[ai][bj][m][0], v1 = acc[ai][bj][m][1];
                    u32x4 w; w.x = cvt_pk_bf16(v0[0], v0[1]); w.y = cvt_pk_bf16(v0[2], v0[3]); w.z = cvt_pk_bf16(v1[0], v1[1]); w.w = cvt_pk_bf16(v1[2], v1[3]);
                    *(u32x4*)(rowp + bj * 512) = w; } }
    }
};
struct EpiLoraStore {
    static constexpr bool PERM = true;
    unsigned char* out; unsigned char* ws;
    __device__ __forceinline__ void operator()(const f32x4 (&acc)[2][2][4][2], const Unit& u, int wr, int wc, int fr, int fq) const {
        const int row0 = u.pm * BM + wr * 64 + fr;
        bf16_t* LWA = (bf16_t*)(out + DO_LWA); bf16_t* GG = (bf16_t*)(ws + WS_GG);
        bf16_t* base = u.pn < 4 ? LWA : GG; const int ldc = u.pn < 4 ? 1024 : 512; const int col0 = (u.pn < 4 ? u.pn : u.pn - 4) * BM + wc * 32 + 8 * fq;
#pragma unroll
        for (int ai = 0; ai < 2; ++ai)
#pragma unroll
            for (int m = 0; m < 4; ++m) { bf16_t* rowp = base + (size_t)(row0 + ai * HALF + m * 16) * ldc + col0;
#pragma unroll
                for (int bj = 0; bj < 2; ++bj) { const f32x4 v0 = acc[ai][bj][m][0], v1 = acc[ai][bj][m][1];
                    u32x4 w; w.x = cvt_pk_bf16(v0[0], v0[1]); w.y = cvt_pk_bf16(v0[2], v0[3]); w.z = cvt_pk_bf16(v1[0], v1[1]); w.w = cvt_pk_bf16(v1[2], v1[3]);
                    *(u32x4*)(rowp + bj * HALF) = w; } }
    }
};
}
__device__ __forceinline__ void phase_gategemm(Frame& F) {
    {
        pg8::Gemm g{(const bf16*)(F.ws + WS_XC), (const bf16*)(F.ws + FW_WGT), 512, 128, 128};
        pg8::GateOrder S; S.init(NTOK, 1024, F.G, (int)blockIdx.x);
        pg8::EpiLruGate E{F.ws};
        pg8::gemm_phase<pg8::EpiLruGate, pg8::GateOrder>(F.lds + RING_OFF, g, S, E, F.tid);
    }
}
__device__ __forceinline__ void phase_loragemm(Frame& F) {
    {
        pg8::Gemm g{(const bf16*)(F.ws + WS_ALORA), (const bf16*)(F.ws + FW_WLORAT), 256, 128, 128};
        pg8::LoraOrder S; S.init(NTOK, 1536, F.G, (int)blockIdx.x);
        pg8::EpiLoraStore E{(unsigned char*)F.out, F.ws};
        pg8::gemm_phase<pg8::EpiLoraStore, pg8::LoraOrder>(F.lds + RING_OFF, g, S, E, F.tid);
    }
}

typedef float f32x2 __attribute__((ext_vector_type(2)));
__device__ __forceinline__ void rwkv_prepass_unit(Frame& F, int unit, LAS float* wl) {
    int lane = F.lane; asm volatile("" : "+v"(lane));
    const int c = unit & 127, bh = unit >> 7, h = bh & 7, b = bh >> 3, ch = h * 64 + lane;
    const size_t m0 = (size_t)b * T + (size_t)c * 64;
    const bf16* P = (const bf16*)(F.ws + WS_P); const bf16* LWA = (const bf16*)((const unsigned char*)F.out + DO_LWA);
    bf16* OLOC = (bf16*)(F.ws + WS_OLOC); bf16* QHAT = (bf16*)(F.ws + WS_QHAT); float* SB = (float*)(F.ws + WS_SB);
    const float* mu = F.in[14];
    const float mu_r = mu[ch], mu_k = mu[512 + ch], mu_v = mu[1024 + ch];
    const float w0v = F.in[15][ch], a0v = F.in[17][ch], kkv = F.in[20][ch], kav = F.in[21][ch], rkv = F.in[22][ch];
    f32x2 S[64];
#pragma unroll
    for (int k = 0; k < 64; ++k) { S[k].x = (k == lane) ? 1.f : 0.f; S[k].y = 0.f; }
    float pr = 0.f, pk = 0.f, pv = 0.f;
    if (c > 0) { const bf16* row = P + (m0 - 1) * PW; pr = bf2f(row[C_R + ch]); pk = bf2f(row[C_K + ch]); pv = bf2f(row[C_V + ch]); }
#pragma unroll 1
    for (int s8 = 0; s8 < 8; ++s8) {
#pragma unroll 2
        for (int tt = 0; tt < 8; ++tt) {
            const size_t m = m0 + s8 * 8 + tt; const bf16* row = P + m * PW;
            const float cr = bf2f(row[C_R + ch]), ck = bf2f(row[C_K + ch]), cv = bf2f(row[C_V + ch]);
            const float lw = bf2f(LWA[m * 1024 + ch]), la = bf2f(LWA[m * 1024 + 512 + ch]);
            const float r = cr + (pr - cr) * mu_r, kx = ck + (pk - ck) * mu_k, v = cv + (pv - cv) * mu_v;
            pr = cr; pk = ck; pv = cv;
            const float w = -__logf(1.f + __expf(-(w0v + lw))) - 0.5f;
            const float decay = __expf(-__expf(w));
            const float a = 1.f / (1.f + __expf(-(a0v + la)));
            float kk = kx * kkv;
            const float nrm = sqrtf(wave_sum(kk * kk));
            kk = kk / fmaxf(nrm, 1e-12f);
            const float km = kx * (1.f + (a - 1.f) * kav);
            const float sbv = wave_sum(r * km * rkv);
            if (lane == 0) SB[m * 8 + h] = sbv;
            LAS float* q = wl + tt * 384;
            q[lane] = -kk; q[64 + lane] = kk * a; q[128 + lane] = decay; q[192 + lane] = km; q[256 + lane] = r; q[320 + lane] = v;
        }
        LDS_WAIT(); asm volatile("" ::: "memory");
#pragma unroll 1
        for (int tt = 0; tt < 8; ++tt) {
            const LAS float* q = wl + tt * 384;
            const LAS f32x4* q4 = (const LAS f32x4*)q;
            f32x2 sa0 = {0.f, 0.f}, sa1 = {0.f, 0.f}, sa2 = {0.f, 0.f}, sa3 = {0.f, 0.f};
            f32x4 ca[4], na[4];
#pragma unroll
            for (int i = 0; i < 4; ++i) ca[i] = q4[i];
            f32x4 c0[4], c1[4];
#pragma unroll
            for (int g = 0; g < 4; ++g) {
                if (g < 3) {
#pragma unroll
                    for (int i = 0; i < 4; ++i) na[i] = q4[4 * (g + 1) + i];
                } else {
#pragma unroll
                    for (int i = 0; i < 4; ++i) { c0[i] = q4[16 * (i + 1)]; c1[i] = q4[16 * (i + 1) + 1]; }
                }
#pragma unroll
                for (int i = 0; i < 4; ++i) { const int kb = 4 * g + i; const f32x4 al = ca[i];
                    sa0 += S[4 * kb] * al.x; sa1 += S[4 * kb + 1] * al.y; sa2 += S[4 * kb + 2] * al.z; sa3 += S[4 * kb + 3] * al.w; }
                if (g < 3) {
#pragma unroll
                    for (int i = 0; i < 4; ++i) ca[i] = na[i];
                }
            }
            const f32x2 sa = (sa0 + sa1) + (sa2 + sa3);
            f32x2 vv; vv.x = 0.f; vv.y = q[320 + lane];
            f32x2 o0 = {0.f, 0.f}, o1 = {0.f, 0.f}, o2 = {0.f, 0.f}, o3 = {0.f, 0.f};
#pragma unroll
            for (int kb = 0; kb < 16; ++kb) {
                f32x4 n2[4];
                if (kb + 2 < 16) {
#pragma unroll
                    for (int i = 0; i < 4; ++i) n2[i] = q4[16 * (i + 1) + kb + 2];
                }
                const f32x4 be = c0[0], w = c0[1], km = c0[2], rr = c0[3];
                S[4 * kb] = S[4 * kb] * w.x + (sa * be.x + vv * km.x); o0 += S[4 * kb] * rr.x;
                S[4 * kb + 1] = S[4 * kb + 1] * w.y + (sa * be.y + vv * km.y); o1 += S[4 * kb + 1] * rr.y;
                S[4 * kb + 2] = S[4 * kb + 2] * w.z + (sa * be.z + vv * km.z); o2 += S[4 * kb + 2] * rr.z;
                S[4 * kb + 3] = S[4 * kb + 3] * w.w + (sa * be.w + vv * km.w); o3 += S[4 * kb + 3] * rr.w;
#pragma unroll
                for (int i = 0; i < 4; ++i) { c0[i] = c1[i]; if (kb + 2 < 16) c1[i] = n2[i]; }
            }
            const f32x2 o = (o0 + o1) + (o2 + o3);
            const size_t m = m0 + s8 * 8 + tt;
            QHAT[m * 512 + ch] = f2bf(o.x); OLOC[m * 512 + ch] = f2bf(o.y);
        }
        LDS_WAIT(); asm volatile("" ::: "memory");
    }
    int lane2 = lane; asm volatile("" : "+v"(lane2) :: "memory");
    bf16* PC = (bf16*)((unsigned char*)F.out + DO_PC) + (size_t)unit * 4096 + lane2; bf16* QCT = (bf16*)((unsigned char*)F.out + DO_QCT) + (size_t)unit * 4096 + lane2 * 64;
#pragma unroll
    for (int k = 0; k < 64; ++k) PC[k * 64] = f2bf(S[k].x);
#pragma unroll
    for (int k = 0; k < 64; k += 8) { v4u o; o.x = pk2(S[k].y, S[k + 1].y); o.y = pk2(S[k + 2].y, S[k + 3].y); o.z = pk2(S[k + 4].y, S[k + 5].y); o.w = pk2(S[k + 6].y, S[k + 7].y);
        *(v4u*)(QCT + k) = o; }
}
__device__ __forceinline__ void phase_lrulocal(Frame& F, bool dry = false) {
    const int gw = F.vcu * NWAVES + F.wave, NGW = F.G * NWAVES, lane = F.lane;
    {
        const bf16* GT = (const bf16*)(F.ws + WS_LOGA); bf16* GO = dry ? (bf16*)(F.ws + WS_OLOC) : (bf16*)(F.ws + WS_LOGA); const bf16* XC = (const bf16*)(F.ws + WS_XC);
        float* LA = (float*)(F.ws + WS_LRUA); float* LB = (float*)(F.ws + WS_LRUB);
        for (int task = gw; task < 4 * 128 * 8; task += NGW) { const int cg = task & 7, bc = task >> 3, ch = cg * 64 + lane;
            const float bav = F.in[9][ch], biv = F.in[11][ch], sp = -8.f * softplusf_(-F.in[12][ch]);
            const size_t m0 = (size_t)bc * 64; float sl = 0.f, hl = 0.f;
#pragma unroll 1
            for (int t8 = 0; t8 < 64; t8 += 8) {
                bf16 g0[8], g1[8], x8[8];
#pragma unroll
                for (int u = 0; u < 8; ++u) { const size_t m = m0 + t8 + u; g0[u] = GT[m * 1024 + ch]; g1[u] = GT[m * 1024 + 512 + ch]; x8[u] = XC[m * 512 + ch]; }
#pragma unroll
                for (int u = 0; u < 8; ++u) { const size_t m = m0 + t8 + u;
                    const float ra = bf2f(g0[u]) + bav, ia = bf2f(g1[u]) + biv, xc = bf2f(x8[u]);
                    const float r = sigmoidf_(ra), ig = sigmoidf_(ia);
                    const bf16 lab = f2bf(r * sp); const float la = bf2f(lab);
                    const bf16 bbb = f2bf(__builtin_amdgcn_sqrtf(fmaxf(1.f - fexp(2.f * la), 0.f)) * (ig * xc)); const float bb = bf2f(bbb);
                    GO[m * 1024 + ch] = lab; GO[m * 1024 + 512 + ch] = bbb;
                    sl += la; hl = fexp(la) * hl + bb; }
            }
            LA[bc * 512 + ch] = sl; LB[bc * 512 + ch] = hl; }
    }
}
__device__ __forceinline__ void phase_rwkvlocal(Frame& F) {
    const int gw = F.vcu * NWAVES + F.wave, NGW = F.G * NWAVES;
    {
        LAS float* wl = (LAS float*)(F.lds + RING_OFF + F.wave * 12288);
        for (int unit = gw; unit < 4096; unit += NGW) rwkv_prepass_unit(F, unit, wl);
    }
}

typedef short bf16x8_t __attribute__((ext_vector_type(8)));
typedef float f32x16 __attribute__((ext_vector_type(16)));
typedef __bf16 bf16x2n_t __attribute__((ext_vector_type(2)));
typedef float f32x2c_t __attribute__((ext_vector_type(2)));
__device__ __forceinline__ unsigned pkbf(float a, float b) { f32x2c_t v = {a, b}; bf16x2n_t r = __builtin_convertvector(v, bf16x2n_t); return __builtin_bit_cast(unsigned, r); }
__device__ __forceinline__ bf16 bf1(float a) { return (bf16)(pkbf(a, 0.f) & 0xffffu); }
constexpr int U_AT = 0, U_RT = 4096, U_BT = 8192, U_KT = 12288, U_BH = 16384, U_KH = 20480, U_VT = 24576, U_LM = 28672, U_G31 = 32768, UNIT_LDS = 33024;
__device__ __forceinline__ int a64(int row, int col) { return row * 128 + (((col >> 3) ^ (row & 7)) << 4) + ((col & 7) << 1); }
__device__ __forceinline__ int a32(int row, int col) { return row * 64 + (((col >> 2) ^ ((row >> 2) & 7)) << 3) + ((col & 3) << 1); }
__device__ __forceinline__ int crow_(int i, int h) { return (i & 3) + 8 * (i >> 2) + 4 * h; }
#define MFMA32(a, b, c) __builtin_amdgcn_mfma_f32_32x32x16_bf16((a), (b), (c), 0, 0, 0)
__device__ __forceinline__ bf16x8_t pack8(const f32x16& x, int s) {
    v4u p; p.x = pkbf(x[8 * s], x[8 * s + 1]); p.y = pkbf(x[8 * s + 2], x[8 * s + 3]); p.z = pkbf(x[8 * s + 4], x[8 * s + 5]); p.w = pkbf(x[8 * s + 6], x[8 * s + 7]);
    return __builtin_bit_cast(bf16x8_t, p); }
__device__ __forceinline__ bf16x8_t ld2x8(const LAS unsigned char* p0, const LAS unsigned char* p1) {
    const v2u lo = *(const LAS v2u*)p0, hi = *(const LAS v2u*)p1; v4u p; p.x = lo.x; p.y = lo.y; p.z = hi.x; p.w = hi.y; return __builtin_bit_cast(bf16x8_t, p); }

__device__ __forceinline__ void phase_rwkvlocal_mfma(Frame& F) {
    int lane = F.lane; asm volatile("" : "+v"(lane));
    const int wave = F.wave, u4 = wave >> 1, wh = wave & 1;
    LAS unsigned char* ub = F.lds + RING_OFF + u4 * UNIT_LDS;
    const bf16* P = (const bf16*)(F.ws + WS_P); const bf16* LWA = (const bf16*)((const unsigned char*)F.out + DO_LWA);
    bf16* OLOC = (bf16*)(F.ws + WS_OLOC); bf16* QHAT = (bf16*)(F.ws + WS_QHAT); float* SB = (float*)(F.ws + WS_SB);
    const float* mu = F.in[14];
    unsigned long long tacc_p = 0, tacc_c = 0;
#pragma unroll 1
    for (int ui = F.vcu; ui < 256; ui += F.G) {
        const int unit = ui * 4 + u4, c = unit & 31, bhd = unit >> 5, hd = bhd & 7, b = bhd >> 3;
        const size_t m0 = (size_t)b * T + (size_t)c * 256;
        f32x16 S[2][2];
        { int r = lane & 31, h = lane >> 5; asm volatile("" : "+v"(r), "+v"(h));
#pragma unroll
        for (int jt = 0; jt < 2; ++jt)
#pragma unroll
            for (int kt = 0; kt < 2; ++kt)
#pragma unroll
                for (int i = 0; i < 16; ++i) S[jt][kt][i] = (wh == 0 && jt == kt && crow_(i, h) == r) ? 1.f : 0.f;
        }
#pragma unroll 1
        for (int sc = 0; sc < 8; ++sc) {
            const size_t ms = m0 + 32 * sc;
            const unsigned long long tp0 = TIMER_A >= 0 ? __builtin_amdgcn_s_memrealtime() : 0ull;
            {
                int lanep = lane; asm volatile("" : "+v"(lanep));
                const int ch = hd * 64 + lanep;
                const float mu_r = mu[ch], mu_k = mu[512 + ch], mu_v = mu[1024 + ch];
                const float w0v = F.in[15][ch], a0v = F.in[17][ch], kkv = F.in[20][ch], kav = F.in[21][ch], rkv = F.in[22][ch];
                const size_t mb = ms + 16 * wh;
                bf16 qr[16], qk[16], qv[16], qw[16], qa[16], lw16[16], p3[3] = {0, 0, 0};
                if ((mb % T) != 0) { const bf16* row = P + (mb - 1) * PW; p3[0] = row[C_R + ch]; p3[1] = row[C_K + ch]; p3[2] = row[C_V + ch]; }
#pragma unroll
                for (int u = 0; u < 16; ++u) { const size_t m = mb + u; const bf16* row = P + m * PW;
                    qr[u] = row[C_R + ch]; qk[u] = row[C_K + ch]; qv[u] = row[C_V + ch]; qw[u] = LWA[m * 1024 + ch]; qa[u] = LWA[m * 1024 + 512 + ch]; }
                if (wh) {
#pragma unroll
                    for (int t = 0; t < 16; ++t) lw16[t] = LWA[(ms + t) * 1024 + ch];
                }
                float cc = 0.f;
                if (wh) {
#pragma unroll
                    for (int t = 0; t < 16; ++t) { const float w = -flog(1.f + fexp(-(w0v + bf2f(lw16[t])))) - 0.5f; cc -= fexp(w); }
                }
                float pr = bf2f(p3[0]), pk = bf2f(p3[1]), pv = bf2f(p3[2]);
                float sbkeep = 0.f, gprev = fexp(cc);
                {
                    constexpr int t8 = 0;
#pragma unroll
                    for (int u = 0; u < 16; ++u) {
                        const int tt = t8 + u, t = 16 * wh + tt;
                        const float cr = bf2f(qr[u]), ck = bf2f(qk[u]), cv = bf2f(qv[u]);
                        const float lw = bf2f(qw[u]), la = bf2f(qa[u]);
                        const float rr = cr + (pr - cr) * mu_r, kx = ck + (pk - ck) * mu_k, v = cv + (pv - cv) * mu_v;
                        pr = cr; pk = ck; pv = cv;
                        const float w = -flog(1.f + fexp(-(w0v + lw))) - 0.5f;
                        cc -= fexp(w);
                        const float a = frcp(1.f + fexp(-(a0v + la)));
                        float kk = kx * kkv;
                        const float nrm = __builtin_amdgcn_sqrtf(wave_sum(kk * kk));
                        kk = kk * __builtin_amdgcn_rcpf(fmaxf(nrm, 1e-12f));
                        const float km = kx * (1.f + (a - 1.f) * kav);
                        const float sbv = wave_sum(rr * km * rkv);
                        if (lanep == tt) sbkeep = sbv;
                        const float gp = gprev, g = fexp(cc), ig = frcp(g);
                        gprev = g;
                        const float be = kk * a;
                        *(LAS bf16*)(ub + U_AT + a64(t, lanep)) = bf1(-kk * gp);
                        *(LAS bf16*)(ub + U_RT + a64(t, lanep)) = bf1(rr * g);
                        *(LAS bf16*)(ub + U_BT + a64(t, lanep)) = bf1(be * ig);
                        *(LAS bf16*)(ub + U_KT + a64(t, lanep)) = bf1(km * ig);
                        *(LAS bf16*)(ub + U_BH + a32(lanep, t)) = bf1(be * ig);
                        *(LAS bf16*)(ub + U_KH + a32(lanep, t)) = bf1(km * ig);
                        *(LAS bf16*)(ub + U_VT + a32(lanep, t)) = bf1(v);
                    }
                }
                if (lanep < 16) SB[(mb + lanep) * 8 + hd] = sbkeep;
                if (wh) *(LAS float*)(ub + U_G31 + lanep * 4) = gprev;
            }
            asm volatile("s_waitcnt lgkmcnt(0)" ::: "memory"); __builtin_amdgcn_s_barrier(); asm volatile("" ::: "memory");
            const unsigned long long tp1 = TIMER_A >= 0 ? __builtin_amdgcn_s_memrealtime() : 0ull;
            {
                int r = lane & 31, h = lane >> 5; asm volatile("" : "+v"(r), "+v"(h));
                bf16x8_t fT[2], fAk[2], fRb[2], fRk[2];
                {
                    f32x16 M, MT, R, RT;
#pragma unroll
                    for (int i = 0; i < 16; ++i) { M[i] = 0.f; MT[i] = 0.f; }
#pragma unroll
                    for (int ks = 0; ks < 4; ++ks) { const int o = a64(r, 16 * ks + 8 * h);
                        const bf16x8_t fb = *(const LAS bf16x8_t*)(ub + U_BT + o), fa = *(const LAS bf16x8_t*)(ub + U_AT + o);
                        M = MFMA32(fb, fa, M); MT = MFMA32(fa, fb, MT); }
#pragma unroll
                    for (int i = 0; i < 16; ++i) { const int q = crow_(i, h); M[i] = (q < r) ? M[i] : 0.f; MT[i] = (r < q) ? MT[i] : 0.f;
                        R[i] = M[i] + ((q == r) ? 1.f : 0.f); RT[i] = MT[i] + ((q == r) ? 1.f : 0.f); }
#pragma unroll
                    for (int lvl = 0; lvl < 4; ++lvl) {
                        bf16x8_t pm[2], pmt[2];
#pragma unroll
                        for (int ks = 0; ks < 2; ++ks) { pm[ks] = pack8(M, ks); pmt[ks] = pack8(MT, ks); }
                        f32x16 M2, MT2;
#pragma unroll
                        for (int i = 0; i < 16; ++i) { M2[i] = 0.f; MT2[i] = 0.f; }
#pragma unroll
                        for (int ks = 0; ks < 2; ++ks) { M2 = MFMA32(pmt[ks], pm[ks], M2); MT2 = MFMA32(pm[ks], pmt[ks], MT2); }
                        M = M2; MT = MT2;
                        bf16x8_t pr[2], prt[2];
#pragma unroll
                        for (int ks = 0; ks < 2; ++ks) { pm[ks] = pack8(M, ks); pr[ks] = pack8(R, ks); prt[ks] = pack8(RT, ks); }
#pragma unroll
                        for (int ks = 0; ks < 2; ++ks) { R = MFMA32(prt[ks], pm[ks], R); RT = MFMA32(pm[ks], prt[ks], RT); }
                        (void)pr;
                    }
#pragma unroll
                    for (int ks = 0; ks < 2; ++ks) fT[ks] = pack8(R, ks);
                }
                __builtin_amdgcn_sched_barrier(0);
                {
                    f32x16 Xak, Xrb, Xrk;
#pragma unroll
                    for (int i = 0; i < 16; ++i) { Xak[i] = 0.f; Xrb[i] = 0.f; Xrk[i] = 0.f; }
#pragma unroll
                    for (int ks = 0; ks < 4; ++ks) { const int o = a64(r, 16 * ks + 8 * h);
                        const bf16x8_t fb = *(const LAS bf16x8_t*)(ub + U_BT + o), fk = *(const LAS bf16x8_t*)(ub + U_KT + o);
                        const bf16x8_t fa = *(const LAS bf16x8_t*)(ub + U_AT + o), fr = *(const LAS bf16x8_t*)(ub + U_RT + o);
                        Xak = MFMA32(fk, fa, Xak); Xrb = MFMA32(fb, fr, Xrb); Xrk = MFMA32(fk, fr, Xrk); }
#pragma unroll
                    for (int i = 0; i < 16; ++i) { const int s = crow_(i, h); Xak[i] = (s < r) ? Xak[i] : 0.f; Xrb[i] = (s <= r) ? Xrb[i] : 0.f; Xrk[i] = (s <= r) ? Xrk[i] : 0.f; }
#pragma unroll
                    for (int ks = 0; ks < 2; ++ks) { fAk[ks] = pack8(Xak, ks); fRb[ks] = pack8(Xrb, ks); fRk[ks] = pack8(Xrk, ks); }
                }
#pragma unroll
                for (int jt = 0; jt < 2; ++jt) {
                    __builtin_amdgcn_sched_barrier(0);
                    bf16x8_t sf[2][2], vf[2];
#pragma unroll
                    for (int kt = 0; kt < 2; ++kt)
#pragma unroll
                        for (int ks = 0; ks < 2; ++ks) sf[kt][ks] = pack8(S[jt][kt], ks);
                    if (wh) {
#pragma unroll
                        for (int ks = 0; ks < 2; ++ks) vf[ks] = ld2x8(ub + U_VT + a32(32 * jt + r, 16 * ks + 4 * h), ub + U_VT + a32(32 * jt + r, 16 * ks + 8 + 4 * h));
                    }
                    f32x16 X1, Uu, Oo;
#pragma unroll
                    for (int i = 0; i < 16; ++i) { X1[i] = 0.f; Uu[i] = 0.f; Oo[i] = 0.f; }
#pragma unroll
                    for (int kt = 0; kt < 2; ++kt)
#pragma unroll
                        for (int ks = 0; ks < 2; ++ks) { const int c0 = 32 * kt + 16 * ks + 4 * h;
                            X1 = MFMA32(ld2x8(ub + U_AT + a64(r, c0), ub + U_AT + a64(r, c0 + 8)), sf[kt][ks], X1);
                            Oo = MFMA32(ld2x8(ub + U_RT + a64(r, c0), ub + U_RT + a64(r, c0 + 8)), sf[kt][ks], Oo); }
                    if (wh) {
#pragma unroll
                        for (int ks = 0; ks < 2; ++ks) { X1 = MFMA32(fAk[ks], vf[ks], X1); Oo = MFMA32(fRk[ks], vf[ks], Oo); }
                    }
                    __builtin_amdgcn_sched_barrier(0);
#pragma unroll
                    for (int ks = 0; ks < 2; ++ks) Uu = MFMA32(fT[ks], pack8(X1, ks), Uu);
                    bf16x8_t uf[2];
#pragma unroll
                    for (int ks = 0; ks < 2; ++ks) { uf[ks] = pack8(Uu, ks); Oo = MFMA32(fRb[ks], uf[ks], Oo); }
                    { bf16* dst = (wh ? OLOC : QHAT) + ms * 512 + hd * 64 + 32 * jt + r;
#pragma unroll
                      for (int i = 0; i < 16; ++i) dst[(size_t)crow_(i, h) * 512] = bf1(Oo[i]); }
                    __builtin_amdgcn_sched_barrier(0);
#pragma unroll
                    for (int kt = 0; kt < 2; ++kt) {
#pragma unroll
                        for (int ks = 0; ks < 2; ++ks) { const int k = 32 * kt + r, t0 = 16 * ks + 4 * h;
                            S[jt][kt] = MFMA32(ld2x8(ub + U_BH + a32(k, t0), ub + U_BH + a32(k, t0 + 8)), uf[ks], S[jt][kt]);
                            if (wh) S[jt][kt] = MFMA32(ld2x8(ub + U_KH + a32(k, t0), ub + U_KH + a32(k, t0 + 8)), vf[ks], S[jt][kt]); }
#pragma unroll
                        for (int g = 0; g < 4; ++g) { const f32x4 gg = *(const LAS f32x4*)(ub + U_G31 + (32 * kt + 8 * g + 4 * h) * 4);
                            S[jt][kt][4 * g] *= gg.x; S[jt][kt][4 * g + 1] *= gg.y; S[jt][kt][4 * g + 2] *= gg.z; S[jt][kt][4 * g + 3] *= gg.w; }
                    }
                }
            }
            asm volatile("s_waitcnt lgkmcnt(0)" ::: "memory"); __builtin_amdgcn_s_barrier(); asm volatile("" ::: "memory");
            if (TIMER_A >= 0) { const unsigned long long tp2 = __builtin_amdgcn_s_memrealtime(); tacc_p += tp1 - tp0; tacc_c += tp2 - tp1; }
        }
        int r = lane & 31, h = lane >> 5; asm volatile("" : "+v"(r), "+v"(h));
        if (wh == 0) { bf16* PC = (bf16*)((unsigned char*)F.out + DO_PC) + (size_t)unit * 4096;
#pragma unroll
            for (int jt = 0; jt < 2; ++jt)
#pragma unroll
                for (int kt = 0; kt < 2; ++kt)
#pragma unroll
                    for (int i = 0; i < 16; ++i) PC[(32 * kt + crow_(i, h)) * 64 + 32 * jt + r] = bf1(S[jt][kt][i]);
        } else { bf16* QCT = (bf16*)((unsigned char*)F.out + DO_QCT) + (size_t)unit * 4096;
#pragma unroll
            for (int jt = 0; jt < 2; ++jt)
#pragma unroll
                for (int kt = 0; kt < 2; ++kt)
#pragma unroll
                    for (int g = 0; g < 4; ++g) { v2u o; o.x = pkbf(S[jt][kt][4 * g], S[jt][kt][4 * g + 1]); o.y = pkbf(S[jt][kt][4 * g + 2], S[jt][kt][4 * g + 3]);
                        *(v2u*)(QCT + (32 * jt + r) * 64 + 32 * kt + 8 * g + 4 * h) = o; }
        }
    }
    if (TIMER_A >= 0 && blockIdx.x == 0 && threadIdx.x == 0) { ((unsigned long long*)(F.ws + 8192))[30] = tacc_p; ((unsigned long long*)(F.ws + 8192))[31] = tacc_c; }
}

template <int V> __device__ __forceinline__ void rwkv_scan(Frame& F, int bh) {
    constexpr int LDT = 72;
    constexpr int SBUF = 64 * LDT;
    LAS bf16* S0 = (LAS bf16*)(F.lds + RING_OFF);
    const int lane = F.lane, w = F.wave, q = lane >> 4, l15 = lane & 15;
    for (int i = F.tid; i < 2 * SBUF; i += 512) S0[i] = 0;
    __syncthreads();
    if (w < 4) {
        const int tr = w;
        const bf16* PC = (const bf16*)((const unsigned char*)F.out + DO_PC) + (size_t)bh * 32 * 4096 + (16 * tr + l15) * 64 + 8 * q;
        const bf16* QCT = (const bf16*)((const unsigned char*)F.out + DO_QCT) + (size_t)bh * 32 * 4096 + l15 * 64 + 16 * tr + 4 * q;
        const int boff0 = l15 * LDT + 8 * q, woff0 = l15 * LDT + 16 * tr + 4 * q;
        bf16x8_t A[8][2]; v2u Qv[8][4];
#define SCAN_LOAD(s, cc) do { \
        asm volatile("global_load_dwordx4 %0, %1, off" : "=v"(A[s][0]) : "v"(PC + (size_t)(cc) * 4096) : "memory"); \
        asm volatile("global_load_dwordx4 %0, %1, off offset:64" : "=v"(A[s][1]) : "v"(PC + (size_t)(cc) * 4096) : "memory"); \
        asm volatile("global_load_dwordx2 %0, %1, off" : "=v"(Qv[s][0]) : "v"(QCT + (size_t)(cc) * 4096) : "memory"); \
        asm volatile("global_load_dwordx2 %0, %1, off offset:2048" : "=v"(Qv[s][1]) : "v"(QCT + (size_t)(cc) * 4096) : "memory"); \
        asm volatile("global_load_dwordx2 %0, %1, off" : "=v"(Qv[s][2]) : "v"(QCT + (size_t)(cc) * 4096 + 2048) : "memory"); \
        asm volatile("global_load_dwordx2 %0, %1, off offset:2048" : "=v"(Qv[s][3]) : "v"(QCT + (size_t)(cc) * 4096 + 2048) : "memory"); } while (0)
#pragma unroll
        for (int s = 0; s < 8; ++s) SCAN_LOAD(s, s);
        if (V == 0) TSTAMP(F, 22); else TSTAMP(F, 26);
#pragma unroll 1
        for (int c0 = 0; c0 < 32; c0 += 8) {
#pragma unroll
            for (int s = 0; s < 8; ++s) {
                const int c = c0 + s;
                const LAS bf16* Sr = S0 + (s & 1) * SBUF; LAS bf16* Sw = S0 + ((s & 1) ^ 1) * SBUF;
                if (V != 3) asm volatile("s_waitcnt vmcnt(42)" : "+v"(A[s][0]), "+v"(A[s][1]), "+v"(Qv[s][0]), "+v"(Qv[s][1]), "+v"(Qv[s][2]), "+v"(Qv[s][3]) :: "memory");
                pg8::f32x4 acc[4];
#pragma unroll
                for (int t = 0; t < 4; ++t) { acc[t][0] = bflo(Qv[s][t].x); acc[t][1] = bfhi(Qv[s][t].x); acc[t][2] = bflo(Qv[s][t].y); acc[t][3] = bfhi(Qv[s][t].y); }
#pragma unroll
                for (int ks = 0; ks < 2; ++ks)
#pragma unroll
                    for (int t = 0; t < 4; ++t) {
                        if (V != 4) { const bf16x8_t bh_ = *(const LAS bf16x8_t*)(Sr + boff0 + 16 * LDT * t + 32 * ks);
                        acc[t] = __builtin_amdgcn_mfma_f32_16x16x32_bf16(A[s][ks], bh_, acc[t], 0, 0, 0); }
                    }
                if (V != 3) { const int cn = (c + 8 < 32) ? c + 8 : 31; SCAN_LOAD(s, cn); }
#pragma unroll
                for (int t = 0; t < 4; ++t) { v2u oh; oh.x = pg8::cvt_pk_bf16(acc[t][0], acc[t][1]); oh.y = pg8::cvt_pk_bf16(acc[t][2], acc[t][3]);
                    *(LAS v2u*)(Sw + woff0 + 16 * LDT * t) = oh; }
                asm volatile("s_waitcnt lgkmcnt(0)" ::: "memory"); __builtin_amdgcn_s_barrier(); asm volatile("" ::: "memory");
            }
        }
#undef SCAN_LOAD
        if (V == 0) TSTAMP(F, 23); else TSTAMP(F, 27);
        asm volatile("s_waitcnt vmcnt(0)" ::: "memory");
    } else {
        const int t256 = F.tid - 256;
        bf16* HIN = (V == 0 ? (bf16*)((unsigned char*)F.out + DO_HIN) : (bf16*)(F.ws + WS_XC)) + (size_t)bh * 32 * 4096 + (t256 >> 2) * 64 + (t256 & 3) * 16;
        const int hoff = (t256 >> 2) * LDT + (t256 & 3) * 16;
#pragma unroll 1
        for (int c = 0; c < 32; ++c) {
            const LAS bf16* Sr = S0 + (c & 1) * SBUF;
            const v4u x0 = *(const LAS v4u*)(Sr + hoff), x1 = *(const LAS v4u*)(Sr + hoff + 8);
            if (V != 2) { *(v4u*)(HIN + (size_t)c * 4096) = x0; *(v4u*)(HIN + (size_t)c * 4096 + 8) = x1; }
            asm volatile("s_waitcnt lgkmcnt(0)" ::: "memory"); __builtin_amdgcn_s_barrier(); asm volatile("" ::: "memory");
        }
    }
}
__device__ __forceinline__ void phase_scan(Frame& F, int flags) {
    if ((flags & 4) && blockIdx.x >= 36) { TSTAMP_B(F, 36, 24); expert_transposes(F, ((int)blockIdx.x - 36) * NWAVES + F.wave, ((int)F.G - 36) * NWAVES); __syncthreads(); TSTAMP_B(F, 36, 25); }
#ifndef SCAN_VARIANT
#define SCAN_VARIANT 0
#endif
    if ((flags & 2) && blockIdx.x < 32) { rwkv_scan<0>(F, blockIdx.x); if (SCAN_VARIANT) { __syncthreads(); rwkv_scan<SCAN_VARIANT>(F, blockIdx.x); } }
    if ((flags & 1) && blockIdx.x >= 32 && blockIdx.x < 36) {
        const int idx = (blockIdx.x - 32) * 512 + F.tid, b = idx >> 9, ch = idx & 511;
        const float* LA = (const float*)(F.ws + WS_LRUA); const float* LB = (const float*)(F.ws + WS_LRUB); float* LH = (float*)(F.ws + WS_LRUH);
        float h = 0.f;
#pragma unroll 1
        for (int c16 = 0; c16 < 128; c16 += 16) { float a16[16], b16[16];
#pragma unroll
            for (int u = 0; u < 16; ++u) { const int o = (b * 128 + c16 + u) * 512 + ch; a16[u] = LA[o]; b16[u] = LB[o]; }
#pragma unroll
            for (int u = 0; u < 16; ++u) { const int o = (b * 128 + c16 + u) * 512 + ch; LH[o] = h; h = fexp(a16[u]) * h + b16[u]; } }
    }
}

__device__ __forceinline__ void rwkv_post_unit(Frame& F, int unit) {
    int lane = F.lane; asm volatile("" : "+v"(lane));
    const int c = unit & 127, bh = unit >> 7, h = bh & 7, b = bh >> 3, q = lane >> 4, l15 = lane & 15;
    const size_t m0 = (size_t)b * T + (size_t)c * 64;
    const bf16* QHAT = (const bf16*)(F.ws + WS_QHAT); const bf16* OLOC = (const bf16*)(F.ws + WS_OLOC); const bf16* GG = (const bf16*)(F.ws + WS_GG);
    const bf16* HIN = (const bf16*)((const unsigned char*)F.out + DO_HIN) + (size_t)(bh * 32 + (c >> 2)) * 4096; const bf16* P = (const bf16*)(F.ws + WS_P);
    const float* SB = (const float*)(F.ws + WS_SB); bf16* YMIX = (bf16*)(F.ws + WS_YMIX);
    bf16x8_t Af[4][2];
#pragma unroll
    for (int jt = 0; jt < 4; ++jt)
#pragma unroll
        for (int ks = 0; ks < 2; ++ks) Af[jt][ks] = *(const bf16x8_t*)(HIN + (16 * jt + l15) * 64 + 32 * ks + 8 * q);
    f32x4 lnw[4], lnb[4], muv[4];
#pragma unroll
    for (int jt = 0; jt < 4; ++jt) { const int ch = h * 64 + 16 * jt + 4 * q; lnw[jt] = *(const f32x4*)(F.in[23] + ch); lnb[jt] = *(const f32x4*)(F.in[24] + ch); muv[jt] = *(const f32x4*)(F.in[14] + 1024 + ch); }
#pragma unroll 1
    for (int tt = 0; tt < 4; ++tt) {
        const size_t m = m0 + 16 * tt + l15;
        bf16x8_t Bf[2];
#pragma unroll
        for (int ks = 0; ks < 2; ++ks) Bf[ks] = *(const bf16x8_t*)(QHAT + m * 512 + h * 64 + 32 * ks + 8 * q);
        pg8::f32x4 acc[4];
#pragma unroll
        for (int jt = 0; jt < 4; ++jt) { const v2u o = *(const v2u*)(OLOC + m * 512 + h * 64 + 16 * jt + 4 * q); acc[jt][0] = bflo(o.x); acc[jt][1] = bfhi(o.x); acc[jt][2] = bflo(o.y); acc[jt][3] = bfhi(o.y); }
#pragma unroll
        for (int ks = 0; ks < 2; ++ks)
#pragma unroll
            for (int jt = 0; jt < 4; ++jt) acc[jt] = __builtin_amdgcn_mfma_f32_16x16x32_bf16(Af[jt][ks], Bf[ks], acc[jt], 0, 0, 0);
        float s = 0.f;
#pragma unroll
        for (int jt = 0; jt < 4; ++jt) s += (acc[jt][0] + acc[jt][1]) + (acc[jt][2] + acc[jt][3]);
        s += __shfl_xor(s, 16); s += __shfl_xor(s, 32);
        const float mean = s * (1.f / 64.f);
        float vs = 0.f;
#pragma unroll
        for (int jt = 0; jt < 4; ++jt)
#pragma unroll
            for (int i = 0; i < 4; ++i) { acc[jt][i] -= mean; vs += acc[jt][i] * acc[jt][i]; }
        vs += __shfl_xor(vs, 16); vs += __shfl_xor(vs, 32);
        const float rstd = rsqrtf(vs * (1.f / 64.f) + 64e-5f);
        const float sbv = SB[m * 8 + h];
        const bool first = ((m % T) == 0);
#pragma unroll
        for (int jt = 0; jt < 4; ++jt) { const int ch = h * 64 + 16 * jt + 4 * q;
            const v2u cvq = *(const v2u*)(P + m * PW + C_V + ch); v2u pvq = {0u, 0u}; if (!first) pvq = *(const v2u*)(P + (m - 1) * PW + C_V + ch);
            const v2u gq = *(const v2u*)(GG + m * 512 + ch);
            const float cv[4] = {bflo(cvq.x), bfhi(cvq.x), bflo(cvq.y), bfhi(cvq.y)}, pv[4] = {bflo(pvq.x), bfhi(pvq.x), bflo(pvq.y), bfhi(pvq.y)}, gg[4] = {bflo(gq.x), bfhi(gq.x), bflo(gq.y), bfhi(gq.y)};
            float y[4];
#pragma unroll
            for (int i = 0; i < 4; ++i) { const float v = cv[i] + (pv[i] - cv[i]) * muv[jt][i]; y[i] = (acc[jt][i] * rstd * lnw[jt][i] + lnb[jt][i] + sbv * v) * gg[i]; }
            v2u o; o.x = pk2(y[0], y[1]); o.y = pk2(y[2], y[3]);
            *(v2u*)(YMIX + m * D + 512 + ch) = o; }
    }
}
__device__ __forceinline__ void phase_post(Frame& F, int flags) {
    const int gw = F.vcu * NWAVES + F.wave, NGW = F.G * NWAVES, lane = F.lane;
    if (flags & 2) for (int unit = gw; unit < 4096; unit += NGW) rwkv_post_unit(F, unit);
    if (flags & 1) {
        const bf16* GT = (const bf16*)(F.ws + WS_LOGA); const bf16* P = (const bf16*)(F.ws + WS_P);
        const float* LH = (const float*)(F.ws + WS_LRUH); bf16* YMIX = (bf16*)(F.ws + WS_YMIX); const float* ng = F.in[13];
        for (int task = gw; task < 4 * 128 * 8; task += NGW) { const int cg = task & 7, bc = task >> 3, ch = cg * 64 + lane;
            const size_t m0 = (size_t)bc * 64; float hl = LH[bc * 512 + ch]; const float g = ng[ch];
#pragma unroll 1
            for (int t8 = 0; t8 < 64; t8 += 8) {
                bf16 g0[8], g1[8], p8[8];
#pragma unroll
                for (int u = 0; u < 8; ++u) { const size_t m = m0 + t8 + u; g0[u] = GT[m * 1024 + ch]; g1[u] = GT[m * 1024 + 512 + ch]; p8[u] = P[m * PW + C_GATE + ch]; }
#pragma unroll
                for (int u = 0; u < 8; ++u) { const size_t m = m0 + t8 + u;
                    const float la = bf2f(g0[u]), bb = bf2f(g1[u]); hl = fexp(la) * hl + bb;
                    float y = hl * gelu_tanh(bf2f(p8[u]));
                    const float ss = wave_sum(y * y) * (1.f / 64.f);
                    YMIX[m * D + ch] = f2bf(y * rsqrtf(ss + 1e-6f) * g); }
            }
        }
    }
}

struct Args { const float* in[35]; float* out; unsigned char* ws; int ph_lo, ph_hi, flags, pad; };
__global__ void __launch_bounds__(NWAVES * 64, 2) mk_fwd(Args args) {
    extern __shared__ __attribute__((aligned(16))) unsigned char lds[];
    Frame F;
    F.lds = (LAS unsigned char*)lds;
    F.tid = threadIdx.x; F.lane = F.tid & 63; F.wave = __builtin_amdgcn_readfirstlane(F.tid >> 6);
    F.G = gridDim.x; { const int bx = blockIdx.x; F.vcu = (F.G % 8 == 0) ? (bx % 8) * (F.G / 8) + bx / 8 : bx; }
    F.in = args.in; F.out = args.out; F.ws = args.ws;
    const int lo = args.ph_lo, hi = args.ph_hi;
#define IN(k) (lo <= (k) && (k) < hi)
    const int flags = args.flags;
    for (int u = threadIdx.x; u < (LDS_BYTES - LDSCTL_OFF) / 4; u += NWAVES * 64) ((LAS unsigned*)(F.lds + LDSCTL_OFF))[u] = 0u;
    __syncthreads();
    XcdBarrier bar; bar.bar = (unsigned*)(args.ws + WS_CTL) + CW_BAR; bar.x = 0; bar.st = nullptr;
    if (hi - lo > 1) bar = xcd_barrier_post((unsigned*)(args.ws + WS_CTL) + CW_BAR, (volatile LAS unsigned*)(F.lds + MISC_OFF) + 8);
#define SEAM(k) if (IN(k) && IN((k) + 1)) { xcd_barrier(bar); TSTAMP(F, (k) + 1); }
#ifndef DUP_MASK
#define DUP_MASK 0
#endif
#define PH1(k, call) { int t_ = threadIdx.x; asm volatile("" : "+v"(t_)); F.tid = t_; F.lane = t_ & 63; F.wave = __builtin_amdgcn_readfirstlane(t_ >> 6); call; }
#define PH(k, bit, call) if (IN(k)) { PH1(k, call) if ((DUP_MASK >> (bit)) & 1) { xcd_barrier(bar); PH1(k, call) } }
    TSTAMP(F, 0);
    TSTAMP_B(F, 255, 50); TSTAMP_B(F, 128, 51);
    PH(0, 0, (phase0(F), p0_small_weights(F)))
    SEAM(0)
    PH(1, 1, phase1(F))
    SEAM(1)
    PH(2, 2, phase2(F))
    SEAM(2)
    PH(3, 3, phase_prepA(F))
    SEAM(3)
    PH(4, 4, phase_gategemm(F))
    PH(4, 5, phase_loragemm(F))
    SEAM(4)
    if ((DUP_MASK >> 6) & 1) { if (IN(5)) { PH1(5, phase_lrulocal(F, true)) xcd_barrier(bar); } }
    PH(5, 30, phase_lrulocal(F))
#ifndef RWKV_MFMA
#define RWKV_MFMA 1
#endif
    if (RWKV_MFMA) { PH(5, 7, phase_rwkvlocal_mfma(F)) } else { PH(5, 7, phase_rwkvlocal(F)) }
    SEAM(5)
    if ((DUP_MASK >> 8) & 1) { if (IN(6)) { PH1(6, phase_scan(F, 6)) xcd_barrier(bar); } }
    PH(6, 30, phase_scan(F, flags | 4))
    SEAM(6)
    PH(7, 9, phase_post(F, flags))
    SEAM(7)
    PH(8, 10, phase_outproj(F))
    SEAM(8)
    if ((DUP_MASK >> 11) & 1) { if (IN(9)) { PH1(9, phase_route(F)) xcd_barrier(bar); if (blockIdx.x == 0 && threadIdx.x < 32) ((int*)(args.ws + WS_CNT))[threadIdx.x * 64] = 0; xcd_barrier(bar); } }
    PH(9, 30, phase_route(F))
    SEAM(9)
    PH(10, 12, phase_m1(F))
    SEAM(10)
    PH(11, 13, phase_m2(F))
    SEAM(11)
    PH(12, 30, phase_final(F))
#undef SEAM
#undef PH
#undef PH1
#undef IN
}

extern "C" void kernel_launch(void* const* d_in, const int* in_sizes, int n_in, void* d_out, int out_size, void* d_ws, size_t ws_size, hipStream_t stream) {
    if (n_in != 35 || out_size != NTOK * D || ws_size < WS_END) { fprintf(stderr, "kernel_launch: unexpected shapes (n_in %d out %d ws %zu)\n", n_in, out_size, ws_size); return; }
    static int grid = 0;
    if (grid == 0) {
        int dev = 0, cus = 0;
        if (hipGetDevice(&dev) != hipSuccess || hipDeviceGetAttribute(&cus, hipDeviceAttributeMultiprocessorCount, dev) != hipSuccess) { grid = -1; return; }
        if (hipFuncSetAttribute((const void*)mk_fwd, hipFuncAttributeMaxDynamicSharedMemorySize, LDS_BYTES) != hipSuccess) { fprintf(stderr, "kernel_launch: hipFuncSetAttribute failed\n"); grid = -1; return; }
        int per_cu = 0;
        if (hipOccupancyMaxActiveBlocksPerMultiprocessor(&per_cu, (const void*)mk_fwd, NWAVES * 64, LDS_BYTES) != hipSuccess || per_cu < 1) { fprintf(stderr, "kernel_launch: occupancy query says %d blocks per CU\n", per_cu); (void)hipGetLastError(); }
        grid = cus;
    }
    if (grid < 0) return;
    const float* const* in = (const float* const*)d_in;
    char* ws = (char*)d_ws; float* out = (float*)d_out;
    Args a{};
    for (int i = 0; i < 35; ++i) a.in[i] = in[i];
    a.out = out; a.ws = (unsigned char*)d_ws;
    hipMemsetAsync(ws + WS_CTL, 0, 64 * 1024, stream);
#define LAUNCH_PH(p) do { a.ph_lo = (p); a.ph_hi = (p) + 1; hipLaunchKernelGGL(mk_fwd, dim3(grid), dim3(NWAVES * 64), LDS_BYTES, stream, a); } while (0)
#ifndef MIX_FLAGS
#define MIX_FLAGS 3
#endif
    a.flags = MIX_FLAGS;
#ifndef N_LAUNCHES
#define N_LAUNCHES 1
#endif
    if (N_LAUNCHES == 1) { a.ph_lo = 0; a.ph_hi = 13; hipLaunchKernelGGL(mk_fwd, dim3(grid), dim3(NWAVES * 64), LDS_BYTES, stream, a); }
    else { for (int p = 0; p < 13; ++p) LAUNCH_PH(p); }
}
```

```cpp
#include <hip/hip_runtime.h>
#include <stdint.h>
#include <cstdio>

typedef unsigned short bf16;
__device__ __forceinline__ bf16 f2bf(float f) { unsigned u = __float_as_uint(f); return (bf16)((u + 0x7fffu + ((u >> 16) & 1u)) >> 16); }
__device__ __forceinline__ float bf2f(bf16 b) { return __uint_as_float(((unsigned)b) << 16); }
__device__ __forceinline__ float bflo(unsigned u) { return __uint_as_float(u << 16); }
__device__ __forceinline__ float bfhi(unsigned u) { return __uint_as_float(u & 0xffff0000u); }

constexpr int NB = 4, T = 8192, D = 1024, NTOK = NB * T;
constexpr int LRU_W = 512, RW = 512, PW = 2816;
constexpr int C_UX = 0, C_GATE = 512, C_R = 1024, C_K = 1536, C_V = 2048, C_WD = 2560, C_AD = 2624, C_GD = 2688;
constexpr int NE = 32, DE = 512;
constexpr size_t MiB = 1u << 20;
constexpr size_t WS_CTL = 0;
constexpr int CW_BAR = 4096;
constexpr size_t WS_CNT = 32 * 1024;
constexpr size_t WS_MOD = 1 * MiB;
constexpr size_t WS_SELW = 384 * MiB;
constexpr size_t WS_SEL = 1 * MiB + 512 * 1024;
constexpr size_t FW_WLORAT = 2 * MiB;
constexpr size_t FW_WGT = 3 * MiB;
constexpr size_t FW_WR = 3 * MiB + 512 * 1024;
constexpr size_t FW_WINT = 4 * MiB;
constexpr size_t FW_WOUTT = 10 * MiB;
constexpr size_t WS_LIST = 12 * MiB;
constexpr size_t WS_H = 16 * MiB;
constexpr size_t WS_YMIX = WS_H;
constexpr size_t WS_P = 80 * MiB;
constexpr size_t WS_HID = WS_P;
constexpr size_t WS_Y = 152 * MiB;
constexpr size_t WS_YS = 256 * MiB;
constexpr size_t FW_W13T = 416 * MiB;
constexpr size_t FW_W2T = 480 * MiB;
constexpr size_t WS_END = 512 * MiB;

__device__ __forceinline__ float wave_sum(float v) {
    v += __int_as_float(__builtin_amdgcn_update_dpp(0, __float_as_int(v), 0xB1, 0xF, 0xF, true));
    v += __int_as_float(__builtin_amdgcn_update_dpp(0, __float_as_int(v), 0x4E, 0xF, 0xF, true));
    v += __int_as_float(__builtin_amdgcn_update_dpp(0, __float_as_int(v), 0x141, 0xF, 0xF, true));
    v += __int_as_float(__builtin_amdgcn_update_dpp(0, __float_as_int(v), 0x140, 0xF, 0xF, true));
    const int vi = __float_as_int(v);
    const float r0 = __int_as_float(__builtin_amdgcn_readlane(vi, 0)), r1 = __int_as_float(__builtin_amdgcn_readlane(vi, 16));
    const float r2 = __int_as_float(__builtin_amdgcn_readlane(vi, 32)), r3 = __int_as_float(__builtin_amdgcn_readlane(vi, 48));
    return (r0 + r1) + (r2 + r3);
}
__device__ __forceinline__ float fexp(float x) { return __builtin_amdgcn_exp2f(x * 1.44269504089f); }
__device__ __forceinline__ float flog(float x) { return __builtin_amdgcn_logf(x) * 0.69314718056f; }
__device__ __forceinline__ float frcp(float x) { return __builtin_amdgcn_rcpf(x); }
__device__ __forceinline__ float sigmoidf_(float x) { return frcp(1.f + fexp(-x)); }
__device__ __forceinline__ float softplusf_(float x) { return x > 20.f ? x : flog(1.f + fexp(x)); }
__device__ __forceinline__ float ftanh(float u) { return 1.f - 2.f * frcp(1.f + fexp(2.f * u)); }
__device__ __forceinline__ float gelu_tanh(float x) { const float u = 0.7978845608028654f * (x + 0.044715f * x * x * x); return 0.5f * x * (1.f + ftanh(u)); }

namespace pg8 {
#define PG8_LAS __attribute__((address_space(3)))
typedef unsigned short bf16_t;
typedef short bf16x8 __attribute__((ext_vector_type(8)));
typedef float f32x4 __attribute__((ext_vector_type(4)));
typedef unsigned u32x4 __attribute__((ext_vector_type(4)));
constexpr int BM = 256, BK = 64, HALF = 128, HTB = HALF * BK * 2  , STAGE_BYTES = 8 * HTB, NXCD = 8, WGM = 8;

__host__ __device__ __forceinline__ int lds_byte(int r, int c) { const int st = (r >> 4) * 2 + (c >> 5), rr = r & 15, cc = c & 31, ob = rr * 64 + cc * 2; return st * 1024 + (ob ^ (((ob >> 9) & 1) << 5)); }
__host__ __device__ __forceinline__ void stage_rc(int b, int& R, int& C) { const int st = b / 1024, sb = b % 1024, swz = sb ^ (((sb >> 9) & 1) << 5); R = (st >> 1) * 16 + swz / 64; C = (st & 1) * 32 + (swz % 64) / 2; }
__host__ __device__ __forceinline__ int perm32(int rho) { const int n = rho >> 4, i = rho & 15; return 8 * (i >> 2) + 4 * n + (i & 3); }

struct Unit { int pm, pn, e, nrows, row0; };
struct Gemm { const bf16_t* A; const bf16_t* Bt; int lda, ldb, K; };

__device__ __forceinline__ unsigned cvt_pk_bf16(float lo, float hi) { unsigned r; asm volatile("v_cvt_pk_bf16_f32 %0, %1, %2" : "=v"(r) : "v"(lo), "v"(hi)); return r; }

struct DenseOrder {
    static constexpr bool GATHER = false;
    int nM, nN, nwg, G, c;
    __device__ void init(int M, int N, int G_, int c_) { nM = M / BM; nN = N / BM; nwg = nM * nN; G = G_; c = c_; }
    __device__ bool next(int i, Unit& u) const {
        const long L = (long)i * G + c; if (L >= nwg) return false;
        int wgid = (int)L; { const int q = nwg / NXCD, r = nwg % NXCD, xcd = wgid % NXCD, off = wgid / NXCD; wgid = (xcd < r ? xcd * (q + 1) : r * (q + 1) + (xcd - r) * q) + off; }
        const int nig = WGM * nN, gid = wgid / nig, fm = gid * WGM, gsz = (nM - fm) < WGM ? (nM - fm) : WGM;
        u.pm = fm + ((wgid % nig) % gsz); u.pn = (wgid % nig) / gsz; u.e = 0; u.nrows = 256; u.row0 = 0; return true;
    }
    __device__ __forceinline__ const char* a_base(const Gemm& g, const Unit& u) const { return (const char*)g.A + (size_t)u.pm * (BM * 2) * g.lda; }
    __device__ __forceinline__ const char* b_base(const Gemm& g, const Unit& u) const { return (const char*)g.Bt + (size_t)u.pn * (BM * 2) * g.ldb; }
    __device__ __forceinline__ int row(const Unit&, int) const { return 0; }
};

template <class Epi, class Sched>
__device__ __forceinline__ void gemm_phase(PG8_LAS unsigned char* lds, const Gemm g, const Sched& S, const Epi& E, const int tid) {
    const int wid = __builtin_amdgcn_readfirstlane(tid >> 6), lane = tid & 63, wr = wid >> 2, wc = wid & 3, fr = lane & 15, fq = lane >> 4;
    const int K = g.K, nt = K / BK;
    unsigned voffA[2], voffB[2]; int sR[2], sC[2];
#pragma unroll
    for (int i = 0; i < 2; ++i) { int R, C; stage_rc(tid * 16 + i * 8192, R, C); const int Rb = Epi::PERM ? ((R & ~31) + perm32(R & 31)) : R;
        voffA[i] = (unsigned)(R * g.lda + C) * 2u; voffB[i] = (unsigned)(Rb * g.ldb + C) * 2u; sR[i] = R; sC[i] = C; }
    const size_t kstep = (size_t)(BK * 2);
    const size_t hstepA = Sched::GATHER ? 0 : (size_t)HALF * g.lda * 2, hstepB = (size_t)HALF * g.ldb * 2;
    const unsigned ldsw = (unsigned)wid * 1024u;
    const int aoff = lds_byte(wr * 64 + fr, fq * 8), boff = lds_byte(wc * 32 + fr, fq * 8);
    unsigned gA[2][2], gN[2][2];
#define PG8_SA(b, h) (((b) * 2 + (h)) * HTB)
#define PG8_SB(b, h) ((4 + (b) * 2 + (h)) * HTB)
#define PG8_STAGE(bufoff, gbase, voff) do { _Pragma("unroll") for (int _i = 0; _i < 2; ++_i) \
        __builtin_amdgcn_global_load_lds((const unsigned*)((const char*)(gbase) + (voff)[_i]), (PG8_LAS unsigned*)(lds + (bufoff) + ldsw + _i * 8192), 16, 0, 0); } while (0)
#define PG8_STAGE_A(bufoff, kp, h, OFF) do { if constexpr (Sched::GATHER) PG8_STAGE(bufoff, kp, OFF[h]); else PG8_STAGE(bufoff, (kp) + (h) * hstepA, voffA); } while (0)
#define PG8_LDA(dst, b, h) do { _Pragma("unroll") for (int m = 0; m < 4; ++m) _Pragma("unroll") for (int k = 0; k < 2; ++k) dst[m][k] = *(const PG8_LAS bf16x8*)(lds + PG8_SA(b, h) + aoff + m * 2048 + k * 1024); } while (0)
#define PG8_LDB(dst, b, h) do { _Pragma("unroll") for (int n = 0; n < 2; ++n) _Pragma("unroll") for (int k = 0; k < 2; ++k) dst[n][k] = *(const PG8_LAS bf16x8*)(lds + PG8_SB(b, h) + boff + n * 2048 + k * 1024); } while (0)
#define PG8_MMA(ai, bj, At, Bt) do { __builtin_amdgcn_s_setprio(1); _Pragma("unroll") for (int m = 0; m < 4; ++m) _Pragma("unroll") for (int n = 0; n < 2; ++n) _Pragma("unroll") for (int k = 0; k < 2; ++k) \
        acc[ai][bj][m][n] = __builtin_amdgcn_mfma_f32_16x16x32_bf16(Bt[n][k], At[m][k], acc[ai][bj][m][n], 0, 0, 0); __builtin_amdgcn_s_setprio(0); } while (0)
#define PG8_WAIT_V(n) asm volatile("s_waitcnt vmcnt(" #n ")" ::: "memory")
#define PG8_WAIT_L(n) asm volatile("s_waitcnt lgkmcnt(" #n ")" ::: "memory")
#define PG8_BAR __builtin_amdgcn_s_barrier()
#define PG8_SCHED __builtin_amdgcn_sched_barrier(0)
    Unit cur, nxt; int ui = 0;
    if (!S.next(0, cur)) return;
    f32x4 acc[2][2][4][2];
#pragma unroll
    for (int a = 0; a < 2; ++a)
#pragma unroll
        for (int b = 0; b < 2; ++b)
#pragma unroll
            for (int m = 0; m < 4; ++m)
#pragma unroll
                for (int n = 0; n < 2; ++n) acc[a][b][m][n] = (f32x4){0.f, 0.f, 0.f, 0.f};
    bf16x8 At[4][2], B0[2][2], B1[2][2];
    const char* cA = S.a_base(g, cur); const char* cB = S.b_base(g, cur);
    if constexpr (Sched::GATHER) {
#pragma unroll
        for (int h = 0; h < 2; ++h)
#pragma unroll
            for (int i = 0; i < 2; ++i) gA[h][i] = (unsigned)(S.row(cur, h * HALF + sR[i]) * g.lda + sC[i]) * 2u;
    }
    PG8_STAGE(PG8_SB(0, 0), cB, voffB); PG8_STAGE(PG8_SB(0, 1), cB + hstepB, voffB); PG8_STAGE_A(PG8_SA(0, 0), cA, 0, gA); PG8_STAGE_A(PG8_SA(0, 1), cA, 1, gA);
    if (wr == 1) PG8_BAR;
    PG8_WAIT_V(2); PG8_BAR;
    PG8_STAGE(PG8_SB(1, 0), cB + kstep, voffB); PG8_STAGE_A(PG8_SA(1, 0), cA + kstep, 0, gA); PG8_STAGE(PG8_SB(1, 1), cB + hstepB + kstep, voffB);
    PG8_WAIT_V(6); PG8_BAR;
    for (;;) {
        const bool has_next = S.next(ui + 1, nxt);
        const char* nA = has_next ? S.a_base(g, nxt) : cA; const char* nB = has_next ? S.b_base(g, nxt) : cB;
        if constexpr (Sched::GATHER) {
#pragma unroll
            for (int h = 0; h < 2; ++h)
#pragma unroll
                for (int i = 0; i < 2; ++i) gN[h][i] = has_next ? (unsigned)(S.row(nxt, h * HALF + sR[i]) * g.lda + sC[i]) * 2u : gA[h][i];
        }
#pragma unroll 1
        for (int t = 0; t < nt; t += 2) {
            const bool last = (t == nt - 2);
            const char* a1 = cA + (size_t)(t + 1) * kstep;
            const char* a2 = last ? nA : cA + (size_t)(t + 2) * kstep; const char* b2 = last ? nB : cB + (size_t)(t + 2) * kstep;
            const char* a3 = a2 + kstep; const char* b3 = b2 + kstep;
            unsigned o2[2][2];
            if constexpr (Sched::GATHER) {
#pragma unroll
                for (int h = 0; h < 2; ++h)
#pragma unroll
                    for (int i = 0; i < 2; ++i) o2[h][i] = last ? gN[h][i] : gA[h][i];
            }
            PG8_LDB(B0, 0, 0); PG8_LDB(B1, 0, 1); PG8_SCHED; PG8_LDA(At, 0, 0); PG8_STAGE_A(PG8_SA(1, 1), a1, 1, gA);
            PG8_WAIT_V(8); PG8_WAIT_L(0); PG8_BAR; PG8_MMA(0, 0, At, B0); PG8_MMA(0, 1, At, B1); PG8_BAR; PG8_SCHED;
            PG8_LDA(At, 0, 1); PG8_STAGE(PG8_SB(0, 0), b2, voffB); PG8_STAGE(PG8_SB(0, 1), b2 + hstepB, voffB); PG8_STAGE_A(PG8_SA(0, 0), a2, 0, o2);
            PG8_WAIT_V(8); PG8_WAIT_L(0); PG8_BAR; PG8_MMA(1, 0, At, B0); PG8_MMA(1, 1, At, B1); PG8_BAR; PG8_SCHED;
            PG8_LDB(B0, 1, 0); PG8_LDB(B1, 1, 1); PG8_SCHED; PG8_LDA(At, 1, 0); PG8_STAGE_A(PG8_SA(0, 1), a2, 1, o2);
            PG8_WAIT_V(8); PG8_WAIT_L(0); PG8_BAR; PG8_MMA(0, 0, At, B0); PG8_MMA(0, 1, At, B1); PG8_BAR; PG8_SCHED;
            PG8_LDA(At, 1, 1); PG8_STAGE(PG8_SB(1, 0), b3, voffB); PG8_STAGE(PG8_SB(1, 1), b3 + hstepB, voffB); PG8_STAGE_A(PG8_SA(1, 0), a3, 0, o2);
            PG8_WAIT_V(8); PG8_WAIT_L(0); PG8_BAR; PG8_MMA(1, 0, At, B0); PG8_MMA(1, 1, At, B1); PG8_BAR; PG8_SCHED;
        }
        if (wr == 0) PG8_BAR;
        E(acc, cur, wr, wc, fr, fq);
        if (!has_next) break;
#pragma unroll
        for (int a = 0; a < 2; ++a)
#pragma unroll
            for (int b = 0; b < 2; ++b)
#pragma unroll
                for (int m = 0; m < 4; ++m)
#pragma unroll
                    for (int n = 0; n < 2; ++n) acc[a][b][m][n] = (f32x4){0.f, 0.f, 0.f, 0.f};
        cur = nxt; cA = nA; cB = nB; ++ui;
        if constexpr (Sched::GATHER) {
#pragma unroll
            for (int h = 0; h < 2; ++h)
#pragma unroll
                for (int i = 0; i < 2; ++i) gA[h][i] = gN[h][i];
        }
        if (wr == 1) PG8_BAR;
    }
    PG8_WAIT_V(0);
    PG8_BAR;
#undef PG8_SA
#undef PG8_SB
#undef PG8_STAGE
#undef PG8_STAGE_A
#undef PG8_LDA
#undef PG8_LDB
#undef PG8_MMA
#undef PG8_WAIT_V
#undef PG8_WAIT_L
#undef PG8_BAR
#undef PG8_SCHED
}

struct EpiBf16Store {
    static constexpr bool PERM = true;
    bf16_t* O; int ldc;
    __device__ __forceinline__ void operator()(const f32x4 (&acc)[2][2][4][2], const Unit& u, int wr, int wc, int fr, int fq) const {
        const int row0 = u.pm * BM + wr * 64 + fr, col0 = u.pn * BM + wc * 32 + 8 * fq;
#pragma unroll
        for (int ai = 0; ai < 2; ++ai)
#pragma unroll
            for (int m = 0; m < 4; ++m) { bf16_t* rowp = O + (size_t)(row0 + ai * HALF + m * 16) * ldc + col0;
#pragma unroll
                for (int bj = 0; bj < 2; ++bj) { const f32x4 v0 = acc[ai][bj][m][0], v1 = acc[ai][bj][m][1];
                    u32x4 w; w.x = cvt_pk_bf16(v0[0], v0[1]); w.y = cvt_pk_bf16(v0[2], v0[3]); w.z = cvt_pk_bf16(v1[0], v1[1]); w.w = cvt_pk_bf16(v1[2], v1[3]);
                    *(u32x4*)(rowp + bj * HALF) = w; } }
    }
};
}
constexpr int NWAVES = 8;
constexpr int RING_OFF = 0, RING_BYTES = 131072;
constexpr int ROUTER_LDS = 147456;
constexpr int LDSCTL_OFF = ROUTER_LDS, MISC_OFF = LDSCTL_OFF + 320;
constexpr int LDS_TAB_OFF = LDSCTL_OFF + 1024;
constexpr int LDS_BYTES = 155648;

#define GAS __attribute__((address_space(1)))
#define LAS __attribute__((address_space(3)))
typedef unsigned v4u __attribute__((ext_vector_type(4)));
typedef unsigned v2u __attribute__((ext_vector_type(2)));
typedef float f32x4 __attribute__((ext_vector_type(4)));
#define LDS_WAIT() asm volatile("s_waitcnt lgkmcnt(0)" ::: "memory")
#define VM_WAIT() asm volatile("s_waitcnt vmcnt(0)" ::: "memory")
__device__ __forceinline__ unsigned pk2(float lo, float hi) { return (unsigned)f2bf(lo) | ((unsigned)f2bf(hi) << 16); }


struct Frame {
    LAS unsigned char* lds;
    int tid, lane, wave, vcu, G;
    const float* const* in;
    float* out; unsigned char* ws;
};

__device__ __forceinline__ void p0_transpose_item(const float* W, int ldw, bf16* WT, int ldt, int k0, int n0, int row0, LAS float* scr, int lane) {
    {
        f32x4 t[8];
#pragma unroll
        for (int i = 0; i < 8; ++i) t[i] = *(const f32x4*)(W + (size_t)(k0 + 8 * i + (lane >> 3)) * ldw + n0 + 4 * (lane & 7));
#pragma unroll
        for (int i = 0; i < 8; ++i) { LAS float* d = scr + (8 * i + (lane >> 3)) * 33 + 4 * (lane & 7); d[0] = t[i].x; d[1] = t[i].y; d[2] = t[i].z; d[3] = t[i].w; }
    }
    LDS_WAIT(); asm volatile("" ::: "memory");
    const int c = lane & 7;
#pragma unroll
    for (int j = 0; j < 4; ++j) { const int n = (lane >> 3) + 8 * j; const LAS float* s = scr + (8 * c) * 33 + n;
        v4u o; o.x = pk2(s[0 * 33], s[1 * 33]); o.y = pk2(s[2 * 33], s[3 * 33]); o.z = pk2(s[4 * 33], s[5 * 33]); o.w = pk2(s[6 * 33], s[7 * 33]);
        *(v4u*)(WT + (size_t)(row0 + n) * ldt + k0 + 8 * c) = o; }
    LDS_WAIT(); asm volatile("" ::: "memory");
}

__device__ __forceinline__ void p0_mod_task(Frame& F, int task) {
    LAS float* sc = (LAS float*)(F.lds);
    LAS float* red = (LAS float*)(F.lds + 16384);
    const float* c = F.in[1]; const float* w_ada = F.in[2]; const float* b_ada = F.in[3];
    for (int i = F.tid; i < 4096; i += 512) { const float cv = c[i]; sc[i] = cv / (1.f + __expf(-cv)); }
    __syncthreads();
    const int j = task * 32 + (F.lane & 31);
    float a0 = 0.f, a1 = 0.f, a2 = 0.f, a3 = 0.f;
    const int kb = F.wave * 128 + (F.lane >> 5) * 64;
#pragma unroll 16
    for (int k = kb; k < kb + 64; ++k) { const float w = w_ada[(size_t)k * 6144 + j]; a0 += sc[k] * w; a1 += sc[1024 + k] * w; a2 += sc[2048 + k] * w; a3 += sc[3072 + k] * w; }
    red[(F.wave * 4 + 0) * 64 + F.lane] = a0; red[(F.wave * 4 + 1) * 64 + F.lane] = a1; red[(F.wave * 4 + 2) * 64 + F.lane] = a2; red[(F.wave * 4 + 3) * 64 + F.lane] = a3;
    __syncthreads();
    if (F.tid < 128) { const int b = F.tid >> 5, l = F.tid & 31; float s = 0.f;
#pragma unroll
        for (int w = 0; w < 8; ++w) s += red[(w * 4 + b) * 64 + l] + red[(w * 4 + b) * 64 + 32 + l];
        ((float*)(F.ws + WS_MOD))[b * 6144 + task * 32 + l] = s + b_ada[task * 32 + l]; }
    __syncthreads();
}

__device__ __forceinline__ void phase0(Frame& F) {
    if (blockIdx.x < 192) p0_mod_task(F, blockIdx.x);
    LAS float* scr = (LAS float*)(F.lds + RING_OFF + F.wave * 16384);
    const int gw = F.vcu * NWAVES + F.wave, NGW = F.G * NWAVES;
    constexpr int I_IN = (D / 64) * (PW / 32), I_OUT = (D / 64) * (D / 32);
    constexpr int NITEMS = I_IN + I_OUT;
    for (int it = gw; it < NITEMS; it += NGW) {
        int r = it;
        if (r < I_IN) { const int nb = PW / 32, kb = r / nb, n = r % nb; p0_transpose_item(F.in[5], PW, (bf16*)(F.ws + FW_WINT), D, 64 * kb, 32 * n, 32 * n, scr, F.lane); continue; } r -= I_IN;
        { const int nb = D / 32, kb = r / nb, n = r % nb; p0_transpose_item(F.in[25], D, (bf16*)(F.ws + FW_WOUTT), D, 64 * kb, 32 * n, 32 * n, scr, F.lane); }
    }
}
__device__ __forceinline__ void expert_transposes(Frame& F, int wv, int nwv) {
    LAS float* scr = (LAS float*)(F.lds + RING_OFF + F.wave * 16384);
    constexpr int I_E13 = NE * 2 * 256, I_E2 = NE * 256;
    for (int it = wv; it < I_E13 + I_E2; it += nwv) {
        int r = it;
        if (r < I_E13) {
            const int e = r >> 9, which = (r >> 8) & 1, q = r & 255, kb = q >> 4, n = q & 15, n0 = 32 * n;
            const float* W = (which ? F.in[32] : F.in[31]) + (size_t)e * D * DE;
            p0_transpose_item(W, DE, (bf16*)(F.ws + FW_W13T) + (size_t)e * 1024 * 1024, D, 64 * kb, n0, (n0 >> 7) * 256 + which * 128 + (n0 & 127), scr, F.lane); continue; } r -= I_E13;
        {
            const int e = r >> 8, q = r & 255, kb = q >> 5, n = q & 31;
            p0_transpose_item(F.in[33] + (size_t)e * DE * D, D, (bf16*)(F.ws + FW_W2T) + (size_t)e * 1024 * DE, DE, 64 * kb, 32 * n, 32 * n, scr, F.lane); }
    }
}

__device__ __forceinline__ void adaln_row(const float* xrow, const float* g, const float* sh, const float* sc, bf16* orow, int lane) {
    const f32x4* xr = (const f32x4*)xrow + lane;
    f32x4 v[4]; float s = 0.f;
#pragma unroll
    for (int j = 0; j < 4; ++j) { v[j] = xr[64 * j]; s += (v[j].x * v[j].x + v[j].y * v[j].y) + (v[j].z * v[j].z + v[j].w * v[j].w); }
    const float rinv = rsqrtf(wave_sum(s) * (1.f / D) + 1e-6f);
    v2u* o8 = (v2u*)orow + lane;
#pragma unroll
    for (int j = 0; j < 4; ++j) { const f32x4 gg = ((const f32x4*)g)[lane + 64 * j], s1 = ((const f32x4*)sc)[lane + 64 * j], s0 = ((const f32x4*)sh)[lane + 64 * j];
        f32x4 y = v[j] * rinv * gg; y = y * (s1 + 1.f) + s0;
        v2u w; w.x = pk2(y.x, y.y); w.y = pk2(y.z, y.w); o8[64 * j] = w; }
}
__device__ __forceinline__ void phase1(Frame& F) {
    const int gw = F.vcu * NWAVES + F.wave, NGW = F.G * NWAVES;
    const float* mod = (const float*)(F.ws + WS_MOD);
    for (int m = gw; m < NTOK; m += NGW) { const int b = m / T;
        adaln_row(F.in[0] + (size_t)m * D, F.in[4], mod + b * 6144, mod + b * 6144 + 1024, (bf16*)(F.ws + WS_H) + (size_t)m * D, F.lane); }
}
__device__ __forceinline__ void phase2(Frame& F) {
    pg8::Gemm g{(const bf16*)(F.ws + WS_H), (const bf16*)(F.ws + FW_WINT), D, D, D};
    pg8::DenseOrder S; S.init(NTOK, PW, F.G, (int)blockIdx.x);
    pg8::EpiBf16Store E{(bf16*)(F.ws + WS_P), PW};
    pg8::gemm_phase<pg8::EpiBf16Store, pg8::DenseOrder>(F.lds + RING_OFF, g, S, E, F.tid);
}


namespace pg8 {
struct EpiX1F {
    static constexpr bool PERM = true;
    const float* const* in; unsigned char* ws; float* out;
    __device__ __forceinline__ void operator()(const f32x4 (&acc)[2][2][4][2], const Unit& u, int wr, int wc, int fr, int fq) const {
        const float* mod = (const float*)(ws + WS_MOD); bf16_t* Y = (bf16_t*)(ws + WS_Y);
        const int row0 = u.pm * BM + wr * 64 + fr, col0 = u.pn * BM + wc * 32 + 8 * fq;
        const float* g1 = mod + ((u.pm * BM) / T) * 6144 + 2048;
        f32x4 gv[2][2];
#pragma unroll
        for (int bj = 0; bj < 2; ++bj)
#pragma unroll
            for (int n = 0; n < 2; ++n) gv[bj][n] = *(const f32x4*)(g1 + col0 + bj * HALF + n * 4);
#pragma unroll
        for (int ai = 0; ai < 2; ++ai)
#pragma unroll
            for (int m = 0; m < 4; ++m) { bf16_t* rowp = Y + (size_t)(row0 + ai * HALF + m * 16) * D + col0;
#pragma unroll
                for (int bj = 0; bj < 2; ++bj) { const f32x4 v0 = acc[ai][bj][m][0] * gv[bj][0], v1 = acc[ai][bj][m][1] * gv[bj][1];
                    u32x4 w; w.x = cvt_pk_bf16(v0[0], v0[1]); w.y = cvt_pk_bf16(v0[2], v0[3]); w.z = cvt_pk_bf16(v1[0], v1[1]); w.w = cvt_pk_bf16(v1[2], v1[3]);
                    *(u32x4*)(rowp + bj * HALF) = w; } }
    }
};
template <bool GATH> struct MoeOrder {
    static constexpr bool GATHER = GATH;
    const LAS int* ub; const LAS int* rb; const LAS int* cn; const int* list; int G, c, brows;
    __device__ bool next(int i, Unit& u) const {
        int e, local;
        if ((G & 7) == 0) {
            const int x = c & 7, L = i * (G >> 3) + (c >> 3); const LAS int* xb = ub + 98 + x * 5;
            if (L >= xb[4]) return false;
            int j = 0;
#pragma unroll
            for (int k = 2; k >= 1; k >>= 1) if (xb[j + k] <= L) j += k;
            e = x + 8 * j; local = L - xb[j];
        } else {
            const int L = i * G + c; if (L >= ub[32]) return false;
            e = 0;
#pragma unroll
            for (int k = 16; k >= 1; k >>= 1) if (ub[e + k] <= L) e += k;
            local = L - ub[e];
        }
        const int tiles = rb[e + 1] - rb[e], pn = local / tiles, mt = local - pn * tiles;
        u.e = e; u.pn = pn; u.pm = rb[e] + mt; u.row0 = e * NTOK + mt * 256; u.nrows = min(256, cn[e] - mt * 256); return true;
    }
    __device__ __forceinline__ const char* a_base(const Gemm& g, const Unit& u) const { return GATH ? (const char*)g.A : (const char*)g.A + (size_t)u.pm * (BM * 2) * g.lda; }
    __device__ __forceinline__ const char* b_base(const Gemm& g, const Unit& u) const { return (const char*)g.Bt + ((size_t)u.e * brows + (size_t)u.pn * BM) * 2 * g.ldb; }
    __device__ __forceinline__ int row(const Unit& u, int r) const { return r < u.nrows ? (list[u.row0 + r] >> 1) : 0; }
};
struct EpiSwiglu {
    static constexpr bool PERM = true;
    bf16_t* HID;
    __device__ __forceinline__ void operator()(const f32x4 (&acc)[2][2][4][2], const Unit& u, int wr, int wc, int fr, int fq) const {
        const int col0 = u.pn * HALF + wc * 32 + 8 * fq;
#pragma unroll
        for (int ai = 0; ai < 2; ++ai)
#pragma unroll
            for (int m = 0; m < 4; ++m) { const int r = ai * HALF + wr * 64 + m * 16 + fr;
                if (r < u.nrows) { float h[8];
#pragma unroll
                    for (int n = 0; n < 2; ++n)
#pragma unroll
                        for (int i = 0; i < 4; ++i) { const float a = acc[ai][0][m][n][i], b = acc[ai][1][m][n][i]; h[n * 4 + i] = a * frcp(1.f + fexp(-a)) * b; }
                    u32x4 w; w.x = cvt_pk_bf16(h[0], h[1]); w.y = cvt_pk_bf16(h[2], h[3]); w.z = cvt_pk_bf16(h[4], h[5]); w.w = cvt_pk_bf16(h[6], h[7]);
                    *(u32x4*)(HID + (size_t)(u.pm * BM + r) * DE + col0) = w; } }
    }
};
struct EpiYs {
    static constexpr bool PERM = true;
    unsigned char* ws;
    __device__ __forceinline__ void operator()(const f32x4 (&acc)[2][2][4][2], const Unit& u, int wr, int wc, int fr, int fq) const {
        bf16_t* YS = (bf16_t*)(ws + WS_YS); const int* list = (const int*)(ws + WS_LIST); const float* selw = (const float*)(ws + WS_SELW);
        const int col0 = u.pn * BM + wc * 32 + 8 * fq;
#pragma unroll
        for (int ai = 0; ai < 2; ++ai)
#pragma unroll
            for (int m = 0; m < 4; ++m) { const int r = ai * HALF + wr * 64 + m * 16 + fr;
                if (r < u.nrows) { const int li = list[u.row0 + r]; const float w8 = selw[u.row0 + r]; bf16_t* rowp = YS + (size_t)li * D + col0;
#pragma unroll
                    for (int bj = 0; bj < 2; ++bj) { const f32x4 v0 = acc[ai][bj][m][0] * w8, v1 = acc[ai][bj][m][1] * w8;
                        u32x4 w; w.x = cvt_pk_bf16(v0[0], v0[1]); w.y = cvt_pk_bf16(v0[2], v0[3]); w.z = cvt_pk_bf16(v1[0], v1[1]); w.w = cvt_pk_bf16(v1[2], v1[3]);
                        *(u32x4*)(rowp + bj * HALF) = w; } } }
    }
};
}

__device__ __forceinline__ void phase_outproj(Frame& F) {
    pg8::Gemm g{(const bf16*)(F.ws + WS_YMIX), (const bf16*)(F.ws + FW_WOUTT), D, D, D};
    pg8::DenseOrder S; S.init(NTOK, D, F.G, (int)blockIdx.x);
    pg8::EpiX1F E{F.in, F.ws, F.out};
    pg8::gemm_phase<pg8::EpiX1F, pg8::DenseOrder>(F.lds + RING_OFF, g, S, E, F.tid);
}

__device__ __forceinline__ void phase_route(Frame& F) {
    LAS float* wt = (LAS float*)F.lds;
    { const f32x4* WR = (const f32x4*)(F.ws + FW_WR); LAS f32x4* wt4 = (LAS f32x4*)F.lds;
      for (int i = F.tid; i < 36 * 256; i += 512) wt4[i] = WR[i]; }
    __syncthreads();
    const float* mod = (const float*)(F.ws + WS_MOD); const float* g2n = F.in[26];
    int* cnt = (int*)(F.ws + WS_CNT); int* list = (int*)(F.ws + WS_LIST); float* selw = (float*)(F.ws + WS_SELW);
    bf16* H2 = (bf16*)(F.ws + WS_H);
    const int gw = F.vcu * NWAVES + F.wave, NGW = F.G * NWAVES, lane = F.lane;
    LAS int* lcnt = (LAS int*)(F.lds + LDSCTL_OFF + 2048); LAS int* lbase = lcnt + 32; LAS int* tokres = lcnt + 64; LAS float* tokw = (LAS float*)(tokres + 256);
    if (F.tid < 32) lcnt[F.tid] = 0;
    __syncthreads();
    int it = 0;
    const float* xin = F.in[0]; const bf16* Yb = (const bf16*)(F.ws + WS_Y);
    f32x4 vn[4]; v2u yn[4];
#pragma unroll
    for (int j = 0; j < 4; ++j) { vn[j] = ((const f32x4*)(xin + (size_t)gw * D) + lane)[64 * j]; yn[j] = ((const v2u*)(Yb + (size_t)gw * D) + lane)[64 * j]; }
    f32x4 ggr[4], s1r[4], s0r[4]; int bcur = -1;
#pragma unroll
    for (int j = 0; j < 4; ++j) ggr[j] = ((const f32x4*)g2n)[lane + 64 * j];
    for (int m = gw; m < NTOK; m += NGW, ++it) {
        const int b = m / T;
        if (b != bcur) { bcur = b;
#pragma unroll
            for (int j = 0; j < 4; ++j) { s1r[j] = ((const f32x4*)(mod + b * 6144 + 4096))[lane + 64 * j] + 1.f; s0r[j] = ((const f32x4*)(mod + b * 6144 + 3072))[lane + 64 * j]; } }
        f32x4 v[4]; float s = 0.f;
#pragma unroll
        for (int j = 0; j < 4; ++j) { v[j] = vn[j]; v[j].x += bflo(yn[j].x); v[j].y += bfhi(yn[j].x); v[j].z += bflo(yn[j].y); v[j].w += bfhi(yn[j].y);
            s += (v[j].x * v[j].x + v[j].y * v[j].y) + (v[j].z * v[j].z + v[j].w * v[j].w); }
        if (m + NGW < NTOK) {
#pragma unroll
            for (int j = 0; j < 4; ++j) { vn[j] = ((const f32x4*)(xin + (size_t)(m + NGW) * D) + lane)[64 * j]; yn[j] = ((const v2u*)(Yb + (size_t)(m + NGW) * D) + lane)[64 * j]; }
        }
        const float rinv = rsqrtf(wave_sum(s) * (1.f / D) + 1e-6f);
        v2u* o8 = (v2u*)(H2 + (size_t)m * D) + lane;
#pragma unroll
        for (int j = 0; j < 4; ++j) { f32x4 y = v[j] * rinv * ggr[j]; y = y * s1r[j] + s0r[j]; v[j] = y;
            v2u w; w.x = pk2(y.x, y.y); w.y = pk2(y.z, y.w); o8[64 * j] = w; }
        float pg[4] = {0.f, 0.f, 0.f, 0.f};
#pragma unroll
        for (int j = 0; j < 4; ++j)
#pragma unroll
            for (int e = 0; e < 4; ++e) { const f32x4 w = *(const LAS f32x4*)(wt + e * 1024 + lane * 4 + 256 * j); pg[e] += (v[j].x * w.x + v[j].y * w.y) + (v[j].z * w.z + v[j].w * w.w); }
        const f32x4 bg = *(const f32x4*)F.in[28];
        const float g0 = wave_sum(pg[0]) + bg.x, g1 = wave_sum(pg[1]) + bg.y, g2 = wave_sum(pg[2]) + bg.z, g3 = wave_sum(pg[3]) + bg.w;
        float gm = g0; int gi = 0;
        if (g1 > gm) { gm = g1; gi = 1; } if (g2 > gm) { gm = g2; gi = 2; } if (g3 > gm) { gm = g3; gi = 3; }
        const float gwt = frcp(fexp(g0 - gm) + fexp(g1 - gm) + fexp(g2 - gm) + fexp(g3 - gm));
        gi = __builtin_amdgcn_readfirstlane(gi);
        const LAS float* we = wt + (4 + gi * 8) * 1024 + lane * 4;
        const f32x4 be0 = *(const f32x4*)(F.in[30] + gi * 8), be1 = *(const f32x4*)(F.in[30] + gi * 8 + 4);
        float xe[8];
#pragma unroll
        for (int hf = 0; hf < 2; ++hf) { float pe[4] = {0.f, 0.f, 0.f, 0.f};
#pragma unroll
            for (int j = 0; j < 4; ++j)
#pragma unroll
                for (int e = 0; e < 4; ++e) { const f32x4 w = *(const LAS f32x4*)(we + (hf * 4 + e) * 1024 + 256 * j); pe[e] += (v[j].x * w.x + v[j].y * w.y) + (v[j].z * w.z + v[j].w * w.w); }
#pragma unroll
            for (int e = 0; e < 4; ++e) xe[hf * 4 + e] = wave_sum(pe[e]); }
        xe[0] += be0.x; xe[1] += be0.y; xe[2] += be0.z; xe[3] += be0.w; xe[4] += be1.x; xe[5] += be1.y; xe[6] += be1.z; xe[7] += be1.w;
        float v1 = xe[0], v2 = -3.4e38f; int i1 = 0, i2 = 0;
#pragma unroll
        for (int ii = 1; ii < 8; ++ii) { const float xx = xe[ii]; const bool a1 = xx > v1, a2 = xx > v2;
            v2 = a1 ? v1 : (a2 ? xx : v2); i2 = a1 ? i1 : (a2 ? ii : i2); v1 = a1 ? xx : v1; i1 = a1 ? ii : i1; }
        const float e2 = fexp(v2 - v1), w1 = frcp(1.f + e2), w2 = e2 * w1;
        if (lane == 0) { const int ea = gi * 8 + i1, eb = gi * 8 + i2;
            tokw[(F.wave * 16 + it) * 2] = w1 * gwt; tokw[(F.wave * 16 + it) * 2 + 1] = w2 * gwt;
            const int ra = atomicAdd((int*)&lcnt[ea], 1), rb2 = atomicAdd((int*)&lcnt[eb], 1);
            tokres[(F.wave * 16 + it) * 2] = ea | (ra << 8); tokres[(F.wave * 16 + it) * 2 + 1] = eb | (rb2 << 8); }
    }
    __syncthreads();
    if (F.tid < 32) { const int c = lcnt[F.tid]; lbase[F.tid] = c ? atomicAdd(&cnt[F.tid * 64], c) : 0; }
    __syncthreads();
    if (lane < 16) { const int m = gw + lane * NGW;
        if (m < NTOK) { const int a = tokres[(F.wave * 16 + lane) * 2], b2 = tokres[(F.wave * 16 + lane) * 2 + 1];
            const int pa = (a & 255) * NTOK + lbase[a & 255] + (a >> 8), pb = (b2 & 255) * NTOK + lbase[b2 & 255] + (b2 >> 8);
            list[pa] = m * 2; list[pb] = m * 2 + 1; selw[pa] = tokw[(F.wave * 16 + lane) * 2]; selw[pb] = tokw[(F.wave * 16 + lane) * 2 + 1]; } }
    __syncthreads();
}

__device__ __forceinline__ void moe_tables(Frame& F, int npn) {
    LAS int* tab = (LAS int*)(F.lds + LDS_TAB_OFF);
    if (F.tid == 0) { const int* cnt = (const int*)(F.ws + WS_CNT); int ub = 0, rb = 0;
        for (int e = 0; e < 32; ++e) { const int c = __hip_atomic_load(cnt + e * 64, __ATOMIC_RELAXED, __HIP_MEMORY_SCOPE_AGENT); const int tl = (c + 255) >> 8; tab[e] = ub; tab[33 + e] = rb; tab[66 + e] = c; ub += tl * npn; rb += tl; }
        tab[32] = ub; tab[33 + 32] = rb;
        for (int x = 0; x < 8; ++x) { int s = 0; for (int j = 0; j < 4; ++j) { tab[98 + x * 5 + j] = s; s += tab[x + 8 * j + 1] - tab[x + 8 * j]; } tab[98 + x * 5 + 4] = s; } }
    __syncthreads();
}
__device__ __forceinline__ void phase_m1(Frame& F) {
    moe_tables(F, 4);
    const LAS int* tab = (const LAS int*)(F.lds + LDS_TAB_OFF);
    pg8::Gemm g{(const bf16*)(F.ws + WS_H), (const bf16*)(F.ws + FW_W13T), D, D, D};
    pg8::MoeOrder<true> S{tab, tab + 33, tab + 66, (const int*)(F.ws + WS_LIST), F.G, (int)blockIdx.x, 1024};
    pg8::EpiSwiglu E{(bf16*)(F.ws + WS_HID)};
    pg8::gemm_phase<pg8::EpiSwiglu, pg8::MoeOrder<true>>(F.lds + RING_OFF, g, S, E, F.tid);
}
__device__ __forceinline__ void phase_m2(Frame& F) {
    moe_tables(F, 4);
    const LAS int* tab = (const LAS int*)(F.lds + LDS_TAB_OFF);
    pg8::Gemm g{(const bf16*)(F.ws + WS_HID), (const bf16*)(F.ws + FW_W2T), DE, DE, DE};
    pg8::MoeOrder<false> S{tab, tab + 33, tab + 66, (const int*)(F.ws + WS_LIST), F.G, (int)blockIdx.x, 1024};
    pg8::EpiYs E{F.ws};
    pg8::gemm_phase<pg8::EpiYs, pg8::MoeOrder<false>>(F.lds + RING_OFF, g, S, E, F.tid);
}
__device__ __forceinline__ void phase_final(Frame& F) {
    const int gw = F.vcu * NWAVES + F.wave, NGW = F.G * NWAVES, lane = F.lane;
    const float* mod = (const float*)(F.ws + WS_MOD); const float* fg = F.in[34]; const bf16* YS = (const bf16*)(F.ws + WS_YS);
    const float* xin = F.in[0]; const bf16* Yb = (const bf16*)(F.ws + WS_Y);
    for (int m = gw; m < NTOK; m += NGW) { const int b = m / T;
        f32x4* xr = (f32x4*)(F.out + (size_t)m * D) + lane; const f32x4* xi = (const f32x4*)(xin + (size_t)m * D) + lane; const v2u* yb = (const v2u*)(Yb + (size_t)m * D) + lane;
        const v2u* y0 = (const v2u*)(YS + (size_t)(2 * m) * D) + lane; const v2u* y1 = (const v2u*)(YS + (size_t)(2 * m + 1) * D) + lane;
        f32x4 v[4]; float s = 0.f;
#pragma unroll
        for (int j = 0; j < 4; ++j) { const v2u a = y0[64 * j], c = y1[64 * j], yy = yb[64 * j]; const f32x4 g2 = ((const f32x4*)(mod + b * 6144 + 5120))[lane + 64 * j];
            f32x4 mo; mo.x = bflo(a.x) + bflo(c.x); mo.y = bfhi(a.x) + bfhi(c.x); mo.z = bflo(a.y) + bflo(c.y); mo.w = bfhi(a.y) + bfhi(c.y);
            f32x4 x1 = xi[64 * j]; x1.x += bflo(yy.x); x1.y += bfhi(yy.x); x1.z += bflo(yy.y); x1.w += bfhi(yy.y);
            v[j] = x1 + g2 * mo; s += (v[j].x * v[j].x + v[j].y * v[j].y) + (v[j].z * v[j].z + v[j].w * v[j].w); }
        const float rinv = rsqrtf(wave_sum(s) * (1.f / D) + 1e-6f);
#pragma unroll
        for (int j = 0; j < 4; ++j) xr[64 * j] = v[j] * rinv * ((const f32x4*)fg)[lane + 64 * j];
    }
}
#define XB_TMO      128
#define XB_XCNT(j)  (256  + 64 * (j))
#define XB_XSUB(j)  (1280 + 64 * (j))
#define XB_XGEN(j)  (2304 + 64 * (j))
#define XB_TOP      3328
#define XB_TOPGEN   3392
#define XCD_BAR_WORDS 3456
#define XB_SPIN_CAP (1u << 18)

__device__ __forceinline__ unsigned xb_ld(unsigned* p)              { return __hip_atomic_load(p, __ATOMIC_RELAXED, __HIP_MEMORY_SCOPE_AGENT); }
__device__ __forceinline__ unsigned xb_add(unsigned* p, unsigned v) { return __hip_atomic_fetch_add(p, v, __ATOMIC_RELAXED, __HIP_MEMORY_SCOPE_AGENT); }
__device__ __forceinline__ unsigned xb_xcc_id() { return (unsigned)__builtin_amdgcn_s_getreg((3 << 11) | 20) & 0xFu; }
#define XB_SPIN(cond, bar) do { unsigned _sp = 0; while (cond) { __builtin_amdgcn_s_sleep(1); \
    if ((++_sp & 255u) == 0u) { if (xb_ld(&(bar)[XB_TMO])) break; if (_sp > XB_SPIN_CAP) { atomicAdd(&(bar)[XB_TMO], 1u); break; } } } } while (0)

struct XcdBarrier {
    unsigned* bar; unsigned x;
    volatile LAS unsigned* st;
};

__device__ __forceinline__ XcdBarrier xcd_barrier_post(unsigned* bar, volatile LAS unsigned* st) {
    XcdBarrier b; b.bar = bar; b.x = xb_xcc_id(); b.st = st;
    if (threadIdx.x == 0) (void)xb_add(&bar[XB_XCNT(b.x)], 1u);
    return b;
}
__device__ __forceinline__ void xcd_barrier_complete(unsigned* bar, unsigned x, unsigned& nloc, unsigned& nx) {
    const unsigned G = gridDim.x * gridDim.y * gridDim.z;
    unsigned sum, cnt, mine, sp = 0u;
    for (;;) {
        sum = 0u; cnt = 0u; mine = 0u;
#pragma unroll
        for (unsigned j = 0; j < 16; ++j) { const unsigned c = xb_ld(&bar[XB_XCNT(j)]); sum += c; cnt += (c > 0u) ? 1u : 0u; mine = (j == x) ? c : mine; }
        if (sum == G) break;
        __builtin_amdgcn_s_sleep(1);
        if ((++sp & 255u) == 0u) { if (xb_ld(&bar[XB_TMO])) break; if (sp > XB_SPIN_CAP) { atomicAdd(&bar[XB_TMO], 1u); break; } }
    }
    nloc = mine > 0u ? mine : 1u; nx = cnt > 0u ? cnt : 1u;
}

__device__ __forceinline__ void xcd_barrier(const XcdBarrier& b) {
    asm volatile("s_waitcnt vmcnt(0)" ::: "memory");
    __syncthreads();
    if (threadIdx.x == 0) {
        unsigned* bar = b.bar;
        __builtin_amdgcn_s_waitcnt(0);
        unsigned nloc = b.st[0], nx = b.st[1];
        if (nloc == 0u) { xcd_barrier_complete(bar, b.x, nloc, nx); b.st[0] = nloc; b.st[1] = nx; }
        const unsigned old = xb_add(&bar[XB_XSUB(b.x)], 1u);
        const unsigned gen = old / nloc;
        if (old + 1u == (gen + 1u) * nloc) {
            __builtin_amdgcn_fence(__ATOMIC_RELEASE, "agent");
            asm volatile("s_waitcnt vmcnt(0)" ::: "memory");
            const unsigned og = xb_add(&bar[XB_TOP], 1u);
            const unsigned tg = og / nx;
            if (og + 1u == (tg + 1u) * nx) xb_add(&bar[XB_TOPGEN], 1u);
            else XB_SPIN(xb_ld(&bar[XB_TOPGEN]) == tg, bar);
            __builtin_amdgcn_fence(__ATOMIC_ACQUIRE, "agent");
            xb_add(&bar[XB_XGEN(b.x)], 1u);
            asm volatile("s_waitcnt vmcnt(0)" ::: "memory");
        } else {
            XB_SPIN(xb_ld(&bar[XB_XGEN(b.x)]) == gen, bar);
            __builtin_amdgcn_fence(__ATOMIC_ACQUIRE, "agent");
            asm volatile("s_waitcnt vmcnt(0)" ::: "memory");
        }
    }
    __syncthreads();
}


constexpr size_t WS_XC = WS_H;
constexpr size_t WS_ALORA = WS_H + 32 * MiB;
constexpr size_t WS_LOGA = 256 * MiB;
constexpr size_t WS_OLOC = 320 * MiB;
constexpr size_t WS_QHAT = 352 * MiB;
constexpr size_t WS_GG = 384 * MiB;
constexpr size_t WS_SB = 12 * MiB;
constexpr size_t WS_LRUA = 13 * MiB;
constexpr size_t WS_LRUB = 14 * MiB;
constexpr size_t WS_LRUH = 15 * MiB;
constexpr size_t DO_LWA = 0;
constexpr size_t DO_PC = 64 * MiB;
constexpr size_t DO_QCT = 96 * MiB;
constexpr size_t DO_HIN = 0;


__device__ __forceinline__ void phase_prepA(Frame& F) {
    const int gw = F.vcu * NWAVES + F.wave, NGW = F.G * NWAVES, lane = F.lane;
    const bf16* P = (const bf16*)(F.ws + WS_P);
    bf16* XC = (bf16*)(F.ws + WS_XC); bf16* AL = (bf16*)(F.ws + WS_ALORA);
    const float* conv_w = F.in[6]; const float* conv_b = F.in[7]; const float* mu = F.in[14];
    float cw[4][8], cb[8];
#pragma unroll
    for (int i = 0; i < 8; ++i) { cb[i] = conv_b[8 * lane + i];
#pragma unroll
        for (int j = 0; j < 4; ++j) cw[j][i] = conv_w[j * 512 + 8 * lane + i]; }
    float mu4[4];
#pragma unroll
    for (int i = 0; i < 4; ++i) mu4[i] = mu[(C_WD - 1024) + 4 * lane + i];
    for (int task = gw; task < NTOK / 16; task += NGW) {
        const int m0 = task * 16, t0 = m0 % T;
        float x1[8], x2[8], x3[8], pl[4];
#pragma unroll
        for (int i = 0; i < 8; ++i) { x1[i] = 0.f; x2[i] = 0.f; x3[i] = 0.f; }
#pragma unroll
        for (int i = 0; i < 4; ++i) pl[i] = 0.f;
        if (t0 > 0) {
            const v4u a = *(const v4u*)(P + (size_t)(m0 - 1) * PW + 8 * lane), b = *(const v4u*)(P + (size_t)(m0 - 2) * PW + 8 * lane), c = *(const v4u*)(P + (size_t)(m0 - 3) * PW + 8 * lane);
            x1[0] = bflo(a.x); x1[1] = bfhi(a.x); x1[2] = bflo(a.y); x1[3] = bfhi(a.y); x1[4] = bflo(a.z); x1[5] = bfhi(a.z); x1[6] = bflo(a.w); x1[7] = bfhi(a.w);
            x2[0] = bflo(b.x); x2[1] = bfhi(b.x); x2[2] = bflo(b.y); x2[3] = bfhi(b.y); x2[4] = bflo(b.z); x2[5] = bfhi(b.z); x2[6] = bflo(b.w); x2[7] = bfhi(b.w);
            x3[0] = bflo(c.x); x3[1] = bfhi(c.x); x3[2] = bflo(c.y); x3[3] = bfhi(c.y); x3[4] = bflo(c.z); x3[5] = bfhi(c.z); x3[6] = bflo(c.w); x3[7] = bfhi(c.w);
            const v2u q = *(const v2u*)(P + (size_t)(m0 - 1) * PW + C_WD + 4 * lane);
            pl[0] = bflo(q.x); pl[1] = bfhi(q.x); pl[2] = bflo(q.y); pl[3] = bfhi(q.y);
        }
#pragma unroll 4
        for (int tt = 0; tt < 16; ++tt) {
            const size_t m = (size_t)(m0 + tt);
            const v4u a = *(const v4u*)(P + m * PW + 8 * lane);
            float x0[8] = {bflo(a.x), bfhi(a.x), bflo(a.y), bfhi(a.y), bflo(a.z), bfhi(a.z), bflo(a.w), bfhi(a.w)};
            float xc[8];
#pragma unroll
            for (int i = 0; i < 8; ++i) { xc[i] = x3[i] * cw[0][i] + x2[i] * cw[1][i] + x1[i] * cw[2][i] + x0[i] * cw[3][i] + cb[i]; x3[i] = x2[i]; x2[i] = x1[i]; x1[i] = x0[i]; }
            v4u o; o.x = pk2(xc[0], xc[1]); o.y = pk2(xc[2], xc[3]); o.z = pk2(xc[4], xc[5]); o.w = pk2(xc[6], xc[7]);
            *(v4u*)(XC + m * 512 + 8 * lane) = o;
            const v2u q = *(const v2u*)(P + m * PW + C_WD + 4 * lane);
            const float cl[4] = {bflo(q.x), bfhi(q.x), bflo(q.y), bfhi(q.y)};
            float al[4];
#pragma unroll
            for (int i = 0; i < 4; ++i) { const float u = cl[i] + (pl[i] - cl[i]) * mu4[i]; pl[i] = cl[i];
                al[i] = (lane < 16) ? ftanh(u) : ((lane < 32) ? u : sigmoidf_(u)); }
            v2u o2; o2.x = pk2(al[0], al[1]); o2.y = pk2(al[2], al[3]);
            *(v2u*)(AL + m * 256 + 4 * lane) = o2;
        }
    }
}
__device__ __forceinline__ void p0_small_weights(Frame& F) {
    const int gt = F.vcu * NWAVES * 64 + F.tid, NT = F.G * NWAVES * 64;
    bf16* WG = (bf16*)(F.ws + FW_WGT); bf16* WL = (bf16*)(F.ws + FW_WLORAT);
    const float* wa = F.in[8]; const float* wi = F.in[10]; const float* w_up = F.in[16]; const float* a_up = F.in[18]; const float* g_up = F.in[19];
    for (int i = gt; i < 4 * 256 * 128; i += NT) { const int kk = i & 127, r = (i >> 7) & 255, pn = i >> 15;
        const int gate = r >> 7, ch = 128 * pn + (r & 127), hh = ch >> 6, j = ch & 63, kin = 128 * pn + kk;
        float v = 0.f; if ((kin >> 6) == hh) v = (gate ? wi : wa)[hh * 4096 + (kin & 63) * 64 + j];
        WG[i] = f2bf(v); }
    { float* WR = (float*)(F.ws + FW_WR); const float* w_grp = F.in[27]; const float* w_exp = F.in[29];
      for (int i = gt; i < 36 * 1024; i += NT) { const int k = i & 1023, e = i >> 10; WR[i] = e < 4 ? w_grp[k * 4 + e] : w_exp[k * 32 + (e - 4)]; } }
    for (int i = gt; i < 1536 * 128; i += NT) { const int kk = i & 127, n = i >> 7; float v = 0.f;
        if (n < 512) { if (kk < 64) v = w_up[kk * 512 + n]; }
        else if (n < 1024) { if (kk >= 64) v = a_up[(kk - 64) * 512 + n - 512]; }
        else v = g_up[kk * 512 + n - 1024];
        WL[i] = f2bf(v); }
}

namespace pg8 {
struct GateOrder : DenseOrder {
    __device__ __forceinline__ const char* a_base(const Gemm& g, const Unit& u) const { return (const char*)g.A + (size_t)u.pm * (BM * 2) * g.lda + (size_t)u.pn * 256; }
};
struct LoraOrder : DenseOrder {
    __device__ __forceinline__ const char* a_base(const Gemm& g, const Unit& u) const { return (const char*)g.A + (size_t)u.pm * (BM * 2) * g.lda + (u.pn >= 4 ? 256 : 0); }
};
struct EpiLruGate {
    static constexpr bool PERM = true;
    unsigned char* ws;
    __device__ __forceinline__ void operator()(const f32x4 (&acc)[2][2][4][2], const Unit& u, int wr, int wc, int fr, int fq) const {
        bf16_t* G = (bf16_t*)(ws + WS_LOGA);
        const int row0 = u.pm * BM + wr * 64 + fr, col0 = u.pn * HALF + wc * 32 + 8 * fq;
#pragma unroll
        for (int ai = 0; ai < 2; ++ai)
#pragma unroll
            for (int m = 0; m < 4; ++m) { bf16_t* rowp = G + (size_t)(row0 + ai * HALF + m * 16) * 1024 + col0;
#pragma unroll
                for (int bj = 0; bj < 2; ++bj) { const f32x4 v0 = acc[ai][bj][m][0], v1 = acc[ai][bj][m][1];
                    u32x4 w; w.x = cvt_pk_bf16(v0[0], v0[1]); w.y = cvt_pk_bf16(v0[2], v0[3]); w.z = cvt_pk_bf16(v1[0], v1[1]); w.w = cvt_pk_bf16(v1[2], v1[3]);
                    *(u32x4*)(rowp + bj * 512) = w; } }
    }
};
struct EpiLoraStore {
    static constexpr bool PERM = true;
    unsigned char* out; unsigned char* ws;
    __device__ __forceinline__ void operator()(const f32x4 (&acc)[2][2][4][2], const Unit& u, int wr, int wc, int fr, int fq) const {
        const int row0 = u.pm * BM + wr * 64 + fr;
        bf16_t* LWA = (bf16_t*)(out + DO_LWA); bf16_t* GG = (bf16_t*)(ws + WS_GG);
        bf16_t* base = u.pn < 4 ? LWA : GG; const int ldc = u.pn < 4 ? 1024 : 512; const int col0 = (u.pn < 4 ? u.pn : u.pn - 4) * BM + wc * 32 + 8 * fq;
#pragma unroll
        for (int ai = 0; ai < 2; ++ai)
#pragma unroll
            for (int m = 0; m < 4; ++m) { bf16_t* rowp = base + (size_t)(row0 + ai * HALF + m * 16) * ldc + col0;
#pragma unroll
                for (int bj = 0; bj < 2; ++bj) { const f32x4 v0 = acc[ai][bj][m][0], v1 = acc[ai][bj][m][1];
                    u32x4 w; w.x = cvt_pk_bf16(v0[0], v0[1]); w.y = cvt_pk_bf16(v0[2], v0[3]); w.z = cvt_pk_bf16(v1[0], v1[1]); w.w = cvt_pk_bf16(v1[2], v1[3]);
                    *(u32x4*)(rowp + bj * HALF) = w; } }
    }
};
}
__device__ __forceinline__ void phase_gategemm(Frame& F) {
    {
        pg8::Gemm g{(const bf16*)(F.ws + WS_XC), (const bf16*)(F.ws + FW_WGT), 512, 128, 128};
        pg8::GateOrder S; S.init(NTOK, 1024, F.G, (int)blockIdx.x);
        pg8::EpiLruGate E{F.ws};
        pg8::gemm_phase<pg8::EpiLruGate, pg8::GateOrder>(F.lds + RING_OFF, g, S, E, F.tid);
    }
}
__device__ __forceinline__ void phase_loragemm(Frame& F) {
    {
        pg8::Gemm g{(const bf16*)(F.ws + WS_ALORA), (const bf16*)(F.ws + FW_WLORAT), 256, 128, 128};
        pg8::LoraOrder S; S.init(NTOK, 1536, F.G, (int)blockIdx.x);
        pg8::EpiLoraStore E{(unsigned char*)F.out, F.ws};
        pg8::gemm_phase<pg8::EpiLoraStore, pg8::LoraOrder>(F.lds + RING_OFF, g, S, E, F.tid);
    }
}

__device__ __forceinline__ void phase_lrulocal(Frame& F) {
    const int gw = F.vcu * NWAVES + F.wave, NGW = F.G * NWAVES, lane = F.lane;
    {
        const bf16* GT = (const bf16*)(F.ws + WS_LOGA); bf16* GO = (bf16*)(F.ws + WS_LOGA); const bf16* XC = (const bf16*)(F.ws + WS_XC);
        float* LA = (float*)(F.ws + WS_LRUA); float* LB = (float*)(F.ws + WS_LRUB);
        for (int task = (F.wave < 4 ? F.vcu * 4 + F.wave : 1 << 30); task < 4 * 128 * 2; task += F.G * 4) { const int hq = task & 1, bc = task >> 1, ch = (4 * hq + (lane >> 4)) * 64 + 4 * (lane & 15);
            const f32x4 bav = *(const f32x4*)(F.in[9] + ch), biv = *(const f32x4*)(F.in[11] + ch), lam = *(const f32x4*)(F.in[12] + ch);
            f32x4 sp; sp.x = -8.f * softplusf_(-lam.x); sp.y = -8.f * softplusf_(-lam.y); sp.z = -8.f * softplusf_(-lam.z); sp.w = -8.f * softplusf_(-lam.w);
            const size_t m0 = (size_t)bc * 64; f32x4 sl = {0.f, 0.f, 0.f, 0.f}, hl = {0.f, 0.f, 0.f, 0.f};
#pragma unroll 1
            for (int t8 = 0; t8 < 64; t8 += 8) {
                v2u g0[8], g1[8], x8[8];
#pragma unroll
                for (int u = 0; u < 8; ++u) { const size_t m = m0 + t8 + u; g0[u] = *(const v2u*)(GT + m * 1024 + ch); g1[u] = *(const v2u*)(GT + m * 1024 + 512 + ch); x8[u] = *(const v2u*)(XC + m * 512 + ch); }
#pragma unroll
                for (int u = 0; u < 8; ++u) { const size_t m = m0 + t8 + u;
                    const f32x4 ra = {bflo(g0[u].x), bfhi(g0[u].x), bflo(g0[u].y), bfhi(g0[u].y)}, ia = {bflo(g1[u].x), bfhi(g1[u].x), bflo(g1[u].y), bfhi(g1[u].y)};
                    const f32x4 xc = {bflo(x8[u].x), bfhi(x8[u].x), bflo(x8[u].y), bfhi(x8[u].y)};
                    float la[4], bb[4];
#pragma unroll
                    for (int i = 0; i < 4; ++i) la[i] = sigmoidf_(ra[i] + bav[i]) * sp[i];
                    const unsigned l01 = pk2(la[0], la[1]), l23 = pk2(la[2], la[3]);
                    la[0] = bflo(l01); la[1] = bfhi(l01); la[2] = bflo(l23); la[3] = bfhi(l23);
#pragma unroll
                    for (int i = 0; i < 4; ++i) bb[i] = __builtin_amdgcn_sqrtf(fmaxf(1.f - fexp(2.f * la[i]), 0.f)) * (sigmoidf_(ia[i] + biv[i]) * xc[i]);
                    const unsigned b01 = pk2(bb[0], bb[1]), b23 = pk2(bb[2], bb[3]);
                    bb[0] = bflo(b01); bb[1] = bfhi(b01); bb[2] = bflo(b23); bb[3] = bfhi(b23);
                    v2u ol, ob; ol.x = l01; ol.y = l23; ob.x = b01; ob.y = b23;
                    *(v2u*)(GO + m * 1024 + ch) = ol; *(v2u*)(GO + m * 1024 + 512 + ch) = ob;
#pragma unroll
                    for (int i = 0; i < 4; ++i) { sl[i] += la[i]; hl[i] = fexp(la[i]) * hl[i] + bb[i]; } }
            }
            *(f32x4*)(LA + bc * 512 + ch) = sl; *(f32x4*)(LB + bc * 512 + ch) = hl; }
    }
}
typedef short bf16x8_t __attribute__((ext_vector_type(8)));
typedef float f32x16 __attribute__((ext_vector_type(16)));
typedef __bf16 bf16x2n_t __attribute__((ext_vector_type(2)));
typedef float f32x2c_t __attribute__((ext_vector_type(2)));
__device__ __forceinline__ unsigned pkbf(float a, float b) { f32x2c_t v = {a, b}; bf16x2n_t r = __builtin_convertvector(v, bf16x2n_t); return __builtin_bit_cast(unsigned, r); }
__device__ __forceinline__ bf16 bf1(float a) { return (bf16)(pkbf(a, 0.f) & 0xffffu); }
constexpr int U_AT = 0, U_RT = 4096, U_BT = 8192, U_KT = 12288, U_BH = 16384, U_KH = 20480, U_VT = 24576, U_LM = 28672, U_G31 = 32768, UNIT_LDS = 33024;
__device__ __forceinline__ int a64(int row, int col) { return row * 128 + (((col >> 3) ^ (row & 7)) << 4) + ((col & 7) << 1); }
__device__ __forceinline__ int a32(int row, int col) { return row * 64 + (((col >> 2) ^ ((row >> 2) & 7)) << 3) + ((col & 3) << 1); }
__device__ __forceinline__ int crow_(int i, int h) { return (i & 3) + 8 * (i >> 2) + 4 * h; }
#define MFMA32(a, b, c) __builtin_amdgcn_mfma_f32_32x32x16_bf16((a), (b), (c), 0, 0, 0)
__device__ __forceinline__ bf16x8_t pack8(const f32x16& x, int s) {
    v4u p; p.x = pkbf(x[8 * s], x[8 * s + 1]); p.y = pkbf(x[8 * s + 2], x[8 * s + 3]); p.z = pkbf(x[8 * s + 4], x[8 * s + 5]); p.w = pkbf(x[8 * s + 6], x[8 * s + 7]);
    return __builtin_bit_cast(bf16x8_t, p); }
__device__ __forceinline__ bf16x8_t ld2x8(const LAS unsigned char* p0, const LAS unsigned char* p1) {
    const v2u lo = *(const LAS v2u*)p0, hi = *(const LAS v2u*)p1; v4u p; p.x = lo.x; p.y = lo.y; p.z = hi.x; p.w = hi.y; return __builtin_bit_cast(bf16x8_t, p); }

__device__ __forceinline__ void phase_rwkvlocal_mfma(Frame& F) {
    int lane = F.lane; asm volatile("" : "+v"(lane));
    const int wave = F.wave, u4 = wave >> 1, wh = wave & 1;
    LAS unsigned char* ub = F.lds + RING_OFF + u4 * UNIT_LDS;
    const bf16* P = (const bf16*)(F.ws + WS_P); const bf16* LWA = (const bf16*)((const unsigned char*)F.out + DO_LWA);
    bf16* OLOC = (bf16*)(F.ws + WS_OLOC); bf16* QHAT = (bf16*)(F.ws + WS_QHAT); float* SB = (float*)(F.ws + WS_SB);
    const float* mu = F.in[14];
#pragma unroll 1
    for (int ui = F.vcu; ui < 256; ui += F.G) {
        const int unit = ui * 4 + u4, c = unit & 31, bhd = unit >> 5, hd = bhd & 7, b = bhd >> 3;
        const size_t m0 = (size_t)b * T + (size_t)c * 256;
        f32x16 S[2][2];
        { int r = lane & 31, h = lane >> 5; asm volatile("" : "+v"(r), "+v"(h));
#pragma unroll
        for (int jt = 0; jt < 2; ++jt)
#pragma unroll
            for (int kt = 0; kt < 2; ++kt)
#pragma unroll
                for (int i = 0; i < 16; ++i) S[jt][kt][i] = (wh == 0 && jt == kt && crow_(i, h) == r) ? 1.f : 0.f;
        }
#pragma unroll 1
        for (int sc = 0; sc < 8; ++sc) {
            const size_t ms = m0 + 32 * sc;
            {
                int lanep = lane; asm volatile("" : "+v"(lanep));
                const int ch = hd * 64 + lanep;
                const float mu_r = mu[ch], mu_k = mu[512 + ch], mu_v = mu[1024 + ch];
                const float w0v = F.in[15][ch], a0v = F.in[17][ch], kkv = F.in[20][ch], kav = F.in[21][ch], rkv = F.in[22][ch];
                const size_t mb = ms + 16 * wh;
                bf16 qr[16], qk[16], qv[16], qw[16], qa[16], lw16[16], p3[3] = {0, 0, 0};
                if ((mb % T) != 0) { const bf16* row = P + (mb - 1) * PW; p3[0] = row[C_R + ch]; p3[1] = row[C_K + ch]; p3[2] = row[C_V + ch]; }
#pragma unroll
                for (int u = 0; u < 16; ++u) { const size_t m = mb + u; const bf16* row = P + m * PW;
                    qr[u] = row[C_R + ch]; qk[u] = row[C_K + ch]; qv[u] = row[C_V + ch]; qw[u] = LWA[m * 1024 + ch]; qa[u] = LWA[m * 1024 + 512 + ch]; }
                if (wh) {
#pragma unroll
                    for (int t = 0; t < 16; ++t) lw16[t] = LWA[(ms + t) * 1024 + ch];
                }
                float cc = 0.f;
                if (wh) {
#pragma unroll
                    for (int t = 0; t < 16; ++t) { const float w = -flog(1.f + fexp(-(w0v + bf2f(lw16[t])))) - 0.5f; cc -= fexp(w); }
                }
                float pr = bf2f(p3[0]), pk = bf2f(p3[1]), pv = bf2f(p3[2]);
                float sbkeep = 0.f, gprev = fexp(cc);
                {
                    constexpr int t8 = 0;
#pragma unroll
                    for (int u = 0; u < 16; ++u) {
                        const int tt = t8 + u, t = 16 * wh + tt;
                        const float cr = bf2f(qr[u]), ck = bf2f(qk[u]), cv = bf2f(qv[u]);
                        const float lw = bf2f(qw[u]), la = bf2f(qa[u]);
                        const float rr = cr + (pr - cr) * mu_r, kx = ck + (pk - ck) * mu_k, v = cv + (pv - cv) * mu_v;
                        pr = cr; pk = ck; pv = cv;
                        const float w = -flog(1.f + fexp(-(w0v + lw))) - 0.5f;
                        cc -= fexp(w);
                        const float a = frcp(1.f + fexp(-(a0v + la)));
                        float kk = kx * kkv;
                        const float nrm = __builtin_amdgcn_sqrtf(wave_sum(kk * kk));
                        kk = kk * __builtin_amdgcn_rcpf(fmaxf(nrm, 1e-12f));
                        const float km = kx * (1.f + (a - 1.f) * kav);
                        const float sbv = wave_sum(rr * km * rkv);
                        if (lanep == tt) sbkeep = sbv;
                        const float gp = gprev, g = fexp(cc), ig = frcp(g);
                        gprev = g;
                        const float be = kk * a;
                        *(LAS bf16*)(ub + U_AT + a64(t, lanep)) = bf1(-kk * gp);
                        *(LAS bf16*)(ub + U_RT + a64(t, lanep)) = bf1(rr * g);
                        *(LAS bf16*)(ub + U_BT + a64(t, lanep)) = bf1(be * ig);
                        *(LAS bf16*)(ub + U_KT + a64(t, lanep)) = bf1(km * ig);
                        *(LAS bf16*)(ub + U_BH + a32(lanep, t)) = bf1(be * ig);
                        *(LAS bf16*)(ub + U_KH + a32(lanep, t)) = bf1(km * ig);
                        *(LAS bf16*)(ub + U_VT + a32(lanep, t)) = bf1(v);
                    }
                }
                if (lanep < 16) SB[(mb + lanep) * 8 + hd] = sbkeep;
                if (wh) *(LAS float*)(ub + U_G31 + lanep * 4) = gprev;
            }
            asm volatile("s_waitcnt lgkmcnt(0)" ::: "memory"); __builtin_amdgcn_s_barrier(); asm volatile("" ::: "memory");
            {
                int r = lane & 31, h = lane >> 5; asm volatile("" : "+v"(r), "+v"(h));
                bf16x8_t fT[2], fAk[2], fRb[2], fRk[2];
                {
                    f32x16 M, MT, R, RT;
#pragma unroll
                    for (int i = 0; i < 16; ++i) { M[i] = 0.f; MT[i] = 0.f; }
#pragma unroll
                    for (int ks = 0; ks < 4; ++ks) { const int o = a64(r, 16 * ks + 8 * h);
                        const bf16x8_t fb = *(const LAS bf16x8_t*)(ub + U_BT + o), fa = *(const LAS bf16x8_t*)(ub + U_AT + o);
                        M = MFMA32(fb, fa, M); MT = MFMA32(fa, fb, MT); }
#pragma unroll
                    for (int i = 0; i < 16; ++i) { const int q = crow_(i, h); M[i] = (q < r) ? M[i] : 0.f; MT[i] = (r < q) ? MT[i] : 0.f;
                        R[i] = M[i] + ((q == r) ? 1.f : 0.f); RT[i] = MT[i] + ((q == r) ? 1.f : 0.f); }
#pragma unroll
                    for (int lvl = 0; lvl < 4; ++lvl) {
                        bf16x8_t pm[2], pmt[2];
#pragma unroll
                        for (int ks = 0; ks < 2; ++ks) { pm[ks] = pack8(M, ks); pmt[ks] = pack8(MT, ks); }
                        f32x16 M2, MT2;
#pragma unroll
                        for (int i = 0; i < 16; ++i) { M2[i] = 0.f; MT2[i] = 0.f; }
#pragma unroll
                        for (int ks = 0; ks < 2; ++ks) { M2 = MFMA32(pmt[ks], pm[ks], M2); MT2 = MFMA32(pm[ks], pmt[ks], MT2); }
                        M = M2; MT = MT2;
                        bf16x8_t pr[2], prt[2];
#pragma unroll
                        for (int ks = 0; ks < 2; ++ks) { pm[ks] = pack8(M, ks); pr[ks] = pack8(R, ks); prt[ks] = pack8(RT, ks); }
#pragma unroll
                        for (int ks = 0; ks < 2; ++ks) { R = MFMA32(prt[ks], pm[ks], R); RT = MFMA32(pm[ks], prt[ks], RT); }
                        (void)pr;
                    }
#pragma unroll
                    for (int ks = 0; ks < 2; ++ks) fT[ks] = pack8(R, ks);
                }
                __builtin_amdgcn_sched_barrier(0);
                {
                    f32x16 Xak, Xrb, Xrk;
#pragma unroll
                    for (int i = 0; i < 16; ++i) { Xak[i] = 0.f; Xrb[i] = 0.f; Xrk[i] = 0.f; }
#pragma unroll
                    for (int ks = 0; ks < 4; ++ks) { const int o = a64(r, 16 * ks + 8 * h);
                        const bf16x8_t fb = *(const LAS bf16x8_t*)(ub + U_BT + o), fk = *(const LAS bf16x8_t*)(ub + U_KT + o);
                        const bf16x8_t fa = *(const LAS bf16x8_t*)(ub + U_AT + o), fr = *(const LAS bf16x8_t*)(ub + U_RT + o);
                        Xak = MFMA32(fk, fa, Xak); Xrb = MFMA32(fb, fr, Xrb); Xrk = MFMA32(fk, fr, Xrk); }
#pragma unroll
                    for (int i = 0; i < 16; ++i) { const int s = crow_(i, h); Xak[i] = (s < r) ? Xak[i] : 0.f; Xrb[i] = (s <= r) ? Xrb[i] : 0.f; Xrk[i] = (s <= r) ? Xrk[i] : 0.f; }
#pragma unroll
                    for (int ks = 0; ks < 2; ++ks) { fAk[ks] = pack8(Xak, ks); fRb[ks] = pack8(Xrb, ks); fRk[ks] = pack8(Xrk, ks); }
                }
#pragma unroll
                for (int jt = 0; jt < 2; ++jt) {
                    __builtin_amdgcn_sched_barrier(0);
                    bf16x8_t sf[2][2], vf[2];
#pragma unroll
                    for (int kt = 0; kt < 2; ++kt)
#pragma unroll
                        for (int ks = 0; ks < 2; ++ks) sf[kt][ks] = pack8(S[jt][kt], ks);
                    if (wh) {
#pragma unroll
                        for (int ks = 0; ks < 2; ++ks) vf[ks] = ld2x8(ub + U_VT + a32(32 * jt + r, 16 * ks + 4 * h), ub + U_VT + a32(32 * jt + r, 16 * ks + 8 + 4 * h));
                    }
                    f32x16 X1, Uu, Oo;
#pragma unroll
                    for (int i = 0; i < 16; ++i) { X1[i] = 0.f; Uu[i] = 0.f; Oo[i] = 0.f; }
#pragma unroll
                    for (int kt = 0; kt < 2; ++kt)
#pragma unroll
                        for (int ks = 0; ks < 2; ++ks) { const int c0 = 32 * kt + 16 * ks + 4 * h;
                            X1 = MFMA32(ld2x8(ub + U_AT + a64(r, c0), ub + U_AT + a64(r, c0 + 8)), sf[kt][ks], X1);
                            Oo = MFMA32(ld2x8(ub + U_RT + a64(r, c0), ub + U_RT + a64(r, c0 + 8)), sf[kt][ks], Oo); }
                    if (wh) {
#pragma unroll
                        for (int ks = 0; ks < 2; ++ks) { X1 = MFMA32(fAk[ks], vf[ks], X1); Oo = MFMA32(fRk[ks], vf[ks], Oo); }
                    }
                    __builtin_amdgcn_sched_barrier(0);
#pragma unroll
                    for (int ks = 0; ks < 2; ++ks) Uu = MFMA32(fT[ks], pack8(X1, ks), Uu);
                    bf16x8_t uf[2];
#pragma unroll
                    for (int ks = 0; ks < 2; ++ks) { uf[ks] = pack8(Uu, ks); Oo = MFMA32(fRb[ks], uf[ks], Oo); }
                    { bf16* dst = (wh ? OLOC : QHAT) + ms * 512 + hd * 64 + 32 * jt + r;
#pragma unroll
                      for (int i = 0; i < 16; ++i) dst[(size_t)crow_(i, h) * 512] = bf1(Oo[i]); }
                    __builtin_amdgcn_sched_barrier(0);
#pragma unroll
                    for (int kt = 0; kt < 2; ++kt) {
#pragma unroll
                        for (int ks = 0; ks < 2; ++ks) { const int k = 32 * kt + r, t0 = 16 * ks + 4 * h;
                            S[jt][kt] = MFMA32(ld2x8(ub + U_BH + a32(k, t0), ub + U_BH + a32(k, t0 + 8)), uf[ks], S[jt][kt]);
                            if (wh) S[jt][kt] = MFMA32(ld2x8(ub + U_KH + a32(k, t0), ub + U_KH + a32(k, t0 + 8)), vf[ks], S[jt][kt]); }
#pragma unroll
                        for (int g = 0; g < 4; ++g) { const f32x4 gg = *(const LAS f32x4*)(ub + U_G31 + (32 * kt + 8 * g + 4 * h) * 4);
                            S[jt][kt][4 * g] *= gg.x; S[jt][kt][4 * g + 1] *= gg.y; S[jt][kt][4 * g + 2] *= gg.z; S[jt][kt][4 * g + 3] *= gg.w; }
                    }
                }
            }
            asm volatile("s_waitcnt lgkmcnt(0)" ::: "memory"); __builtin_amdgcn_s_barrier(); asm volatile("" ::: "memory");
        }
        int r = lane & 31, h = lane >> 5; asm volatile("" : "+v"(r), "+v"(h));
        if (wh == 0) { bf16* PC = (bf16*)((unsigned char*)F.out + DO_PC) + (size_t)unit * 4096;
#pragma unroll
            for (int jt = 0; jt < 2; ++jt)
#pragma unroll
                for (int kt = 0; kt < 2; ++kt)
#pragma unroll
                    for (int i = 0; i < 16; ++i) PC[(32 * kt + crow_(i, h)) * 64 + 32 * jt + r] = bf1(S[jt][kt][i]);
        } else { bf16* QCT = (bf16*)((unsigned char*)F.out + DO_QCT) + (size_t)unit * 4096;
#pragma unroll
            for (int jt = 0; jt < 2; ++jt)
#pragma unroll
                for (int kt = 0; kt < 2; ++kt)
#pragma unroll
                    for (int g = 0; g < 4; ++g) { v2u o; o.x = pkbf(S[jt][kt][4 * g], S[jt][kt][4 * g + 1]); o.y = pkbf(S[jt][kt][4 * g + 2], S[jt][kt][4 * g + 3]);
                        *(v2u*)(QCT + (32 * jt + r) * 64 + 32 * kt + 8 * g + 4 * h) = o; }
        }
    }
}

__device__ __forceinline__ void rwkv_scan(Frame& F, int bh) {
    constexpr int LDT = 72;
    constexpr int SBUF = 64 * LDT;
    LAS bf16* S0 = (LAS bf16*)(F.lds + RING_OFF);
    const int lane = F.lane, w = F.wave, q = lane >> 4, l15 = lane & 15;
    for (int i = F.tid; i < 2 * SBUF; i += 512) S0[i] = 0;
    __syncthreads();
    if (w < 4) {
        const int tr = w;
        const bf16* PC = (const bf16*)((const unsigned char*)F.out + DO_PC) + (size_t)bh * 32 * 4096 + (16 * tr + l15) * 64 + 8 * q;
        const bf16* QCT = (const bf16*)((const unsigned char*)F.out + DO_QCT) + (size_t)bh * 32 * 4096 + l15 * 64 + 16 * tr + 4 * q;
        const int boff0 = l15 * LDT + 8 * q, woff0 = l15 * LDT + 16 * tr + 4 * q;
        bf16x8_t A[8][2]; v2u Qv[8][4];
#define SCAN_LOAD(s, cc) do { \
        asm volatile("global_load_dwordx4 %0, %1, off" : "=v"(A[s][0]) : "v"(PC + (size_t)(cc) * 4096) : "memory"); \
        asm volatile("global_load_dwordx4 %0, %1, off offset:64" : "=v"(A[s][1]) : "v"(PC + (size_t)(cc) * 4096) : "memory"); \
        asm volatile("global_load_dwordx2 %0, %1, off" : "=v"(Qv[s][0]) : "v"(QCT + (size_t)(cc) * 4096) : "memory"); \
        asm volatile("global_load_dwordx2 %0, %1, off offset:2048" : "=v"(Qv[s][1]) : "v"(QCT + (size_t)(cc) * 4096) : "memory"); \
        asm volatile("global_load_dwordx2 %0, %1, off" : "=v"(Qv[s][2]) : "v"(QCT + (size_t)(cc) * 4096 + 2048) : "memory"); \
        asm volatile("global_load_dwordx2 %0, %1, off offset:2048" : "=v"(Qv[s][3]) : "v"(QCT + (size_t)(cc) * 4096 + 2048) : "memory"); } while (0)
#pragma unroll
        for (int s = 0; s < 8; ++s) SCAN_LOAD(s, s);
#pragma unroll 1
        for (int c0 = 0; c0 < 32; c0 += 8) {
#pragma unroll
            for (int s = 0; s < 8; ++s) {
                const int c = c0 + s;
                const LAS bf16* Sr = S0 + (s & 1) * SBUF; LAS bf16* Sw = S0 + ((s & 1) ^ 1) * SBUF;
                asm volatile("s_waitcnt vmcnt(42)" : "+v"(A[s][0]), "+v"(A[s][1]), "+v"(Qv[s][0]), "+v"(Qv[s][1]), "+v"(Qv[s][2]), "+v"(Qv[s][3]) :: "memory");
                pg8::f32x4 acc[4];
#pragma unroll
                for (int t = 0; t < 4; ++t) { acc[t][0] = bflo(Qv[s][t].x); acc[t][1] = bfhi(Qv[s][t].x); acc[t][2] = bflo(Qv[s][t].y); acc[t][3] = bfhi(Qv[s][t].y); }
#pragma unroll
                for (int ks = 0; ks < 2; ++ks)
#pragma unroll
                    for (int t = 0; t < 4; ++t) {
                        const bf16x8_t bh_ = *(const LAS bf16x8_t*)(Sr + boff0 + 16 * LDT * t + 32 * ks);
                        acc[t] = __builtin_amdgcn_mfma_f32_16x16x32_bf16(A[s][ks], bh_, acc[t], 0, 0, 0);
                    }
                { const int cn = (c + 8 < 32) ? c + 8 : 31; SCAN_LOAD(s, cn); }
#pragma unroll
                for (int t = 0; t < 4; ++t) { v2u oh; oh.x = pg8::cvt_pk_bf16(acc[t][0], acc[t][1]); oh.y = pg8::cvt_pk_bf16(acc[t][2], acc[t][3]);
                    *(LAS v2u*)(Sw + woff0 + 16 * LDT * t) = oh; }
                asm volatile("s_waitcnt lgkmcnt(0)" ::: "memory"); __builtin_amdgcn_s_barrier(); asm volatile("" ::: "memory");
            }
        }
#undef SCAN_LOAD
        asm volatile("s_waitcnt vmcnt(0)" ::: "memory");
    } else {
        const int t256 = F.tid - 256;
        bf16* HIN = (bf16*)((unsigned char*)F.out + DO_HIN) + (size_t)bh * 32 * 4096 + (t256 >> 2) * 64 + (t256 & 3) * 16;
        const int hoff = (t256 >> 2) * LDT + (t256 & 3) * 16;
#pragma unroll 1
        for (int c = 0; c < 32; ++c) {
            const LAS bf16* Sr = S0 + (c & 1) * SBUF;
            const v4u x0 = *(const LAS v4u*)(Sr + hoff), x1 = *(const LAS v4u*)(Sr + hoff + 8);
            *(v4u*)(HIN + (size_t)c * 4096) = x0; *(v4u*)(HIN + (size_t)c * 4096 + 8) = x1;
            asm volatile("s_waitcnt lgkmcnt(0)" ::: "memory"); __builtin_amdgcn_s_barrier(); asm volatile("" ::: "memory");
        }
    }
}
__device__ __forceinline__ void phase_scan(Frame& F, int flags) {
    if ((flags & 4) && blockIdx.x >= 36) { expert_transposes(F, ((int)blockIdx.x - 36) * NWAVES + F.wave, ((int)F.G - 36) * NWAVES); }
    if ((flags & 2) && blockIdx.x < 32) rwkv_scan(F, blockIdx.x);
    if ((flags & 1) && blockIdx.x >= 32 && blockIdx.x < 36) {
        const int idx = (blockIdx.x - 32) * 512 + F.tid, b = idx >> 9, ch = idx & 511;
        const float* LA = (const float*)(F.ws + WS_LRUA); const float* LB = (const float*)(F.ws + WS_LRUB); float* LH = (float*)(F.ws + WS_LRUH);
        float h = 0.f;
#pragma unroll 1
        for (int c16 = 0; c16 < 128; c16 += 16) { float a16[16], b16[16];
#pragma unroll
            for (int u = 0; u < 16; ++u) { const int o = (b * 128 + c16 + u) * 512 + ch; a16[u] = LA[o]; b16[u] = LB[o]; }
#pragma unroll
            for (int u = 0; u < 16; ++u) { const int o = (b * 128 + c16 + u) * 512 + ch; LH[o] = h; h = fexp(a16[u]) * h + b16[u]; } }
    }
}

__device__ __forceinline__ void rwkv_post_unit(Frame& F, int unit) {
    int lane = F.lane; asm volatile("" : "+v"(lane));
    const int c = unit & 127, bh = unit >> 7, h = bh & 7, b = bh >> 3, q = lane >> 4, l15 = lane & 15;
    const size_t m0 = (size_t)b * T + (size_t)c * 64;
    const bf16* QHAT = (const bf16*)(F.ws + WS_QHAT); const bf16* OLOC = (const bf16*)(F.ws + WS_OLOC); const bf16* GG = (const bf16*)(F.ws + WS_GG);
    const bf16* HIN = (const bf16*)((const unsigned char*)F.out + DO_HIN) + (size_t)(bh * 32 + (c >> 2)) * 4096; const bf16* P = (const bf16*)(F.ws + WS_P);
    const float* SB = (const float*)(F.ws + WS_SB); bf16* YMIX = (bf16*)(F.ws + WS_YMIX);
    bf16x8_t Af[4][2];
#pragma unroll
    for (int jt = 0; jt < 4; ++jt)
#pragma unroll
        for (int ks = 0; ks < 2; ++ks) Af[jt][ks] = *(const bf16x8_t*)(HIN + (16 * jt + l15) * 64 + 32 * ks + 8 * q);
    f32x4 lnw[4], lnb[4], muv[4];
#pragma unroll
    for (int jt = 0; jt < 4; ++jt) { const int ch = h * 64 + 16 * jt + 4 * q; lnw[jt] = *(const f32x4*)(F.in[23] + ch); lnb[jt] = *(const f32x4*)(F.in[24] + ch); muv[jt] = *(const f32x4*)(F.in[14] + 1024 + ch); }
#pragma unroll 1
    for (int tt = 0; tt < 4; ++tt) {
        const size_t m = m0 + 16 * tt + l15;
        bf16x8_t Bf[2];
#pragma unroll
        for (int ks = 0; ks < 2; ++ks) Bf[ks] = *(const bf16x8_t*)(QHAT + m * 512 + h * 64 + 32 * ks + 8 * q);
        pg8::f32x4 acc[4];
#pragma unroll
        for (int jt = 0; jt < 4; ++jt) { const v2u o = *(const v2u*)(OLOC + m * 512 + h * 64 + 16 * jt + 4 * q); acc[jt][0] = bflo(o.x); acc[jt][1] = bfhi(o.x); acc[jt][2] = bflo(o.y); acc[jt][3] = bfhi(o.y); }
#pragma unroll
        for (int ks = 0; ks < 2; ++ks)
#pragma unroll
            for (int jt = 0; jt < 4; ++jt) acc[jt] = __builtin_amdgcn_mfma_f32_16x16x32_bf16(Af[jt][ks], Bf[ks], acc[jt], 0, 0, 0);
        float s = 0.f;
#pragma unroll
        for (int jt = 0; jt < 4; ++jt) s += (acc[jt][0] + acc[jt][1]) + (acc[jt][2] + acc[jt][3]);
        s += __shfl_xor(s, 16); s += __shfl_xor(s, 32);
        const float mean = s * (1.f / 64.f);
        float vs = 0.f;
#pragma unroll
        for (int jt = 0; jt < 4; ++jt)
#pragma unroll
            for (int i = 0; i < 4; ++i) { acc[jt][i] -= mean; vs += acc[jt][i] * acc[jt][i]; }
        vs += __shfl_xor(vs, 16); vs += __shfl_xor(vs, 32);
        const float rstd = rsqrtf(vs * (1.f / 64.f) + 64e-5f);
        const float sbv = SB[m * 8 + h];
        const bool first = ((m % T) == 0);
#pragma unroll
        for (int jt = 0; jt < 4; ++jt) { const int ch = h * 64 + 16 * jt + 4 * q;
            const v2u cvq = *(const v2u*)(P + m * PW + C_V + ch); v2u pvq = {0u, 0u}; if (!first) pvq = *(const v2u*)(P + (m - 1) * PW + C_V + ch);
            const v2u gq = *(const v2u*)(GG + m * 512 + ch);
            const float cv[4] = {bflo(cvq.x), bfhi(cvq.x), bflo(cvq.y), bfhi(cvq.y)}, pv[4] = {bflo(pvq.x), bfhi(pvq.x), bflo(pvq.y), bfhi(pvq.y)}, gg[4] = {bflo(gq.x), bfhi(gq.x), bflo(gq.y), bfhi(gq.y)};
            float y[4];
#pragma unroll
            for (int i = 0; i < 4; ++i) { const float v = cv[i] + (pv[i] - cv[i]) * muv[jt][i]; y[i] = (acc[jt][i] * rstd * lnw[jt][i] + lnb[jt][i] + sbv * v) * gg[i]; }
            v2u o; o.x = pk2(y[0], y[1]); o.y = pk2(y[2], y[3]);
            *(v2u*)(YMIX + m * D + 512 + ch) = o; }
    }
}
__device__ __forceinline__ void phase_post(Frame& F, int flags) {
    const int gw = F.vcu * NWAVES + F.wave, NGW = F.G * NWAVES, lane = F.lane;
    if (flags & 2) for (int unit = gw; unit < 4096; unit += NGW) rwkv_post_unit(F, unit);
    if (flags & 1) {
        const bf16* GT = (const bf16*)(F.ws + WS_LOGA); const bf16* P = (const bf16*)(F.ws + WS_P);
        const float* LH = (const float*)(F.ws + WS_LRUH); bf16* YMIX = (bf16*)(F.ws + WS_YMIX); const float* ng = F.in[13];
        for (int task = (F.wave < 4 ? F.vcu * 4 + F.wave : 1 << 30); task < 4 * 128 * 2; task += F.G * 4) { const int hq = task & 1, bc = task >> 1, ch = (4 * hq + (lane >> 4)) * 64 + 4 * (lane & 15);
            const size_t m0 = (size_t)bc * 64; f32x4 hl = *(const f32x4*)(LH + bc * 512 + ch); const f32x4 g = *(const f32x4*)(ng + ch);
#pragma unroll 1
            for (int t8 = 0; t8 < 64; t8 += 8) {
                v2u g0[8], g1[8], p8[8];
#pragma unroll
                for (int u = 0; u < 8; ++u) { const size_t m = m0 + t8 + u; g0[u] = *(const v2u*)(GT + m * 1024 + ch); g1[u] = *(const v2u*)(GT + m * 1024 + 512 + ch); p8[u] = *(const v2u*)(P + m * PW + C_GATE + ch); }
#pragma unroll
                for (int u = 0; u < 8; ++u) { const size_t m = m0 + t8 + u;
                    const f32x4 la = {bflo(g0[u].x), bfhi(g0[u].x), bflo(g0[u].y), bfhi(g0[u].y)}, bb = {bflo(g1[u].x), bfhi(g1[u].x), bflo(g1[u].y), bfhi(g1[u].y)};
                    const f32x4 gt = {bflo(p8[u].x), bfhi(p8[u].x), bflo(p8[u].y), bfhi(p8[u].y)};
                    f32x4 y;
#pragma unroll
                    for (int i = 0; i < 4; ++i) { hl[i] = fexp(la[i]) * hl[i] + bb[i]; y[i] = hl[i] * gelu_tanh(gt[i]); }
                    float ss = (y.x * y.x + y.y * y.y) + (y.z * y.z + y.w * y.w);
                    ss += __int_as_float(__builtin_amdgcn_update_dpp(0, __float_as_int(ss), 0xB1, 0xF, 0xF, true));
                    ss += __int_as_float(__builtin_amdgcn_update_dpp(0, __float_as_int(ss), 0x4E, 0xF, 0xF, true));
                    ss += __int_as_float(__builtin_amdgcn_update_dpp(0, __float_as_int(ss), 0x141, 0xF, 0xF, true));
                    ss += __int_as_float(__builtin_amdgcn_update_dpp(0, __float_as_int(ss), 0x140, 0xF, 0xF, true));
                    const float rs = rsqrtf(ss * (1.f / 64.f) + 1e-6f);
                    v2u o; o.x = pk2(y.x * rs * g.x, y.y * rs * g.y); o.y = pk2(y.z * rs * g.z, y.w * rs * g.w);
                    *(v2u*)(YMIX + m * D + ch) = o; }
            }
        }
    }
}

struct Args { const float* in[35]; float* out; unsigned char* ws; int ph_lo, ph_hi, flags, pad; };
__global__ void __launch_bounds__(NWAVES * 64, 2) mk_fwd(Args args) {
    extern __shared__ __attribute__((aligned(16))) unsigned char lds[];
    Frame F;
    F.lds = (LAS unsigned char*)lds;
    F.tid = threadIdx.x; F.lane = F.tid & 63; F.wave = __builtin_amdgcn_readfirstlane(F.tid >> 6);
    F.G = gridDim.x; { const int bx = blockIdx.x; F.vcu = (F.G % 8 == 0) ? (bx % 8) * (F.G / 8) + bx / 8 : bx; }
    F.in = args.in; F.out = args.out; F.ws = args.ws;
    const int lo = args.ph_lo, hi = args.ph_hi;
#define IN(k) (lo <= (k) && (k) < hi)
    const int flags = args.flags;
    for (int u = threadIdx.x; u < (LDS_BYTES - LDSCTL_OFF) / 4; u += NWAVES * 64) ((LAS unsigned*)(F.lds + LDSCTL_OFF))[u] = 0u;
    __syncthreads();
    XcdBarrier bar; bar.bar = (unsigned*)(args.ws + WS_CTL) + CW_BAR; bar.x = 0; bar.st = nullptr;
    if (hi - lo > 1) bar = xcd_barrier_post((unsigned*)(args.ws + WS_CTL) + CW_BAR, (volatile LAS unsigned*)(F.lds + MISC_OFF) + 8);
#define SEAM(k) if (IN(k) && IN((k) + 1)) xcd_barrier(bar);
#define PH1(k, call) { int t_ = threadIdx.x; asm volatile("" : "+v"(t_)); F.tid = t_; F.lane = t_ & 63; F.wave = __builtin_amdgcn_readfirstlane(t_ >> 6); call; }
#define PH(k, bit, call) if (IN(k)) { PH1(k, call) }
    PH(0, 0, (phase0(F), p0_small_weights(F)))
    SEAM(0)
    PH(1, 1, phase1(F))
    SEAM(1)
    PH(2, 2, phase2(F))
    SEAM(2)
    PH(3, 3, phase_prepA(F))
    SEAM(3)
    PH(4, 4, phase_gategemm(F))
    PH(4, 5, phase_loragemm(F))
    SEAM(4)
    PH(5, 30, phase_lrulocal(F))
    PH(5, 7, phase_rwkvlocal_mfma(F))
    SEAM(5)
    PH(6, 30, phase_scan(F, flags | 4))
    SEAM(6)
    PH(7, 9, phase_post(F, flags))
    SEAM(7)
    PH(8, 10, phase_outproj(F))
    SEAM(8)
    PH(9, 30, phase_route(F))
    SEAM(9)
    PH(10, 12, phase_m1(F))
    SEAM(10)
    PH(11, 13, phase_m2(F))
    SEAM(11)
    PH(12, 30, phase_final(F))
#undef SEAM
#undef PH
#undef PH1
#undef IN
}

extern "C" void kernel_launch(void* const* d_in, const int* in_sizes, int n_in, void* d_out, int out_size, void* d_ws, size_t ws_size, hipStream_t stream) {
    if (n_in != 35 || out_size != NTOK * D || ws_size < WS_END) { fprintf(stderr, "kernel_launch: unexpected shapes (n_in %d out %d ws %zu)\n", n_in, out_size, ws_size); return; }
    static int grid = 0;
    if (grid == 0) {
        int dev = 0, cus = 0;
        if (hipGetDevice(&dev) != hipSuccess || hipDeviceGetAttribute(&cus, hipDeviceAttributeMultiprocessorCount, dev) != hipSuccess) { grid = -1; return; }
        if (hipFuncSetAttribute((const void*)mk_fwd, hipFuncAttributeMaxDynamicSharedMemorySize, LDS_BYTES) != hipSuccess) { fprintf(stderr, "kernel_launch: hipFuncSetAttribute failed\n"); grid = -1; return; }
        int per_cu = 0;
        if (hipOccupancyMaxActiveBlocksPerMultiprocessor(&per_cu, (const void*)mk_fwd, NWAVES * 64, LDS_BYTES) != hipSuccess || per_cu < 1) { fprintf(stderr, "kernel_launch: occupancy query says %d blocks per CU\n", per_cu); (void)hipGetLastError(); }
        grid = cus;
        if (cus != 256) { fprintf(stderr, "kernel_launch: built for a 256-CU device (found %d CUs); nothing launched\n", cus); grid = -1; return; }
    }
    if (grid < 0) return;
    Args a{};
    for (int i = 0; i < 35; ++i) a.in[i] = (const float*)d_in[i];
    a.out = (float*)d_out; a.ws = (unsigned char*)d_ws; a.ph_lo = 0; a.ph_hi = 13; a.flags = 3;
    (void)hipMemsetAsync((char*)d_ws + WS_CTL, 0, 64 * 1024, stream);
    hipLaunchKernelGGL(mk_fwd, dim3(grid), dim3(NWAVES * 64), LDS_BYTES, stream, a);
}
```

```cpp
#include <hip/hip_runtime.h>
#include <stdint.h>
#include <cstdio>

typedef unsigned short bf16;
__device__ __forceinline__ bf16 f2bf(float f) { unsigned u = __float_as_uint(f); return (bf16)((u + 0x7fffu + ((u >> 16) & 1u)) >> 16); }
__device__ __forceinline__ float bf2f(bf16 b) { return __uint_as_float(((unsigned)b) << 16); }
__device__ __forceinline__ float bflo(unsigned u) { return __uint_as_float(u << 16); }
__device__ __forceinline__ float bfhi(unsigned u) { return __uint_as_float(u & 0xffff0000u); }

constexpr int NB = 4, T = 8192, D = 1024, NTOK = NB * T;
constexpr int LRU_W = 512, RW = 512, PW = 2816;
constexpr int C_UX = 0, C_GATE = 512, C_R = 1024, C_K = 1536, C_V = 2048, C_WD = 2560, C_AD = 2624, C_GD = 2688;
constexpr int NE = 32, DE = 512;
constexpr size_t MiB = 1u << 20;
constexpr size_t WS_CTL = 0;
constexpr int CW_BAR = 4096;
constexpr size_t WS_CNT = 32 * 1024;
constexpr size_t WS_MOD = 1 * MiB;
constexpr size_t WS_SELW = 384 * MiB;
constexpr size_t WS_SEL = 1 * MiB + 512 * 1024;
constexpr size_t FW_WLORAT = 2 * MiB;
constexpr size_t FW_WGT = 3 * MiB;
constexpr size_t FW_WR = 3 * MiB + 512 * 1024;
constexpr size_t FW_WINT = 4 * MiB;
constexpr size_t FW_WOUTT = 10 * MiB;
constexpr size_t WS_LIST = 12 * MiB;
constexpr size_t WS_H = 16 * MiB;
constexpr size_t WS_YMIX = WS_H;
constexpr size_t WS_P = 80 * MiB;
constexpr size_t WS_HID = WS_P;
constexpr size_t WS_Y = 152 * MiB;
constexpr size_t WS_YS = 256 * MiB;
constexpr size_t FW_W13T = 416 * MiB;
constexpr size_t FW_W2T = 480 * MiB;
constexpr size_t WS_END = 512 * MiB;

__device__ __forceinline__ float wave_sum(float v) {
    v += __int_as_float(__builtin_amdgcn_update_dpp(0, __float_as_int(v), 0xB1, 0xF, 0xF, true));
    v += __int_as_float(__builtin_amdgcn_update_dpp(0, __float_as_int(v), 0x4E, 0xF, 0xF, true));
    v += __int_as_float(__builtin_amdgcn_update_dpp(0, __float_as_int(v), 0x141, 0xF, 0xF, true));
    v += __int_as_float(__builtin_amdgcn_update_dpp(0, __float_as_int(v), 0x140, 0xF, 0xF, true));
    const int vi = __float_as_int(v);
    const float r0 = __int_as_float(__builtin_amdgcn_readlane(vi, 0)), r1 = __int_as_float(__builtin_amdgcn_readlane(vi, 16));
    const float r2 = __int_as_float(__builtin_amdgcn_readlane(vi, 32)), r3 = __int_as_float(__builtin_amdgcn_readlane(vi, 48));
    return (r0 + r1) + (r2 + r3);
}
__device__ __forceinline__ float fexp(float x) { return __builtin_amdgcn_exp2f(x * 1.44269504089f); }
__device__ __forceinline__ float flog(float x) { return __builtin_amdgcn_logf(x) * 0.69314718056f; }
__device__ __forceinline__ float frcp(float x) { return __builtin_amdgcn_rcpf(x); }
__device__ __forceinline__ float sigmoidf_(float x) { return frcp(1.f + fexp(-x)); }
__device__ __forceinline__ float softplusf_(float x) { return x > 20.f ? x : flog(1.f + fexp(x)); }
__device__ __forceinline__ float ftanh(float u) { return 1.f - 2.f * frcp(1.f + fexp(2.f * u)); }
__device__ __forceinline__ float gelu_tanh(float x) { const float u = 0.7978845608028654f * (x + 0.044715f * x * x * x); return 0.5f * x * (1.f + ftanh(u)); }

namespace pg8 {
#define PG8_LAS __attribute__((address_space(3)))
typedef unsigned short bf16_t;
typedef short bf16x8 __attribute__((ext_vector_type(8)));
typedef float f32x4 __attribute__((ext_vector_type(4)));
typedef unsigned u32x4 __attribute__((ext_vector_type(4)));
constexpr int BM = 256, BK = 64, HALF = 128, HTB = HALF * BK * 2  , STAGE_BYTES = 8 * HTB, NXCD = 8, WGM = 8;

__host__ __device__ __forceinline__ int lds_byte(int r, int c) { const int st = (r >> 4) * 2 + (c >> 5), rr = r & 15, cc = c & 31, ob = rr * 64 + cc * 2; return st * 1024 + (ob ^ (((ob >> 9) & 1) << 5)); }
__host__ __device__ __forceinline__ void stage_rc(int b, int& R, int& C) { const int st = b / 1024, sb = b % 1024, swz = sb ^ (((sb >> 9) & 1) << 5); R = (st >> 1) * 16 + swz / 64; C = (st & 1) * 32 + (swz % 64) / 2; }
__host__ __device__ __forceinline__ int perm32(int rho) { const int n = rho >> 4, i = rho & 15; return 8 * (i >> 2) + 4 * n + (i & 3); }

struct Unit { int pm, pn, e, nrows, row0; };
struct Gemm { const bf16_t* A; const bf16_t* Bt; int lda, ldb, K; };

__device__ __forceinline__ unsigned cvt_pk_bf16(float lo, float hi) { unsigned r; asm volatile("v_cvt_pk_bf16_f32 %0, %1, %2" : "=v"(r) : "v"(lo), "v"(hi)); return r; }

struct DenseOrder {
    static constexpr bool GATHER = false;
    int nM, nN, nwg, G, c;
    __device__ void init(int M, int N, int G_, int c_) { nM = M / BM; nN = N / BM; nwg = nM * nN; G = G_; c = c_; }
    __device__ bool next(int i, Unit& u) const {
        const long L = (long)i * G + c; if (L >= nwg) return false;
        int wgid = (int)L; { const int q = nwg / NXCD, r = nwg % NXCD, xcd = wgid % NXCD, off = wgid / NXCD; wgid = (xcd < r ? xcd * (q + 1) : r * (q + 1) + (xcd - r) * q) + off; }
        const int nig = WGM * nN, gid = wgid / nig, fm = gid * WGM, gsz = (nM - fm) < WGM ? (nM - fm) : WGM;
        u.pm = fm + ((wgid % nig) % gsz); u.pn = (wgid % nig) / gsz; u.e = 0; u.nrows = 256; u.row0 = 0; return true;
    }
    __device__ __forceinline__ const char* a_base(const Gemm& g, const Unit& u) const { return (const char*)g.A + (size_t)u.pm * (BM * 2) * g.lda; }
    __device__ __forceinline__ const char* b_base(const Gemm& g, const Unit& u) const { return (const char*)g.Bt + (size_t)u.pn * (BM * 2) * g.ldb; }
    __device__ __forceinline__ int row(const Unit&, int) const { return 0; }
};

template <class Epi, class Sched>
__device__ __forceinline__ void gemm_phase(PG8_LAS unsigned char* lds, const Gemm g, const Sched& S, const Epi& E, const int tid) {
    const int wid = __builtin_amdgcn_readfirstlane(tid >> 6), lane = tid & 63, wr = wid >> 2, wc = wid & 3, fr = lane & 15, fq = lane >> 4;
    const int K = g.K, nt = K / BK;
    unsigned voffA[2], voffB[2]; int sR[2], sC[2];
#pragma unroll
    for (int i = 0; i < 2; ++i) { int R, C; stage_rc(tid * 16 + i * 8192, R, C); const int Rb = Epi::PERM ? ((R & ~31) + perm32(R & 31)) : R;
        voffA[i] = (unsigned)(R * g.lda + C) * 2u; voffB[i] = (unsigned)(Rb * g.ldb + C) * 2u; sR[i] = R; sC[i] = C; }
    const size_t kstep = (size_t)(BK * 2);
    const size_t hstepA = Sched::GATHER ? 0 : (size_t)HALF * g.lda * 2, hstepB = (size_t)HALF * g.ldb * 2;
    const unsigned ldsw = (unsigned)wid * 1024u;
    const int aoff = lds_byte(wr * 64 + fr, fq * 8), boff = lds_byte(wc * 32 + fr, fq * 8);
    unsigned gA[2][2], gN[2][2];
#define PG8_SA(b, h) (((b) * 2 + (h)) * HTB)
#define PG8_SB(b, h) ((4 + (b) * 2 + (h)) * HTB)
#define PG8_STAGE(bufoff, gbase, voff) do { _Pragma("unroll") for (int _i = 0; _i < 2; ++_i) \
        __builtin_amdgcn_global_load_lds((const unsigned*)((const char*)(gbase) + (voff)[_i]), (PG8_LAS unsigned*)(lds + (bufoff) + ldsw + _i * 8192), 16, 0, 0); } while (0)
#define PG8_STAGE_A(bufoff, kp, h, OFF) do { if constexpr (Sched::GATHER) PG8_STAGE(bufoff, kp, OFF[h]); else PG8_STAGE(bufoff, (kp) + (h) * hstepA, voffA); } while (0)
#define PG8_LDA(dst, b, h) do { _Pragma("unroll") for (int m = 0; m < 4; ++m) _Pragma("unroll") for (int k = 0; k < 2; ++k) dst[m][k] = *(const PG8_LAS bf16x8*)(lds + PG8_SA(b, h) + aoff + m * 2048 + k * 1024); } while (0)
#define PG8_LDB(dst, b, h) do { _Pragma("unroll") for (int n = 0; n < 2; ++n) _Pragma("unroll") for (int k = 0; k < 2; ++k) dst[n][k] = *(const PG8_LAS bf16x8*)(lds + PG8_SB(b, h) + boff + n * 2048 + k * 1024); } while (0)
#define PG8_MMA(ai, bj, At, Bt) do { __builtin_amdgcn_s_setprio(1); _Pragma("unroll") for (int m = 0; m < 4; ++m) _Pragma("unroll") for (int n = 0; n < 2; ++n) _Pragma("unroll") for (int k = 0; k < 2; ++k) \
        acc[ai][bj][m][n] = __builtin_amdgcn_mfma_f32_16x16x32_bf16(Bt[n][k], At[m][k], acc[ai][bj][m][n], 0, 0, 0); __builtin_amdgcn_s_setprio(0); } while (0)
#define PG8_WAIT_V(n) asm volatile("s_waitcnt vmcnt(" #n ")" ::: "memory")
#define PG8_WAIT_L(n) asm volatile("s_waitcnt lgkmcnt(" #n ")" ::: "memory")
#define PG8_BAR __builtin_amdgcn_s_barrier()
#define PG8_SCHED __builtin_amdgcn_sched_barrier(0)
    Unit cur, nxt; int ui = 0;
    if (!S.next(0, cur)) return;
    f32x4 acc[2][2][4][2];
#pragma unroll
    for (int a = 0; a < 2; ++a)
#pragma unroll
        for (int b = 0; b < 2; ++b)
#pragma unroll
            for (int m = 0; m < 4; ++m)
#pragma unroll
                for (int n = 0; n < 2; ++n) acc[a][b][m][n] = (f32x4){0.f, 0.f, 0.f, 0.f};
    bf16x8 At[4][2], B0[2][2], B1[2][2];
    const char* cA = S.a_base(g, cur); const char* cB = S.b_base(g, cur);
    if constexpr (Sched::GATHER) {
#pragma unroll
        for (int h = 0; h < 2; ++h)
#pragma unroll
            for (int i = 0; i < 2; ++i) gA[h][i] = (unsigned)(S.row(cur, h * HALF + sR[i]) * g.lda + sC[i]) * 2u;
    }
    PG8_STAGE(PG8_SB(0, 0), cB, voffB); PG8_STAGE(PG8_SB(0, 1), cB + hstepB, voffB); PG8_STAGE_A(PG8_SA(0, 0), cA, 0, gA); PG8_STAGE_A(PG8_SA(0, 1), cA, 1, gA);
    if (wr == 1) PG8_BAR;
    PG8_WAIT_V(2); PG8_BAR;
    PG8_STAGE(PG8_SB(1, 0), cB + kstep, voffB); PG8_STAGE_A(PG8_SA(1, 0), cA + kstep, 0, gA); PG8_STAGE(PG8_SB(1, 1), cB + hstepB + kstep, voffB);
    PG8_WAIT_V(6); PG8_BAR;
    for (;;) {
        const bool has_next = S.next(ui + 1, nxt);
        const char* nA = has_next ? S.a_base(g, nxt) : cA; const char* nB = has_next ? S.b_base(g, nxt) : cB;
        if constexpr (Sched::GATHER) {
#pragma unroll
            for (int h = 0; h < 2; ++h)
#pragma unroll
                for (int i = 0; i < 2; ++i) gN[h][i] = has_next ? (unsigned)(S.row(nxt, h * HALF + sR[i]) * g.lda + sC[i]) * 2u : gA[h][i];
        }
#pragma unroll 1
        for (int t = 0; t < nt; t += 2) {
            const bool last = (t == nt - 2);
            const char* a1 = cA + (size_t)(t + 1) * kstep;
            const char* a2 = last ? nA : cA + (size_t)(t + 2) * kstep; const char* b2 = last ? nB : cB + (size_t)(t + 2) * kstep;
            const char* a3 = a2 + kstep; const char* b3 = b2 + kstep;
            unsigned o2[2][2];
            if constexpr (Sched::GATHER) {
#pragma unroll
                for (int h = 0; h < 2; ++h)
#pragma unroll
                    for (int i = 0; i < 2; ++i) o2[h][i] = last ? gN[h][i] : gA[h][i];
            }
            PG8_LDB(B0, 0, 0); PG8_LDB(B1, 0, 1); PG8_SCHED; PG8_LDA(At, 0, 0); PG8_STAGE_A(PG8_SA(1, 1), a1, 1, gA);
            PG8_WAIT_V(8); PG8_WAIT_L(0); PG8_BAR; PG8_MMA(0, 0, At, B0); PG8_MMA(0, 1, At, B1); PG8_BAR; PG8_SCHED;
            PG8_LDA(At, 0, 1); PG8_STAGE(PG8_SB(0, 0), b2, voffB); PG8_STAGE(PG8_SB(0, 1), b2 + hstepB, voffB); PG8_STAGE_A(PG8_SA(0, 0), a2, 0, o2);
            PG8_WAIT_V(8); PG8_WAIT_L(0); PG8_BAR; PG8_MMA(1, 0, At, B0); PG8_MMA(1, 1, At, B1); PG8_BAR; PG8_SCHED;
            PG8_LDB(B0, 1, 0); PG8_LDB(B1, 1, 1); PG8_SCHED; PG8_LDA(At, 1, 0); PG8_STAGE_A(PG8_SA(0, 1), a2, 1, o2);
            PG8_WAIT_V(8); PG8_WAIT_L(0); PG8_BAR; PG8_MMA(0, 0, At, B0); PG8_MMA(0, 1, At, B1); PG8_BAR; PG8_SCHED;
            PG8_LDA(At, 1, 1); PG8_STAGE(PG8_SB(1, 0), b3, voffB); PG8_STAGE(PG8_SB(1, 1), b3 + hstepB, voffB); PG8_STAGE_A(PG8_SA(1, 0), a3, 0, o2);
            PG8_WAIT_V(8); PG8_WAIT_L(0); PG8_BAR; PG8_MMA(1, 0, At, B0); PG8_MMA(1, 1, At, B1); PG8_BAR; PG8_SCHED;
        }
        if (wr == 0) PG8_BAR;
        E(acc, cur, wr, wc, fr, fq);
        if (!has_next) break;
#pragma unroll
        for (int a = 0; a < 2; ++a)
#pragma unroll
            for (int b = 0; b < 2; ++b)
#pragma unroll
                for (int m = 0; m < 4; ++m)
#pragma unroll
                    for (int n = 0; n < 2; ++n) acc[a][b][m][n] = (f32x4){0.f, 0.f, 0.f, 0.f};
        cur = nxt; cA = nA; cB = nB; ++ui;
        if constexpr (Sched::GATHER) {
#pragma unroll
            for (int h = 0; h < 2; ++h)
#pragma unroll
                for (int i = 0; i < 2; ++i) gA[h][i] = gN[h][i];
        }
        if (wr == 1) PG8_BAR;
    }
    PG8_WAIT_V(0);
    PG8_BAR;
#undef PG8_SA
#undef PG8_SB
#undef PG8_STAGE
#undef PG8_STAGE_A
#undef PG8_LDA
#undef PG8_LDB
#undef PG8_MMA
#undef PG8_WAIT_V
#undef PG8_WAIT_L
#undef PG8_BAR
#undef PG8_SCHED
}

struct EpiBf16Store {
    static constexpr bool PERM = true;
    bf16_t* O; int ldc;
    __device__ __forceinline__ void operator()(const f32x4 (&acc)[2][2][4][2], const Unit& u, int wr, int wc, int fr, int fq) const {
        const int row0 = u.pm * BM + wr * 64 + fr, col0 = u.pn * BM + wc * 32 + 8 * fq;
#pragma unroll
        for (int ai = 0; ai < 2; ++ai)
#pragma unroll
            for (int m = 0; m < 4; ++m) { bf16_t* rowp = O + (size_t)(row0 + ai * HALF + m * 16) * ldc + col0;
#pragma unroll
                for (int bj = 0; bj < 2; ++bj) { const f32x4 v0 = acc[ai][bj][m][0], v1 = acc[ai][bj][m][1];
                    u32x4 w; w.x = cvt_pk_bf16(v0[0], v0[1]); w.y = cvt_pk_bf16(v0[2], v0[3]); w.z = cvt_pk_bf16(v1[0], v1[1]); w.w = cvt_pk_bf16(v1[2], v1[3]);
                    *(u32x4*)(rowp + bj * HALF) = w; } }
    }
};
}
constexpr int NWAVES = 8;
constexpr int RING_OFF = 0, RING_BYTES = 131072;
constexpr int ROUTER_LDS = 147456;
constexpr int LDSCTL_OFF = ROUTER_LDS, MISC_OFF = LDSCTL_OFF + 320;
constexpr int LDS_TAB_OFF = LDSCTL_OFF + 1024;
constexpr int LDS_BYTES = 155648;

#define GAS __attribute__((address_space(1)))
#define LAS __attribute__((address_space(3)))
typedef unsigned v4u __attribute__((ext_vector_type(4)));
typedef unsigned v2u __attribute__((ext_vector_type(2)));
typedef float f32x4 __attribute__((ext_vector_type(4)));
#define LDS_WAIT() asm volatile("s_waitcnt lgkmcnt(0)" ::: "memory")
#define VM_WAIT() asm volatile("s_waitcnt vmcnt(0)" ::: "memory")
__device__ __forceinline__ unsigned pk2(float lo, float hi) { return (unsigned)f2bf(lo) | ((unsigned)f2bf(hi) << 16); }


struct Frame {
    LAS unsigned char* lds;
    int tid, lane, wave, vcu, G;
    const float* const* in;
    float* out; unsigned char* ws;
};

__device__ __forceinline__ void p0_transpose_item(const float* W, int ldw, bf16* WT, int ldt, int k0, int n0, int row0, LAS float* scr, int lane) {
    {
        f32x4 t[8];
#pragma unroll
        for (int i = 0; i < 8; ++i) t[i] = *(const f32x4*)(W + (size_t)(k0 + 8 * i + (lane >> 3)) * ldw + n0 + 4 * (lane & 7));
#pragma unroll
        for (int i = 0; i < 8; ++i) { LAS float* d = scr + (8 * i + (lane >> 3)) * 33 + 4 * (lane & 7); d[0] = t[i].x; d[1] = t[i].y; d[2] = t[i].z; d[3] = t[i].w; }
    }
    LDS_WAIT(); asm volatile("" ::: "memory");
    const int c = lane & 7;
#pragma unroll
    for (int j = 0; j < 4; ++j) { const int n = (lane >> 3) + 8 * j; const LAS float* s = scr + (8 * c) * 33 + n;
        v4u o; o.x = pk2(s[0 * 33], s[1 * 33]); o.y = pk2(s[2 * 33], s[3 * 33]); o.z = pk2(s[4 * 33], s[5 * 33]); o.w = pk2(s[6 * 33], s[7 * 33]);
        *(v4u*)(WT + (size_t)(row0 + n) * ldt + k0 + 8 * c) = o; }
    LDS_WAIT(); asm volatile("" ::: "memory");
}

__device__ __forceinline__ void p0_mod_task(Frame& F, int task) {
    LAS float* sc = (LAS float*)(F.lds);
    LAS float* red = (LAS float*)(F.lds + 16384);
    const float* c = F.in[1]; const float* w_ada = F.in[2]; const float* b_ada = F.in[3];
    for (int i = F.tid; i < 4096; i += 512) { const float cv = c[i]; sc[i] = cv / (1.f + __expf(-cv)); }
    __syncthreads();
    const int j = task * 32 + (F.lane & 31);
    float a0 = 0.f, a1 = 0.f, a2 = 0.f, a3 = 0.f;
    const int kb = F.wave * 128 + (F.lane >> 5) * 64;
#pragma unroll 16
    for (int k = kb; k < kb + 64; ++k) { const float w = w_ada[(size_t)k * 6144 + j]; a0 += sc[k] * w; a1 += sc[1024 + k] * w; a2 += sc[2048 + k] * w; a3 += sc[3072 + k] * w; }
    red[(F.wave * 4 + 0) * 64 + F.lane] = a0; red[(F.wave * 4 + 1) * 64 + F.lane] = a1; red[(F.wave * 4 + 2) * 64 + F.lane] = a2; red[(F.wave * 4 + 3) * 64 + F.lane] = a3;
    __syncthreads();
    if (F.tid < 128) { const int b = F.tid >> 5, l = F.tid & 31; float s = 0.f;
#pragma unroll
        for (int w = 0; w < 8; ++w) s += red[(w * 4 + b) * 64 + l] + red[(w * 4 + b) * 64 + 32 + l];
        ((float*)(F.ws + WS_MOD))[b * 6144 + task * 32 + l] = s + b_ada[task * 32 + l]; }
    __syncthreads();
}

__device__ __forceinline__ void phase0(Frame& F) {
    if (blockIdx.x < 192) p0_mod_task(F, blockIdx.x);
    LAS float* scr = (LAS float*)(F.lds + RING_OFF + F.wave * 16384);
    const int gw = F.vcu * NWAVES + F.wave, NGW = F.G * NWAVES;
    constexpr int I_IN = (D / 64) * (PW / 32), I_OUT = (D / 64) * (D / 32);
    constexpr int NITEMS = I_IN + I_OUT;
    for (int it = gw; it < NITEMS; it += NGW) {
        int r = it;
        if (r < I_IN) { const int nb = PW / 32, kb = r / nb, n = r % nb; p0_transpose_item(F.in[5], PW, (bf16*)(F.ws + FW_WINT), D, 64 * kb, 32 * n, 32 * n, scr, F.lane); continue; } r -= I_IN;
        { const int nb = D / 32, kb = r / nb, n = r % nb; p0_transpose_item(F.in[25], D, (bf16*)(F.ws + FW_WOUTT), D, 64 * kb, 32 * n, 32 * n, scr, F.lane); }
    }
}
__device__ __forceinline__ void expert_transposes(Frame& F, int wv, int nwv) {
    LAS float* scr = (LAS float*)(F.lds + RING_OFF + F.wave * 16384);
    constexpr int I_E13 = NE * 2 * 256, I_E2 = NE * 256;
    for (int it = wv; it < I_E13 + I_E2; it += nwv) {
        int r = it;
        if (r < I_E13) {
            const int e = r >> 9, which = (r >> 8) & 1, q = r & 255, kb = q >> 4, n = q & 15, n0 = 32 * n;
            const float* W = (which ? F.in[32] : F.in[31]) + (size_t)e * D * DE;
            p0_transpose_item(W, DE, (bf16*)(F.ws + FW_W13T) + (size_t)e * 1024 * 1024, D, 64 * kb, n0, (n0 >> 7) * 256 + which * 128 + (n0 & 127), scr, F.lane); continue; } r -= I_E13;
        {
            const int e = r >> 8, q = r & 255, kb = q >> 5, n = q & 31;
            p0_transpose_item(F.in[33] + (size_t)e * DE * D, D, (bf16*)(F.ws + FW_W2T) + (size_t)e * 1024 * DE, DE, 64 * kb, 32 * n, 32 * n, scr, F.lane); }
    }
}

__device__ __forceinline__ void adaln_row(const float* xrow, const float* g, const float* sh, const float* sc, bf16* orow, int lane) {
    const f32x4* xr = (const f32x4*)xrow + lane;
    f32x4 v[4]; float s = 0.f;
#pragma unroll
    for (int j = 0; j < 4; ++j) { v[j] = xr[64 * j]; s += (v[j].x * v[j].x + v[j].y * v[j].y) + (v[j].z * v[j].z + v[j].w * v[j].w); }
    const float rinv = rsqrtf(wave_sum(s) * (1.f / D) + 1e-6f);
    v2u* o8 = (v2u*)orow + lane;
#pragma unroll
    for (int j = 0; j < 4; ++j) { const f32x4 gg = ((const f32x4*)g)[lane + 64 * j], s1 = ((const f32x4*)sc)[lane + 64 * j], s0 = ((const f32x4*)sh)[lane + 64 * j];
        f32x4 y = v[j] * rinv * gg; y = y * (s1 + 1.f) + s0;
        v2u w; w.x = pk2(y.x, y.y); w.y = pk2(y.z, y.w); o8[64 * j] = w; }
}
__device__ __forceinline__ void phase1(Frame& F) {
    const int gw = F.vcu * NWAVES + F.wave, NGW = F.G * NWAVES;
    const float* mod = (const float*)(F.ws + WS_MOD);
    for (int m = gw; m < NTOK; m += NGW) { const int b = m / T;
        adaln_row(F.in[0] + (size_t)m * D, F.in[4], mod + b * 6144, mod + b * 6144 + 1024, (bf16*)(F.ws + WS_H) + (size_t)m * D, F.lane); }
}
__device__ __forceinline__ void phase2(Frame& F) {
    pg8::Gemm g{(const bf16*)(F.ws + WS_H), (const bf16*)(F.ws + FW_WINT), D, D, D};
    pg8::DenseOrder S; S.init(NTOK, PW, F.G, (int)blockIdx.x);
    pg8::EpiBf16Store E{(bf16*)(F.ws + WS_P), PW};
    pg8::gemm_phase<pg8::EpiBf16Store, pg8::DenseOrder>(F.lds + RING_OFF, g, S, E, F.tid);
}


namespace pg8 {
struct EpiX1F {
    static constexpr bool PERM = true;
    const float* const* in; unsigned char* ws; float* out;
    __device__ __forceinline__ void operator()(const f32x4 (&acc)[2][2][4][2], const Unit& u, int wr, int wc, int fr, int fq) const {
        const float* mod = (const float*)(ws + WS_MOD); bf16_t* Y = (bf16_t*)(ws + WS_Y);
        const int row0 = u.pm * BM + wr * 64 + fr, col0 = u.pn * BM + wc * 32 + 8 * fq;
        const float* g1 = mod + ((u.pm * BM) / T) * 6144 + 2048;
        f32x4 gv[2][2];
#pragma unroll
        for (int bj = 0; bj < 2; ++bj)
#pragma unroll
            for (int n = 0; n < 2; ++n) gv[bj][n] = *(const f32x4*)(g1 + col0 + bj * HALF + n * 4);
#pragma unroll
        for (int ai = 0; ai < 2; ++ai)
#pragma unroll
            for (int m = 0; m < 4; ++m) { bf16_t* rowp = Y + (size_t)(row0 + ai * HALF + m * 16) * D + col0;
#pragma unroll
                for (int bj = 0; bj < 2; ++bj) { const f32x4 v0 = acc[ai][bj][m][0] * gv[bj][0], v1 = acc[ai][bj][m][1] * gv[bj][1];
                    u32x4 w; w.x = cvt_pk_bf16(v0[0], v0[1]); w.y = cvt_pk_bf16(v0[2], v0[3]); w.z = cvt_pk_bf16(v1[0], v1[1]); w.w = cvt_pk_bf16(v1[2], v1[3]);
                    *(u32x4*)(rowp + bj * HALF) = w; } }
    }
};
template <bool GATH> struct MoeOrder {
    static constexpr bool GATHER = GATH;
    const LAS int* ub; const LAS int* rb; const LAS int* cn; const int* list; int G, c, brows;
    __device__ bool next(int i, Unit& u) const {
        int e, local;
        if ((G & 7) == 0) {
            const int x = c & 7, L = i * (G >> 3) + (c >> 3); const LAS int* xb = ub + 98 + x * 5;
            if (L >= xb[4]) return false;
            int j = 0;
#pragma unroll
            for (int k = 2; k >= 1; k >>= 1) if (xb[j + k] <= L) j += k;
            e = x + 8 * j; local = L - xb[j];
        } else {
            const int L = i * G + c; if (L >= ub[32]) return false;
            e = 0;
#pragma unroll
            for (int k = 16; k >= 1; k >>= 1) if (ub[e + k] <= L) e += k;
            local = L - ub[e];
        }
        const int tiles = rb[e + 1] - rb[e], pn = local / tiles, mt = local - pn * tiles;
        u.e = e; u.pn = pn; u.pm = rb[e] + mt; u.row0 = e * NTOK + mt * 256; u.nrows = min(256, cn[e] - mt * 256); return true;
    }
    __device__ __forceinline__ const char* a_base(const Gemm& g, const Unit& u) const { return GATH ? (const char*)g.A : (const char*)g.A + (size_t)u.pm * (BM * 2) * g.lda; }
    __device__ __forceinline__ const char* b_base(const Gemm& g, const Unit& u) const { return (const char*)g.Bt + ((size_t)u.e * brows + (size_t)u.pn * BM) * 2 * g.ldb; }
    __device__ __forceinline__ int row(const Unit& u, int r) const { return r < u.nrows ? (list[u.row0 + r] >> 1) : 0; }
};
struct EpiSwiglu {
    static constexpr bool PERM = true;
    bf16_t* HID;
    __device__ __forceinline__ void operator()(const f32x4 (&acc)[2][2][4][2], const Unit& u, int wr, int wc, int fr, int fq) const {
        const int col0 = u.pn * HALF + wc * 32 + 8 * fq;
#pragma unroll
        for (int ai = 0; ai < 2; ++ai)
#pragma unroll
            for (int m = 0; m < 4; ++m) { const int r = ai * HALF + wr * 64 + m * 16 + fr;
                if (r < u.nrows) { float h[8];
#pragma unroll
                    for (int n = 0; n < 2; ++n)
#pragma unroll
                        for (int i = 0; i < 4; ++i) { const float a = acc[ai][0][m][n][i], b = acc[ai][1][m][n][i]; h[n * 4 + i] = a * frcp(1.f + fexp(-a)) * b; }
                    u32x4 w; w.x = cvt_pk_bf16(h[0], h[1]); w.y = cvt_pk_bf16(h[2], h[3]); w.z = cvt_pk_bf16(h[4], h[5]); w.w = cvt_pk_bf16(h[6], h[7]);
                    *(u32x4*)(HID + (size_t)(u.pm * BM + r) * DE + col0) = w; } }
    }
};
struct EpiYs {
    static constexpr bool PERM = true;
    unsigned char* ws;
    __device__ __forceinline__ void operator()(const f32x4 (&acc)[2][2][4][2], const Unit& u, int wr, int wc, int fr, int fq) const {
        bf16_t* YS = (bf16_t*)(ws + WS_YS); const int* list = (const int*)(ws + WS_LIST); const float* selw = (const float*)(ws + WS_SELW);
        const int col0 = u.pn * BM + wc * 32 + 8 * fq;
#pragma unroll
        for (int ai = 0; ai < 2; ++ai)
#pragma unroll
            for (int m = 0; m < 4; ++m) { const int r = ai * HALF + wr * 64 + m * 16 + fr;
                if (r < u.nrows) { const int li = list[u.row0 + r]; const float w8 = selw[u.row0 + r]; bf16_t* rowp = YS + (size_t)li * D + col0;
#pragma unroll
                    for (int bj = 0; bj < 2; ++bj) { const f32x4 v0 = acc[ai][bj][m][0] * w8, v1 = acc[ai][bj][m][1] * w8;
                        u32x4 w; w.x = cvt_pk_bf16(v0[0], v0[1]); w.y = cvt_pk_bf16(v0[2], v0[3]); w.z = cvt_pk_bf16(v1[0], v1[1]); w.w = cvt_pk_bf16(v1[2], v1[3]);
                        *(u32x4*)(rowp + bj * HALF) = w; } } }
    }
};
}

__device__ __forceinline__ void phase_outproj(Frame& F) {
    pg8::Gemm g{(const bf16*)(F.ws + WS_YMIX), (const bf16*)(F.ws + FW_WOUTT), D, D, D};
    pg8::DenseOrder S; S.init(NTOK, D, F.G, (int)blockIdx.x);
    pg8::EpiX1F E{F.in, F.ws, F.out};
    pg8::gemm_phase<pg8::EpiX1F, pg8::DenseOrder>(F.lds + RING_OFF, g, S, E, F.tid);
}

__device__ __forceinline__ void phase_route(Frame& F) {
    LAS float* wt = (LAS float*)F.lds;
    { const f32x4* WR = (const f32x4*)(F.ws + FW_WR); LAS f32x4* wt4 = (LAS f32x4*)F.lds;
      for (int i = F.tid; i < 36 * 256; i += 512) wt4[i] = WR[i]; }
    __syncthreads();
    const float* mod = (const float*)(F.ws + WS_MOD); const float* g2n = F.in[26];
    int* cnt = (int*)(F.ws + WS_CNT); int* list = (int*)(F.ws + WS_LIST); float* selw = (float*)(F.ws + WS_SELW);
    bf16* H2 = (bf16*)(F.ws + WS_H);
    const int gw = F.vcu * NWAVES + F.wave, NGW = F.G * NWAVES, lane = F.lane;
    LAS int* lcnt = (LAS int*)(F.lds + LDSCTL_OFF + 2048); LAS int* lbase = lcnt + 32; LAS int* tokres = lcnt + 64; LAS float* tokw = (LAS float*)(tokres + 256);
    if (F.tid < 32) lcnt[F.tid] = 0;
    __syncthreads();
    int it = 0;
    const float* xin = F.in[0]; const bf16* Yb = (const bf16*)(F.ws + WS_Y);
    f32x4 vn[4]; v2u yn[4];
#pragma unroll
    for (int j = 0; j < 4; ++j) { vn[j] = ((const f32x4*)(xin + (size_t)gw * D) + lane)[64 * j]; yn[j] = ((const v2u*)(Yb + (size_t)gw * D) + lane)[64 * j]; }
    f32x4 ggr[4], s1r[4], s0r[4]; int bcur = -1;
#pragma unroll
    for (int j = 0; j < 4; ++j) ggr[j] = ((const f32x4*)g2n)[lane + 64 * j];
    for (int m = gw; m < NTOK; m += NGW, ++it) {
        const int b = m / T;
        if (b != bcur) { bcur = b;
#pragma unroll
            for (int j = 0; j < 4; ++j) { s1r[j] = ((const f32x4*)(mod + b * 6144 + 4096))[lane + 64 * j] + 1.f; s0r[j] = ((const f32x4*)(mod + b * 6144 + 3072))[lane + 64 * j]; } }
        f32x4 v[4]; float s = 0.f;
#pragma unroll
        for (int j = 0; j < 4; ++j) { v[j] = vn[j]; v[j].x += bflo(yn[j].x); v[j].y += bfhi(yn[j].x); v[j].z += bflo(yn[j].y); v[j].w += bfhi(yn[j].y);
            s += (v[j].x * v[j].x + v[j].y * v[j].y) + (v[j].z * v[j].z + v[j].w * v[j].w); }
        if (m + NGW < NTOK) {
#pragma unroll
            for (int j = 0; j < 4; ++j) { vn[j] = ((const f32x4*)(xin + (size_t)(m + NGW) * D) + lane)[64 * j]; yn[j] = ((const v2u*)(Yb + (size_t)(m + NGW) * D) + lane)[64 * j]; }
        }
        const float rinv = rsqrtf(wave_sum(s) * (1.f / D) + 1e-6f);
        v2u* o8 = (v2u*)(H2 + (size_t)m * D) + lane;
#pragma unroll
        for (int j = 0; j < 4; ++j) { f32x4 y = v[j] * rinv * ggr[j]; y = y * s1r[j] + s0r[j]; v[j] = y;
            v2u w; w.x = pk2(y.x, y.y); w.y = pk2(y.z, y.w); o8[64 * j] = w; }
        float pg[4] = {0.f, 0.f, 0.f, 0.f};
#pragma unroll
        for (int j = 0; j < 4; ++j)
#pragma unroll
            for (int e = 0; e < 4; ++e) { const f32x4 w = *(const LAS f32x4*)(wt + e * 1024 + lane * 4 + 256 * j); pg[e] += (v[j].x * w.x + v[j].y * w.y) + (v[j].z * w.z + v[j].w * w.w); }
        const f32x4 bg = *(const f32x4*)F.in[28];
        const float g0 = wave_sum(pg[0]) + bg.x, g1 = wave_sum(pg[1]) + bg.y, g2 = wave_sum(pg[2]) + bg.z, g3 = wave_sum(pg[3]) + bg.w;
        float gm = g0; int gi = 0;
        if (g1 > gm) { gm = g1; gi = 1; } if (g2 > gm) { gm = g2; gi = 2; } if (g3 > gm) { gm = g3; gi = 3; }
        const float gwt = frcp(fexp(g0 - gm) + fexp(g1 - gm) + fexp(g2 - gm) + fexp(g3 - gm));
        gi = __builtin_amdgcn_readfirstlane(gi);
        const LAS float* we = wt + (4 + gi * 8) * 1024 + lane * 4;
        const f32x4 be0 = *(const f32x4*)(F.in[30] + gi * 8), be1 = *(const f32x4*)(F.in[30] + gi * 8 + 4);
        float xe[8];
#pragma unroll
        for (int hf = 0; hf < 2; ++hf) { float pe[4] = {0.f, 0.f, 0.f, 0.f};
#pragma unroll
            for (int j = 0; j < 4; ++j)
#pragma unroll
                for (int e = 0; e < 4; ++e) { const f32x4 w = *(const LAS f32x4*)(we + (hf * 4 + e) * 1024 + 256 * j); pe[e] += (v[j].x * w.x + v[j].y * w.y) + (v[j].z * w.z + v[j].w * w.w); }
#pragma unroll
            for (int e = 0; e < 4; ++e) xe[hf * 4 + e] = wave_sum(pe[e]); }
        xe[0] += be0.x; xe[1] += be0.y; xe[2] += be0.z; xe[3] += be0.w; xe[4] += be1.x; xe[5] += be1.y; xe[6] += be1.z; xe[7] += be1.w;
        float v1 = xe[0], v2 = -3.4e38f; int i1 = 0, i2 = 0;
#pragma unroll
        for (int ii = 1; ii < 8; ++ii) { const float xx = xe[ii]; const bool a1 = xx > v1, a2 = xx > v2;
            v2 = a1 ? v1 : (a2 ? xx : v2); i2 = a1 ? i1 : (a2 ? ii : i2); v1 = a1 ? xx : v1; i1 = a1 ? ii : i1; }
        const float e2 = fexp(v2 - v1), w1 = frcp(1.f + e2), w2 = e2 * w1;
        if (lane == 0) { const int ea = gi * 8 + i1, eb = gi * 8 + i2;
            tokw[(F.wave * 16 + it) * 2] = w1 * gwt; tokw[(F.wave * 16 + it) * 2 + 1] = w2 * gwt;
            const int ra = atomicAdd((int*)&lcnt[ea], 1), rb2 = atomicAdd((int*)&lcnt[eb], 1);
            tokres[(F.wave * 16 + it) * 2] = ea | (ra << 8); tokres[(F.wave * 16 + it) * 2 + 1] = eb | (rb2 << 8); }
    }
    __syncthreads();
    if (F.tid < 32) { const int c = lcnt[F.tid]; lbase[F.tid] = c ? atomicAdd(&cnt[F.tid * 64], c) : 0; }
    __syncthreads();
    if (lane < 16) { const int m = gw + lane * NGW;
        if (m < NTOK) { const int a = tokres[(F.wave * 16 + lane) * 2], b2 = tokres[(F.wave * 16 + lane) * 2 + 1];
            const int pa = (a & 255) * NTOK + lbase[a & 255] + (a >> 8), pb = (b2 & 255) * NTOK + lbase[b2 & 255] + (b2 >> 8);
            list[pa] = m * 2; list[pb] = m * 2 + 1; selw[pa] = tokw[(F.wave * 16 + lane) * 2]; selw[pb] = tokw[(F.wave * 16 + lane) * 2 + 1]; } }
    __syncthreads();
}

__device__ __forceinline__ void moe_tables(Frame& F, int npn) {
    LAS int* tab = (LAS int*)(F.lds + LDS_TAB_OFF);
    if (F.tid == 0) { const int* cnt = (const int*)(F.ws + WS_CNT); int ub = 0, rb = 0;
        for (int e = 0; e < 32; ++e) { const int c = __hip_atomic_load(cnt + e * 64, __ATOMIC_RELAXED, __HIP_MEMORY_SCOPE_AGENT); const int tl = (c + 255) >> 8; tab[e] = ub; tab[33 + e] = rb; tab[66 + e] = c; ub += tl * npn; rb += tl; }
        tab[32] = ub; tab[33 + 32] = rb;
        for (int x = 0; x < 8; ++x) { int s = 0; for (int j = 0; j < 4; ++j) { tab[98 + x * 5 + j] = s; s += tab[x + 8 * j + 1] - tab[x + 8 * j]; } tab[98 + x * 5 + 4] = s; } }
    __syncthreads();
}
__device__ __forceinline__ void phase_m1(Frame& F) {
    moe_tables(F, 4);
    const LAS int* tab = (const LAS int*)(F.lds + LDS_TAB_OFF);
    pg8::Gemm g{(const bf16*)(F.ws + WS_H), (const bf16*)(F.ws + FW_W13T), D, D, D};
    pg8::MoeOrder<true> S{tab, tab + 33, tab + 66, (const int*)(F.ws + WS_LIST), F.G, (int)blockIdx.x, 1024};
    pg8::EpiSwiglu E{(bf16*)(F.ws + WS_HID)};
    pg8::gemm_phase<pg8::EpiSwiglu, pg8::MoeOrder<true>>(F.lds + RING_OFF, g, S, E, F.tid);
}
__device__ __forceinline__ void phase_m2(Frame& F) {
    moe_tables(F, 4);
    const LAS int* tab = (const LAS int*)(F.lds + LDS_TAB_OFF);
    pg8::Gemm g{(const bf16*)(F.ws + WS_HID), (const bf16*)(F.ws + FW_W2T), DE, DE, DE};
    pg8::MoeOrder<false> S{tab, tab + 33, tab + 66, (const int*)(F.ws + WS_LIST), F.G, (int)blockIdx.x, 1024};
    pg8::EpiYs E{F.ws};
    pg8::gemm_phase<pg8::EpiYs, pg8::MoeOrder<false>>(F.lds + RING_OFF, g, S, E, F.tid);
}
__device__ __forceinline__ void phase_final(Frame& F) {
    const int gw = F.vcu * NWAVES + F.wave, NGW = F.G * NWAVES, lane = F.lane;
    const float* mod = (const float*)(F.ws + WS_MOD); const float* fg = F.in[34]; const bf16* YS = (const bf16*)(F.ws + WS_YS);
    const float* xin = F.in[0]; const bf16* Yb = (const bf16*)(F.ws + WS_Y);
    for (int m = gw; m < NTOK; m += NGW) { const int b = m / T;
        f32x4* xr = (f32x4*)(F.out + (size_t)m * D) + lane; const f32x4* xi = (const f32x4*)(xin + (size_t)m * D) + lane; const v2u* yb = (const v2u*)(Yb + (size_t)m * D) + lane;
        const v2u* y0 = (const v2u*)(YS + (size_t)(2 * m) * D) + lane; const v2u* y1 = (const v2u*)(YS + (size_t)(2 * m + 1) * D) + lane;
        f32x4 v[4]; float s = 0.f;
#pragma unroll
        for (int j = 0; j < 4; ++j) { const v2u a = y0[64 * j], c = y1[64 * j], yy = yb[64 * j]; const f32x4 g2 = ((const f32x4*)(mod + b * 6144 + 5120))[lane + 64 * j];
            f32x4 mo; mo.x = bflo(a.x) + bflo(c.x); mo.y = bfhi(a.x) + bfhi(c.x); mo.z = bflo(a.y) + bflo(c.y); mo.w = bfhi(a.y) + bfhi(c.y);
            f32x4 x1 = xi[64 * j]; x1.x += bflo(yy.x); x1.y += bfhi(yy.x); x1.z += bflo(yy.y); x1.w += bfhi(yy.y);
            v[j] = x1 + g2 * mo; s += (v[j].x * v[j].x + v[j].y * v[j].y) + (v[j].z * v[j].z + v[j].w * v[j].w); }
        const float rinv = rsqrtf(wave_sum(s) * (1.f / D) + 1e-6f);
#pragma unroll
        for (int j = 0; j < 4; ++j) xr[64 * j] = v[j] * rinv * ((const f32x4*)fg)[lane + 64 * j];
    }
}
#define XB_TMO      128
#define XB_XCNT(j)  (256  + 64 * (j))
#define XB_XSUB(j)  (1280 + 64 * (j))
#define XB_XGEN(j)  (2304 + 64 * (j))
#define XB_TOP      3328
#define XB_TOPGEN   3392
#define XCD_BAR_WORDS 3456
#define XB_SPIN_CAP (1u << 18)

__device__ __forceinline__ unsigned xb_ld(unsigned* p)              { return __hip_atomic_load(p, __ATOMIC_RELAXED, __HIP_MEMORY_SCOPE_AGENT); }
__device__ __forceinline__ unsigned xb_add(unsigned* p, unsigned v) { return __hip_atomic_fetch_add(p, v, __ATOMIC_RELAXED, __HIP_MEMORY_SCOPE_AGENT); }
__device__ __forceinline__ unsigned xb_xcc_id() { return (unsigned)__builtin_amdgcn_s_getreg((3 << 11) | 20) & 0xFu; }
#define XB_SPIN(cond, bar) do { unsigned _sp = 0; while (cond) { __builtin_amdgcn_s_sleep(1); \
    if ((++_sp & 255u) == 0u) { if (xb_ld(&(bar)[XB_TMO])) break; if (_sp > XB_SPIN_CAP) { atomicAdd(&(bar)[XB_TMO], 1u); break; } } } } while (0)

struct XcdBarrier {
    unsigned* bar; unsigned x;
    volatile LAS unsigned* st;
};

__device__ __forceinline__ XcdBarrier xcd_barrier_post(unsigned* bar, volatile LAS unsigned* st) {
    XcdBarrier b; b.bar = bar; b.x = xb_xcc_id(); b.st = st;
    if (threadIdx.x == 0) (void)xb_add(&bar[XB_XCNT(b.x)], 1u);
    return b;
}
__device__ __forceinline__ void xcd_barrier_complete(unsigned* bar, unsigned x, unsigned& nloc, unsigned& nx) {
    const unsigned G = gridDim.x * gridDim.y * gridDim.z;
    unsigned sum, cnt, mine, sp = 0u;
    for (;;) {
        sum = 0u; cnt = 0u; mine = 0u;
#pragma unroll
        for (unsigned j = 0; j < 16; ++j) { const unsigned c = xb_ld(&bar[XB_XCNT(j)]); sum += c; cnt += (c > 0u) ? 1u : 0u; mine = (j == x) ? c : mine; }
        if (sum == G) break;
        __builtin_amdgcn_s_sleep(1);
        if ((++sp & 255u) == 0u) { if (xb_ld(&bar[XB_TMO])) break; if (sp > XB_SPIN_CAP) { atomicAdd(&bar[XB_TMO], 1u); break; } }
    }
    nloc = mine > 0u ? mine : 1u; nx = cnt > 0u ? cnt : 1u;
}

__device__ __forceinline__ void xcd_barrier(const XcdBarrier& b) {
    asm volatile("s_waitcnt vmcnt(0)" ::: "memory");
    __syncthreads();
    if (threadIdx.x == 0) {
        unsigned* bar = b.bar;
        __builtin_amdgcn_s_waitcnt(0);
        unsigned nloc = b.st[0], nx = b.st[1];
        if (nloc == 0u) { xcd_barrier_complete(bar, b.x, nloc, nx); b.st[0] = nloc; b.st[1] = nx; }
        const unsigned old = xb_add(&bar[XB_XSUB(b.x)], 1u);
        const unsigned gen = old / nloc;
        if (old + 1u == (gen + 1u) * nloc) {
            __builtin_amdgcn_fence(__ATOMIC_RELEASE, "agent");
            asm volatile("s_waitcnt vmcnt(0)" ::: "memory");
            const unsigned og = xb_add(&bar[XB_TOP], 1u);
            const unsigned tg = og / nx;
            if (og + 1u == (tg + 1u) * nx) xb_add(&bar[XB_TOPGEN], 1u);
            else XB_SPIN(xb_ld(&bar[XB_TOPGEN]) == tg, bar);
            __builtin_amdgcn_fence(__ATOMIC_ACQUIRE, "agent");
            xb_add(&bar[XB_XGEN(b.x)], 1u);
            asm volatile("s_waitcnt vmcnt(0)" ::: "memory");
        } else {
            XB_SPIN(xb_ld(&bar[XB_XGEN(b.x)]) == gen, bar);
            __builtin_amdgcn_fence(__ATOMIC_ACQUIRE, "agent");
            asm volatile("s_waitcnt vmcnt(0)" ::: "memory");
        }
    }
    __syncthreads();
}


constexpr size_t WS_XC = WS_H;
constexpr size_t WS_ALORA = WS_H + 32 * MiB;
constexpr size_t WS_LOGA = 256 * MiB;
constexpr size_t WS_OLOC = 320 * MiB;
constexpr size_t WS_QHAT = 352 * MiB;
constexpr size_t WS_GG = 384 * MiB;
constexpr size_t WS_SB = 12 * MiB;
constexpr size_t WS_LRUA = 13 * MiB;
constexpr size_t WS_LRUB = 14 * MiB;
constexpr size_t WS_LRUH = 15 * MiB;
constexpr size_t DO_LWA = 0;
constexpr size_t DO_PC = 64 * MiB;
constexpr size_t DO_QCT = 96 * MiB;
constexpr size_t DO_HIN = 0;


__device__ __forceinline__ void phase_prepA(Frame& F) {
    const int gw = F.vcu * NWAVES + F.wave, NGW = F.G * NWAVES, lane = F.lane;
    const bf16* P = (const bf16*)(F.ws + WS_P);
    bf16* XC = (bf16*)(F.ws + WS_XC); bf16* AL = (bf16*)(F.ws + WS_ALORA);
    const float* conv_w = F.in[6]; const float* conv_b = F.in[7]; const float* mu = F.in[14];
    float cw[4][8], cb[8];
#pragma unroll
    for (int i = 0; i < 8; ++i) { cb[i] = conv_b[8 * lane + i];
#pragma unroll
        for (int j = 0; j < 4; ++j) cw[j][i] = conv_w[j * 512 + 8 * lane + i]; }
    float mu4[4];
#pragma unroll
    for (int i = 0; i < 4; ++i) mu4[i] = mu[(C_WD - 1024) + 4 * lane + i];
    for (int task = gw; task < NTOK / 16; task += NGW) {
        const int m0 = task * 16, t0 = m0 % T;
        float x1[8], x2[8], x3[8], pl[4];
#pragma unroll
        for (int i = 0; i < 8; ++i) { x1[i] = 0.f; x2[i] = 0.f; x3[i] = 0.f; }
#pragma unroll
        for (int i = 0; i < 4; ++i) pl[i] = 0.f;
        if (t0 > 0) {
            const v4u a = *(const v4u*)(P + (size_t)(m0 - 1) * PW + 8 * lane), b = *(const v4u*)(P + (size_t)(m0 - 2) * PW + 8 * lane), c = *(const v4u*)(P + (size_t)(m0 - 3) * PW + 8 * lane);
            x1[0] = bflo(a.x); x1[1] = bfhi(a.x); x1[2] = bflo(a.y); x1[3] = bfhi(a.y); x1[4] = bflo(a.z); x1[5] = bfhi(a.z); x1[6] = bflo(a.w); x1[7] = bfhi(a.w);
            x2[0] = bflo(b.x); x2[1] = bfhi(b.x); x2[2] = bflo(b.y); x2[3] = bfhi(b.y); x2[4] = bflo(b.z); x2[5] = bfhi(b.z); x2[6] = bflo(b.w); x2[7] = bfhi(b.w);
            x3[0] = bflo(c.x); x3[1] = bfhi(c.x); x3[2] = bflo(c.y); x3[3] = bfhi(c.y); x3[4] = bflo(c.z); x3[5] = bfhi(c.z); x3[6] = bflo(c.w); x3[7] = bfhi(c.w);
            const v2u q = *(const v2u*)(P + (size_t)(m0 - 1) * PW + C_WD + 4 * lane);
            pl[0] = bflo(q.x); pl[1] = bfhi(q.x); pl[2] = bflo(q.y); pl[3] = bfhi(q.y);
        }
#pragma unroll 4
        for (int tt = 0; tt < 16; ++tt) {
            const size_t m = (size_t)(m0 + tt);
            const v4u a = *(const v4u*)(P + m * PW + 8 * lane);
            float x0[8] = {bflo(a.x), bfhi(a.x), bflo(a.y), bfhi(a.y), bflo(a.z), bfhi(a.z), bflo(a.w), bfhi(a.w)};
            float xc[8];
#pragma unroll
            for (int i = 0; i < 8; ++i) { xc[i] = x3[i] * cw[0][i] + x2[i] * cw[1][i] + x1[i] * cw[2][i] + x0[i] * cw[3][i] + cb[i]; x3[i] = x2[i]; x2[i] = x1[i]; x1[i] = x0[i]; }
            v4u o; o.x = pk2(xc[0], xc[1]); o.y = pk2(xc[2], xc[3]); o.z = pk2(xc[4], xc[5]); o.w = pk2(xc[6], xc[7]);
            *(v4u*)(XC + m * 512 + 8 * lane) = o;
            const v2u q = *(const v2u*)(P + m * PW + C_WD + 4 * lane);
            const float cl[4] = {bflo(q.x), bfhi(q.x), bflo(q.y), bfhi(q.y)};
            float al[4];
#pragma unroll
            for (int i = 0; i < 4; ++i) { const float u = cl[i] + (pl[i] - cl[i]) * mu4[i]; pl[i] = cl[i];
                al[i] = (lane < 16) ? ftanh(u) : ((lane < 32) ? u : sigmoidf_(u)); }
            v2u o2; o2.x = pk2(al[0], al[1]); o2.y = pk2(al[2], al[3]);
            *(v2u*)(AL + m * 256 + 4 * lane) = o2;
        }
    }
}
__device__ __forceinline__ void p0_small_weights(Frame& F) {
    const int gt = F.vcu * NWAVES * 64 + F.tid, NT = F.G * NWAVES * 64;
    bf16* WG = (bf16*)(F.ws + FW_WGT); bf16* WL = (bf16*)(F.ws + FW_WLORAT);
    const float* wa = F.in[8]; const float* wi = F.in[10]; const float* w_up = F.in[16]; const float* a_up = F.in[18]; const float* g_up = F.in[19];
    for (int i = gt; i < 4 * 256 * 128; i += NT) { const int kk = i & 127, r = (i >> 7) & 255, pn = i >> 15;
        const int gate = r >> 7, ch = 128 * pn + (r & 127), hh = ch >> 6, j = ch & 63, kin = 128 * pn + kk;
        float v = 0.f; if ((kin >> 6) == hh) v = (gate ? wi : wa)[hh * 4096 + (kin & 63) * 64 + j];
        WG[i] = f2bf(v); }
    { float* WR = (float*)(F.ws + FW_WR); const float* w_grp = F.in[27]; const float* w_exp = F.in[29];
      for (int i = gt; i < 36 * 1024; i += NT) { const int k = i & 1023, e = i >> 10; WR[i] = e < 4 ? w_grp[k * 4 + e] : w_exp[k * 32 + (e - 4)]; } }
    for (int i = gt; i < 1536 * 128; i += NT) { const int kk = i & 127, n = i >> 7; float v = 0.f;
        if (n < 512) { if (kk < 64) v = w_up[kk * 512 + n]; }
        else if (n < 1024) { if (kk >= 64) v = a_up[(kk - 64) * 512 + n - 512]; }
        else v = g_up[kk * 512 + n - 1024];
        WL[i] = f2bf(v); }
}

namespace pg8 {
struct GateOrder : DenseOrder {
    __device__ __forceinline__ const char* a_base(const Gemm& g, const Unit& u) const { return (const char*)g.A + (size_t)u.pm * (BM * 2) * g.lda + (size_t)u.pn * 256; }
};
struct LoraOrder : DenseOrder {
    __device__ __forceinline__ const char* a_base(const Gemm& g, const Unit& u) const { return (const char*)g.A + (size_t)u.pm * (BM * 2) * g.lda + (u.pn >= 4 ? 256 : 0); }
};
struct EpiLruGate {
    static constexpr bool PERM = true;
    unsigned char* ws;
    __device__ __forceinline__ void operator()(const f32x4 (&acc)[2][2][4][2], const Unit& u, int wr, int wc, int fr, int fq) const {
        bf16_t* G = (bf16_t*)(ws + WS_LOGA);
        const int row0 = u.pm * BM + wr * 64 + fr, col0 = u.pn * HALF + wc * 32 + 8 * fq;
#pragma unroll
        for (int ai = 0; ai < 2; ++ai)
#pragma unroll
            for (int m = 0; m < 4; ++m) { bf16_t* rowp = G + (size_t)(row0 + ai * HALF + m * 16) * 1024 + col0;
#pragma unroll
                for (int bj = 0; bj < 2; ++bj) { const f32x4 v0 = acc[ai][bj][m][0], v1 = acc[ai][bj][m][1];
                    u32x4 w; w.x = cvt_pk_bf16(v0[0], v0[1]); w.y = cvt_pk_bf16(v0[2], v0[3]); w.z = cvt_pk_bf16(v1[0], v1[1]); w.w = cvt_pk_bf16(v1[2], v1[3]);
                    *(u32x4*)(rowp + bj * 512) = w; } }
    }
};
struct EpiLoraStore {
    static constexpr bool PERM = true;
    unsigned char* out; unsigned char* ws;
    __device__ __forceinline__ void operator()(const f32x4 (&acc)[2][2][4][2], const Unit& u, int wr, int wc, int fr, int fq) const {
        const int row0 = u.pm * BM + wr * 64 + fr;
        bf16_t* LWA = (bf16_t*)(out + DO_LWA); bf16_t* GG = (bf16_t*)(ws + WS_GG);
        bf16_t* base = u.pn < 4 ? LWA : GG; const int ldc = u.pn < 4 ? 1024 : 512; const int col0 = (u.pn < 4 ? u.pn : u.pn - 4) * BM + wc * 32 + 8 * fq;
#pragma unroll
        for (int ai = 0; ai < 2; ++ai)
#pragma unroll
            for (int m = 0; m < 4; ++m) { bf16_t* rowp = base + (size_t)(row0 + ai * HALF + m * 16) * ldc + col0;
#pragma unroll
                for (int bj = 0; bj < 2; ++bj) { const f32x4 v0 = acc[ai][bj][m][0], v1 = acc[ai][bj][m][1];
                    u32x4 w; w.x = cvt_pk_bf16(v0[0], v0[1]); w.y = cvt_pk_bf16(v0[2], v0[3]); w.z = cvt_pk_bf16(v1[0], v1[1]); w.w = cvt_pk_bf16(v1[2], v1[3]);
                    *(u32x4*)(rowp + bj * HALF) = w; } }
    }
};
}
__device__ __forceinline__ void phase_gategemm(Frame& F) {
    {
        pg8::Gemm g{(const bf16*)(F.ws + WS_XC), (const bf16*)(F.ws + FW_WGT), 512, 128, 128};
        pg8::GateOrder S; S.init(NTOK, 1024, F.G, (int)blockIdx.x);
        pg8::EpiLruGate E{F.ws};
        pg8::gemm_phase<pg8::EpiLruGate, pg8::GateOrder>(F.lds + RING_OFF, g, S, E, F.tid);
    }
}
__device__ __forceinline__ void phase_loragemm(Frame& F) {
    {
        pg8::Gemm g{(const bf16*)(F.ws + WS_ALORA), (const bf16*)(F.ws + FW_WLORAT), 256, 128, 128};
        pg8::LoraOrder S; S.init(NTOK, 1536, F.G, (int)blockIdx.x);
        pg8::EpiLoraStore E{(unsigned char*)F.out, F.ws};
        pg8::gemm_phase<pg8::EpiLoraStore, pg8::LoraOrder>(F.lds + RING_OFF, g, S, E, F.tid);
    }
}

__device__ __forceinline__ void phase_lrulocal(Frame& F) {
    const int gw = F.vcu * NWAVES + F.wave, NGW = F.G * NWAVES, lane = F.lane;
    {
        const bf16* GT = (const bf16*)(F.ws + WS_LOGA); bf16* GO = (bf16*)(F.ws + WS_LOGA); const bf16* XC = (const bf16*)(F.ws + WS_XC);
        float* LA = (float*)(F.ws + WS_LRUA); float* LB = (float*)(F.ws + WS_LRUB);
        for (int task = (F.wave < 4 ? F.vcu * 4 + F.wave : 1 << 30); task < 4 * 128 * 2; task += F.G * 4) { const int hq = task & 1, bc = task >> 1, ch = (4 * hq + (lane >> 4)) * 64 + 4 * (lane & 15);
            const f32x4 bav = *(const f32x4*)(F.in[9] + ch), biv = *(const f32x4*)(F.in[11] + ch), lam = *(const f32x4*)(F.in[12] + ch);
            f32x4 sp; sp.x = -8.f * softplusf_(-lam.x); sp.y = -8.f * softplusf_(-lam.y); sp.z = -8.f * softplusf_(-lam.z); sp.w = -8.f * softplusf_(-lam.w);
            const size_t m0 = (size_t)bc * 64; f32x4 sl = {0.f, 0.f, 0.f, 0.f}, hl = {0.f, 0.f, 0.f, 0.f};
#pragma unroll 1
            for (int t8 = 0; t8 < 64; t8 += 8) {
                v2u g0[8], g1[8], x8[8];
#pragma unroll
                for (int u = 0; u < 8; ++u) { const size_t m = m0 + t8 + u; g0[u] = *(const v2u*)(GT + m * 1024 + ch); g1[u] = *(const v2u*)(GT + m * 1024 + 512 + ch); x8[u] = *(const v2u*)(XC + m * 512 + ch); }
#pragma unroll
                for (int u = 0; u < 8; ++u) { const size_t m = m0 + t8 + u;
                    const f32x4 ra = {bflo(g0[u].x), bfhi(g0[u].x), bflo(g0[u].y), bfhi(g0[u].y)}, ia = {bflo(g1[u].x), bfhi(g1[u].x), bflo(g1[u].y), bfhi(g1[u].y)};
                    const f32x4 xc = {bflo(x8[u].x), bfhi(x8[u].x), bflo(x8[u].y), bfhi(x8[u].y)};
                    float la[4], bb[4];
#pragma unroll
                    for (int i = 0; i < 4; ++i) la[i] = sigmoidf_(ra[i] + bav[i]) * sp[i];
                    const unsigned l01 = pk2(la[0], la[1]), l23 = pk2(la[2], la[3]);
                    la[0] = bflo(l01); la[1] = bfhi(l01); la[2] = bflo(l23); la[3] = bfhi(l23);
#pragma unroll
                    for (int i = 0; i < 4; ++i) bb[i] = __builtin_amdgcn_sqrtf(fmaxf(1.f - fexp(2.f * la[i]), 0.f)) * (sigmoidf_(ia[i] + biv[i]) * xc[i]);
                    const unsigned b01 = pk2(bb[0], bb[1]), b23 = pk2(bb[2], bb[3]);
                    bb[0] = bflo(b01); bb[1] = bfhi(b01); bb[2] = bflo(b23); bb[3] = bfhi(b23);
                    v2u ol, ob; ol.x = l01; ol.y = l23; ob.x = b01; ob.y = b23;
                    *(v2u*)(GO + m * 1024 + ch) = ol; *(v2u*)(GO + m * 1024 + 512 + ch) = ob;
#pragma unroll
                    for (int i = 0; i < 4; ++i) { sl[i] += la[i]; hl[i] = fexp(la[i]) * hl[i] + bb[i]; } }
            }
            *(f32x4*)(LA + bc * 512 + ch) = sl; *(f32x4*)(LB + bc * 512 + ch) = hl; }
    }
}
typedef short bf16x8_t __attribute__((ext_vector_type(8)));
typedef float f32x16 __attribute__((ext_vector_type(16)));
typedef __bf16 bf16x2n_t __attribute__((ext_vector_type(2)));
typedef float f32x2c_t __attribute__((ext_vector_type(2)));
__device__ __forceinline__ unsigned pkbf(float a, float b) { f32x2c_t v = {a, b}; bf16x2n_t r = __builtin_convertvector(v, bf16x2n_t); return __builtin_bit_cast(unsigned, r); }
__device__ __forceinline__ bf16 bf1(float a) { return (bf16)(pkbf(a, 0.f) & 0xffffu); }
constexpr int U_AT = 0, U_RT = 4096, U_BT = 8192, U_KT = 12288, U_BH = 16384, U_KH = 20480, U_VT = 24576, U_LM = 28672, U_G31 = 32768, UNIT_LDS = 33024;
__device__ __forceinline__ int a64(int row, int col) { return row * 128 + (((col >> 3) ^ (row & 7)) << 4) + ((col & 7) << 1); }
__device__ __forceinline__ int a32(int row, int col) { return row * 64 + (((col >> 2) ^ ((row >> 2) & 7)) << 3) + ((col & 3) << 1); }
__device__ __forceinline__ int crow_(int i, int h) { return (i & 3) + 8 * (i >> 2) + 4 * h; }
#define MFMA32(a, b, c) __builtin_amdgcn_mfma_f32_32x32x16_bf16((a), (b), (c), 0, 0, 0)
__device__ __forceinline__ bf16x8_t pack8(const f32x16& x, int s) {
    v4u p; p.x = pkbf(x[8 * s], x[8 * s + 1]); p.y = pkbf(x[8 * s + 2], x[8 * s + 3]); p.z = pkbf(x[8 * s + 4], x[8 * s + 5]); p.w = pkbf(x[8 * s + 6], x[8 * s + 7]);
    return __builtin_bit_cast(bf16x8_t, p); }
__device__ __forceinline__ bf16x8_t ld2x8(const LAS unsigned char* p0, const LAS unsigned char* p1) {
    const v2u lo = *(const LAS v2u*)p0, hi = *(const LAS v2u*)p1; v4u p; p.x = lo.x; p.y = lo.y; p.z = hi.x; p.w = hi.y; return __builtin_bit_cast(bf16x8_t, p); }

__device__ __forceinline__ void phase_rwkvlocal_mfma(Frame& F) {
    int lane = F.lane; asm volatile("" : "+v"(lane));
    const int wave = F.wave, u4 = wave >> 1, wh = wave & 1;
    LAS unsigned char* ub = F.lds + RING_OFF + u4 * UNIT_LDS;
    const bf16* P = (const bf16*)(F.ws + WS_P); const bf16* LWA = (const bf16*)((const unsigned char*)F.out + DO_LWA);
    bf16* OLOC = (bf16*)(F.ws + WS_OLOC); bf16* QHAT = (bf16*)(F.ws + WS_QHAT); float* SB = (float*)(F.ws + WS_SB);
    const float* mu = F.in[14];
#pragma unroll 1
    for (int ui = F.vcu; ui < 256; ui += F.G) {
        const int unit = ui * 4 + u4, c = unit & 31, bhd = unit >> 5, hd = bhd & 7, b = bhd >> 3;
        const size_t m0 = (size_t)b * T + (size_t)c * 256;
        f32x16 S[2][2];
        { int r = lane & 31, h = lane >> 5; asm volatile("" : "+v"(r), "+v"(h));
#pragma unroll
        for (int jt = 0; jt < 2; ++jt)
#pragma unroll
            for (int kt = 0; kt < 2; ++kt)
#pragma unroll
                for (int i = 0; i < 16; ++i) S[jt][kt][i] = (wh == 0 && jt == kt && crow_(i, h) == r) ? 1.f : 0.f;
        }
#pragma unroll 1
        for (int sc = 0; sc < 8; ++sc) {
            const size_t ms = m0 + 32 * sc;
            {
                int lanep = lane; asm volatile("" : "+v"(lanep));
                const int ch = hd * 64 + lanep;
                const float mu_r = mu[ch], mu_k = mu[512 + ch], mu_v = mu[1024 + ch];
                const float w0v = F.in[15][ch], a0v = F.in[17][ch], kkv = F.in[20][ch], kav = F.in[21][ch], rkv = F.in[22][ch];
                const size_t mb = ms + 16 * wh;
                bf16 qr[16], qk[16], qv[16], qw[16], qa[16], lw16[16], p3[3] = {0, 0, 0};
                if ((mb % T) != 0) { const bf16* row = P + (mb - 1) * PW; p3[0] = row[C_R + ch]; p3[1] = row[C_K + ch]; p3[2] = row[C_V + ch]; }
#pragma unroll
                for (int u = 0; u < 16; ++u) { const size_t m = mb + u; const bf16* row = P + m * PW;
                    qr[u] = row[C_R + ch]; qk[u] = row[C_K + ch]; qv[u] = row[C_V + ch]; qw[u] = LWA[m * 1024 + ch]; qa[u] = LWA[m * 1024 + 512 + ch]; }
                if (wh) {
#pragma unroll
                    for (int t = 0; t < 16; ++t) lw16[t] = LWA[(ms + t) * 1024 + ch];
                }
                float cc = 0.f;
                if (wh) {
#pragma unroll
                    for (int t = 0; t < 16; ++t) { const float w = -flog(1.f + fexp(-(w0v + bf2f(lw16[t])))) - 0.5f; cc -= fexp(w); }
                }
                float pr = bf2f(p3[0]), pk = bf2f(p3[1]), pv = bf2f(p3[2]);
                float sbkeep = 0.f, gprev = fexp(cc);
                {
                    constexpr int t8 = 0;
#pragma unroll
                    for (int u = 0; u < 16; ++u) {
                        const int tt = t8 + u, t = 16 * wh + tt;
                        const float cr = bf2f(qr[u]), ck = bf2f(qk[u]), cv = bf2f(qv[u]);
                        const float lw = bf2f(qw[u]), la = bf2f(qa[u]);
                        const float rr = cr + (pr - cr) * mu_r, kx = ck + (pk - ck) * mu_k, v = cv + (pv - cv) * mu_v;
                        pr = cr; pk = ck; pv = cv;
                        const float w = -flog(1.f + fexp(-(w0v + lw))) - 0.5f;
                        cc -= fexp(w);
                        const float a = frcp(1.f + fexp(-(a0v + la)));
                        float kk = kx * kkv;
                        const float nrm = __builtin_amdgcn_sqrtf(wave_sum(kk * kk));
                        kk = kk * __builtin_amdgcn_rcpf(fmaxf(nrm, 1e-12f));
                        const float km = kx * (1.f + (a - 1.f) * kav);
                        const float sbv = wave_sum(rr * km * rkv);
                        if (lanep == tt) sbkeep = sbv;
                        const float gp = gprev, g = fexp(cc), ig = frcp(g);
                        gprev = g;
                        const float be = kk * a;
                        *(LAS bf16*)(ub + U_AT + a64(t, lanep)) = bf1(-kk * gp);
                        *(LAS bf16*)(ub + U_RT + a64(t, lanep)) = bf1(rr * g);
                        *(LAS bf16*)(ub + U_BT + a64(t, lanep)) = bf1(be * ig);
                        *(LAS bf16*)(ub + U_KT + a64(t, lanep)) = bf1(km * ig);
                        *(LAS bf16*)(ub + U_BH + a32(lanep, t)) = bf1(be * ig);
                        *(LAS bf16*)(ub + U_KH + a32(lanep, t)) = bf1(km * ig);
                        *(LAS bf16*)(ub + U_VT + a32(lanep, t)) = bf1(v);
                    }
                }
                if (lanep < 16) SB[(mb + lanep) * 8 + hd] = sbkeep;
                if (wh) *(LAS float*)(ub + U_G31 + lanep * 4) = gprev;
            }
            asm volatile("s_waitcnt lgkmcnt(0)" ::: "memory"); __builtin_amdgcn_s_barrier(); asm volatile("" ::: "memory");
            {
                int r = lane & 31, h = lane >> 5; asm volatile("" : "+v"(r), "+v"(h));
                bf16x8_t fT[2], fAk[2], fRb[2], fRk[2];
                {
                    f32x16 M, MT, R, RT;
#pragma unroll
                    for (int i = 0; i < 16; ++i) { M[i] = 0.f; MT[i] = 0.f; }
#pragma unroll
                    for (int ks = 0; ks < 4; ++ks) { const int o = a64(r, 16 * ks + 8 * h);
                        const bf16x8_t fb = *(const LAS bf16x8_t*)(ub + U_BT + o), fa = *(const LAS bf16x8_t*)(ub + U_AT + o);
                        M = MFMA32(fb, fa, M); MT = MFMA32(fa, fb, MT); }
#pragma unroll
                    for (int i = 0; i < 16; ++i) { const int q = crow_(i, h); M[i] = (q < r) ? M[i] : 0.f; MT[i] = (r < q) ? MT[i] : 0.f;
                        R[i] = M[i] + ((q == r) ? 1.f : 0.f); RT[i] = MT[i] + ((q == r) ? 1.f : 0.f); }
#pragma unroll
                    for (int lvl = 0; lvl < 4; ++lvl) {
                        bf16x8_t pm[2], pmt[2];
#pragma unroll
                        for (int ks = 0; ks < 2; ++ks) { pm[ks] = pack8(M, ks); pmt[ks] = pack8(MT, ks); }
                        f32x16 M2, MT2;
#pragma unroll
                        for (int i = 0; i < 16; ++i) { M2[i] = 0.f; MT2[i] = 0.f; }
#pragma unroll
                        for (int ks = 0; ks < 2; ++ks) { M2 = MFMA32(pmt[ks], pm[ks], M2); MT2 = MFMA32(pm[ks], pmt[ks], MT2); }
                        M = M2; MT = MT2;
                        bf16x8_t pr[2], prt[2];
#pragma unroll
                        for (int ks = 0; ks < 2; ++ks) { pm[ks] = pack8(M, ks); pr[ks] = pack8(R, ks); prt[ks] = pack8(RT, ks); }
#pragma unroll
                        for (int ks = 0; ks < 2; ++ks) { R = MFMA32(prt[ks], pm[ks], R); RT = MFMA32(pm[ks], prt[ks], RT); }
                        (void)pr;
                    }
#pragma unroll
                    for (int ks = 0; ks < 2; ++ks) fT[ks] = pack8(R, ks);
                }
                __builtin_amdgcn_sched_barrier(0);
                {
                    f32x16 Xak, Xrb, Xrk;
#pragma unroll
                    for (int i = 0; i < 16; ++i) { Xak[i] = 0.f; Xrb[i] = 0.f; Xrk[i] = 0.f; }
#pragma unroll
                    for (int ks = 0; ks < 4; ++ks) { const int o = a64(r, 16 * ks + 8 * h);
                        const bf16x8_t fb = *(const LAS bf16x8_t*)(ub + U_BT + o), fk = *(const LAS bf16x8_t*)(ub + U_KT + o);
                        const bf16x8_t fa = *(const LAS bf16x8_t*)(ub + U_AT + o), fr = *(const LAS bf16x8_t*)(ub + U_RT + o);
                        Xak = MFMA32(fk, fa, Xak); Xrb = MFMA32(fb, fr, Xrb); Xrk = MFMA32(fk, fr, Xrk); }
#pragma unroll
                    for (int i = 0; i < 16; ++i) { const int s = crow_(i, h); Xak[i] = (s < r) ? Xak[i] : 0.f; Xrb[i] = (s <= r) ? Xrb[i] : 0.f; Xrk[i] = (s <= r) ? Xrk[i] : 0.f; }
#pragma unroll
                    for (int ks = 0; ks < 2; ++ks) { fAk[ks] = pack8(Xak, ks); fRb[ks] = pack8(Xrb, ks); fRk[ks] = pack8(Xrk, ks); }
                }
#pragma unroll
                for (int jt = 0; jt < 2; ++jt) {
                    __builtin_amdgcn_sched_barrier(0);
                    bf16x8_t sf[2][2], vf[2];
#pragma unroll
                    for (int kt = 0; kt < 2; ++kt)
#pragma unroll
                        for (int ks = 0; ks < 2; ++ks) sf[kt][ks] = pack8(S[jt][kt], ks);
                    if (wh) {
#pragma unroll
                        for (int ks = 0; ks < 2; ++ks) vf[ks] = ld2x8(ub + U_VT + a32(32 * jt + r, 16 * ks + 4 * h), ub + U_VT + a32(32 * jt + r, 16 * ks + 8 + 4 * h));
                    }
                    f32x16 X1, Uu, Oo;
#pragma unroll
                    for (int i = 0; i < 16; ++i) { X1[i] = 0.f; Uu[i] = 0.f; Oo[i] = 0.f; }
#pragma unroll
                    for (int kt = 0; kt < 2; ++kt)
#pragma unroll
                        for (int ks = 0; ks < 2; ++ks) { const int c0 = 32 * kt + 16 * ks + 4 * h;
                            X1 = MFMA32(ld2x8(ub + U_AT + a64(r, c0), ub + U_AT + a64(r, c0 + 8)), sf[kt][ks], X1);
                            Oo = MFMA32(ld2x8(ub + U_RT + a64(r, c0), ub + U_RT + a64(r, c0 + 8)), sf[kt][ks], Oo); }
                    if (wh) {
#pragma unroll
                        for (int ks = 0; ks < 2; ++ks) { X1 = MFMA32(fAk[ks], vf[ks], X1); Oo = MFMA32(fRk[ks], vf[ks], Oo); }
                    }
                    __builtin_amdgcn_sched_barrier(0);
#pragma unroll
                    for (int ks = 0; ks < 2; ++ks) Uu = MFMA32(fT[ks], pack8(X1, ks), Uu);
                    bf16x8_t uf[2];
#pragma unroll
                    for (int ks = 0; ks < 2; ++ks) { uf[ks] = pack8(Uu, ks); Oo = MFMA32(fRb[ks], uf[ks], Oo); }
                    { bf16* dst = (wh ? OLOC : QHAT) + ms * 512 + hd * 64 + 32 * jt + r;
#pragma unroll
                      for (int i = 0; i < 16; ++i) dst[(size_t)crow_(i, h) * 512] = bf1(Oo[i]); }
                    __builtin_amdgcn_sched_barrier(0);
#pragma unroll
                    for (int kt = 0; kt < 2; ++kt) {
#pragma unroll
                        for (int ks = 0; ks < 2; ++ks) { const int k = 32 * kt + r, t0 = 16 * ks + 4 * h;
                            S[jt][kt] = MFMA32(ld2x8(ub + U_BH + a32(k, t0), ub + U_BH + a32(k, t0 + 8)), uf[ks], S[jt][kt]);
                            if (wh) S[jt][kt] = MFMA32(ld2x8(ub + U_KH + a32(k, t0), ub + U_KH + a32(k, t0 + 8)), vf[ks], S[jt][kt]); }
#pragma unroll
                        for (int g = 0; g < 4; ++g) { const f32x4 gg = *(const LAS f32x4*)(ub + U_G31 + (32 * kt + 8 * g + 4 * h) * 4);
                            S[jt][kt][4 * g] *= gg.x; S[jt][kt][4 * g + 1] *= gg.y; S[jt][kt][4 * g + 2] *= gg.z; S[jt][kt][4 * g + 3] *= gg.w; }
                    }
                }
            }
            asm volatile("s_waitcnt lgkmcnt(0)" ::: "memory"); __builtin_amdgcn_s_barrier(); asm volatile("" ::: "memory");
        }
        int r = lane & 31, h = lane >> 5; asm volatile("" : "+v"(r), "+v"(h));
        if (wh == 0) { bf16* PC = (bf16*)((unsigned char*)F.out + DO_PC) + (size_t)unit * 4096;
#pragma unroll
            for (int jt = 0; jt < 2; ++jt)
#pragma unroll
                for (int kt = 0; kt < 2; ++kt)
#pragma unroll
                    for (int i = 0; i < 16; ++i) PC[(32 * kt + crow_(i, h)) * 64 + 32 * jt + r] = bf1(S[jt][kt][i]);
        } else { bf16* QCT = (bf16*)((unsigned char*)F.out + DO_QCT) + (size_t)unit * 4096;
#pragma unroll
            for (int jt = 0; jt < 2; ++jt)
#pragma unroll
                for (int kt = 0; kt < 2; ++kt)
#pragma unroll
                    for (int g = 0; g < 4; ++g) { v2u o; o.x = pkbf(S[jt][kt][4 * g], S[jt][kt][4 * g + 1]); o.y = pkbf(S[jt][kt][4 * g + 2], S[jt][kt][4 * g + 3]);
                        *(v2u*)(QCT + (32 * jt + r) * 64 + 32 * kt + 8 * g + 4 * h) = o; }
        }
    }
}

__device__ __forceinline__ void rwkv_scan(Frame& F, int bh) {
    constexpr int LDT = 72;
    constexpr int SBUF = 64 * LDT;
    LAS bf16* S0 = (LAS bf16*)(F.lds + RING_OFF);
    const int lane = F.lane, w = F.wave, q = lane >> 4, l15 = lane & 15;
    for (int i = F.tid; i < 2 * SBUF; i += 512) S0[i] = 0;
    __syncthreads();
    if (w < 4) {
        const int tr = w;
        const bf16* PC = (const bf16*)((const unsigned char*)F.out + DO_PC) + (size_t)bh * 32 * 4096 + (16 * tr + l15) * 64 + 8 * q;
        const bf16* QCT = (const bf16*)((const unsigned char*)F.out + DO_QCT) + (size_t)bh * 32 * 4096 + l15 * 64 + 16 * tr + 4 * q;
        const int boff0 = l15 * LDT + 8 * q, woff0 = l15 * LDT + 16 * tr + 4 * q;
        bf16x8_t A[8][2]; v2u Qv[8][4];
#define SCAN_LOAD(s, cc) do { \
        asm volatile("global_load_dwordx4 %0, %1, off" : "=v"(A[s][0]) : "v"(PC + (size_t)(cc) * 4096) : "memory"); \
        asm volatile("global_load_dwordx4 %0, %1, off offset:64" : "=v"(A[s][1]) : "v"(PC + (size_t)(cc) * 4096) : "memory"); \
        asm volatile("global_load_dwordx2 %0, %1, off" : "=v"(Qv[s][0]) : "v"(QCT + (size_t)(cc) * 4096) : "memory"); \
        asm volatile("global_load_dwordx2 %0, %1, off offset:2048" : "=v"(Qv[s][1]) : "v"(QCT + (size_t)(cc) * 4096) : "memory"); \
        asm volatile("global_load_dwordx2 %0, %1, off" : "=v"(Qv[s][2]) : "v"(QCT + (size_t)(cc) * 4096 + 2048) : "memory"); \
        asm volatile("global_load_dwordx2 %0, %1, off offset:2048" : "=v"(Qv[s][3]) : "v"(QCT + (size_t)(cc) * 4096 + 2048) : "memory"); } while (0)
#pragma unroll
        for (int s = 0; s < 8; ++s) SCAN_LOAD(s, s);
#pragma unroll 1
        for (int c0 = 0; c0 < 32; c0 += 8) {
#pragma unroll
            for (int s = 0; s < 8; ++s) {
                const int c = c0 + s;
                const LAS bf16* Sr = S0 + (s & 1) * SBUF; LAS bf16* Sw = S0 + ((s & 1) ^ 1) * SBUF;
                asm volatile("s_waitcnt vmcnt(42)" : "+v"(A[s][0]), "+v"(A[s][1]), "+v"(Qv[s][0]), "+v"(Qv[s][1]), "+v"(Qv[s][2]), "+v"(Qv[s][3]) :: "memory");
                pg8::f32x4 acc[4];
#pragma unroll
                for (int t = 0; t < 4; ++t) { acc[t][0] = bflo(Qv[s][t].x); acc[t][1] = bfhi(Qv[s][t].x); acc[t][2] = bflo(Qv[s][t].y); acc[t][3] = bfhi(Qv[s][t].y); }
#pragma unroll
                for (int ks = 0; ks < 2; ++ks)
#pragma unroll
                    for (int t = 0; t < 4; ++t) {
                        const bf16x8_t bh_ = *(const LAS bf16x8_t*)(Sr + boff0 + 16 * LDT * t + 32 * ks);
                        acc[t] = __builtin_amdgcn_mfma_f32_16x16x32_bf16(A[s][ks], bh_, acc[t], 0, 0, 0);
                    }
                { const int cn = (c + 8 < 32) ? c + 8 : 31; SCAN_LOAD(s, cn); }
#pragma unroll
                for (int t = 0; t < 4; ++t) { v2u oh; oh.x = pg8::cvt_pk_bf16(acc[t][0], acc[t][1]); oh.y = pg8::cvt_pk_bf16(acc[t][2], acc[t][3]);
                    *(LAS v2u*)(Sw + woff0 + 16 * LDT * t) = oh; }
                asm volatile("s_waitcnt lgkmcnt(0)" ::: "memory"); __builtin_amdgcn_s_barrier(); asm volatile("" ::: "memory");
            }
        }
#undef SCAN_LOAD
        asm volatile("s_waitcnt vmcnt(0)" ::: "memory");
    } else {
        const int t256 = F.tid - 256;
        bf16* HIN = (bf16*)((unsigned char*)F.out + DO_HIN) + (size_t)bh * 32 * 4096 + (t256 >> 2) * 64 + (t256 & 3) * 16;
        const int hoff = (t256 >> 2) * LDT + (t256 & 3) * 16;
#pragma unroll 1
        for (int c = 0; c < 32; ++c) {
            const LAS bf16* Sr = S0 + (c & 1) * SBUF;
            const v4u x0 = *(const LAS v4u*)(Sr + hoff), x1 = *(const LAS v4u*)(Sr + hoff + 8);
            *(v4u*)(HIN + (size_t)c * 4096) = x0; *(v4u*)(HIN + (size_t)c * 4096 + 8) = x1;
            asm volatile("s_waitcnt lgkmcnt(0)" ::: "memory"); __builtin_amdgcn_s_barrier(); asm volatile("" ::: "memory");
        }
    }
}
__device__ __forceinline__ void phase_scan(Frame& F, int flags) {
    if ((flags & 4) && blockIdx.x >= 36) { expert_transposes(F, ((int)blockIdx.x - 36) * NWAVES + F.wave, ((int)F.G - 36) * NWAVES); }
    if ((flags & 2) && blockIdx.x < 32) rwkv_scan(F, blockIdx.x);
    if ((flags & 1) && blockIdx.x >= 32 && blockIdx.x < 36) {
        const int idx = (blockIdx.x - 32) * 512 + F.tid, b = idx >> 9, ch = idx & 511;
        const float* LA = (const float*)(F.ws + WS_LRUA); const float* LB = (const float*)(F.ws + WS_LRUB); float* LH = (float*)(F.ws + WS_LRUH);
        float h = 0.f;
#pragma unroll 1
        for (int c16 = 0; c16 < 128; c16 += 16) { float a16[16], b16[16];
#pragma unroll
            for (int u = 0; u < 16; ++u) { const int o = (b * 128 + c16 + u) * 512 + ch; a16[u] = LA[o]; b16[u] = LB[o]; }
#pragma unroll
            for (int u = 0; u < 16; ++u) { const int o = (b * 128 + c16 + u) * 512 + ch; LH[o] = h; h = fexp(a16[u]) * h + b16[u]; } }
    }
}

__device__ __forceinline__ void rwkv_post_unit(Frame& F, int unit) {
    int lane = F.lane; asm volatile("" : "+v"(lane));
    const int c = unit & 127, bh = unit >> 7, h = bh & 7, b = bh >> 3, q = lane >> 4, l15 = lane & 15;
    const size_t m0 = (size_t)b * T + (size_t)c * 64;
    const bf16* QHAT = (const bf16*)(F.ws + WS_QHAT); const bf16* OLOC = (const bf16*)(F.ws + WS_OLOC); const bf16* GG = (const bf16*)(F.ws + WS_GG);
    const bf16* HIN = (const bf16*)((const unsigned char*)F.out + DO_HIN) + (size_t)(bh * 32 + (c >> 2)) * 4096; const bf16* P = (const bf16*)(F.ws + WS_P);
    const float* SB = (const float*)(F.ws + WS_SB); bf16* YMIX = (bf16*)(F.ws + WS_YMIX);
    bf16x8_t Af[4][2];
#pragma unroll
    for (int jt = 0; jt < 4; ++jt)
#pragma unroll
        for (int ks = 0; ks < 2; ++ks) Af[jt][ks] = *(const bf16x8_t*)(HIN + (16 * jt + l15) * 64 + 32 * ks + 8 * q);
    f32x4 lnw[4], lnb[4], muv[4];
#pragma unroll
    for (int jt = 0; jt < 4; ++jt) { const int ch = h * 64 + 16 * jt + 4 * q; lnw[jt] = *(const f32x4*)(F.in[23] + ch); lnb[jt] = *(const f32x4*)(F.in[24] + ch); muv[jt] = *(const f32x4*)(F.in[14] + 1024 + ch); }
#pragma unroll 1
    for (int tt = 0; tt < 4; ++tt) {
        const size_t m = m0 + 16 * tt + l15;
        bf16x8_t Bf[2];
#pragma unroll
        for (int ks = 0; ks < 2; ++ks) Bf[ks] = *(const bf16x8_t*)(QHAT + m * 512 + h * 64 + 32 * ks + 8 * q);
        pg8::f32x4 acc[4];
#pragma unroll
        for (int jt = 0; jt < 4; ++jt) { const v2u o = *(const v2u*)(OLOC + m * 512 + h * 64 + 16 * jt + 4 * q); acc[jt][0] = bflo(o.x); acc[jt][1] = bfhi(o.x); acc[jt][2] = bflo(o.y); acc[jt][3] = bfhi(o.y); }
#pragma unroll
        for (int ks = 0; ks < 2; ++ks)
#pragma unroll
            for (int jt = 0; jt < 4; ++jt) acc[jt] = __builtin_amdgcn_mfma_f32_16x16x32_bf16(Af[jt][ks], Bf[ks], acc[jt], 0, 0, 0);
        float s = 0.f;
#pragma unroll
        for (int jt = 0; jt < 4; ++jt) s += (acc[jt][0] + acc[jt][1]) + (acc[jt][2] + acc[jt][3]);
        s += __shfl_xor(s, 16); s += __shfl_xor(s, 32);
        const float mean = s * (1.f / 64.f);
        float vs = 0.f;
#pragma unroll
        for (int jt = 0; jt < 4; ++jt)
#pragma unroll
            for (int i = 0; i < 4; ++i) { acc[jt][i] -= mean; vs += acc[jt][i] * acc[jt][i]; }
        vs += __shfl_xor(vs, 16); vs += __shfl_xor(vs, 32);
        const float rstd = rsqrtf(vs * (1.f / 64.f) + 64e-5f);
        const float sbv = SB[m * 8 + h];
        const bool first = ((m % T) == 0);
#pragma unroll
        for (int jt = 0; jt < 4; ++jt) { const int ch = h * 64 + 16 * jt + 4 * q;
            const v2u cvq = *(const v2u*)(P + m * PW + C_V + ch); v2u pvq = {0u, 0u}; if (!first) pvq = *(const v2u*)(P + (m - 1) * PW + C_V + ch);
            const v2u gq = *(const v2u*)(GG + m * 512 + ch);
            const float cv[4] = {bflo(cvq.x), bfhi(cvq.x), bflo(cvq.y), bfhi(cvq.y)}, pv[4] = {bflo(pvq.x), bfhi(pvq.x), bflo(pvq.y), bfhi(pvq.y)}, gg[4] = {bflo(gq.x), bfhi(gq.x), bflo(gq.y), bfhi(gq.y)};
            float y[4];
#pragma unroll
            for (int i = 0; i < 4; ++i) { const float v = cv[i] + (pv[i] - cv[i]) * muv[jt][i]; y[i] = (acc[jt][i] * rstd * lnw[jt][i] + lnb[jt][i] + sbv * v) * gg[i]; }
            v2u o; o.x = pk2(y[0], y[1]); o.y = pk2(y[2], y[3]);
            *(v2u*)(YMIX + m * D + 512 + ch) = o; }
    }
}
__device__ __forceinline__ void phase_post(Frame& F, int flags) {
    const int gw = F.vcu * NWAVES + F.wave, NGW = F.G * NWAVES, lane = F.lane;
    if ((flags & 2) && F.G * 16 == 4096) {
        if (F.wave >= 4) { for (int k = 0; k < 3; ++k) rwkv_post_unit(F, F.vcu * 16 + (F.wave - 4) * 3 + k); }
    } else if (flags & 2) for (int unit = gw; unit < 4096; unit += NGW) rwkv_post_unit(F, unit);
    if (flags & 1) {
        const bf16* GT = (const bf16*)(F.ws + WS_LOGA); const bf16* P = (const bf16*)(F.ws + WS_P);
        const float* LH = (const float*)(F.ws + WS_LRUH); bf16* YMIX = (bf16*)(F.ws + WS_YMIX); const float* ng = F.in[13];
        for (int task = (F.wave < 4 ? F.vcu * 4 + F.wave : 1 << 30); task < 4 * 128 * 2; task += F.G * 4) { const int hq = task & 1, bc = task >> 1, ch = (4 * hq + (lane >> 4)) * 64 + 4 * (lane & 15);
            const size_t m0 = (size_t)bc * 64; f32x4 hl = *(const f32x4*)(LH + bc * 512 + ch); const f32x4 g = *(const f32x4*)(ng + ch);
#pragma unroll 1
            for (int t8 = 0; t8 < 64; t8 += 8) {
                v2u g0[8], g1[8], p8[8];
#pragma unroll
                for (int u = 0; u < 8; ++u) { const size_t m = m0 + t8 + u; g0[u] = *(const v2u*)(GT + m * 1024 + ch); g1[u] = *(const v2u*)(GT + m * 1024 + 512 + ch); p8[u] = *(const v2u*)(P + m * PW + C_GATE + ch); }
#pragma unroll
                for (int u = 0; u < 8; ++u) { const size_t m = m0 + t8 + u;
                    const f32x4 la = {bflo(g0[u].x), bfhi(g0[u].x), bflo(g0[u].y), bfhi(g0[u].y)}, bb = {bflo(g1[u].x), bfhi(g1[u].x), bflo(g1[u].y), bfhi(g1[u].y)};
                    const f32x4 gt = {bflo(p8[u].x), bfhi(p8[u].x), bflo(p8[u].y), bfhi(p8[u].y)};
                    f32x4 y;
#pragma unroll
                    for (int i = 0; i < 4; ++i) { hl[i] = fexp(la[i]) * hl[i] + bb[i]; y[i] = hl[i] * gelu_tanh(gt[i]); }
                    float ss = (y.x * y.x + y.y * y.y) + (y.z * y.z + y.w * y.w);
                    ss += __int_as_float(__builtin_amdgcn_update_dpp(0, __float_as_int(ss), 0xB1, 0xF, 0xF, true));
                    ss += __int_as_float(__builtin_amdgcn_update_dpp(0, __float_as_int(ss), 0x4E, 0xF, 0xF, true));
                    ss += __int_as_float(__builtin_amdgcn_update_dpp(0, __float_as_int(ss), 0x141, 0xF, 0xF, true));
                    ss += __int_as_float(__builtin_amdgcn_update_dpp(0, __float_as_int(ss), 0x140, 0xF, 0xF, true));
                    const float rs = rsqrtf(ss * (1.f / 64.f) + 1e-6f);
                    v2u o; o.x = pk2(y.x * rs * g.x, y.y * rs * g.y); o.y = pk2(y.z * rs * g.z, y.w * rs * g.w);
                    *(v2u*)(YMIX + m * D + ch) = o; }
            }
        }
    }
    if ((flags & 2) && F.G * 16 == 4096 && F.wave < 4) rwkv_post_unit(F, F.vcu * 16 + 12 + F.wave);
}

struct Args { const float* in[35]; float* out; unsigned char* ws; int ph_lo, ph_hi, flags, pad; };
__global__ void __launch_bounds__(NWAVES * 64, 2) mk_fwd(Args args) {
    extern __shared__ __attribute__((aligned(16))) unsigned char lds[];
    Frame F;
    F.lds = (LAS unsigned char*)lds;
    F.tid = threadIdx.x; F.lane = F.tid & 63; F.wave = __builtin_amdgcn_readfirstlane(F.tid >> 6);
    F.G = gridDim.x; { const int bx = blockIdx.x; F.vcu = (F.G % 8 == 0) ? (bx % 8) * (F.G / 8) + bx / 8 : bx; }
    F.in = args.in; F.out = args.out; F.ws = args.ws;
    const int lo = args.ph_lo, hi = args.ph_hi;
#define IN(k) (lo <= (k) && (k) < hi)
    const int flags = args.flags;
    for (int u = threadIdx.x; u < (LDS_BYTES - LDSCTL_OFF) / 4; u += NWAVES * 64) ((LAS unsigned*)(F.lds + LDSCTL_OFF))[u] = 0u;
    __syncthreads();
    XcdBarrier bar; bar.bar = (unsigned*)(args.ws + WS_CTL) + CW_BAR; bar.x = 0; bar.st = nullptr;
    if (hi - lo > 1) bar = xcd_barrier_post((unsigned*)(args.ws + WS_CTL) + CW_BAR, (volatile LAS unsigned*)(F.lds + MISC_OFF) + 8);
#define SEAM(k) if (IN(k) && IN((k) + 1)) xcd_barrier(bar);
#define PH1(k, call) { int t_ = threadIdx.x; asm volatile("" : "+v"(t_)); F.tid = t_; F.lane = t_ & 63; F.wave = __builtin_amdgcn_readfirstlane(t_ >> 6); call; }
#define PH(k, bit, call) if (IN(k)) { PH1(k, call) }
    PH(0, 0, (phase0(F), p0_small_weights(F)))
    SEAM(0)
    PH(1, 1, phase1(F))
    SEAM(1)
    PH(2, 2, phase2(F))
    SEAM(2)
    PH(3, 3, phase_prepA(F))
    SEAM(3)
    PH(4, 4, phase_gategemm(F))
    PH(4, 5, phase_loragemm(F))
    SEAM(4)
    PH(5, 30, phase_lrulocal(F))
    PH(5, 7, phase_rwkvlocal_mfma(F))
    SEAM(5)
    PH(6, 30, phase_scan(F, flags | 4))
    SEAM(6)
    PH(7, 9, phase_post(F, flags))
    SEAM(7)
    PH(8, 10, phase_outproj(F))
    SEAM(8)
    PH(9, 30, phase_route(F))
    SEAM(9)
    PH(10, 12, phase_m1(F))
    SEAM(10)
    PH(11, 13, phase_m2(F))
    SEAM(11)
    PH(12, 30, phase_final(F))
#undef SEAM
#undef PH
#undef PH1
#undef IN
}

extern "C" void kernel_launch(void* const* d_in, const int* in_sizes, int n_in, void* d_out, int out_size, void* d_ws, size_t ws_size, hipStream_t stream) {
    if (n_in != 35 || out_size != NTOK * D || ws_size < WS_END) { fprintf(stderr, "kernel_launch: unexpected shapes (n_in %d out %d ws %zu)\n", n_in, out_size, ws_size); return; }
    static int grid = 0;
    if (grid == 0) {
        int dev = 0, cus = 0;
        if (hipGetDevice(&dev) != hipSuccess || hipDeviceGetAttribute(&cus, hipDeviceAttributeMultiprocessorCount, dev) != hipSuccess) { grid = -1; return; }
        if (hipFuncSetAttribute((const void*)mk_fwd, hipFuncAttributeMaxDynamicSharedMemorySize, LDS_BYTES) != hipSuccess) { fprintf(stderr, "kernel_launch: hipFuncSetAttribute failed\n"); grid = -1; return; }
        int per_cu = 0;
        if (hipOccupancyMaxActiveBlocksPerMultiprocessor(&per_cu, (const void*)mk_fwd, NWAVES * 64, LDS_BYTES) != hipSuccess || per_cu < 1) { fprintf(stderr, "kernel_launch: occupancy query says %d blocks per CU\n", per_cu); (void)hipGetLastError(); }
        grid = cus;
        if (cus != 256) { fprintf(stderr, "kernel_launch: built for a 256-CU device (found %d CUs); nothing launched\n", cus); grid = -1; return; }
    }
    if (grid < 0) return;
    Args a{};
    for (int i = 0; i < 35; ++i) a.in[i] = (const float*)d_in[i];
    a.out = (float*)d_out; a.ws = (unsigned char*)d_ws; a.ph_lo = 0; a.ph_hi = 13; a.flags = 3;
    (void)hipMemsetAsync((char*)d_ws + WS_CTL, 0, 64 * 1024, stream);
    hipLaunchKernelGGL(mk_fwd, dim3(grid), dim3(NWAVES * 64), LDS_BYTES, stream, a);
}
```

```cpp
#include <hip/hip_runtime.h>
#include <stdint.h>
#include <cstdio>

typedef unsigned short bf16;
__device__ __forceinline__ bf16 f2bf(float f) { unsigned u = __float_as_uint(f); return (bf16)((u + 0x7fffu + ((u >> 16) & 1u)) >> 16); }
__device__ __forceinline__ float bf2f(bf16 b) { return __uint_as_float(((unsigned)b) << 16); }
__device__ __forceinline__ float bflo(unsigned u) { return __uint_as_float(u << 16); }
__device__ __forceinline__ float bfhi(unsigned u) { return __uint_as_float(u & 0xffff0000u); }

constexpr int NB = 4, T = 8192, D = 1024, NTOK = NB * T;
constexpr int LRU_W = 512, RW = 512, PW = 2816;
constexpr int C_UX = 0, C_GATE = 512, C_R = 1024, C_K = 1536, C_V = 2048, C_WD = 2560, C_AD = 2624, C_GD = 2688;
constexpr int NE = 32, DE = 512;
constexpr size_t MiB = 1u << 20;
constexpr size_t WS_CTL = 0;
constexpr int CW_FANIN = 1024;
constexpr int CW_BAR = 4096;
constexpr size_t WS_CNT = 32 * 1024;
constexpr size_t WS_MOD = 1 * MiB;
constexpr size_t WS_SELW = 384 * MiB;
constexpr size_t WS_SEL = 1 * MiB + 512 * 1024;
constexpr size_t FW_WLORAT = 2 * MiB;
constexpr size_t FW_WGT = 3 * MiB;
constexpr size_t FW_WR = 3 * MiB + 512 * 1024;
constexpr size_t FW_WINT = 4 * MiB;
constexpr size_t FW_WOUTT = 10 * MiB;
constexpr size_t WS_LIST = 12 * MiB;
constexpr size_t WS_H = 16 * MiB;
constexpr size_t WS_YMIX = WS_H;
constexpr size_t WS_P = 80 * MiB;
constexpr size_t WS_HID = WS_P;
constexpr size_t WS_Y = 152 * MiB;
constexpr size_t WS_YS = 256 * MiB;
constexpr size_t FW_W13T = 416 * MiB;
constexpr size_t FW_W2T = 480 * MiB;
constexpr size_t WS_END = 512 * MiB;

__device__ __forceinline__ float wave_sum(float v) {
    v += __int_as_float(__builtin_amdgcn_update_dpp(0, __float_as_int(v), 0xB1, 0xF, 0xF, true));
    v += __int_as_float(__builtin_amdgcn_update_dpp(0, __float_as_int(v), 0x4E, 0xF, 0xF, true));
    v += __int_as_float(__builtin_amdgcn_update_dpp(0, __float_as_int(v), 0x141, 0xF, 0xF, true));
    v += __int_as_float(__builtin_amdgcn_update_dpp(0, __float_as_int(v), 0x140, 0xF, 0xF, true));
    const int vi = __float_as_int(v);
    const float r0 = __int_as_float(__builtin_amdgcn_readlane(vi, 0)), r1 = __int_as_float(__builtin_amdgcn_readlane(vi, 16));
    const float r2 = __int_as_float(__builtin_amdgcn_readlane(vi, 32)), r3 = __int_as_float(__builtin_amdgcn_readlane(vi, 48));
    return (r0 + r1) + (r2 + r3);
}
__device__ __forceinline__ float fexp(float x) { return __builtin_amdgcn_exp2f(x * 1.44269504089f); }
__device__ __forceinline__ float flog(float x) { return __builtin_amdgcn_logf(x) * 0.69314718056f; }
__device__ __forceinline__ float frcp(float x) { return __builtin_amdgcn_rcpf(x); }
__device__ __forceinline__ float sigmoidf_(float x) { return frcp(1.f + fexp(-x)); }
__device__ __forceinline__ float softplusf_(float x) { return x > 20.f ? x : flog(1.f + fexp(x)); }
__device__ __forceinline__ float ftanh(float u) { return 1.f - 2.f * frcp(1.f + fexp(2.f * u)); }
__device__ __forceinline__ float gelu_tanh(float x) { const float u = 0.7978845608028654f * (x + 0.044715f * x * x * x); return 0.5f * x * (1.f + ftanh(u)); }

namespace pg8 {
#define PG8_LAS __attribute__((address_space(3)))
typedef unsigned short bf16_t;
typedef short bf16x8 __attribute__((ext_vector_type(8)));
typedef float f32x4 __attribute__((ext_vector_type(4)));
typedef unsigned u32x4 __attribute__((ext_vector_type(4)));
constexpr int BM = 256, BK = 64, HALF = 128, HTB = HALF * BK * 2  , STAGE_BYTES = 8 * HTB, NXCD = 8, WGM = 8;

__host__ __device__ __forceinline__ int lds_byte(int r, int c) { const int st = (r >> 4) * 2 + (c >> 5), rr = r & 15, cc = c & 31, ob = rr * 64 + cc * 2; return st * 1024 + (ob ^ (((ob >> 9) & 1) << 5)); }
__host__ __device__ __forceinline__ void stage_rc(int b, int& R, int& C) { const int st = b / 1024, sb = b % 1024, swz = sb ^ (((sb >> 9) & 1) << 5); R = (st >> 1) * 16 + swz / 64; C = (st & 1) * 32 + (swz % 64) / 2; }
__host__ __device__ __forceinline__ int perm32(int rho) { const int n = rho >> 4, i = rho & 15; return 8 * (i >> 2) + 4 * n + (i & 3); }

struct Unit { int pm, pn, e, nrows, row0; };
struct Gemm { const bf16_t* A; const bf16_t* Bt; int lda, ldb, K; };

__device__ __forceinline__ unsigned cvt_pk_bf16(float lo, float hi) { unsigned r; asm volatile("v_cvt_pk_bf16_f32 %0, %1, %2" : "=v"(r) : "v"(lo), "v"(hi)); return r; }

struct DenseOrder {
    static constexpr bool GATHER = false;
    int nM, nN, nwg, G, c;
    __device__ void init(int M, int N, int G_, int c_) { nM = M / BM; nN = N / BM; nwg = nM * nN; G = G_; c = c_; }
    __device__ bool next(int i, Unit& u) const {
        const long L = (long)i * G + c; if (L >= nwg) return false;
        int wgid = (int)L; { const int q = nwg / NXCD, r = nwg % NXCD, xcd = wgid % NXCD, off = wgid / NXCD; wgid = (xcd < r ? xcd * (q + 1) : r * (q + 1) + (xcd - r) * q) + off; }
        const int nig = WGM * nN, gid = wgid / nig, fm = gid * WGM, gsz = (nM - fm) < WGM ? (nM - fm) : WGM;
        u.pm = fm + ((wgid % nig) % gsz); u.pn = (wgid % nig) / gsz; u.e = 0; u.nrows = 256; u.row0 = 0; return true;
    }
    __device__ __forceinline__ const char* a_base(const Gemm& g, const Unit& u) const { return (const char*)g.A + (size_t)u.pm * (BM * 2) * g.lda; }
    __device__ __forceinline__ const char* b_base(const Gemm& g, const Unit& u) const { return (const char*)g.Bt + (size_t)u.pn * (BM * 2) * g.ldb; }
    __device__ __forceinline__ int row(const Unit&, int) const { return 0; }
};

template <class Epi, class Sched>
__device__ __forceinline__ void gemm_phase(PG8_LAS unsigned char* lds, const Gemm g, const Sched& S, const Epi& E, const int tid) {
    const int wid = __builtin_amdgcn_readfirstlane(tid >> 6), lane = tid & 63, wr = wid >> 2, wc = wid & 3, fr = lane & 15, fq = lane >> 4;
    const int K = g.K, nt = K / BK;
    unsigned voffA[2], voffB[2]; int sR[2], sC[2];
#pragma unroll
    for (int i = 0; i < 2; ++i) { int R, C; stage_rc(tid * 16 + i * 8192, R, C); const int Rb = Epi::PERM ? ((R & ~31) + perm32(R & 31)) : R;
        voffA[i] = (unsigned)(R * g.lda + C) * 2u; voffB[i] = (unsigned)(Rb * g.ldb + C) * 2u; sR[i] = R; sC[i] = C; }
    const size_t kstep = (size_t)(BK * 2);
    const size_t hstepA = Sched::GATHER ? 0 : (size_t)HALF * g.lda * 2, hstepB = (size_t)HALF * g.ldb * 2;
    const unsigned ldsw = (unsigned)wid * 1024u;
    const int aoff = lds_byte(wr * 64 + fr, fq * 8), boff = lds_byte(wc * 32 + fr, fq * 8);
    unsigned gA[2][2], gN[2][2];
#define PG8_SA(b, h) (((b) * 2 + (h)) * HTB)
#define PG8_SB(b, h) ((4 + (b) * 2 + (h)) * HTB)
#define PG8_STAGE(bufoff, gbase, voff) do { _Pragma("unroll") for (int _i = 0; _i < 2; ++_i) \
        __builtin_amdgcn_global_load_lds((const unsigned*)((const char*)(gbase) + (voff)[_i]), (PG8_LAS unsigned*)(lds + (bufoff) + ldsw + _i * 8192), 16, 0, 0); } while (0)
#define PG8_STAGE_A(bufoff, kp, h, OFF) do { if constexpr (Sched::GATHER) PG8_STAGE(bufoff, kp, OFF[h]); else PG8_STAGE(bufoff, (kp) + (h) * hstepA, voffA); } while (0)
#define PG8_LDA(dst, b, h) do { _Pragma("unroll") for (int m = 0; m < 4; ++m) _Pragma("unroll") for (int k = 0; k < 2; ++k) dst[m][k] = *(const PG8_LAS bf16x8*)(lds + PG8_SA(b, h) + aoff + m * 2048 + k * 1024); } while (0)
#define PG8_LDB(dst, b, h) do { _Pragma("unroll") for (int n = 0; n < 2; ++n) _Pragma("unroll") for (int k = 0; k < 2; ++k) dst[n][k] = *(const PG8_LAS bf16x8*)(lds + PG8_SB(b, h) + boff + n * 2048 + k * 1024); } while (0)
#define PG8_MMA(ai, bj, At, Bt) do { __builtin_amdgcn_s_setprio(1); _Pragma("unroll") for (int m = 0; m < 4; ++m) _Pragma("unroll") for (int n = 0; n < 2; ++n) _Pragma("unroll") for (int k = 0; k < 2; ++k) \
        acc[ai][bj][m][n] = __builtin_amdgcn_mfma_f32_16x16x32_bf16(Bt[n][k], At[m][k], acc[ai][bj][m][n], 0, 0, 0); __builtin_amdgcn_s_setprio(0); } while (0)
#define PG8_WAIT_V(n) asm volatile("s_waitcnt vmcnt(" #n ")" ::: "memory")
#define PG8_WAIT_L(n) asm volatile("s_waitcnt lgkmcnt(" #n ")" ::: "memory")
#define PG8_BAR __builtin_amdgcn_s_barrier()
#define PG8_SCHED __builtin_amdgcn_sched_barrier(0)
    Unit cur, nxt; int ui = 0;
    if (!S.next(0, cur)) return;
    f32x4 acc[2][2][4][2];
#pragma unroll
    for (int a = 0; a < 2; ++a)
#pragma unroll
        for (int b = 0; b < 2; ++b)
#pragma unroll
            for (int m = 0; m < 4; ++m)
#pragma unroll
                for (int n = 0; n < 2; ++n) acc[a][b][m][n] = (f32x4){0.f, 0.f, 0.f, 0.f};
    bf16x8 At[4][2], B0[2][2], B1[2][2];
    const char* cA = S.a_base(g, cur); const char* cB = S.b_base(g, cur);
    if constexpr (Sched::GATHER) {
#pragma unroll
        for (int h = 0; h < 2; ++h)
#pragma unroll
            for (int i = 0; i < 2; ++i) gA[h][i] = (unsigned)(S.row(cur, h * HALF + sR[i]) * g.lda + sC[i]) * 2u;
    }
    PG8_STAGE(PG8_SB(0, 0), cB, voffB); PG8_STAGE(PG8_SB(0, 1), cB + hstepB, voffB); PG8_STAGE_A(PG8_SA(0, 0), cA, 0, gA); PG8_STAGE_A(PG8_SA(0, 1), cA, 1, gA);
    if (wr == 1) PG8_BAR;
    PG8_WAIT_V(2); PG8_BAR;
    PG8_STAGE(PG8_SB(1, 0), cB + kstep, voffB); PG8_STAGE_A(PG8_SA(1, 0), cA + kstep, 0, gA); PG8_STAGE(PG8_SB(1, 1), cB + hstepB + kstep, voffB);
    PG8_WAIT_V(6); PG8_BAR;
    for (;;) {
        const bool has_next = S.next(ui + 1, nxt);
        const char* nA = has_next ? S.a_base(g, nxt) : cA; const char* nB = has_next ? S.b_base(g, nxt) : cB;
        if constexpr (Sched::GATHER) {
#pragma unroll
            for (int h = 0; h < 2; ++h)
#pragma unroll
                for (int i = 0; i < 2; ++i) gN[h][i] = has_next ? (unsigned)(S.row(nxt, h * HALF + sR[i]) * g.lda + sC[i]) * 2u : gA[h][i];
        }
#pragma unroll 1
        for (int t = 0; t < nt; t += 2) {
            const bool last = (t == nt - 2);
            const char* a1 = cA + (size_t)(t + 1) * kstep;
            const char* a2 = last ? nA : cA + (size_t)(t + 2) * kstep; const char* b2 = last ? nB : cB + (size_t)(t + 2) * kstep;
            const char* a3 = a2 + kstep; const char* b3 = b2 + kstep;
            unsigned o2[2][2];
            if constexpr (Sched::GATHER) {
#pragma unroll
                for (int h = 0; h < 2; ++h)
#pragma unroll
                    for (int i = 0; i < 2; ++i) o2[h][i] = last ? gN[h][i] : gA[h][i];
            }
            PG8_LDB(B0, 0, 0); PG8_LDB(B1, 0, 1); PG8_SCHED; PG8_LDA(At, 0, 0); PG8_STAGE_A(PG8_SA(1, 1), a1, 1, gA);
            PG8_WAIT_V(8); PG8_WAIT_L(0); PG8_BAR; PG8_MMA(0, 0, At, B0); PG8_MMA(0, 1, At, B1); PG8_BAR; PG8_SCHED;
            PG8_LDA(At, 0, 1); PG8_STAGE(PG8_SB(0, 0), b2, voffB); PG8_STAGE(PG8_SB(0, 1), b2 + hstepB, voffB); PG8_STAGE_A(PG8_SA(0, 0), a2, 0, o2);
            PG8_WAIT_V(8); PG8_WAIT_L(0); PG8_BAR; PG8_MMA(1, 0, At, B0); PG8_MMA(1, 1, At, B1); PG8_BAR; PG8_SCHED;
            PG8_LDB(B0, 1, 0); PG8_LDB(B1, 1, 1); PG8_SCHED; PG8_LDA(At, 1, 0); PG8_STAGE_A(PG8_SA(0, 1), a2, 1, o2);
            PG8_WAIT_V(8); PG8_WAIT_L(0); PG8_BAR; PG8_MMA(0, 0, At, B0); PG8_MMA(0, 1, At, B1); PG8_BAR; PG8_SCHED;
            PG8_LDA(At, 1, 1); PG8_STAGE(PG8_SB(1, 0), b3, voffB); PG8_STAGE(PG8_SB(1, 1), b3 + hstepB, voffB); PG8_STAGE_A(PG8_SA(1, 0), a3, 0, o2);
            PG8_WAIT_V(8); PG8_WAIT_L(0); PG8_BAR; PG8_MMA(1, 0, At, B0); PG8_MMA(1, 1, At, B1); PG8_BAR; PG8_SCHED;
        }
        if (wr == 0) PG8_BAR;
        E(acc, cur, wr, wc, fr, fq);
        if (!has_next) break;
#pragma unroll
        for (int a = 0; a < 2; ++a)
#pragma unroll
            for (int b = 0; b < 2; ++b)
#pragma unroll
                for (int m = 0; m < 4; ++m)
#pragma unroll
                    for (int n = 0; n < 2; ++n) acc[a][b][m][n] = (f32x4){0.f, 0.f, 0.f, 0.f};
        cur = nxt; cA = nA; cB = nB; ++ui;
        if constexpr (Sched::GATHER) {
#pragma unroll
            for (int h = 0; h < 2; ++h)
#pragma unroll
                for (int i = 0; i < 2; ++i) gA[h][i] = gN[h][i];
        }
        if (wr == 1) PG8_BAR;
    }
    PG8_WAIT_V(0);
    PG8_BAR;
#undef PG8_SA
#undef PG8_SB
#undef PG8_STAGE
#undef PG8_STAGE_A
#undef PG8_LDA
#undef PG8_LDB
#undef PG8_MMA
#undef PG8_WAIT_V
#undef PG8_WAIT_L
#undef PG8_BAR
#undef PG8_SCHED
}

struct EpiBf16Store {
    static constexpr bool PERM = true;
    bf16_t* O; int ldc;
    __device__ __forceinline__ void operator()(const f32x4 (&acc)[2][2][4][2], const Unit& u, int wr, int wc, int fr, int fq) const {
        const int row0 = u.pm * BM + wr * 64 + fr, col0 = u.pn * BM + wc * 32 + 8 * fq;
#pragma unroll
        for (int ai = 0; ai < 2; ++ai)
#pragma unroll
            for (int m = 0; m < 4; ++m) { bf16_t* rowp = O + (size_t)(row0 + ai * HALF + m * 16) * ldc + col0;
#pragma unroll
                for (int bj = 0; bj < 2; ++bj) { const f32x4 v0 = acc[ai][bj][m][0], v1 = acc[ai][bj][m][1];
                    u32x4 w; w.x = cvt_pk_bf16(v0[0], v0[1]); w.y = cvt_pk_bf16(v0[2], v0[3]); w.z = cvt_pk_bf16(v1[0], v1[1]); w.w = cvt_pk_bf16(v1[2], v1[3]);
                    *(u32x4*)(rowp + bj * HALF) = w; } }
    }
};
}
constexpr int NWAVES = 8;
constexpr int RING_OFF = 0, RING_BYTES = 131072;
constexpr int ROUTER_LDS = 147456;
constexpr int LDSCTL_OFF = ROUTER_LDS, MISC_OFF = LDSCTL_OFF + 320;
constexpr int LDS_TAB_OFF = LDSCTL_OFF + 1024;
constexpr int LDS_BYTES = 155648;

#define GAS __attribute__((address_space(1)))
#define LAS __attribute__((address_space(3)))
typedef unsigned v4u __attribute__((ext_vector_type(4)));
typedef unsigned v2u __attribute__((ext_vector_type(2)));
typedef float f32x4 __attribute__((ext_vector_type(4)));
#define LDS_WAIT() asm volatile("s_waitcnt lgkmcnt(0)" ::: "memory")
#define VM_WAIT() asm volatile("s_waitcnt vmcnt(0)" ::: "memory")
__device__ __forceinline__ unsigned pk2(float lo, float hi) { return (unsigned)f2bf(lo) | ((unsigned)f2bf(hi) << 16); }


struct Frame {
    LAS unsigned char* lds;
    int tid, lane, wave, vcu, G;
    const float* const* in;
    float* out; unsigned char* ws;
};

__device__ __forceinline__ void p0_transpose_item(const float* W, int ldw, bf16* WT, int ldt, int k0, int n0, int row0, LAS float* scr, int lane) {
    {
        f32x4 t[8];
#pragma unroll
        for (int i = 0; i < 8; ++i) t[i] = *(const f32x4*)(W + (size_t)(k0 + 8 * i + (lane >> 3)) * ldw + n0 + 4 * (lane & 7));
#pragma unroll
        for (int i = 0; i < 8; ++i) { LAS float* d = scr + (8 * i + (lane >> 3)) * 33 + 4 * (lane & 7); d[0] = t[i].x; d[1] = t[i].y; d[2] = t[i].z; d[3] = t[i].w; }
    }
    LDS_WAIT(); asm volatile("" ::: "memory");
    const int c = lane & 7;
#pragma unroll
    for (int j = 0; j < 4; ++j) { const int n = (lane >> 3) + 8 * j; const LAS float* s = scr + (8 * c) * 33 + n;
        v4u o; o.x = pk2(s[0 * 33], s[1 * 33]); o.y = pk2(s[2 * 33], s[3 * 33]); o.z = pk2(s[4 * 33], s[5 * 33]); o.w = pk2(s[6 * 33], s[7 * 33]);
        *(v4u*)(WT + (size_t)(row0 + n) * ldt + k0 + 8 * c) = o; }
    LDS_WAIT(); asm volatile("" ::: "memory");
}

__device__ __forceinline__ void p0_mod_task(Frame& F, int task) {
    LAS float* sc = (LAS float*)(F.lds);
    LAS float* red = (LAS float*)(F.lds + 16384);
    const float* c = F.in[1]; const float* w_ada = F.in[2]; const float* b_ada = F.in[3];
    for (int i = F.tid; i < 4096; i += 512) { const float cv = c[i]; sc[i] = cv / (1.f + __expf(-cv)); }
    __syncthreads();
    const int j = task * 32 + (F.lane & 31);
    float a0 = 0.f, a1 = 0.f, a2 = 0.f, a3 = 0.f;
    const int kb = F.wave * 128 + (F.lane >> 5) * 64;
#pragma unroll 16
    for (int k = kb; k < kb + 64; ++k) { const float w = w_ada[(size_t)k * 6144 + j]; a0 += sc[k] * w; a1 += sc[1024 + k] * w; a2 += sc[2048 + k] * w; a3 += sc[3072 + k] * w; }
    red[(F.wave * 4 + 0) * 64 + F.lane] = a0; red[(F.wave * 4 + 1) * 64 + F.lane] = a1; red[(F.wave * 4 + 2) * 64 + F.lane] = a2; red[(F.wave * 4 + 3) * 64 + F.lane] = a3;
    __syncthreads();
    if (F.tid < 128) { const int b = F.tid >> 5, l = F.tid & 31; float s = 0.f;
#pragma unroll
        for (int w = 0; w < 8; ++w) s += red[(w * 4 + b) * 64 + l] + red[(w * 4 + b) * 64 + 32 + l];
        ((float*)(F.ws + WS_MOD))[b * 6144 + task * 32 + l] = s + b_ada[task * 32 + l]; }
    __syncthreads();
}

__device__ __forceinline__ void phase0(Frame& F) {
    if (blockIdx.x < 192) p0_mod_task(F, blockIdx.x);
    LAS float* scr = (LAS float*)(F.lds + RING_OFF + F.wave * 16384);
    const int gw = F.vcu * NWAVES + F.wave, NGW = F.G * NWAVES;
    constexpr int I_IN = (D / 64) * (PW / 32), I_OUT = (D / 64) * (D / 32);
    constexpr int NITEMS = I_IN + I_OUT;
    for (int it = gw; it < NITEMS; it += NGW) {
        int r = it;
        if (r < I_IN) { const int nb = PW / 32, kb = r / nb, n = r % nb; p0_transpose_item(F.in[5], PW, (bf16*)(F.ws + FW_WINT), D, 64 * kb, 32 * n, 32 * n, scr, F.lane); continue; } r -= I_IN;
        { const int nb = D / 32, kb = r / nb, n = r % nb; p0_transpose_item(F.in[25], D, (bf16*)(F.ws + FW_WOUTT), D, 64 * kb, 32 * n, 32 * n, scr, F.lane); }
    }
}
__device__ __forceinline__ void expert_transposes(Frame& F, int wv, int nwv) {
    LAS float* scr = (LAS float*)(F.lds + RING_OFF + F.wave * 16384);
    constexpr int I_E13 = NE * 2 * 256, I_E2 = NE * 256;
    for (int it = wv; it < I_E13 + I_E2; it += nwv) {
        int r = it;
        if (r < I_E13) {
            const int e = r >> 9, which = (r >> 8) & 1, q = r & 255, kb = q >> 4, n = q & 15, n0 = 32 * n;
            const float* W = (which ? F.in[32] : F.in[31]) + (size_t)e * D * DE;
            p0_transpose_item(W, DE, (bf16*)(F.ws + FW_W13T) + (size_t)e * 1024 * 1024, D, 64 * kb, n0, (n0 >> 7) * 256 + which * 128 + (n0 & 127), scr, F.lane); continue; } r -= I_E13;
        {
            const int e = r >> 8, q = r & 255, kb = q >> 5, n = q & 31;
            p0_transpose_item(F.in[33] + (size_t)e * DE * D, D, (bf16*)(F.ws + FW_W2T) + (size_t)e * 1024 * DE, DE, 64 * kb, 32 * n, 32 * n, scr, F.lane); }
    }
}

__device__ __forceinline__ void adaln_row(const float* xrow, const float* g, const float* sh, const float* sc, bf16* orow, int lane) {
    const f32x4* xr = (const f32x4*)xrow + lane;
    f32x4 v[4]; float s = 0.f;
#pragma unroll
    for (int j = 0; j < 4; ++j) { v[j] = xr[64 * j]; s += (v[j].x * v[j].x + v[j].y * v[j].y) + (v[j].z * v[j].z + v[j].w * v[j].w); }
    const float rinv = rsqrtf(wave_sum(s) * (1.f / D) + 1e-6f);
    v2u* o8 = (v2u*)orow + lane;
#pragma unroll
    for (int j = 0; j < 4; ++j) { const f32x4 gg = ((const f32x4*)g)[lane + 64 * j], s1 = ((const f32x4*)sc)[lane + 64 * j], s0 = ((const f32x4*)sh)[lane + 64 * j];
        f32x4 y = v[j] * rinv * gg; y = y * (s1 + 1.f) + s0;
        v2u w; w.x = pk2(y.x, y.y); w.y = pk2(y.z, y.w); o8[64 * j] = w; }
}
__device__ __forceinline__ void phase1(Frame& F) {
    const int gw = F.vcu * NWAVES + F.wave, NGW = F.G * NWAVES;
    const float* mod = (const float*)(F.ws + WS_MOD);
    for (int m = gw; m < NTOK; m += NGW) { const int b = m / T;
        adaln_row(F.in[0] + (size_t)m * D, F.in[4], mod + b * 6144, mod + b * 6144 + 1024, (bf16*)(F.ws + WS_H) + (size_t)m * D, F.lane); }
}
__device__ __forceinline__ void phase2(Frame& F) {
    pg8::Gemm g{(const bf16*)(F.ws + WS_H), (const bf16*)(F.ws + FW_WINT), D, D, D};
    pg8::DenseOrder S; S.init(NTOK, PW, F.G, (int)blockIdx.x);
    pg8::EpiBf16Store E{(bf16*)(F.ws + WS_P), PW};
    pg8::gemm_phase<pg8::EpiBf16Store, pg8::DenseOrder>(F.lds + RING_OFF, g, S, E, F.tid);
}


namespace pg8 {
struct EpiX1F {
    static constexpr bool PERM = true;
    const float* const* in; unsigned char* ws; float* out;
    __device__ __forceinline__ void operator()(const f32x4 (&acc)[2][2][4][2], const Unit& u, int wr, int wc, int fr, int fq) const {
        const float* mod = (const float*)(ws + WS_MOD); bf16_t* Y = (bf16_t*)(ws + WS_Y);
        const int row0 = u.pm * BM + wr * 64 + fr, col0 = u.pn * BM + wc * 32 + 8 * fq;
        const float* g1 = mod + ((u.pm * BM) / T) * 6144 + 2048;
        f32x4 gv[2][2];
#pragma unroll
        for (int bj = 0; bj < 2; ++bj)
#pragma unroll
            for (int n = 0; n < 2; ++n) gv[bj][n] = *(const f32x4*)(g1 + col0 + bj * HALF + n * 4);
#pragma unroll
        for (int ai = 0; ai < 2; ++ai)
#pragma unroll
            for (int m = 0; m < 4; ++m) { bf16_t* rowp = Y + (size_t)(row0 + ai * HALF + m * 16) * D + col0;
#pragma unroll
                for (int bj = 0; bj < 2; ++bj) { const f32x4 v0 = acc[ai][bj][m][0] * gv[bj][0], v1 = acc[ai][bj][m][1] * gv[bj][1];
                    u32x4 w; w.x = cvt_pk_bf16(v0[0], v0[1]); w.y = cvt_pk_bf16(v0[2], v0[3]); w.z = cvt_pk_bf16(v1[0], v1[1]); w.w = cvt_pk_bf16(v1[2], v1[3]);
                    *(u32x4*)(rowp + bj * HALF) = w; } }
    }
};
template <bool GATH> struct MoeOrder {
    static constexpr bool GATHER = GATH;
    const LAS int* ub; const LAS int* rb; const LAS int* cn; const int* list; int G, c, brows;
    __device__ bool next(int i, Unit& u) const {
        int e, local;
        if ((G & 7) == 0) {
            const int x = c & 7, L = i * (G >> 3) + (c >> 3); const LAS int* xb = ub + 98 + x * 5;
            if (L >= xb[4]) return false;
            int j = 0;
#pragma unroll
            for (int k = 2; k >= 1; k >>= 1) if (xb[j + k] <= L) j += k;
            e = x + 8 * j; local = L - xb[j];
        } else {
            const int L = i * G + c; if (L >= ub[32]) return false;
            e = 0;
#pragma unroll
            for (int k = 16; k >= 1; k >>= 1) if (ub[e + k] <= L) e += k;
            local = L - ub[e];
        }
        const int tiles = rb[e + 1] - rb[e], pn = local / tiles, mt = local - pn * tiles;
        u.e = e; u.pn = pn; u.pm = rb[e] + mt; u.row0 = e * NTOK + mt * 256; u.nrows = min(256, cn[e] - mt * 256); return true;
    }
    __device__ __forceinline__ const char* a_base(const Gemm& g, const Unit& u) const { return GATH ? (const char*)g.A : (const char*)g.A + (size_t)u.pm * (BM * 2) * g.lda; }
    __device__ __forceinline__ const char* b_base(const Gemm& g, const Unit& u) const { return (const char*)g.Bt + ((size_t)u.e * brows + (size_t)u.pn * BM) * 2 * g.ldb; }
    __device__ __forceinline__ int row(const Unit& u, int r) const { return r < u.nrows ? (list[u.row0 + r] >> 1) : 0; }
};
struct EpiSwiglu {
    static constexpr bool PERM = true;
    bf16_t* HID;
    __device__ __forceinline__ void operator()(const f32x4 (&acc)[2][2][4][2], const Unit& u, int wr, int wc, int fr, int fq) const {
        const int col0 = u.pn * HALF + wc * 32 + 8 * fq;
#pragma unroll
        for (int ai = 0; ai < 2; ++ai)
#pragma unroll
            for (int m = 0; m < 4; ++m) { const int r = ai * HALF + wr * 64 + m * 16 + fr;
                if (r < u.nrows) { float h[8];
#pragma unroll
                    for (int n = 0; n < 2; ++n)
#pragma unroll
                        for (int i = 0; i < 4; ++i) { const float a = acc[ai][0][m][n][i], b = acc[ai][1][m][n][i]; h[n * 4 + i] = a * frcp(1.f + fexp(-a)) * b; }
                    u32x4 w; w.x = cvt_pk_bf16(h[0], h[1]); w.y = cvt_pk_bf16(h[2], h[3]); w.z = cvt_pk_bf16(h[4], h[5]); w.w = cvt_pk_bf16(h[6], h[7]);
                    *(u32x4*)(HID + (size_t)(u.pm * BM + r) * DE + col0) = w; } }
    }
};
struct EpiYs {
    static constexpr bool PERM = true;
    unsigned char* ws;
    __device__ __forceinline__ void operator()(const f32x4 (&acc)[2][2][4][2], const Unit& u, int wr, int wc, int fr, int fq) const {
        bf16_t* YS = (bf16_t*)(ws + WS_YS); const int* list = (const int*)(ws + WS_LIST); const float* selw = (const float*)(ws + WS_SELW);
        const int col0 = u.pn * BM + wc * 32 + 8 * fq;
#pragma unroll
        for (int ai = 0; ai < 2; ++ai)
#pragma unroll
            for (int m = 0; m < 4; ++m) { const int r = ai * HALF + wr * 64 + m * 16 + fr;
                if (r < u.nrows) { const int li = list[u.row0 + r]; const float w8 = selw[u.row0 + r]; bf16_t* rowp = YS + (size_t)li * D + col0;
#pragma unroll
                    for (int bj = 0; bj < 2; ++bj) { const f32x4 v0 = acc[ai][bj][m][0] * w8, v1 = acc[ai][bj][m][1] * w8;
                        u32x4 w; w.x = cvt_pk_bf16(v0[0], v0[1]); w.y = cvt_pk_bf16(v0[2], v0[3]); w.z = cvt_pk_bf16(v1[0], v1[1]); w.w = cvt_pk_bf16(v1[2], v1[3]);
                        *(u32x4*)(rowp + bj * HALF) = w; } } }
    }
};
}

__device__ __forceinline__ void phase_outproj(Frame& F) {
    pg8::Gemm g{(const bf16*)(F.ws + WS_YMIX), (const bf16*)(F.ws + FW_WOUTT), D, D, D};
    pg8::DenseOrder S; S.init(NTOK, D, F.G, (int)blockIdx.x);
    pg8::EpiX1F E{F.in, F.ws, F.out};
    pg8::gemm_phase<pg8::EpiX1F, pg8::DenseOrder>(F.lds + RING_OFF, g, S, E, F.tid);
}

__device__ __forceinline__ void phase_route(Frame& F) {
    LAS float* wt = (LAS float*)F.lds;
    { const f32x4* WR = (const f32x4*)(F.ws + FW_WR); LAS f32x4* wt4 = (LAS f32x4*)F.lds;
      for (int i = F.tid; i < 36 * 256; i += 512) wt4[i] = WR[i]; }
    __syncthreads();
    const float* mod = (const float*)(F.ws + WS_MOD); const float* g2n = F.in[26];
    int* cnt = (int*)(F.ws + WS_CNT); int* list = (int*)(F.ws + WS_LIST); float* selw = (float*)(F.ws + WS_SELW);
    bf16* H2 = (bf16*)(F.ws + WS_H);
    const int gw = F.vcu * NWAVES + F.wave, NGW = F.G * NWAVES, lane = F.lane;
    LAS int* lcnt = (LAS int*)(F.lds + LDSCTL_OFF + 2048); LAS int* lbase = lcnt + 32; LAS int* tokres = lcnt + 64; LAS float* tokw = (LAS float*)(tokres + 256);
    if (F.tid < 32) lcnt[F.tid] = 0;
    __syncthreads();
    int it = 0;
    const float* xin = F.in[0]; const bf16* Yb = (const bf16*)(F.ws + WS_Y);
    f32x4 vn[4]; v2u yn[4];
#pragma unroll
    for (int j = 0; j < 4; ++j) { vn[j] = ((const f32x4*)(xin + (size_t)gw * D) + lane)[64 * j]; yn[j] = ((const v2u*)(Yb + (size_t)gw * D) + lane)[64 * j]; }
    f32x4 ggr[4], s1r[4], s0r[4]; int bcur = -1;
#pragma unroll
    for (int j = 0; j < 4; ++j) ggr[j] = ((const f32x4*)g2n)[lane + 64 * j];
    for (int m = gw; m < NTOK; m += NGW, ++it) {
        const int b = m / T;
        if (b != bcur) { bcur = b;
#pragma unroll
            for (int j = 0; j < 4; ++j) { s1r[j] = ((const f32x4*)(mod + b * 6144 + 4096))[lane + 64 * j] + 1.f; s0r[j] = ((const f32x4*)(mod + b * 6144 + 3072))[lane + 64 * j]; } }
        f32x4 v[4]; float s = 0.f;
#pragma unroll
        for (int j = 0; j < 4; ++j) { v[j] = vn[j]; v[j].x += bflo(yn[j].x); v[j].y += bfhi(yn[j].x); v[j].z += bflo(yn[j].y); v[j].w += bfhi(yn[j].y);
            s += (v[j].x * v[j].x + v[j].y * v[j].y) + (v[j].z * v[j].z + v[j].w * v[j].w); }
        if (m + NGW < NTOK) {
#pragma unroll
            for (int j = 0; j < 4; ++j) { vn[j] = ((const f32x4*)(xin + (size_t)(m + NGW) * D) + lane)[64 * j]; yn[j] = ((const v2u*)(Yb + (size_t)(m + NGW) * D) + lane)[64 * j]; }
        }
        const float rinv = rsqrtf(wave_sum(s) * (1.f / D) + 1e-6f);
        v2u* o8 = (v2u*)(H2 + (size_t)m * D) + lane;
#pragma unroll
        for (int j = 0; j < 4; ++j) { f32x4 y = v[j] * rinv * ggr[j]; y = y * s1r[j] + s0r[j]; v[j] = y;
            v2u w; w.x = pk2(y.x, y.y); w.y = pk2(y.z, y.w); o8[64 * j] = w; }
        float pg[4] = {0.f, 0.f, 0.f, 0.f};
#pragma unroll
        for (int j = 0; j < 4; ++j)
#pragma unroll
            for (int e = 0; e < 4; ++e) { const f32x4 w = *(const LAS f32x4*)(wt + e * 1024 + lane * 4 + 256 * j); pg[e] += (v[j].x * w.x + v[j].y * w.y) + (v[j].z * w.z + v[j].w * w.w); }
        const f32x4 bg = *(const f32x4*)F.in[28];
        const float g0 = wave_sum(pg[0]) + bg.x, g1 = wave_sum(pg[1]) + bg.y, g2 = wave_sum(pg[2]) + bg.z, g3 = wave_sum(pg[3]) + bg.w;
        float gm = g0; int gi = 0;
        if (g1 > gm) { gm = g1; gi = 1; } if (g2 > gm) { gm = g2; gi = 2; } if (g3 > gm) { gm = g3; gi = 3; }
        const float gwt = frcp(fexp(g0 - gm) + fexp(g1 - gm) + fexp(g2 - gm) + fexp(g3 - gm));
        gi = __builtin_amdgcn_readfirstlane(gi);
        const LAS float* we = wt + (4 + gi * 8) * 1024 + lane * 4;
        const f32x4 be0 = *(const f32x4*)(F.in[30] + gi * 8), be1 = *(const f32x4*)(F.in[30] + gi * 8 + 4);
        float xe[8];
#pragma unroll
        for (int hf = 0; hf < 2; ++hf) { float pe[4] = {0.f, 0.f, 0.f, 0.f};
#pragma unroll
            for (int j = 0; j < 4; ++j)
#pragma unroll
                for (int e = 0; e < 4; ++e) { const f32x4 w = *(const LAS f32x4*)(we + (hf * 4 + e) * 1024 + 256 * j); pe[e] += (v[j].x * w.x + v[j].y * w.y) + (v[j].z * w.z + v[j].w * w.w); }
#pragma unroll
            for (int e = 0; e < 4; ++e) xe[hf * 4 + e] = wave_sum(pe[e]); }
        xe[0] += be0.x; xe[1] += be0.y; xe[2] += be0.z; xe[3] += be0.w; xe[4] += be1.x; xe[5] += be1.y; xe[6] += be1.z; xe[7] += be1.w;
        float v1 = xe[0], v2 = -3.4e38f; int i1 = 0, i2 = 0;
#pragma unroll
        for (int ii = 1; ii < 8; ++ii) { const float xx = xe[ii]; const bool a1 = xx > v1, a2 = xx > v2;
            v2 = a1 ? v1 : (a2 ? xx : v2); i2 = a1 ? i1 : (a2 ? ii : i2); v1 = a1 ? xx : v1; i1 = a1 ? ii : i1; }
        const float e2 = fexp(v2 - v1), w1 = frcp(1.f + e2), w2 = e2 * w1;
        if (lane == 0) { const int ea = gi * 8 + i1, eb = gi * 8 + i2;
            tokw[(F.wave * 16 + it) * 2] = w1 * gwt; tokw[(F.wave * 16 + it) * 2 + 1] = w2 * gwt;
            const int ra = atomicAdd((int*)&lcnt[ea], 1), rb2 = atomicAdd((int*)&lcnt[eb], 1);
            tokres[(F.wave * 16 + it) * 2] = ea | (ra << 8); tokres[(F.wave * 16 + it) * 2 + 1] = eb | (rb2 << 8); }
    }
    __syncthreads();
    if (F.tid < 32) { const int c = lcnt[F.tid]; lbase[F.tid] = c ? atomicAdd(&cnt[F.tid * 64], c) : 0; }
    __syncthreads();
    if (lane < 16) { const int m = gw + lane * NGW;
        if (m < NTOK) { const int a = tokres[(F.wave * 16 + lane) * 2], b2 = tokres[(F.wave * 16 + lane) * 2 + 1];
            const int pa = (a & 255) * NTOK + lbase[a & 255] + (a >> 8), pb = (b2 & 255) * NTOK + lbase[b2 & 255] + (b2 >> 8);
            list[pa] = m * 2; list[pb] = m * 2 + 1; selw[pa] = tokw[(F.wave * 16 + lane) * 2]; selw[pb] = tokw[(F.wave * 16 + lane) * 2 + 1]; } }
    __syncthreads();
}

__device__ __forceinline__ void moe_tables(Frame& F, int npn) {
    LAS int* tab = (LAS int*)(F.lds + LDS_TAB_OFF);
    if (F.tid == 0) { const int* cnt = (const int*)(F.ws + WS_CNT); int ub = 0, rb = 0;
        for (int e = 0; e < 32; ++e) { const int c = __hip_atomic_load(cnt + e * 64, __ATOMIC_RELAXED, __HIP_MEMORY_SCOPE_AGENT); const int tl = (c + 255) >> 8; tab[e] = ub; tab[33 + e] = rb; tab[66 + e] = c; ub += tl * npn; rb += tl; }
        tab[32] = ub; tab[33 + 32] = rb;
        for (int x = 0; x < 8; ++x) { int s = 0; for (int j = 0; j < 4; ++j) { tab[98 + x * 5 + j] = s; s += tab[x + 8 * j + 1] - tab[x + 8 * j]; } tab[98 + x * 5 + 4] = s; } }
    __syncthreads();
}
__device__ __forceinline__ void phase_m1(Frame& F) {
    moe_tables(F, 4);
    const LAS int* tab = (const LAS int*)(F.lds + LDS_TAB_OFF);
    pg8::Gemm g{(const bf16*)(F.ws + WS_H), (const bf16*)(F.ws + FW_W13T), D, D, D};
    pg8::MoeOrder<true> S{tab, tab + 33, tab + 66, (const int*)(F.ws + WS_LIST), F.G, (int)blockIdx.x, 1024};
    pg8::EpiSwiglu E{(bf16*)(F.ws + WS_HID)};
    pg8::gemm_phase<pg8::EpiSwiglu, pg8::MoeOrder<true>>(F.lds + RING_OFF, g, S, E, F.tid);
}
__device__ __forceinline__ void phase_m2(Frame& F) {
    moe_tables(F, 4);
    const LAS int* tab = (const LAS int*)(F.lds + LDS_TAB_OFF);
    pg8::Gemm g{(const bf16*)(F.ws + WS_HID), (const bf16*)(F.ws + FW_W2T), DE, DE, DE};
    pg8::MoeOrder<false> S{tab, tab + 33, tab + 66, (const int*)(F.ws + WS_LIST), F.G, (int)blockIdx.x, 1024};
    pg8::EpiYs E{F.ws};
    pg8::gemm_phase<pg8::EpiYs, pg8::MoeOrder<false>>(F.lds + RING_OFF, g, S, E, F.tid);
}
__device__ __forceinline__ void phase_final(Frame& F) {
    const int gw = F.vcu * NWAVES + F.wave, NGW = F.G * NWAVES, lane = F.lane;
    const float* mod = (const float*)(F.ws + WS_MOD); const float* fg = F.in[34]; const bf16* YS = (const bf16*)(F.ws + WS_YS);
    const float* xin = F.in[0]; const bf16* Yb = (const bf16*)(F.ws + WS_Y);
    for (int m = gw; m < NTOK; m += NGW) { const int b = m / T;
        f32x4* xr = (f32x4*)(F.out + (size_t)m * D) + lane; const f32x4* xi = (const f32x4*)(xin + (size_t)m * D) + lane; const v2u* yb = (const v2u*)(Yb + (size_t)m * D) + lane;
        const v2u* y0 = (const v2u*)(YS + (size_t)(2 * m) * D) + lane; const v2u* y1 = (const v2u*)(YS + (size_t)(2 * m + 1) * D) + lane;
        f32x4 v[4]; float s = 0.f;
#pragma unroll
        for (int j = 0; j < 4; ++j) { const v2u a = y0[64 * j], c = y1[64 * j], yy = yb[64 * j]; const f32x4 g2 = ((const f32x4*)(mod + b * 6144 + 5120))[lane + 64 * j];
            f32x4 mo; mo.x = bflo(a.x) + bflo(c.x); mo.y = bfhi(a.x) + bfhi(c.x); mo.z = bflo(a.y) + bflo(c.y); mo.w = bfhi(a.y) + bfhi(c.y);
            f32x4 x1 = xi[64 * j]; x1.x += bflo(yy.x); x1.y += bfhi(yy.x); x1.z += bflo(yy.y); x1.w += bfhi(yy.y);
            v[j] = x1 + g2 * mo; s += (v[j].x * v[j].x + v[j].y * v[j].y) + (v[j].z * v[j].z + v[j].w * v[j].w); }
        const float rinv = rsqrtf(wave_sum(s) * (1.f / D) + 1e-6f);
#pragma unroll
        for (int j = 0; j < 4; ++j) xr[64 * j] = v[j] * rinv * ((const f32x4*)fg)[lane + 64 * j];
    }
}
#define XB_TMO      128
#define XB_XCNT(j)  (256  + 64 * (j))
#define XB_XSUB(j)  (1280 + 64 * (j))
#define XB_XGEN(j)  (2304 + 64 * (j))
#define XB_TOP      3328
#define XB_TOPGEN   3392
#define XCD_BAR_WORDS 3456
#define XB_SPIN_CAP (1u << 18)

__device__ __forceinline__ unsigned xb_ld(unsigned* p)              { return __hip_atomic_load(p, __ATOMIC_RELAXED, __HIP_MEMORY_SCOPE_AGENT); }
__device__ __forceinline__ unsigned xb_add(unsigned* p, unsigned v) { return __hip_atomic_fetch_add(p, v, __ATOMIC_RELAXED, __HIP_MEMORY_SCOPE_AGENT); }
__device__ __forceinline__ unsigned xb_xcc_id() { return (unsigned)__builtin_amdgcn_s_getreg((3 << 11) | 20) & 0xFu; }
#define XB_SPIN(cond, bar) do { unsigned _sp = 0; while (cond) { __builtin_amdgcn_s_sleep(1); \
    if ((++_sp & 255u) == 0u) { if (xb_ld(&(bar)[XB_TMO])) break; if (_sp > XB_SPIN_CAP) { atomicAdd(&(bar)[XB_TMO], 1u); break; } } } } while (0)

struct XcdBarrier {
    unsigned* bar; unsigned x;
    volatile LAS unsigned* st;
};

__device__ __forceinline__ XcdBarrier xcd_barrier_post(unsigned* bar, volatile LAS unsigned* st) {
    XcdBarrier b; b.bar = bar; b.x = xb_xcc_id(); b.st = st;
    if (threadIdx.x == 0) (void)xb_add(&bar[XB_XCNT(b.x)], 1u);
    return b;
}
__device__ __forceinline__ void xcd_barrier_complete(unsigned* bar, unsigned x, unsigned& nloc, unsigned& nx) {
    const unsigned G = gridDim.x * gridDim.y * gridDim.z;
    unsigned sum, cnt, mine, sp = 0u;
    for (;;) {
        sum = 0u; cnt = 0u; mine = 0u;
#pragma unroll
        for (unsigned j = 0; j < 16; ++j) { const unsigned c = xb_ld(&bar[XB_XCNT(j)]); sum += c; cnt += (c > 0u) ? 1u : 0u; mine = (j == x) ? c : mine; }
        if (sum == G) break;
        __builtin_amdgcn_s_sleep(1);
        if ((++sp & 255u) == 0u) { if (xb_ld(&bar[XB_TMO])) break; if (sp > XB_SPIN_CAP) { atomicAdd(&bar[XB_TMO], 1u); break; } }
    }
    nloc = mine > 0u ? mine : 1u; nx = cnt > 0u ? cnt : 1u;
}

__device__ __forceinline__ void xcd_barrier(const XcdBarrier& b) {
    asm volatile("s_waitcnt vmcnt(0)" ::: "memory");
    __syncthreads();
    if (threadIdx.x == 0) {
        unsigned* bar = b.bar;
        __builtin_amdgcn_s_waitcnt(0);
        unsigned nloc = b.st[0], nx = b.st[1];
        if (nloc == 0u) { xcd_barrier_complete(bar, b.x, nloc, nx); b.st[0] = nloc; b.st[1] = nx; }
        const unsigned old = xb_add(&bar[XB_XSUB(b.x)], 1u);
        const unsigned gen = old / nloc;
        if (old + 1u == (gen + 1u) * nloc) {
            __builtin_amdgcn_fence(__ATOMIC_RELEASE, "agent");
            asm volatile("s_waitcnt vmcnt(0)" ::: "memory");
            const unsigned og = xb_add(&bar[XB_TOP], 1u);
            const unsigned tg = og / nx;
            if (og + 1u == (tg + 1u) * nx) xb_add(&bar[XB_TOPGEN], 1u);
            else XB_SPIN(xb_ld(&bar[XB_TOPGEN]) == tg, bar);
            __builtin_amdgcn_fence(__ATOMIC_ACQUIRE, "agent");
            xb_add(&bar[XB_XGEN(b.x)], 1u);
            asm volatile("s_waitcnt vmcnt(0)" ::: "memory");
        } else {
            XB_SPIN(xb_ld(&bar[XB_XGEN(b.x)]) == gen, bar);
            __builtin_amdgcn_fence(__ATOMIC_ACQUIRE, "agent");
            asm volatile("s_waitcnt vmcnt(0)" ::: "memory");
        }
    }
    __syncthreads();
}


__device__ __forceinline__ void fanin_publish(unsigned* cnt) {
    asm volatile("s_waitcnt vmcnt(0)" ::: "memory");
    __syncthreads();
    if (threadIdx.x == 0) {
        __builtin_amdgcn_fence(__ATOMIC_RELEASE, "agent");
        asm volatile("s_waitcnt vmcnt(0)" ::: "memory");
        (void)xb_add(cnt, 1u);
    }
}
__device__ __forceinline__ void fanin_wait(unsigned* cnt, unsigned need, unsigned* bar) {
    if (threadIdx.x == 0) {
        XB_SPIN(xb_ld(cnt) < need, bar);
        __builtin_amdgcn_fence(__ATOMIC_ACQUIRE, "agent");
        asm volatile("s_waitcnt vmcnt(0)" ::: "memory");
    }
    __syncthreads();
}

constexpr size_t WS_XC = WS_H;
constexpr size_t WS_ALORA = WS_H + 32 * MiB;
constexpr size_t WS_LOGA = 256 * MiB;
constexpr size_t WS_OLOC = 320 * MiB;
constexpr size_t WS_QHAT = 352 * MiB;
constexpr size_t WS_GG = 384 * MiB;
constexpr size_t WS_SB = 12 * MiB;
constexpr size_t WS_LRUA = 13 * MiB;
constexpr size_t WS_LRUB = 14 * MiB;
constexpr size_t WS_LRUH = 15 * MiB;
constexpr size_t DO_LWA = 0;
constexpr size_t DO_PC = 64 * MiB;
constexpr size_t DO_QCT = 96 * MiB;
constexpr size_t DO_HIN = 0;


__device__ __forceinline__ void phase_prepA(Frame& F) {
    const int gw = F.vcu * NWAVES + F.wave, NGW = F.G * NWAVES, lane = F.lane;
    const bf16* P = (const bf16*)(F.ws + WS_P);
    bf16* XC = (bf16*)(F.ws + WS_XC); bf16* AL = (bf16*)(F.ws + WS_ALORA);
    const float* conv_w = F.in[6]; const float* conv_b = F.in[7]; const float* mu = F.in[14];
    float cw[4][8], cb[8];
#pragma unroll
    for (int i = 0; i < 8; ++i) { cb[i] = conv_b[8 * lane + i];
#pragma unroll
        for (int j = 0; j < 4; ++j) cw[j][i] = conv_w[j * 512 + 8 * lane + i]; }
    float mu4[4];
#pragma unroll
    for (int i = 0; i < 4; ++i) mu4[i] = mu[(C_WD - 1024) + 4 * lane + i];
    for (int task = gw; task < NTOK / 16; task += NGW) {
        const int m0 = task * 16, t0 = m0 % T;
        float x1[8], x2[8], x3[8], pl[4];
#pragma unroll
        for (int i = 0; i < 8; ++i) { x1[i] = 0.f; x2[i] = 0.f; x3[i] = 0.f; }
#pragma unroll
        for (int i = 0; i < 4; ++i) pl[i] = 0.f;
        if (t0 > 0) {
            const v4u a = *(const v4u*)(P + (size_t)(m0 - 1) * PW + 8 * lane), b = *(const v4u*)(P + (size_t)(m0 - 2) * PW + 8 * lane), c = *(const v4u*)(P + (size_t)(m0 - 3) * PW + 8 * lane);
            x1[0] = bflo(a.x); x1[1] = bfhi(a.x); x1[2] = bflo(a.y); x1[3] = bfhi(a.y); x1[4] = bflo(a.z); x1[5] = bfhi(a.z); x1[6] = bflo(a.w); x1[7] = bfhi(a.w);
            x2[0] = bflo(b.x); x2[1] = bfhi(b.x); x2[2] = bflo(b.y); x2[3] = bfhi(b.y); x2[4] = bflo(b.z); x2[5] = bfhi(b.z); x2[6] = bflo(b.w); x2[7] = bfhi(b.w);
            x3[0] = bflo(c.x); x3[1] = bfhi(c.x); x3[2] = bflo(c.y); x3[3] = bfhi(c.y); x3[4] = bflo(c.z); x3[5] = bfhi(c.z); x3[6] = bflo(c.w); x3[7] = bfhi(c.w);
            const v2u q = *(const v2u*)(P + (size_t)(m0 - 1) * PW + C_WD + 4 * lane);
            pl[0] = bflo(q.x); pl[1] = bfhi(q.x); pl[2] = bflo(q.y); pl[3] = bfhi(q.y);
        }
#pragma unroll 4
        for (int tt = 0; tt < 16; ++tt) {
            const size_t m = (size_t)(m0 + tt);
            const v4u a = *(const v4u*)(P + m * PW + 8 * lane);
            float x0[8] = {bflo(a.x), bfhi(a.x), bflo(a.y), bfhi(a.y), bflo(a.z), bfhi(a.z), bflo(a.w), bfhi(a.w)};
            float xc[8];
#pragma unroll
            for (int i = 0; i < 8; ++i) { xc[i] = x3[i] * cw[0][i] + x2[i] * cw[1][i] + x1[i] * cw[2][i] + x0[i] * cw[3][i] + cb[i]; x3[i] = x2[i]; x2[i] = x1[i]; x1[i] = x0[i]; }
            v4u o; o.x = pk2(xc[0], xc[1]); o.y = pk2(xc[2], xc[3]); o.z = pk2(xc[4], xc[5]); o.w = pk2(xc[6], xc[7]);
            *(v4u*)(XC + m * 512 + 8 * lane) = o;
            const v2u q = *(const v2u*)(P + m * PW + C_WD + 4 * lane);
            const float cl[4] = {bflo(q.x), bfhi(q.x), bflo(q.y), bfhi(q.y)};
            float al[4];
#pragma unroll
            for (int i = 0; i < 4; ++i) { const float u = cl[i] + (pl[i] - cl[i]) * mu4[i]; pl[i] = cl[i];
                al[i] = (lane < 16) ? ftanh(u) : ((lane < 32) ? u : sigmoidf_(u)); }
            v2u o2; o2.x = pk2(al[0], al[1]); o2.y = pk2(al[2], al[3]);
            *(v2u*)(AL + m * 256 + 4 * lane) = o2;
        }
    }
}
__device__ __forceinline__ void p0_small_weights(Frame& F) {
    const int gt = F.vcu * NWAVES * 64 + F.tid, NT = F.G * NWAVES * 64;
    bf16* WG = (bf16*)(F.ws + FW_WGT); bf16* WL = (bf16*)(F.ws + FW_WLORAT);
    const float* wa = F.in[8]; const float* wi = F.in[10]; const float* w_up = F.in[16]; const float* a_up = F.in[18]; const float* g_up = F.in[19];
    for (int i = gt; i < 4 * 256 * 128; i += NT) { const int kk = i & 127, r = (i >> 7) & 255, pn = i >> 15;
        const int gate = r >> 7, ch = 128 * pn + (r & 127), hh = ch >> 6, j = ch & 63, kin = 128 * pn + kk;
        float v = 0.f; if ((kin >> 6) == hh) v = (gate ? wi : wa)[hh * 4096 + (kin & 63) * 64 + j];
        WG[i] = f2bf(v); }
    { float* WR = (float*)(F.ws + FW_WR); const float* w_grp = F.in[27]; const float* w_exp = F.in[29];
      for (int i = gt; i < 36 * 1024; i += NT) { const int k = i & 1023, e = i >> 10; WR[i] = e < 4 ? w_grp[k * 4 + e] : w_exp[k * 32 + (e - 4)]; } }
    for (int i = gt; i < 1536 * 128; i += NT) { const int kk = i & 127, n = i >> 7; float v = 0.f;
        if (n < 512) { if (kk < 64) v = w_up[kk * 512 + n]; }
        else if (n < 1024) { if (kk >= 64) v = a_up[(kk - 64) * 512 + n - 512]; }
        else v = g_up[kk * 512 + n - 1024];
        WL[i] = f2bf(v); }
}

namespace pg8 {
struct GateOrder : DenseOrder {
    __device__ __forceinline__ const char* a_base(const Gemm& g, const Unit& u) const { return (const char*)g.A + (size_t)u.pm * (BM * 2) * g.lda + (size_t)u.pn * 256; }
};
struct LoraOrder : DenseOrder {
    __device__ __forceinline__ const char* a_base(const Gemm& g, const Unit& u) const { return (const char*)g.A + (size_t)u.pm * (BM * 2) * g.lda + (u.pn >= 4 ? 256 : 0); }
};
struct EpiLruGate {
    static constexpr bool PERM = true;
    unsigned char* ws;
    __device__ __forceinline__ void operator()(const f32x4 (&acc)[2][2][4][2], const Unit& u, int wr, int wc, int fr, int fq) const {
        bf16_t* G = (bf16_t*)(ws + WS_LOGA);
        const int row0 = u.pm * BM + wr * 64 + fr, col0 = u.pn * HALF + wc * 32 + 8 * fq;
#pragma unroll
        for (int ai = 0; ai < 2; ++ai)
#pragma unroll
            for (int m = 0; m < 4; ++m) { bf16_t* rowp = G + (size_t)(row0 + ai * HALF + m * 16) * 1024 + col0;
#pragma unroll
                for (int bj = 0; bj < 2; ++bj) { const f32x4 v0 = acc[ai][bj][m][0], v1 = acc[ai][bj][m][1];
                    u32x4 w; w.x = cvt_pk_bf16(v0[0], v0[1]); w.y = cvt_pk_bf16(v0[2], v0[3]); w.z = cvt_pk_bf16(v1[0], v1[1]); w.w = cvt_pk_bf16(v1[2], v1[3]);
                    *(u32x4*)(rowp + bj * 512) = w; } }
    }
};
struct EpiLoraStore {
    static constexpr bool PERM = true;
    unsigned char* out; unsigned char* ws;
    __device__ __forceinline__ void operator()(const f32x4 (&acc)[2][2][4][2], const Unit& u, int wr, int wc, int fr, int fq) const {
        const int row0 = u.pm * BM + wr * 64 + fr;
        bf16_t* LWA = (bf16_t*)(out + DO_LWA); bf16_t* GG = (bf16_t*)(ws + WS_GG);
        bf16_t* base = u.pn < 4 ? LWA : GG; const int ldc = u.pn < 4 ? 1024 : 512; const int col0 = (u.pn < 4 ? u.pn : u.pn - 4) * BM + wc * 32 + 8 * fq;
#pragma unroll
        for (int ai = 0; ai < 2; ++ai)
#pragma unroll
            for (int m = 0; m < 4; ++m) { bf16_t* rowp = base + (size_t)(row0 + ai * HALF + m * 16) * ldc + col0;
#pragma unroll
                for (int bj = 0; bj < 2; ++bj) { const f32x4 v0 = acc[ai][bj][m][0], v1 = acc[ai][bj][m][1];
                    u32x4 w; w.x = cvt_pk_bf16(v0[0], v0[1]); w.y = cvt_pk_bf16(v0[2], v0[3]); w.z = cvt_pk_bf16(v1[0], v1[1]); w.w = cvt_pk_bf16(v1[2], v1[3]);
                    *(u32x4*)(rowp + bj * HALF) = w; } }
    }
};
}
__device__ __forceinline__ void phase_gategemm(Frame& F) {
    {
        pg8::Gemm g{(const bf16*)(F.ws + WS_XC), (const bf16*)(F.ws + FW_WGT), 512, 128, 128};
        pg8::GateOrder S; S.init(NTOK, 1024, F.G, (int)blockIdx.x);
        pg8::EpiLruGate E{F.ws};
        pg8::gemm_phase<pg8::EpiLruGate, pg8::GateOrder>(F.lds + RING_OFF, g, S, E, F.tid);
    }
}
__device__ __forceinline__ void phase_loragemm(Frame& F) {
    {
        pg8::Gemm g{(const bf16*)(F.ws + WS_ALORA), (const bf16*)(F.ws + FW_WLORAT), 256, 128, 128};
        pg8::LoraOrder S; S.init(NTOK, 1536, F.G, (int)blockIdx.x);
        pg8::EpiLoraStore E{(unsigned char*)F.out, F.ws};
        pg8::gemm_phase<pg8::EpiLoraStore, pg8::LoraOrder>(F.lds + RING_OFF, g, S, E, F.tid);
    }
}

__device__ __forceinline__ void phase_lrulocal(Frame& F) {
    const int gw = F.vcu * NWAVES + F.wave, NGW = F.G * NWAVES, lane = F.lane;
    {
        const bf16* GT = (const bf16*)(F.ws + WS_LOGA); bf16* GO = (bf16*)(F.ws + WS_LOGA); const bf16* XC = (const bf16*)(F.ws + WS_XC);
        float* LA = (float*)(F.ws + WS_LRUA); float* LB = (float*)(F.ws + WS_LRUB);
        for (int task = (F.wave < 4 ? F.vcu * 4 + F.wave : 1 << 30); task < 4 * 128 * 2; task += F.G * 4) { const int hq = task & 1, bc = task >> 1, ch = (4 * hq + (lane >> 4)) * 64 + 4 * (lane & 15);
            const f32x4 bav = *(const f32x4*)(F.in[9] + ch), biv = *(const f32x4*)(F.in[11] + ch), lam = *(const f32x4*)(F.in[12] + ch);
            f32x4 sp; sp.x = -8.f * softplusf_(-lam.x); sp.y = -8.f * softplusf_(-lam.y); sp.z = -8.f * softplusf_(-lam.z); sp.w = -8.f * softplusf_(-lam.w);
            const size_t m0 = (size_t)bc * 64; f32x4 sl = {0.f, 0.f, 0.f, 0.f}, hl = {0.f, 0.f, 0.f, 0.f};
#pragma unroll 1
            for (int t8 = 0; t8 < 64; t8 += 8) {
                v2u g0[8], g1[8], x8[8];
#pragma unroll
                for (int u = 0; u < 8; ++u) { const size_t m = m0 + t8 + u; g0[u] = *(const v2u*)(GT + m * 1024 + ch); g1[u] = *(const v2u*)(GT + m * 1024 + 512 + ch); x8[u] = *(const v2u*)(XC + m * 512 + ch); }
#pragma unroll
                for (int u = 0; u < 8; ++u) { const size_t m = m0 + t8 + u;
                    const f32x4 ra = {bflo(g0[u].x), bfhi(g0[u].x), bflo(g0[u].y), bfhi(g0[u].y)}, ia = {bflo(g1[u].x), bfhi(g1[u].x), bflo(g1[u].y), bfhi(g1[u].y)};
                    const f32x4 xc = {bflo(x8[u].x), bfhi(x8[u].x), bflo(x8[u].y), bfhi(x8[u].y)};
                    float la[4], bb[4];
#pragma unroll
                    for (int i = 0; i < 4; ++i) la[i] = sigmoidf_(ra[i] + bav[i]) * sp[i];
                    const unsigned l01 = pk2(la[0], la[1]), l23 = pk2(la[2], la[3]);
                    la[0] = bflo(l01); la[1] = bfhi(l01); la[2] = bflo(l23); la[3] = bfhi(l23);
#pragma unroll
                    for (int i = 0; i < 4; ++i) bb[i] = __builtin_amdgcn_sqrtf(fmaxf(1.f - fexp(2.f * la[i]), 0.f)) * (sigmoidf_(ia[i] + biv[i]) * xc[i]);
                    const unsigned b01 = pk2(bb[0], bb[1]), b23 = pk2(bb[2], bb[3]);
                    bb[0] = bflo(b01); bb[1] = bfhi(b01); bb[2] = bflo(b23); bb[3] = bfhi(b23);
                    v2u ol, ob; ol.x = l01; ol.y = l23; ob.x = b01; ob.y = b23;
                    *(v2u*)(GO + m * 1024 + ch) = ol; *(v2u*)(GO + m * 1024 + 512 + ch) = ob;
#pragma unroll
                    for (int i = 0; i < 4; ++i) { sl[i] += la[i]; hl[i] = fexp(la[i]) * hl[i] + bb[i]; } }
            }
            *(f32x4*)(LA + bc * 512 + ch) = sl; *(f32x4*)(LB + bc * 512 + ch) = hl; }
    }
}
typedef short bf16x8_t __attribute__((ext_vector_type(8)));
typedef float f32x16 __attribute__((ext_vector_type(16)));
typedef __bf16 bf16x2n_t __attribute__((ext_vector_type(2)));
typedef float f32x2c_t __attribute__((ext_vector_type(2)));
__device__ __forceinline__ unsigned pkbf(float a, float b) { f32x2c_t v = {a, b}; bf16x2n_t r = __builtin_convertvector(v, bf16x2n_t); return __builtin_bit_cast(unsigned, r); }
__device__ __forceinline__ bf16 bf1(float a) { return (bf16)(pkbf(a, 0.f) & 0xffffu); }
constexpr int U_AT = 0, U_RT = 4096, U_BT = 8192, U_KT = 12288, U_BH = 16384, U_KH = 20480, U_VT = 24576, U_LM = 28672, U_G31 = 32768, UNIT_LDS = 33024;
__device__ __forceinline__ int a64(int row, int col) { return row * 128 + (((col >> 3) ^ (row & 7)) << 4) + ((col & 7) << 1); }
__device__ __forceinline__ int a32(int row, int col) { return row * 64 + (((col >> 2) ^ ((row >> 2) & 7)) << 3) + ((col & 3) << 1); }
__device__ __forceinline__ int crow_(int i, int h) { return (i & 3) + 8 * (i >> 2) + 4 * h; }
#define MFMA32(a, b, c) __builtin_amdgcn_mfma_f32_32x32x16_bf16((a), (b), (c), 0, 0, 0)
__device__ __forceinline__ bf16x8_t pack8(const f32x16& x, int s) {
    v4u p; p.x = pkbf(x[8 * s], x[8 * s + 1]); p.y = pkbf(x[8 * s + 2], x[8 * s + 3]); p.z = pkbf(x[8 * s + 4], x[8 * s + 5]); p.w = pkbf(x[8 * s + 6], x[8 * s + 7]);
    return __builtin_bit_cast(bf16x8_t, p); }
__device__ __forceinline__ bf16x8_t ld2x8(const LAS unsigned char* p0, const LAS unsigned char* p1) {
    const v2u lo = *(const LAS v2u*)p0, hi = *(const LAS v2u*)p1; v4u p; p.x = lo.x; p.y = lo.y; p.z = hi.x; p.w = hi.y; return __builtin_bit_cast(bf16x8_t, p); }

__device__ __forceinline__ void phase_rwkvlocal_mfma(Frame& F) {
    int lane = F.lane; asm volatile("" : "+v"(lane));
    const int wave = F.wave, u4 = wave >> 1, wh = wave & 1;
    LAS unsigned char* ub = F.lds + RING_OFF + u4 * UNIT_LDS;
    const bf16* P = (const bf16*)(F.ws + WS_P); const bf16* LWA = (const bf16*)((const unsigned char*)F.out + DO_LWA);
    bf16* OLOC = (bf16*)(F.ws + WS_OLOC); bf16* QHAT = (bf16*)(F.ws + WS_QHAT); float* SB = (float*)(F.ws + WS_SB);
    const float* mu = F.in[14];
#pragma unroll 1
    for (int ui = F.vcu; ui < 256; ui += F.G) {
        const int unit = ui * 4 + u4, c = unit & 31, bhd = unit >> 5, hd = bhd & 7, b = bhd >> 3;
        const size_t m0 = (size_t)b * T + (size_t)c * 256;
        f32x16 S[2][2];
        { int r = lane & 31, h = lane >> 5; asm volatile("" : "+v"(r), "+v"(h));
#pragma unroll
        for (int jt = 0; jt < 2; ++jt)
#pragma unroll
            for (int kt = 0; kt < 2; ++kt)
#pragma unroll
                for (int i = 0; i < 16; ++i) S[jt][kt][i] = (wh == 0 && jt == kt && crow_(i, h) == r) ? 1.f : 0.f;
        }
#pragma unroll 1
        for (int sc = 0; sc < 8; ++sc) {
            const size_t ms = m0 + 32 * sc;
            {
                int lanep = lane; asm volatile("" : "+v"(lanep));
                const int ch = hd * 64 + lanep;
                const float mu_r = mu[ch], mu_k = mu[512 + ch], mu_v = mu[1024 + ch];
                const float w0v = F.in[15][ch], a0v = F.in[17][ch], kkv = F.in[20][ch], kav = F.in[21][ch], rkv = F.in[22][ch];
                const size_t mb = ms + 16 * wh;
                bf16 qr[16], qk[16], qv[16], qw[16], qa[16], lw16[16], p3[3] = {0, 0, 0};
                if ((mb % T) != 0) { const bf16* row = P + (mb - 1) * PW; p3[0] = row[C_R + ch]; p3[1] = row[C_K + ch]; p3[2] = row[C_V + ch]; }
#pragma unroll
                for (int u = 0; u < 16; ++u) { const size_t m = mb + u; const bf16* row = P + m * PW;
                    qr[u] = row[C_R + ch]; qk[u] = row[C_K + ch]; qv[u] = row[C_V + ch]; qw[u] = LWA[m * 1024 + ch]; qa[u] = LWA[m * 1024 + 512 + ch]; }
                if (wh) {
#pragma unroll
                    for (int t = 0; t < 16; ++t) lw16[t] = LWA[(ms + t) * 1024 + ch];
                }
                float cc = 0.f;
                if (wh) {
#pragma unroll
                    for (int t = 0; t < 16; ++t) { const float w = -flog(1.f + fexp(-(w0v + bf2f(lw16[t])))) - 0.5f; cc -= fexp(w); }
                }
                float pr = bf2f(p3[0]), pk = bf2f(p3[1]), pv = bf2f(p3[2]);
                float sbkeep = 0.f, gprev = fexp(cc);
                {
                    constexpr int t8 = 0;
#pragma unroll
                    for (int u = 0; u < 16; ++u) {
                        const int tt = t8 + u, t = 16 * wh + tt;
                        const float cr = bf2f(qr[u]), ck = bf2f(qk[u]), cv = bf2f(qv[u]);
                        const float lw = bf2f(qw[u]), la = bf2f(qa[u]);
                        const float rr = cr + (pr - cr) * mu_r, kx = ck + (pk - ck) * mu_k, v = cv + (pv - cv) * mu_v;
                        pr = cr; pk = ck; pv = cv;
                        const float w = -flog(1.f + fexp(-(w0v + lw))) - 0.5f;
                        cc -= fexp(w);
                        const float a = frcp(1.f + fexp(-(a0v + la)));
                        float kk = kx * kkv;
                        const float nrm = __builtin_amdgcn_sqrtf(wave_sum(kk * kk));
                        kk = kk * __builtin_amdgcn_rcpf(fmaxf(nrm, 1e-12f));
                        const float km = kx * (1.f + (a - 1.f) * kav);
                        const float sbv = wave_sum(rr * km * rkv);
                        if (lanep == tt) sbkeep = sbv;
                        const float gp = gprev, g = fexp(cc), ig = frcp(g);
                        gprev = g;
                        const float be = kk * a;
                        *(LAS bf16*)(ub + U_AT + a64(t, lanep)) = bf1(-kk * gp);
                        *(LAS bf16*)(ub + U_RT + a64(t, lanep)) = bf1(rr * g);
                        *(LAS bf16*)(ub + U_BT + a64(t, lanep)) = bf1(be * ig);
                        *(LAS bf16*)(ub + U_KT + a64(t, lanep)) = bf1(km * ig);
                        *(LAS bf16*)(ub + U_BH + a32(lanep, t)) = bf1(be * ig);
                        *(LAS bf16*)(ub + U_KH + a32(lanep, t)) = bf1(km * ig);
                        *(LAS bf16*)(ub + U_VT + a32(lanep, t)) = bf1(v);
                    }
                }
                if (lanep < 16) SB[(mb + lanep) * 8 + hd] = sbkeep;
                if (wh) *(LAS float*)(ub + U_G31 + lanep * 4) = gprev;
            }
            asm volatile("s_waitcnt lgkmcnt(0)" ::: "memory"); __builtin_amdgcn_s_barrier(); asm volatile("" ::: "memory");
            {
                int r = lane & 31, h = lane >> 5; asm volatile("" : "+v"(r), "+v"(h));
                bf16x8_t fT[2], fAk[2], fRb[2], fRk[2];
                {
                    f32x16 M, MT, R, RT;
#pragma unroll
                    for (int i = 0; i < 16; ++i) { M[i] = 0.f; MT[i] = 0.f; }
#pragma unroll
                    for (int ks = 0; ks < 4; ++ks) { const int o = a64(r, 16 * ks + 8 * h);
                        const bf16x8_t fb = *(const LAS bf16x8_t*)(ub + U_BT + o), fa = *(const LAS bf16x8_t*)(ub + U_AT + o);
                        M = MFMA32(fb, fa, M); MT = MFMA32(fa, fb, MT); }
#pragma unroll
                    for (int i = 0; i < 16; ++i) { const int q = crow_(i, h); M[i] = (q < r) ? M[i] : 0.f; MT[i] = (r < q) ? MT[i] : 0.f;
                        R[i] = M[i] + ((q == r) ? 1.f : 0.f); RT[i] = MT[i] + ((q == r) ? 1.f : 0.f); }
#pragma unroll
                    for (int lvl = 0; lvl < 4; ++lvl) {
                        bf16x8_t pm[2], pmt[2];
#pragma unroll
                        for (int ks = 0; ks < 2; ++ks) { pm[ks] = pack8(M, ks); pmt[ks] = pack8(MT, ks); }
                        f32x16 M2, MT2;
#pragma unroll
                        for (int i = 0; i < 16; ++i) { M2[i] = 0.f; MT2[i] = 0.f; }
#pragma unroll
                        for (int ks = 0; ks < 2; ++ks) { M2 = MFMA32(pmt[ks], pm[ks], M2); MT2 = MFMA32(pm[ks], pmt[ks], MT2); }
                        M = M2; MT = MT2;
                        bf16x8_t pr[2], prt[2];
#pragma unroll
                        for (int ks = 0; ks < 2; ++ks) { pm[ks] = pack8(M, ks); pr[ks] = pack8(R, ks); prt[ks] = pack8(RT, ks); }
#pragma unroll
                        for (int ks = 0; ks < 2; ++ks) { R = MFMA32(prt[ks], pm[ks], R); RT = MFMA32(pm[ks], prt[ks], RT); }
                        (void)pr;
                    }
#pragma unroll
                    for (int ks = 0; ks < 2; ++ks) fT[ks] = pack8(R, ks);
                }
                __builtin_amdgcn_sched_barrier(0);
                {
                    f32x16 Xak, Xrb, Xrk;
#pragma unroll
                    for (int i = 0; i < 16; ++i) { Xak[i] = 0.f; Xrb[i] = 0.f; Xrk[i] = 0.f; }
#pragma unroll
                    for (int ks = 0; ks < 4; ++ks) { const int o = a64(r, 16 * ks + 8 * h);
                        const bf16x8_t fb = *(const LAS bf16x8_t*)(ub + U_BT + o), fk = *(const LAS bf16x8_t*)(ub + U_KT + o);
                        const bf16x8_t fa = *(const LAS bf16x8_t*)(ub + U_AT + o), fr = *(const LAS bf16x8_t*)(ub + U_RT + o);
                        Xak = MFMA32(fk, fa, Xak); Xrb = MFMA32(fb, fr, Xrb); Xrk = MFMA32(fk, fr, Xrk); }
#pragma unroll
                    for (int i = 0; i < 16; ++i) { const int s = crow_(i, h); Xak[i] = (s < r) ? Xak[i] : 0.f; Xrb[i] = (s <= r) ? Xrb[i] : 0.f; Xrk[i] = (s <= r) ? Xrk[i] : 0.f; }
#pragma unroll
                    for (int ks = 0; ks < 2; ++ks) { fAk[ks] = pack8(Xak, ks); fRb[ks] = pack8(Xrb, ks); fRk[ks] = pack8(Xrk, ks); }
                }
#pragma unroll
                for (int jt = 0; jt < 2; ++jt) {
                    __builtin_amdgcn_sched_barrier(0);
                    bf16x8_t sf[2][2], vf[2];
#pragma unroll
                    for (int kt = 0; kt < 2; ++kt)
#pragma unroll
                        for (int ks = 0; ks < 2; ++ks) sf[kt][ks] = pack8(S[jt][kt], ks);
                    if (wh) {
#pragma unroll
                        for (int ks = 0; ks < 2; ++ks) vf[ks] = ld2x8(ub + U_VT + a32(32 * jt + r, 16 * ks + 4 * h), ub + U_VT + a32(32 * jt + r, 16 * ks + 8 + 4 * h));
                    }
                    f32x16 X1, Uu, Oo;
#pragma unroll
                    for (int i = 0; i < 16; ++i) { X1[i] = 0.f; Uu[i] = 0.f; Oo[i] = 0.f; }
#pragma unroll
                    for (int kt = 0; kt < 2; ++kt)
#pragma unroll
                        for (int ks = 0; ks < 2; ++ks) { const int c0 = 32 * kt + 16 * ks + 4 * h;
                            X1 = MFMA32(ld2x8(ub + U_AT + a64(r, c0), ub + U_AT + a64(r, c0 + 8)), sf[kt][ks], X1);
                            Oo = MFMA32(ld2x8(ub + U_RT + a64(r, c0), ub + U_RT + a64(r, c0 + 8)), sf[kt][ks], Oo); }
                    if (wh) {
#pragma unroll
                        for (int ks = 0; ks < 2; ++ks) { X1 = MFMA32(fAk[ks], vf[ks], X1); Oo = MFMA32(fRk[ks], vf[ks], Oo); }
                    }
                    __builtin_amdgcn_sched_barrier(0);
#pragma unroll
                    for (int ks = 0; ks < 2; ++ks) Uu = MFMA32(fT[ks], pack8(X1, ks), Uu);
                    bf16x8_t uf[2];
#pragma unroll
                    for (int ks = 0; ks < 2; ++ks) { uf[ks] = pack8(Uu, ks); Oo = MFMA32(fRb[ks], uf[ks], Oo); }
                    { bf16* dst = (wh ? OLOC : QHAT) + ms * 512 + hd * 64 + 32 * jt + r;
#pragma unroll
                      for (int i = 0; i < 16; ++i) dst[(size_t)crow_(i, h) * 512] = bf1(Oo[i]); }
                    __builtin_amdgcn_sched_barrier(0);
#pragma unroll
                    for (int kt = 0; kt < 2; ++kt) {
#pragma unroll
                        for (int ks = 0; ks < 2; ++ks) { const int k = 32 * kt + r, t0 = 16 * ks + 4 * h;
                            S[jt][kt] = MFMA32(ld2x8(ub + U_BH + a32(k, t0), ub + U_BH + a32(k, t0 + 8)), uf[ks], S[jt][kt]);
                            if (wh) S[jt][kt] = MFMA32(ld2x8(ub + U_KH + a32(k, t0), ub + U_KH + a32(k, t0 + 8)), vf[ks], S[jt][kt]); }
#pragma unroll
                        for (int g = 0; g < 4; ++g) { const f32x4 gg = *(const LAS f32x4*)(ub + U_G31 + (32 * kt + 8 * g + 4 * h) * 4);
                            S[jt][kt][4 * g] *= gg.x; S[jt][kt][4 * g + 1] *= gg.y; S[jt][kt][4 * g + 2] *= gg.z; S[jt][kt][4 * g + 3] *= gg.w; }
                    }
                }
            }
            asm volatile("s_waitcnt lgkmcnt(0)" ::: "memory"); __builtin_amdgcn_s_barrier(); asm volatile("" ::: "memory");
        }
        int r = lane & 31, h = lane >> 5; asm volatile("" : "+v"(r), "+v"(h));
        if (wh == 0) { bf16* PC = (bf16*)((unsigned char*)F.out + DO_PC) + (size_t)unit * 4096;
#pragma unroll
            for (int jt = 0; jt < 2; ++jt)
#pragma unroll
                for (int kt = 0; kt < 2; ++kt)
#pragma unroll
                    for (int i = 0; i < 16; ++i) PC[(32 * kt + crow_(i, h)) * 64 + 32 * jt + r] = bf1(S[jt][kt][i]);
        } else { bf16* QCT = (bf16*)((unsigned char*)F.out + DO_QCT) + (size_t)unit * 4096;
#pragma unroll
            for (int jt = 0; jt < 2; ++jt)
#pragma unroll
                for (int kt = 0; kt < 2; ++kt)
#pragma unroll
                    for (int g = 0; g < 4; ++g) { v2u o; o.x = pkbf(S[jt][kt][4 * g], S[jt][kt][4 * g + 1]); o.y = pkbf(S[jt][kt][4 * g + 2], S[jt][kt][4 * g + 3]);
                        *(v2u*)(QCT + (32 * jt + r) * 64 + 32 * kt + 8 * g + 4 * h) = o; }
        }
    }
}

__device__ __forceinline__ void rwkv_scan(Frame& F, int bh) {
    constexpr int LDT = 72;
    constexpr int SBUF = 64 * LDT;
    LAS bf16* S0 = (LAS bf16*)(F.lds + RING_OFF);
    const int lane = F.lane, w = F.wave, q = lane >> 4, l15 = lane & 15;
    for (int i = F.tid; i < 2 * SBUF; i += 512) S0[i] = 0;
    __syncthreads();
    if (w < 4) {
        const int tr = w;
        const bf16* PC = (const bf16*)((const unsigned char*)F.out + DO_PC) + (size_t)bh * 32 * 4096 + (16 * tr + l15) * 64 + 8 * q;
        const bf16* QCT = (const bf16*)((const unsigned char*)F.out + DO_QCT) + (size_t)bh * 32 * 4096 + l15 * 64 + 16 * tr + 4 * q;
        const int boff0 = l15 * LDT + 8 * q, woff0 = l15 * LDT + 16 * tr + 4 * q;
        bf16x8_t A[8][2]; v2u Qv[8][4];
#define SCAN_LOAD(s, cc) do { \
        asm volatile("global_load_dwordx4 %0, %1, off" : "=v"(A[s][0]) : "v"(PC + (size_t)(cc) * 4096) : "memory"); \
        asm volatile("global_load_dwordx4 %0, %1, off offset:64" : "=v"(A[s][1]) : "v"(PC + (size_t)(cc) * 4096) : "memory"); \
        asm volatile("global_load_dwordx2 %0, %1, off" : "=v"(Qv[s][0]) : "v"(QCT + (size_t)(cc) * 4096) : "memory"); \
        asm volatile("global_load_dwordx2 %0, %1, off offset:2048" : "=v"(Qv[s][1]) : "v"(QCT + (size_t)(cc) * 4096) : "memory"); \
        asm volatile("global_load_dwordx2 %0, %1, off" : "=v"(Qv[s][2]) : "v"(QCT + (size_t)(cc) * 4096 + 2048) : "memory"); \
        asm volatile("global_load_dwordx2 %0, %1, off offset:2048" : "=v"(Qv[s][3]) : "v"(QCT + (size_t)(cc) * 4096 + 2048) : "memory"); } while (0)
#pragma unroll
        for (int s = 0; s < 8; ++s) SCAN_LOAD(s, s);
#pragma unroll 1
        for (int c0 = 0; c0 < 32; c0 += 8) {
#pragma unroll
            for (int s = 0; s < 8; ++s) {
                const int c = c0 + s;
                const LAS bf16* Sr = S0 + (s & 1) * SBUF; LAS bf16* Sw = S0 + ((s & 1) ^ 1) * SBUF;
                asm volatile("s_waitcnt vmcnt(42)" : "+v"(A[s][0]), "+v"(A[s][1]), "+v"(Qv[s][0]), "+v"(Qv[s][1]), "+v"(Qv[s][2]), "+v"(Qv[s][3]) :: "memory");
                pg8::f32x4 acc[4];
#pragma unroll
                for (int t = 0; t < 4; ++t) { acc[t][0] = bflo(Qv[s][t].x); acc[t][1] = bfhi(Qv[s][t].x); acc[t][2] = bflo(Qv[s][t].y); acc[t][3] = bfhi(Qv[s][t].y); }
#pragma unroll
                for (int ks = 0; ks < 2; ++ks)
#pragma unroll
                    for (int t = 0; t < 4; ++t) {
                        const bf16x8_t bh_ = *(const LAS bf16x8_t*)(Sr + boff0 + 16 * LDT * t + 32 * ks);
                        acc[t] = __builtin_amdgcn_mfma_f32_16x16x32_bf16(A[s][ks], bh_, acc[t], 0, 0, 0);
                    }
                { const int cn = (c + 8 < 32) ? c + 8 : 31; SCAN_LOAD(s, cn); }
#pragma unroll
                for (int t = 0; t < 4; ++t) { v2u oh; oh.x = pg8::cvt_pk_bf16(acc[t][0], acc[t][1]); oh.y = pg8::cvt_pk_bf16(acc[t][2], acc[t][3]);
                    *(LAS v2u*)(Sw + woff0 + 16 * LDT * t) = oh; }
                asm volatile("s_waitcnt lgkmcnt(0)" ::: "memory"); __builtin_amdgcn_s_barrier(); asm volatile("" ::: "memory");
            }
        }
#undef SCAN_LOAD
        asm volatile("s_waitcnt vmcnt(0)" ::: "memory");
    } else {
        const int t256 = F.tid - 256;
        bf16* HIN = (bf16*)((unsigned char*)F.out + DO_HIN) + (size_t)bh * 32 * 4096 + (t256 >> 2) * 64 + (t256 & 3) * 16;
        const int hoff = (t256 >> 2) * LDT + (t256 & 3) * 16;
#pragma unroll 1
        for (int c = 0; c < 32; ++c) {
            const LAS bf16* Sr = S0 + (c & 1) * SBUF;
            const v4u x0 = *(const LAS v4u*)(Sr + hoff), x1 = *(const LAS v4u*)(Sr + hoff + 8);
            *(v4u*)(HIN + (size_t)c * 4096) = x0; *(v4u*)(HIN + (size_t)c * 4096 + 8) = x1;
            asm volatile("s_waitcnt lgkmcnt(0)" ::: "memory"); __builtin_amdgcn_s_barrier(); asm volatile("" ::: "memory");
        }
    }
}
__device__ __forceinline__ void phase_scan(Frame& F, int flags) {
    if ((flags & 4) && blockIdx.x >= 36) { expert_transposes(F, ((int)blockIdx.x - 36) * NWAVES + F.wave, ((int)F.G - 36) * NWAVES); }
    if ((flags & 2) && blockIdx.x < 32) rwkv_scan(F, blockIdx.x);
    if ((flags & 1) && blockIdx.x >= 32 && blockIdx.x < 36) {
        const int idx = (blockIdx.x - 32) * 512 + F.tid, b = idx >> 9, ch = idx & 511;
        const float* LA = (const float*)(F.ws + WS_LRUA); const float* LB = (const float*)(F.ws + WS_LRUB); float* LH = (float*)(F.ws + WS_LRUH);
        float h = 0.f;
#pragma unroll 1
        for (int c16 = 0; c16 < 128; c16 += 16) { float a16[16], b16[16];
#pragma unroll
            for (int u = 0; u < 16; ++u) { const int o = (b * 128 + c16 + u) * 512 + ch; a16[u] = LA[o]; b16[u] = LB[o]; }
#pragma unroll
            for (int u = 0; u < 16; ++u) { const int o = (b * 128 + c16 + u) * 512 + ch; LH[o] = h; h = fexp(a16[u]) * h + b16[u]; } }
    }
}

__device__ __forceinline__ void rwkv_post_unit(Frame& F, int unit) {
    int lane = F.lane; asm volatile("" : "+v"(lane));
    const int c = unit & 127, bh = unit >> 7, h = bh & 7, b = bh >> 3, q = lane >> 4, l15 = lane & 15;
    const size_t m0 = (size_t)b * T + (size_t)c * 64;
    const bf16* QHAT = (const bf16*)(F.ws + WS_QHAT); const bf16* OLOC = (const bf16*)(F.ws + WS_OLOC); const bf16* GG = (const bf16*)(F.ws + WS_GG);
    const bf16* HIN = (const bf16*)((const unsigned char*)F.out + DO_HIN) + (size_t)(bh * 32 + (c >> 2)) * 4096; const bf16* P = (const bf16*)(F.ws + WS_P);
    const float* SB = (const float*)(F.ws + WS_SB); bf16* YMIX = (bf16*)(F.ws + WS_YMIX);
    bf16x8_t Af[4][2];
#pragma unroll
    for (int jt = 0; jt < 4; ++jt)
#pragma unroll
        for (int ks = 0; ks < 2; ++ks) Af[jt][ks] = *(const bf16x8_t*)(HIN + (16 * jt + l15) * 64 + 32 * ks + 8 * q);
    f32x4 lnw[4], lnb[4], muv[4];
#pragma unroll
    for (int jt = 0; jt < 4; ++jt) { const int ch = h * 64 + 16 * jt + 4 * q; lnw[jt] = *(const f32x4*)(F.in[23] + ch); lnb[jt] = *(const f32x4*)(F.in[24] + ch); muv[jt] = *(const f32x4*)(F.in[14] + 1024 + ch); }
#pragma unroll 1
    for (int tt = 0; tt < 4; ++tt) {
        const size_t m = m0 + 16 * tt + l15;
        bf16x8_t Bf[2];
#pragma unroll
        for (int ks = 0; ks < 2; ++ks) Bf[ks] = *(const bf16x8_t*)(QHAT + m * 512 + h * 64 + 32 * ks + 8 * q);
        pg8::f32x4 acc[4];
#pragma unroll
        for (int jt = 0; jt < 4; ++jt) { const v2u o = *(const v2u*)(OLOC + m * 512 + h * 64 + 16 * jt + 4 * q); acc[jt][0] = bflo(o.x); acc[jt][1] = bfhi(o.x); acc[jt][2] = bflo(o.y); acc[jt][3] = bfhi(o.y); }
#pragma unroll
        for (int ks = 0; ks < 2; ++ks)
#pragma unroll
            for (int jt = 0; jt < 4; ++jt) acc[jt] = __builtin_amdgcn_mfma_f32_16x16x32_bf16(Af[jt][ks], Bf[ks], acc[jt], 0, 0, 0);
        float s = 0.f;
#pragma unroll
        for (int jt = 0; jt < 4; ++jt) s += (acc[jt][0] + acc[jt][1]) + (acc[jt][2] + acc[jt][3]);
        s += __shfl_xor(s, 16); s += __shfl_xor(s, 32);
        const float mean = s * (1.f / 64.f);
        float vs = 0.f;
#pragma unroll
        for (int jt = 0; jt < 4; ++jt)
#pragma unroll
            for (int i = 0; i < 4; ++i) { acc[jt][i] -= mean; vs += acc[jt][i] * acc[jt][i]; }
        vs += __shfl_xor(vs, 16); vs += __shfl_xor(vs, 32);
        const float rstd = rsqrtf(vs * (1.f / 64.f) + 64e-5f);
        const float sbv = SB[m * 8 + h];
        const bool first = ((m % T) == 0);
#pragma unroll
        for (int jt = 0; jt < 4; ++jt) { const int ch = h * 64 + 16 * jt + 4 * q;
            const v2u cvq = *(const v2u*)(P + m * PW + C_V + ch); v2u pvq = {0u, 0u}; if (!first) pvq = *(const v2u*)(P + (m - 1) * PW + C_V + ch);
            const v2u gq = *(const v2u*)(GG + m * 512 + ch);
            const float cv[4] = {bflo(cvq.x), bfhi(cvq.x), bflo(cvq.y), bfhi(cvq.y)}, pv[4] = {bflo(pvq.x), bfhi(pvq.x), bflo(pvq.y), bfhi(pvq.y)}, gg[4] = {bflo(gq.x), bfhi(gq.x), bflo(gq.y), bfhi(gq.y)};
            float y[4];
#pragma unroll
            for (int i = 0; i < 4; ++i) { const float v = cv[i] + (pv[i] - cv[i]) * muv[jt][i]; y[i] = (acc[jt][i] * rstd * lnw[jt][i] + lnb[jt][i] + sbv * v) * gg[i]; }
            v2u o; o.x = pk2(y[0], y[1]); o.y = pk2(y[2], y[3]);
            *(v2u*)(YMIX + m * D + 512 + ch) = o; }
    }
}
__device__ __forceinline__ void phase_post(Frame& F, int flags) {
    const int gw = F.vcu * NWAVES + F.wave, NGW = F.G * NWAVES, lane = F.lane;
    if ((flags & 2) && F.G * 16 == 4096) {
        if (F.wave >= 4) { for (int k = 0; k < 3; ++k) rwkv_post_unit(F, F.vcu * 16 + (F.wave - 4) * 3 + k); }
    } else if (flags & 2) for (int unit = gw; unit < 4096; unit += NGW) rwkv_post_unit(F, unit);
    if (flags & 1) {
        const bf16* GT = (const bf16*)(F.ws + WS_LOGA); const bf16* P = (const bf16*)(F.ws + WS_P);
        const float* LH = (const float*)(F.ws + WS_LRUH); bf16* YMIX = (bf16*)(F.ws + WS_YMIX); const float* ng = F.in[13];
        for (int task = (F.wave < 4 ? F.vcu * 4 + F.wave : 1 << 30); task < 4 * 128 * 2; task += F.G * 4) { const int hq = task & 1, bc = task >> 1, ch = (4 * hq + (lane >> 4)) * 64 + 4 * (lane & 15);
            const size_t m0 = (size_t)bc * 64; f32x4 hl = *(const f32x4*)(LH + bc * 512 + ch); const f32x4 g = *(const f32x4*)(ng + ch);
#pragma unroll 1
            for (int t8 = 0; t8 < 64; t8 += 8) {
                v2u g0[8], g1[8], p8[8];
#pragma unroll
                for (int u = 0; u < 8; ++u) { const size_t m = m0 + t8 + u; g0[u] = *(const v2u*)(GT + m * 1024 + ch); g1[u] = *(const v2u*)(GT + m * 1024 + 512 + ch); p8[u] = *(const v2u*)(P + m * PW + C_GATE + ch); }
#pragma unroll
                for (int u = 0; u < 8; ++u) { const size_t m = m0 + t8 + u;
                    const f32x4 la = {bflo(g0[u].x), bfhi(g0[u].x), bflo(g0[u].y), bfhi(g0[u].y)}, bb = {bflo(g1[u].x), bfhi(g1[u].x), bflo(g1[u].y), bfhi(g1[u].y)};
                    const f32x4 gt = {bflo(p8[u].x), bfhi(p8[u].x), bflo(p8[u].y), bfhi(p8[u].y)};
                    f32x4 y;
#pragma unroll
                    for (int i = 0; i < 4; ++i) { hl[i] = fexp(la[i]) * hl[i] + bb[i]; y[i] = hl[i] * gelu_tanh(gt[i]); }
                    float ss = (y.x * y.x + y.y * y.y) + (y.z * y.z + y.w * y.w);
                    ss += __int_as_float(__builtin_amdgcn_update_dpp(0, __float_as_int(ss), 0xB1, 0xF, 0xF, true));
                    ss += __int_as_float(__builtin_amdgcn_update_dpp(0, __float_as_int(ss), 0x4E, 0xF, 0xF, true));
                    ss += __int_as_float(__builtin_amdgcn_update_dpp(0, __float_as_int(ss), 0x141, 0xF, 0xF, true));
                    ss += __int_as_float(__builtin_amdgcn_update_dpp(0, __float_as_int(ss), 0x140, 0xF, 0xF, true));
                    const float rs = rsqrtf(ss * (1.f / 64.f) + 1e-6f);
                    v2u o; o.x = pk2(y.x * rs * g.x, y.y * rs * g.y); o.y = pk2(y.z * rs * g.z, y.w * rs * g.w);
                    *(v2u*)(YMIX + m * D + ch) = o; }
            }
        }
    }
    if ((flags & 2) && F.G * 16 == 4096 && F.wave < 4) rwkv_post_unit(F, F.vcu * 16 + 12 + F.wave);
}

struct Args { const float* in[35]; float* out; unsigned char* ws; int ph_lo, ph_hi, flags, pad; };
__global__ void __launch_bounds__(NWAVES * 64, 2) mk_fwd(Args args) {
    extern __shared__ __attribute__((aligned(16))) unsigned char lds[];
    Frame F;
    F.lds = (LAS unsigned char*)lds;
    F.tid = threadIdx.x; F.lane = F.tid & 63; F.wave = __builtin_amdgcn_readfirstlane(F.tid >> 6);
    F.G = gridDim.x; { const int bx = blockIdx.x; F.vcu = (F.G % 8 == 0) ? (bx % 8) * (F.G / 8) + bx / 8 : bx; }
    F.in = args.in; F.out = args.out; F.ws = args.ws;
    const int lo = args.ph_lo, hi = args.ph_hi;
#define IN(k) (lo <= (k) && (k) < hi)
    const int flags = args.flags;
    for (int u = threadIdx.x; u < (LDS_BYTES - LDSCTL_OFF) / 4; u += NWAVES * 64) ((LAS unsigned*)(F.lds + LDSCTL_OFF))[u] = 0u;
    __syncthreads();
    XcdBarrier bar; bar.bar = (unsigned*)(args.ws + WS_CTL) + CW_BAR; bar.x = 0; bar.st = nullptr;
    if (hi - lo > 1) bar = xcd_barrier_post((unsigned*)(args.ws + WS_CTL) + CW_BAR, (volatile LAS unsigned*)(F.lds + MISC_OFF) + 8);
#define SEAM(k) if (IN(k) && IN((k) + 1)) xcd_barrier(bar);
#define PH1(k, call) { int t_ = threadIdx.x; asm volatile("" : "+v"(t_)); F.tid = t_; F.lane = t_ & 63; F.wave = __builtin_amdgcn_readfirstlane(t_ >> 6); call; }
#define PH(k, bit, call) if (IN(k)) { PH1(k, call) }
    PH(0, 0, (phase0(F), p0_small_weights(F)))
    SEAM(0)
    PH(1, 1, phase1(F))
    SEAM(1)
    PH(2, 2, phase2(F))
    SEAM(2)
    PH(3, 3, phase_prepA(F))
    SEAM(3)
    PH(4, 4, phase_gategemm(F))
    PH(4, 5, phase_loragemm(F))
    SEAM(4)
    PH(5, 30, phase_lrulocal(F))
    PH(5, 7, phase_rwkvlocal_mfma(F))
    SEAM(5)
    PH(6, 30, phase_scan(F, flags | 4))
    if (IN(6) && IN(7)) {
        unsigned* fcnt = (unsigned*)(args.ws + WS_CTL) + CW_FANIN;
        if (blockIdx.x < 36) fanin_publish(fcnt);
        fanin_wait(fcnt, gridDim.x < 36u ? gridDim.x : 36u, bar.bar);
    }
    PH(7, 9, phase_post(F, flags))
    SEAM(7)
    PH(8, 10, phase_outproj(F))
    SEAM(8)
    PH(9, 30, phase_route(F))
    SEAM(9)
    PH(10, 12, phase_m1(F))
    SEAM(10)
    PH(11, 13, phase_m2(F))
    SEAM(11)
    PH(12, 30, phase_final(F))
#undef SEAM
#undef PH
#undef PH1
#undef IN
}

extern "C" void kernel_launch(void* const* d_in, const int* in_sizes, int n_in, void* d_out, int out_size, void* d_ws, size_t ws_size, hipStream_t stream) {
    if (n_in != 35 || out_size != NTOK * D || ws_size < WS_END) { fprintf(stderr, "kernel_launch: unexpected shapes (n_in %d out %d ws %zu)\n", n_in, out_size, ws_size); return; }
    static int grid = 0;
    if (grid == 0) {
        int dev = 0, cus = 0;
        if (hipGetDevice(&dev) != hipSuccess || hipDeviceGetAttribute(&cus, hipDeviceAttributeMultiprocessorCount, dev) != hipSuccess) { grid = -1; return; }
        if (hipFuncSetAttribute((const void*)mk_fwd, hipFuncAttributeMaxDynamicSharedMemorySize, LDS_BYTES) != hipSuccess) { fprintf(stderr, "kernel_launch: hipFuncSetAttribute failed\n"); grid = -1; return; }
        int per_cu = 0;
        if (hipOccupancyMaxActiveBlocksPerMultiprocessor(&per_cu, (const void*)mk_fwd, NWAVES * 64, LDS_BYTES) != hipSuccess || per_cu < 1) { fprintf(stderr, "kernel_launch: occupancy query says %d blocks per CU\n", per_cu); (void)hipGetLastError(); }
        grid = cus;
        if (cus != 256) { fprintf(stderr, "kernel_launch: built for a 256-CU device (found %d CUs); nothing launched\n", cus); grid = -1; return; }
    }
    if (grid < 0) return;
    Args a{};
    for (int i = 0; i < 35; ++i) a.in[i] = (const float*)d_in[i];
    a.out = (float*)d_out; a.ws = (unsigned char*)d_ws; a.ph_lo = 0; a.ph_hi = 13; a.flags = 3;
    (void)hipMemsetAsync((char*)d_ws + WS_CTL, 0, 64 * 1024, stream);
    hipLaunchKernelGGL(mk_fwd, dim3(grid), dim3(NWAVES * 64), LDS_BYTES, stream, a);
}
```

```cpp
#include <hip/hip_runtime.h>
#include <stdint.h>
#include <cstdio>

typedef unsigned short bf16;
__device__ __forceinline__ bf16 f2bf(float f) { unsigned u = __float_as_uint(f); return (bf16)((u + 0x7fffu + ((u >> 16) & 1u)) >> 16); }
__device__ __forceinline__ float bf2f(bf16 b) { return __uint_as_float(((unsigned)b) << 16); }
__device__ __forceinline__ float bflo(unsigned u) { return __uint_as_float(u << 16); }
__device__ __forceinline__ float bfhi(unsigned u) { return __uint_as_float(u & 0xffff0000u); }

constexpr int NB = 4, T = 8192, D = 1024, NTOK = NB * T;
constexpr int LRU_W = 512, RW = 512, PW = 2816;
constexpr int C_UX = 0, C_GATE = 512, C_R = 1024, C_K = 1536, C_V = 2048, C_WD = 2560, C_AD = 2624, C_GD = 2688;
constexpr int NE = 32, DE = 512;
constexpr size_t MiB = 1u << 20;
constexpr size_t WS_CTL = 0;
constexpr int CW_FANIN = 1024;
constexpr int CW_BAR = 4096;
constexpr size_t WS_CNT = 32 * 1024;
constexpr size_t WS_MOD = 1 * MiB;
constexpr size_t WS_SELW = 384 * MiB;
constexpr size_t WS_SEL = 1 * MiB + 512 * 1024;
constexpr size_t FW_WLORAT = 2 * MiB;
constexpr size_t FW_WGT = 3 * MiB;
constexpr size_t FW_WR = 3 * MiB + 512 * 1024;
constexpr size_t FW_WINT = 4 * MiB;
constexpr size_t FW_WOUTT = 10 * MiB;
constexpr size_t WS_LIST = 12 * MiB;
constexpr size_t WS_H = 16 * MiB;
constexpr size_t WS_YMIX = WS_H;
constexpr size_t WS_P = 80 * MiB;
constexpr size_t WS_HID = WS_P;
constexpr size_t WS_Y = 152 * MiB;
constexpr size_t WS_YS = 256 * MiB;
constexpr size_t FW_W13T = 416 * MiB;
constexpr size_t FW_W2T = 480 * MiB;
constexpr size_t WS_END = 512 * MiB;

__device__ __forceinline__ float wave_sum(float v) {
    v += __int_as_float(__builtin_amdgcn_update_dpp(0, __float_as_int(v), 0xB1, 0xF, 0xF, true));
    v += __int_as_float(__builtin_amdgcn_update_dpp(0, __float_as_int(v), 0x4E, 0xF, 0xF, true));
    v += __int_as_float(__builtin_amdgcn_update_dpp(0, __float_as_int(v), 0x141, 0xF, 0xF, true));
    v += __int_as_float(__builtin_amdgcn_update_dpp(0, __float_as_int(v), 0x140, 0xF, 0xF, true));
    const int vi = __float_as_int(v);
    const float r0 = __int_as_float(__builtin_amdgcn_readlane(vi, 0)), r1 = __int_as_float(__builtin_amdgcn_readlane(vi, 16));
    const float r2 = __int_as_float(__builtin_amdgcn_readlane(vi, 32)), r3 = __int_as_float(__builtin_amdgcn_readlane(vi, 48));
    return (r0 + r1) + (r2 + r3);
}
__device__ __forceinline__ float fexp(float x) { return __builtin_amdgcn_exp2f(x * 1.44269504089f); }
__device__ __forceinline__ float flog(float x) { return __builtin_amdgcn_logf(x) * 0.69314718056f; }
__device__ __forceinline__ float frcp(float x) { return __builtin_amdgcn_rcpf(x); }
__device__ __forceinline__ float sigmoidf_(float x) { return frcp(1.f + fexp(-x)); }
__device__ __forceinline__ float softplusf_(float x) { return x > 20.f ? x : flog(1.f + fexp(x)); }
__device__ __forceinline__ float ftanh(float u) { return 1.f - 2.f * frcp(1.f + fexp(2.f * u)); }
__device__ __forceinline__ float gelu_tanh(float x) { const float u = 0.7978845608028654f * (x + 0.044715f * x * x * x); return 0.5f * x * (1.f + ftanh(u)); }

namespace pg8 {
#define PG8_LAS __attribute__((address_space(3)))
typedef unsigned short bf16_t;
typedef short bf16x8 __attribute__((ext_vector_type(8)));
typedef float f32x4 __attribute__((ext_vector_type(4)));
typedef unsigned u32x4 __attribute__((ext_vector_type(4)));
constexpr int BM = 256, BK = 64, HALF = 128, HTB = HALF * BK * 2  , STAGE_BYTES = 8 * HTB, NXCD = 8, WGM = 8;

__host__ __device__ __forceinline__ int lds_byte(int r, int c) { const int st = (r >> 4) * 2 + (c >> 5), rr = r & 15, cc = c & 31, ob = rr * 64 + cc * 2; return st * 1024 + (ob ^ (((ob >> 9) & 1) << 5)); }
__host__ __device__ __forceinline__ void stage_rc(int b, int& R, int& C) { const int st = b / 1024, sb = b % 1024, swz = sb ^ (((sb >> 9) & 1) << 5); R = (st >> 1) * 16 + swz / 64; C = (st & 1) * 32 + (swz % 64) / 2; }
__host__ __device__ __forceinline__ int perm32(int rho) { const int n = rho >> 4, i = rho & 15; return 8 * (i >> 2) + 4 * n + (i & 3); }

struct Unit { int pm, pn, e, nrows, row0; };
struct Gemm { const bf16_t* A; const bf16_t* Bt; int lda, ldb, K; };

__device__ __forceinline__ unsigned cvt_pk_bf16(float lo, float hi) { unsigned r; asm volatile("v_cvt_pk_bf16_f32 %0, %1, %2" : "=v"(r) : "v"(lo), "v"(hi)); return r; }

struct DenseOrder {
    static constexpr bool GATHER = false;
    int nM, nN, nwg, G, c;
    __device__ void init(int M, int N, int G_, int c_) { nM = M / BM; nN = N / BM; nwg = nM * nN; G = G_; c = c_; }
    __device__ bool next(int i, Unit& u) const {
        const long L = (long)i * G + c; if (L >= nwg) return false;
        int wgid = (int)L; { const int q = nwg / NXCD, r = nwg % NXCD, xcd = wgid % NXCD, off = wgid / NXCD; wgid = (xcd < r ? xcd * (q + 1) : r * (q + 1) + (xcd - r) * q) + off; }
        const int nig = WGM * nN, gid = wgid / nig, fm = gid * WGM, gsz = (nM - fm) < WGM ? (nM - fm) : WGM;
        u.pm = fm + ((wgid % nig) % gsz); u.pn = (wgid % nig) / gsz; u.e = 0; u.nrows = 256; u.row0 = 0; return true;
    }
    __device__ __forceinline__ const char* a_base(const Gemm& g, const Unit& u) const { return (const char*)g.A + (size_t)u.pm * (BM * 2) * g.lda; }
    __device__ __forceinline__ const char* b_base(const Gemm& g, const Unit& u) const { return (const char*)g.Bt + (size_t)u.pn * (BM * 2) * g.ldb; }
    __device__ __forceinline__ int row(const Unit&, int) const { return 0; }
};

template <class Epi, class Sched>
__device__ __forceinline__ void gemm_phase(PG8_LAS unsigned char* lds, const Gemm g, const Sched& S, const Epi& E, const int tid) {
    const int wid = __builtin_amdgcn_readfirstlane(tid >> 6), lane = tid & 63, wr = wid >> 2, wc = wid & 3, fr = lane & 15, fq = lane >> 4;
    const int K = g.K, nt = K / BK;
    unsigned voffA[2], voffB[2]; int sR[2], sC[2];
#pragma unroll
    for (int i = 0; i < 2; ++i) { int R, C; stage_rc(tid * 16 + i * 8192, R, C); const int Rb = Epi::ADJ ? ((R >> 5) * 64 + perm32(R & 31)) : (Epi::PERM ? ((R & ~31) + perm32(R & 31)) : R);
        voffA[i] = (unsigned)(R * g.lda + C) * 2u; voffB[i] = (unsigned)(Rb * g.ldb + C) * 2u; sR[i] = R; sC[i] = C; }
    const size_t kstep = (size_t)(BK * 2);
    const size_t hstepA = Sched::GATHER ? 0 : (size_t)HALF * g.lda * 2, hstepB = (size_t)(Epi::ADJ ? 32 : HALF) * g.ldb * 2;
    const unsigned ldsw = (unsigned)wid * 1024u;
    const int aoff = lds_byte(wr * 64 + fr, fq * 8), boff = lds_byte(wc * 32 + fr, fq * 8);
    unsigned gA[2][2], gN[2][2];
#define PG8_SA(b, h) (((b) * 2 + (h)) * HTB)
#define PG8_SB(b, h) ((4 + (b) * 2 + (h)) * HTB)
#define PG8_STAGE(bufoff, gbase, voff) do { _Pragma("unroll") for (int _i = 0; _i < 2; ++_i) \
        __builtin_amdgcn_global_load_lds((const unsigned*)((const char*)(gbase) + (voff)[_i]), (PG8_LAS unsigned*)(lds + (bufoff) + ldsw + _i * 8192), 16, 0, 0); } while (0)
#define PG8_STAGE_A(bufoff, kp, h, OFF) do { if constexpr (Sched::GATHER) PG8_STAGE(bufoff, kp, OFF[h]); else PG8_STAGE(bufoff, (kp) + (h) * hstepA, voffA); } while (0)
#define PG8_LDA(dst, b, h) do { _Pragma("unroll") for (int m = 0; m < 4; ++m) _Pragma("unroll") for (int k = 0; k < 2; ++k) dst[m][k] = *(const PG8_LAS bf16x8*)(lds + PG8_SA(b, h) + aoff + m * 2048 + k * 1024); } while (0)
#define PG8_LDB(dst, b, h) do { _Pragma("unroll") for (int n = 0; n < 2; ++n) _Pragma("unroll") for (int k = 0; k < 2; ++k) dst[n][k] = *(const PG8_LAS bf16x8*)(lds + PG8_SB(b, h) + boff + n * 2048 + k * 1024); } while (0)
#define PG8_MMA(ai, bj, At, Bt) do { __builtin_amdgcn_s_setprio(1); _Pragma("unroll") for (int m = 0; m < 4; ++m) _Pragma("unroll") for (int n = 0; n < 2; ++n) _Pragma("unroll") for (int k = 0; k < 2; ++k) \
        acc[ai][bj][m][n] = __builtin_amdgcn_mfma_f32_16x16x32_bf16(Bt[n][k], At[m][k], acc[ai][bj][m][n], 0, 0, 0); __builtin_amdgcn_s_setprio(0); } while (0)
#define PG8_WAIT_V(n) asm volatile("s_waitcnt vmcnt(" #n ")" ::: "memory")
#define PG8_WAIT_L(n) asm volatile("s_waitcnt lgkmcnt(" #n ")" ::: "memory")
#define PG8_BAR __builtin_amdgcn_s_barrier()
#define PG8_SCHED __builtin_amdgcn_sched_barrier(0)
    Unit cur, nxt; int ui = 0;
    if (!S.next(0, cur)) return;
    f32x4 acc[2][2][4][2];
#pragma unroll
    for (int a = 0; a < 2; ++a)
#pragma unroll
        for (int b = 0; b < 2; ++b)
#pragma unroll
            for (int m = 0; m < 4; ++m)
#pragma unroll
                for (int n = 0; n < 2; ++n) acc[a][b][m][n] = (f32x4){0.f, 0.f, 0.f, 0.f};
    bf16x8 At[4][2], B0[2][2], B1[2][2];
    const char* cA = S.a_base(g, cur); const char* cB = S.b_base(g, cur);
    if constexpr (Sched::GATHER) {
#pragma unroll
        for (int h = 0; h < 2; ++h)
#pragma unroll
            for (int i = 0; i < 2; ++i) gA[h][i] = (unsigned)(S.row(cur, h * HALF + sR[i]) * g.lda + sC[i]) * 2u;
    }
    PG8_STAGE(PG8_SB(0, 0), cB, voffB); PG8_STAGE(PG8_SB(0, 1), cB + hstepB, voffB); PG8_STAGE_A(PG8_SA(0, 0), cA, 0, gA); PG8_STAGE_A(PG8_SA(0, 1), cA, 1, gA);
    if (wr == 1) PG8_BAR;
    PG8_WAIT_V(2); PG8_BAR;
    PG8_STAGE(PG8_SB(1, 0), cB + kstep, voffB); PG8_STAGE_A(PG8_SA(1, 0), cA + kstep, 0, gA); PG8_STAGE(PG8_SB(1, 1), cB + hstepB + kstep, voffB);
    PG8_WAIT_V(6); PG8_BAR;
    for (;;) {
        const bool has_next = S.next(ui + 1, nxt);
        const char* nA = has_next ? S.a_base(g, nxt) : cA; const char* nB = has_next ? S.b_base(g, nxt) : cB;
        if constexpr (Sched::GATHER) {
            if (has_next) { int rv[2][2];
#pragma unroll
                for (int h = 0; h < 2; ++h)
#pragma unroll
                    for (int i = 0; i < 2; ++i) rv[h][i] = S.row(nxt, h * HALF + sR[i]);
#pragma unroll
                for (int h = 0; h < 2; ++h)
#pragma unroll
                    for (int i = 0; i < 2; ++i) gN[h][i] = (unsigned)(rv[h][i] * g.lda + sC[i]) * 2u;
            } else {
#pragma unroll
                for (int h = 0; h < 2; ++h)
#pragma unroll
                    for (int i = 0; i < 2; ++i) gN[h][i] = gA[h][i];
            }
        }
#pragma unroll 1
        for (int t = 0; t < nt; t += 2) {
            const bool last = (t == nt - 2);
            const char* a1 = cA + (size_t)(t + 1) * kstep;
            const char* a2 = last ? nA : cA + (size_t)(t + 2) * kstep; const char* b2 = last ? nB : cB + (size_t)(t + 2) * kstep;
            const char* a3 = a2 + kstep; const char* b3 = b2 + kstep;
            unsigned o2[2][2];
            if constexpr (Sched::GATHER) {
#pragma unroll
                for (int h = 0; h < 2; ++h)
#pragma unroll
                    for (int i = 0; i < 2; ++i) o2[h][i] = last ? gN[h][i] : gA[h][i];
            }
            PG8_LDB(B0, 0, 0); PG8_LDB(B1, 0, 1); PG8_SCHED; PG8_LDA(At, 0, 0); PG8_STAGE_A(PG8_SA(1, 1), a1, 1, gA);
            PG8_WAIT_V(8); PG8_WAIT_L(0); PG8_BAR; PG8_MMA(0, 0, At, B0); PG8_MMA(0, 1, At, B1); PG8_BAR; PG8_SCHED;
            PG8_LDA(At, 0, 1); PG8_STAGE(PG8_SB(0, 0), b2, voffB); PG8_STAGE(PG8_SB(0, 1), b2 + hstepB, voffB); PG8_STAGE_A(PG8_SA(0, 0), a2, 0, o2);
            PG8_WAIT_V(8); PG8_WAIT_L(0); PG8_BAR; PG8_MMA(1, 0, At, B0); PG8_MMA(1, 1, At, B1); PG8_BAR; PG8_SCHED;
            PG8_LDB(B0, 1, 0); PG8_LDB(B1, 1, 1); PG8_SCHED; PG8_LDA(At, 1, 0); PG8_STAGE_A(PG8_SA(0, 1), a2, 1, o2);
            PG8_WAIT_V(8); PG8_WAIT_L(0); PG8_BAR; PG8_MMA(0, 0, At, B0); PG8_MMA(0, 1, At, B1); PG8_BAR; PG8_SCHED;
            PG8_LDA(At, 1, 1); PG8_STAGE(PG8_SB(1, 0), b3, voffB); PG8_STAGE(PG8_SB(1, 1), b3 + hstepB, voffB); PG8_STAGE_A(PG8_SA(1, 0), a3, 0, o2);
            PG8_WAIT_V(8); PG8_WAIT_L(0); PG8_BAR; PG8_MMA(1, 0, At, B0); PG8_MMA(1, 1, At, B1); PG8_BAR; PG8_SCHED;
        }
        if (wr == 0) PG8_BAR;
        { int le = (int)__builtin_amdgcn_mbcnt_hi(~0u, __builtin_amdgcn_mbcnt_lo(~0u, 0u)); asm volatile("" : "+v"(le));
          E(acc, cur, wr, wc, le & 15, le >> 4); }
        if (!has_next) break;
#pragma unroll
        for (int a = 0; a < 2; ++a)
#pragma unroll
            for (int b = 0; b < 2; ++b)
#pragma unroll
                for (int m = 0; m < 4; ++m)
#pragma unroll
                    for (int n = 0; n < 2; ++n) acc[a][b][m][n] = (f32x4){0.f, 0.f, 0.f, 0.f};
        cur = nxt; cA = nA; cB = nB; ++ui;
        if constexpr (Sched::GATHER) {
#pragma unroll
            for (int h = 0; h < 2; ++h)
#pragma unroll
                for (int i = 0; i < 2; ++i) gA[h][i] = gN[h][i];
        }
        if (wr == 1) PG8_BAR;
    }
    PG8_WAIT_V(0);
    PG8_BAR;
#undef PG8_SA
#undef PG8_SB
#undef PG8_STAGE
#undef PG8_STAGE_A
#undef PG8_LDA
#undef PG8_LDB
#undef PG8_MMA
#undef PG8_WAIT_V
#undef PG8_WAIT_L
#undef PG8_BAR
#undef PG8_SCHED
}

struct EpiBf16Store {
    static constexpr bool PERM = true; static constexpr bool ADJ = true;
    bf16_t* O; int ldc;
    __device__ __forceinline__ void operator()(const f32x4 (&acc)[2][2][4][2], const Unit& u, int wr, int wc, int fr, int fq) const {
        const bool odd = (fr & 1) != 0;
        const int row0 = u.pm * BM + wr * 64 + fr, col0 = u.pn * BM + wc * 64 + (odd ? 32 : 0) + 8 * fq;
#pragma unroll
        for (int ai = 0; ai < 2; ++ai)
#pragma unroll
            for (int m = 0; m < 4; ++m) { const int r = row0 + ai * HALF + m * 16;
                u32x4 w[2];
#pragma unroll
                for (int bj = 0; bj < 2; ++bj) { const f32x4 v0 = acc[ai][bj][m][0], v1 = acc[ai][bj][m][1];
                    w[bj].x = cvt_pk_bf16(v0[0], v0[1]); w[bj].y = cvt_pk_bf16(v0[2], v0[3]); w[bj].z = cvt_pk_bf16(v1[0], v1[1]); w[bj].w = cvt_pk_bf16(v1[2], v1[3]); }
                u32x4 give, recv, dA, dB;
#pragma unroll
                for (int e = 0; e < 4; ++e) { give[e] = odd ? w[0][e] : w[1][e]; recv[e] = (unsigned)__builtin_amdgcn_update_dpp(0, (int)give[e], 0xB1, 0xF, 0xF, true);
                    dA[e] = odd ? recv[e] : w[0][e]; dB[e] = odd ? w[1][e] : recv[e]; }
                *(u32x4*)(O + (size_t)(r & ~1) * ldc + col0) = dA;
                *(u32x4*)(O + (size_t)(r | 1) * ldc + col0) = dB; }
    }
};
}
constexpr int NWAVES = 8;
constexpr int RING_OFF = 0, RING_BYTES = 131072;
constexpr int ROUTER_LDS = 147456;
constexpr int LDSCTL_OFF = ROUTER_LDS, MISC_OFF = LDSCTL_OFF + 320;
constexpr int LDS_TAB_OFF = LDSCTL_OFF + 1024;
constexpr int LDS_BYTES = 155648;

#define GAS __attribute__((address_space(1)))
#define LAS __attribute__((address_space(3)))
typedef unsigned v4u __attribute__((ext_vector_type(4)));
typedef unsigned v2u __attribute__((ext_vector_type(2)));
typedef float f32x4 __attribute__((ext_vector_type(4)));
#define LDS_WAIT() asm volatile("s_waitcnt lgkmcnt(0)" ::: "memory")
#define VM_WAIT() asm volatile("s_waitcnt vmcnt(0)" ::: "memory")
__device__ __forceinline__ unsigned pk2(float lo, float hi) { return (unsigned)f2bf(lo) | ((unsigned)f2bf(hi) << 16); }


struct Frame {
    LAS unsigned char* lds;
    int tid, lane, wave, vcu, G;
    const float* const* in;
    float* out; unsigned char* ws;
};

__device__ __forceinline__ void p0_transpose_item(const float* W, int ldw, bf16* WT, int ldt, int k0, int n0, int row0, LAS float* scr, int lane) {
    {
        f32x4 t[8];
#pragma unroll
        for (int i = 0; i < 8; ++i) t[i] = *(const f32x4*)(W + (size_t)(k0 + 8 * i + (lane >> 3)) * ldw + n0 + 4 * (lane & 7));
#pragma unroll
        for (int i = 0; i < 8; ++i) { LAS float* d = scr + (8 * i + (lane >> 3)) * 33 + 4 * (lane & 7); d[0] = t[i].x; d[1] = t[i].y; d[2] = t[i].z; d[3] = t[i].w; }
    }
    LDS_WAIT(); asm volatile("" ::: "memory");
    const int c = lane & 7;
#pragma unroll
    for (int j = 0; j < 4; ++j) { const int n = (lane >> 3) + 8 * j; const LAS float* s = scr + (8 * c) * 33 + n;
        v4u o; o.x = pk2(s[0 * 33], s[1 * 33]); o.y = pk2(s[2 * 33], s[3 * 33]); o.z = pk2(s[4 * 33], s[5 * 33]); o.w = pk2(s[6 * 33], s[7 * 33]);
        *(v4u*)(WT + (size_t)(row0 + n) * ldt + k0 + 8 * c) = o; }
    LDS_WAIT(); asm volatile("" ::: "memory");
}

__device__ __forceinline__ void p0_mod_task(Frame& F, int task) {
    LAS float* sc = (LAS float*)(F.lds);
    LAS float* red = (LAS float*)(F.lds + 16384);
    const float* c = F.in[1]; const float* w_ada = F.in[2]; const float* b_ada = F.in[3];

    const int j = task * 32 + (F.lane & 31);
    float a0 = 0.f, a1 = 0.f, a2 = 0.f, a3 = 0.f;
    const int kb = F.wave * 128 + (F.lane >> 5) * 64;
    float wv[64], cvv[8];
#pragma unroll
    for (int i = 0; i < 8; ++i) cvv[i] = c[F.tid + 512 * i];
#pragma unroll
    for (int i = 0; i < 64; ++i) wv[i] = w_ada[(size_t)(kb + i) * 6144 + j];
#pragma unroll
    for (int i = 0; i < 8; ++i) sc[F.tid + 512 * i] = cvv[i] / (1.f + __expf(-cvv[i]));
    __syncthreads();
#pragma unroll
    for (int i = 0; i < 64; ++i) { const int k = kb + i; const float w = wv[i]; a0 += sc[k] * w; a1 += sc[1024 + k] * w; a2 += sc[2048 + k] * w; a3 += sc[3072 + k] * w; }
    red[(F.wave * 4 + 0) * 64 + F.lane] = a0; red[(F.wave * 4 + 1) * 64 + F.lane] = a1; red[(F.wave * 4 + 2) * 64 + F.lane] = a2; red[(F.wave * 4 + 3) * 64 + F.lane] = a3;
    __syncthreads();
    if (F.tid < 128) { const int b = F.tid >> 5, l = F.tid & 31; float s = 0.f;
#pragma unroll
        for (int w = 0; w < 8; ++w) s += red[(w * 4 + b) * 64 + l] + red[(w * 4 + b) * 64 + 32 + l];
        ((float*)(F.ws + WS_MOD))[b * 6144 + task * 32 + l] = s + b_ada[task * 32 + l]; }
    __syncthreads();
}

__device__ __forceinline__ void phase0(Frame& F) {
    if (blockIdx.x < 192) p0_mod_task(F, blockIdx.x);
    LAS float* scr = (LAS float*)(F.lds + RING_OFF + F.wave * 16384);
    const int gw = F.vcu * NWAVES + F.wave, NGW = F.G * NWAVES;
    constexpr int I_IN = (D / 64) * (PW / 32), I_OUT = (D / 64) * (D / 32);
    constexpr int NITEMS = I_IN + I_OUT;
    for (int it = gw; it < NITEMS; it += NGW) {
        int r = it;
        if (r < I_IN) { const int nb = PW / 32, kb = r / nb, n = r % nb; p0_transpose_item(F.in[5], PW, (bf16*)(F.ws + FW_WINT), D, 64 * kb, 32 * n, 32 * n, scr, F.lane); continue; } r -= I_IN;
        { const int nb = D / 32, kb = r / nb, n = r % nb; p0_transpose_item(F.in[25], D, (bf16*)(F.ws + FW_WOUTT), D, 64 * kb, 32 * n, 32 * n, scr, F.lane); }
    }
}
__device__ __forceinline__ void expert_transposes(Frame& F, int wv, int nwv) {
    LAS float* scr = (LAS float*)(F.lds + RING_OFF + F.wave * 16384);
    constexpr int I_E13 = NE * 2 * 256, I_E2 = NE * 256;
    for (int it = wv; it < I_E13 + I_E2; it += nwv) {
        int r = it;
        if (r < I_E13) {
            const int e = r >> 9, which = (r >> 8) & 1, q = r & 255, kb = q >> 4, n = q & 15, n0 = 32 * n;
            const float* W = (which ? F.in[32] : F.in[31]) + (size_t)e * D * DE;
            p0_transpose_item(W, DE, (bf16*)(F.ws + FW_W13T) + (size_t)e * 1024 * 1024, D, 64 * kb, n0, (n0 >> 7) * 256 + which * 128 + (n0 & 127), scr, F.lane); continue; } r -= I_E13;
        {
            const int e = r >> 8, q = r & 255, kb = q >> 5, n = q & 31;
            p0_transpose_item(F.in[33] + (size_t)e * DE * D, D, (bf16*)(F.ws + FW_W2T) + (size_t)e * 1024 * DE, DE, 64 * kb, 32 * n, 32 * n, scr, F.lane); }
    }
}

__device__ __forceinline__ void adaln_row(const float* xrow, const float* g, const float* sh, const float* sc, bf16* orow, int lane) {
    const f32x4* xr = (const f32x4*)xrow + lane;
    f32x4 v[4]; float s = 0.f;
#pragma unroll
    for (int j = 0; j < 4; ++j) { v[j] = xr[64 * j]; s += (v[j].x * v[j].x + v[j].y * v[j].y) + (v[j].z * v[j].z + v[j].w * v[j].w); }
    const float rinv = rsqrtf(wave_sum(s) * (1.f / D) + 1e-6f);
    v2u* o8 = (v2u*)orow + lane;
#pragma unroll
    for (int j = 0; j < 4; ++j) { const f32x4 gg = ((const f32x4*)g)[lane + 64 * j], s1 = ((const f32x4*)sc)[lane + 64 * j], s0 = ((const f32x4*)sh)[lane + 64 * j];
        f32x4 y = v[j] * rinv * gg; y = y * (s1 + 1.f) + s0;
        v2u w; w.x = pk2(y.x, y.y); w.y = pk2(y.z, y.w); o8[64 * j] = w; }
}
__device__ __forceinline__ void phase1(Frame& F) {
    const int gw = F.vcu * NWAVES + F.wave, NGW = F.G * NWAVES, lane = F.lane;
    const float* mod = (const float*)(F.ws + WS_MOD); const float* xin = F.in[0]; bf16* H = (bf16*)(F.ws + WS_H);
    f32x4 vn[4];
#pragma unroll
    for (int j = 0; j < 4; ++j) vn[j] = ((const f32x4*)(xin + (size_t)gw * D) + lane)[64 * j];
    f32x4 ga[4], sb[4]; int bcur = -1;
    for (int m = gw; m < NTOK; m += NGW) { const int b = m / T;
        if (b != bcur) { bcur = b;
#pragma unroll
            for (int j = 0; j < 4; ++j) { ga[j] = ((const f32x4*)F.in[4])[lane + 64 * j] * (((const f32x4*)(mod + b * 6144 + 1024))[lane + 64 * j] + 1.f); sb[j] = ((const f32x4*)(mod + b * 6144))[lane + 64 * j]; } }
        f32x4 v[4]; float s = 0.f;
#pragma unroll
        for (int j = 0; j < 4; ++j) { v[j] = vn[j]; s += (v[j].x * v[j].x + v[j].y * v[j].y) + (v[j].z * v[j].z + v[j].w * v[j].w); }
        if (m + NGW < NTOK) {
#pragma unroll
            for (int j = 0; j < 4; ++j) vn[j] = ((const f32x4*)(xin + (size_t)(m + NGW) * D) + lane)[64 * j];
        }
        const float rinv = rsqrtf(wave_sum(s) * (1.f / D) + 1e-6f);
        v2u* o8 = (v2u*)(H + (size_t)m * D) + lane;
#pragma unroll
        for (int j = 0; j < 4; ++j) { const f32x4 y = v[j] * rinv * ga[j] + sb[j];
            v2u w; w.x = pk2(y.x, y.y); w.y = pk2(y.z, y.w); o8[64 * j] = w; }
    }
}
__device__ __forceinline__ void phase2(Frame& F) {
    pg8::Gemm g{(const bf16*)(F.ws + WS_H), (const bf16*)(F.ws + FW_WINT), D, D, D};
    pg8::DenseOrder S; S.init(NTOK, PW, F.G, (int)blockIdx.x);
    pg8::EpiBf16Store E{(bf16*)(F.ws + WS_P), PW};
    pg8::gemm_phase<pg8::EpiBf16Store, pg8::DenseOrder>(F.lds + RING_OFF, g, S, E, F.tid);
}


namespace pg8 {
struct EpiX1F {
    static constexpr bool PERM = true; static constexpr bool ADJ = true;
    const float* const* in; unsigned char* ws; float* out;
    __device__ __forceinline__ void operator()(const f32x4 (&acc)[2][2][4][2], const Unit& u, int wr, int wc, int fr, int fq) const {
        const float* mod = (const float*)(ws + WS_MOD); bf16_t* Y = (bf16_t*)(ws + WS_Y);
        const bool odd = (fr & 1) != 0;
        const int row0 = u.pm * BM + wr * 64 + fr, colw = u.pn * BM + wc * 64 + 8 * fq, col0 = colw + (odd ? 32 : 0);
        const float* g1 = mod + ((u.pm * BM) / T) * 6144 + 2048;
        f32x4 gv[2][2];
#pragma unroll
        for (int bj = 0; bj < 2; ++bj)
#pragma unroll
            for (int n = 0; n < 2; ++n) gv[bj][n] = *(const f32x4*)(g1 + colw + bj * 32 + n * 4);
#pragma unroll
        for (int ai = 0; ai < 2; ++ai)
#pragma unroll
            for (int m = 0; m < 4; ++m) { const int r = row0 + ai * HALF + m * 16;
                u32x4 w[2];
#pragma unroll
                for (int bj = 0; bj < 2; ++bj) { const f32x4 v0 = acc[ai][bj][m][0] * gv[bj][0], v1 = acc[ai][bj][m][1] * gv[bj][1];
                    w[bj].x = cvt_pk_bf16(v0[0], v0[1]); w[bj].y = cvt_pk_bf16(v0[2], v0[3]); w[bj].z = cvt_pk_bf16(v1[0], v1[1]); w[bj].w = cvt_pk_bf16(v1[2], v1[3]); }
                u32x4 give, recv, dA, dB;
#pragma unroll
                for (int e = 0; e < 4; ++e) { give[e] = odd ? w[0][e] : w[1][e]; recv[e] = (unsigned)__builtin_amdgcn_update_dpp(0, (int)give[e], 0xB1, 0xF, 0xF, true);
                    dA[e] = odd ? recv[e] : w[0][e]; dB[e] = odd ? w[1][e] : recv[e]; }
                *(u32x4*)(Y + (size_t)(r & ~1) * D + col0) = dA;
                *(u32x4*)(Y + (size_t)(r | 1) * D + col0) = dB; }
    }
};
template <bool GATH> struct MoeOrder {
    static constexpr bool GATHER = GATH;
    const LAS int* ub; const LAS int* rb; const LAS int* cn; const int* list; int G, c, brows;
    __device__ bool next(int i, Unit& u) const {
        int e, local;
        if ((G & 7) == 0) {
            const int x = c & 7, L = i * (G >> 3) + (c >> 3); const LAS int* xb = ub + 98 + x * 5;
            if (L >= xb[4]) return false;
            int j = 0;
#pragma unroll
            for (int k = 2; k >= 1; k >>= 1) if (xb[j + k] <= L) j += k;
            e = x + 8 * j; local = L - xb[j];
        } else {
            const int L = i * G + c; if (L >= ub[32]) return false;
            e = 0;
#pragma unroll
            for (int k = 16; k >= 1; k >>= 1) if (ub[e + k] <= L) e += k;
            local = L - ub[e];
        }
        const int tiles = rb[e + 1] - rb[e], pn = local / tiles, mt = local - pn * tiles;
        u.e = e; u.pn = pn; u.pm = rb[e] + mt; u.row0 = e * NTOK + mt * 256; u.nrows = min(256, cn[e] - mt * 256); return true;
    }
    __device__ __forceinline__ const char* a_base(const Gemm& g, const Unit& u) const { return GATH ? (const char*)g.A : (const char*)g.A + (size_t)u.pm * (BM * 2) * g.lda; }
    __device__ __forceinline__ const char* b_base(const Gemm& g, const Unit& u) const { return (const char*)g.Bt + ((size_t)u.e * brows + (size_t)u.pn * BM) * 2 * g.ldb; }
    __device__ __forceinline__ int row(const Unit& u, int r) const { const bool ok = r < u.nrows; const int v = list[u.row0 + (ok ? r : 0)]; return ok ? (v >> 1) : 0; }
};
struct EpiSwiglu {
    static constexpr bool PERM = true; static constexpr bool ADJ = false;
    bf16_t* HID;
    __device__ __forceinline__ void operator()(const f32x4 (&acc)[2][2][4][2], const Unit& u, int wr, int wc, int fr, int fq) const {
        const int col0 = u.pn * HALF + wc * 32 + 8 * fq;
#pragma unroll
        for (int ai = 0; ai < 2; ++ai)
#pragma unroll
            for (int m = 0; m < 4; ++m) { const int r = ai * HALF + wr * 64 + m * 16 + fr;
                if (r < u.nrows) { float h[8];
#pragma unroll
                    for (int n = 0; n < 2; ++n)
#pragma unroll
                        for (int i = 0; i < 4; ++i) { const float a = acc[ai][0][m][n][i], b = acc[ai][1][m][n][i]; h[n * 4 + i] = a * frcp(1.f + fexp(-a)) * b; }
                    u32x4 w; w.x = cvt_pk_bf16(h[0], h[1]); w.y = cvt_pk_bf16(h[2], h[3]); w.z = cvt_pk_bf16(h[4], h[5]); w.w = cvt_pk_bf16(h[6], h[7]);
                    *(u32x4*)(HID + (size_t)(u.pm * BM + r) * DE + col0) = w; } }
    }
};
struct EpiYs {
    static constexpr bool PERM = true; static constexpr bool ADJ = true;
    unsigned char* ws;
    __device__ __forceinline__ void operator()(const f32x4 (&acc)[2][2][4][2], const Unit& u, int wr, int wc, int fr, int fq) const {
        bf16_t* YS = (bf16_t*)(ws + WS_YS); const int* list = (const int*)(ws + WS_LIST); const float* selw = (const float*)(ws + WS_SELW);
        const bool odd = (fr & 1) != 0;
        const int col0 = u.pn * BM + wc * 64 + (odd ? 32 : 0) + 8 * fq;
        int liv[8]; float w8v[8];
#pragma unroll
        for (int k = 0; k < 8; ++k) { const int r = (k >> 2) * HALF + wr * 64 + (k & 3) * 16 + fr, rc = r < u.nrows ? r : 0; liv[k] = list[u.row0 + rc]; w8v[k] = selw[u.row0 + rc]; }
#pragma unroll
        for (int k = 0; k < 8; ++k) asm volatile("" : "+v"(liv[k]), "+v"(w8v[k]));
#pragma unroll
        for (int ai = 0; ai < 2; ++ai)
#pragma unroll
            for (int m = 0; m < 4; ++m) { const int r = ai * HALF + wr * 64 + m * 16 + fr; const int li = liv[ai * 4 + m]; const float w8 = w8v[ai * 4 + m];
                u32x4 w[2];
#pragma unroll
                for (int bj = 0; bj < 2; ++bj) { const f32x4 v0 = acc[ai][bj][m][0] * w8, v1 = acc[ai][bj][m][1] * w8;
                    w[bj].x = cvt_pk_bf16(v0[0], v0[1]); w[bj].y = cvt_pk_bf16(v0[2], v0[3]); w[bj].z = cvt_pk_bf16(v1[0], v1[1]); w[bj].w = cvt_pk_bf16(v1[2], v1[3]); }
                u32x4 give, recv;
#pragma unroll
                for (int e = 0; e < 4; ++e) { give[e] = odd ? w[0][e] : w[1][e]; recv[e] = (unsigned)__builtin_amdgcn_update_dpp(0, (int)give[e], 0xB1, 0xF, 0xF, true); }
                const int lin = __builtin_amdgcn_update_dpp(0, li, 0xB1, 0xF, 0xF, true);
                const int rA = r & ~1, rB = r | 1; const int liA = odd ? lin : li, liB = odd ? li : lin;
                u32x4 dA, dB;
#pragma unroll
                for (int e = 0; e < 4; ++e) { dA[e] = odd ? recv[e] : w[0][e]; dB[e] = odd ? w[1][e] : recv[e]; }
                if (rA < u.nrows) *(u32x4*)(YS + (size_t)liA * D + col0) = dA;
                if (rB < u.nrows) *(u32x4*)(YS + (size_t)liB * D + col0) = dB; }
    }
};
}

__device__ __forceinline__ void phase_outproj(Frame& F) {
    pg8::Gemm g{(const bf16*)(F.ws + WS_YMIX), (const bf16*)(F.ws + FW_WOUTT), D, D, D};
    pg8::DenseOrder S; S.init(NTOK, D, F.G, (int)blockIdx.x);
    pg8::EpiX1F E{F.in, F.ws, F.out};
    pg8::gemm_phase<pg8::EpiX1F, pg8::DenseOrder>(F.lds + RING_OFF, g, S, E, F.tid);
}

__device__ __forceinline__ void phase_route(Frame& F) {
    LAS float* wt = (LAS float*)F.lds;
    { const f32x4* WR = (const f32x4*)(F.ws + FW_WR); LAS f32x4* wt4 = (LAS f32x4*)F.lds;
      f32x4 wr_[18];
#pragma unroll
      for (int k = 0; k < 18; ++k) wr_[k] = WR[F.tid + 512 * k];
#pragma unroll
      for (int k = 0; k < 18; ++k) wt4[F.tid + 512 * k] = wr_[k]; }
    __syncthreads();
    const float* mod = (const float*)(F.ws + WS_MOD); const float* g2n = F.in[26];
    int* cnt = (int*)(F.ws + WS_CNT); int* list = (int*)(F.ws + WS_LIST); float* selw = (float*)(F.ws + WS_SELW);
    bf16* H2 = (bf16*)(F.ws + WS_H);
    const int gw = F.vcu * NWAVES + F.wave, NGW = F.G * NWAVES, lane = F.lane;
    LAS int* lcnt = (LAS int*)(F.lds + LDSCTL_OFF + 2048); LAS int* lbase = lcnt + 32; LAS int* tokres = lcnt + 64; LAS float* tokw = (LAS float*)(tokres + 256);
    if (F.tid < 32) lcnt[F.tid] = 0;
    __syncthreads();
    int it = 0;
    const float* xin = F.in[0]; bf16* Yb = (bf16*)(F.ws + WS_Y);
    f32x4 vn[4]; v2u yn[4];
#pragma unroll
    for (int j = 0; j < 4; ++j) { vn[j] = ((const f32x4*)(xin + (size_t)gw * D) + lane)[64 * j]; yn[j] = ((const v2u*)(Yb + (size_t)gw * D) + lane)[64 * j]; }
    f32x4 ggr[4], s1r[4], s0r[4]; int bcur = -1;
#pragma unroll
    for (int j = 0; j < 4; ++j) ggr[j] = ((const f32x4*)g2n)[lane + 64 * j];
    for (int m = gw; m < NTOK; m += NGW, ++it) {
        const int b = m / T;
        if (b != bcur) { bcur = b;
#pragma unroll
            for (int j = 0; j < 4; ++j) { s1r[j] = ((const f32x4*)(mod + b * 6144 + 4096))[lane + 64 * j] + 1.f; s0r[j] = ((const f32x4*)(mod + b * 6144 + 3072))[lane + 64 * j]; } }
        f32x4 v[4]; float s = 0.f;
#pragma unroll
        for (int j = 0; j < 4; ++j) { v[j] = vn[j]; v[j].x += bflo(yn[j].x); v[j].y += bfhi(yn[j].x); v[j].z += bflo(yn[j].y); v[j].w += bfhi(yn[j].y);
            s += (v[j].x * v[j].x + v[j].y * v[j].y) + (v[j].z * v[j].z + v[j].w * v[j].w); }
        if (m + NGW < NTOK) {
#pragma unroll
            for (int j = 0; j < 4; ++j) { vn[j] = ((const f32x4*)(xin + (size_t)(m + NGW) * D) + lane)[64 * j]; yn[j] = ((const v2u*)(Yb + (size_t)(m + NGW) * D) + lane)[64 * j]; }
        }
        { v2u* x8 = (v2u*)(Yb + (size_t)m * D) + lane;
#pragma unroll
          for (int j = 0; j < 4; ++j) { v2u w; w.x = pk2(v[j].x, v[j].y); w.y = pk2(v[j].z, v[j].w); x8[64 * j] = w; } }
        const float rinv = rsqrtf(wave_sum(s) * (1.f / D) + 1e-6f);
        v2u* o8 = (v2u*)(H2 + (size_t)m * D) + lane;
#pragma unroll
        for (int j = 0; j < 4; ++j) { f32x4 y = v[j] * rinv * ggr[j]; y = y * s1r[j] + s0r[j]; v[j] = y;
            v2u w; w.x = pk2(y.x, y.y); w.y = pk2(y.z, y.w); o8[64 * j] = w; }
        float pg[4] = {0.f, 0.f, 0.f, 0.f};
#pragma unroll
        for (int j = 0; j < 4; ++j)
#pragma unroll
            for (int e = 0; e < 4; ++e) { const f32x4 w = *(const LAS f32x4*)(wt + e * 1024 + lane * 4 + 256 * j); pg[e] += (v[j].x * w.x + v[j].y * w.y) + (v[j].z * w.z + v[j].w * w.w); }
        const f32x4 bg = *(const f32x4*)F.in[28];
        const float g0 = wave_sum(pg[0]) + bg.x, g1 = wave_sum(pg[1]) + bg.y, g2 = wave_sum(pg[2]) + bg.z, g3 = wave_sum(pg[3]) + bg.w;
        float gm = g0; int gi = 0;
        if (g1 > gm) { gm = g1; gi = 1; } if (g2 > gm) { gm = g2; gi = 2; } if (g3 > gm) { gm = g3; gi = 3; }
        const float gwt = frcp(fexp(g0 - gm) + fexp(g1 - gm) + fexp(g2 - gm) + fexp(g3 - gm));
        gi = __builtin_amdgcn_readfirstlane(gi);
        const LAS float* we = wt + (4 + gi * 8) * 1024 + lane * 4;
        const f32x4 be0 = *(const f32x4*)(F.in[30] + gi * 8), be1 = *(const f32x4*)(F.in[30] + gi * 8 + 4);
        float xe[8];
#pragma unroll
        for (int hf = 0; hf < 2; ++hf) { float pe[4] = {0.f, 0.f, 0.f, 0.f};
#pragma unroll
            for (int j = 0; j < 4; ++j)
#pragma unroll
                for (int e = 0; e < 4; ++e) { const f32x4 w = *(const LAS f32x4*)(we + (hf * 4 + e) * 1024 + 256 * j); pe[e] += (v[j].x * w.x + v[j].y * w.y) + (v[j].z * w.z + v[j].w * w.w); }
#pragma unroll
            for (int e = 0; e < 4; ++e) xe[hf * 4 + e] = wave_sum(pe[e]); }
        xe[0] += be0.x; xe[1] += be0.y; xe[2] += be0.z; xe[3] += be0.w; xe[4] += be1.x; xe[5] += be1.y; xe[6] += be1.z; xe[7] += be1.w;
        float v1 = xe[0], v2 = -3.4e38f; int i1 = 0, i2 = 0;
#pragma unroll
        for (int ii = 1; ii < 8; ++ii) { const float xx = xe[ii]; const bool a1 = xx > v1, a2 = xx > v2;
            v2 = a1 ? v1 : (a2 ? xx : v2); i2 = a1 ? i1 : (a2 ? ii : i2); v1 = a1 ? xx : v1; i1 = a1 ? ii : i1; }
        const float e2 = fexp(v2 - v1), w1 = frcp(1.f + e2), w2 = e2 * w1;
        if (lane == 0) { const int ea = gi * 8 + i1, eb = gi * 8 + i2;
            tokw[(F.wave * 16 + it) * 2] = w1 * gwt; tokw[(F.wave * 16 + it) * 2 + 1] = w2 * gwt;
            const int ra = atomicAdd((int*)&lcnt[ea], 1), rb2 = atomicAdd((int*)&lcnt[eb], 1);
            tokres[(F.wave * 16 + it) * 2] = ea | (ra << 8); tokres[(F.wave * 16 + it) * 2 + 1] = eb | (rb2 << 8); }
    }
    __syncthreads();
    if (F.tid < 32) { const int c = lcnt[F.tid]; lbase[F.tid] = c ? atomicAdd(&cnt[F.tid * 64], c) : 0; }
    __syncthreads();
    if (lane < 16) { const int m = gw + lane * NGW;
        if (m < NTOK) { const int a = tokres[(F.wave * 16 + lane) * 2], b2 = tokres[(F.wave * 16 + lane) * 2 + 1];
            const int pa = (a & 255) * NTOK + lbase[a & 255] + (a >> 8), pb = (b2 & 255) * NTOK + lbase[b2 & 255] + (b2 >> 8);
            list[pa] = m * 2; list[pb] = m * 2 + 1; selw[pa] = tokw[(F.wave * 16 + lane) * 2]; selw[pb] = tokw[(F.wave * 16 + lane) * 2 + 1]; } }
    __syncthreads();
}

__device__ __forceinline__ void moe_tables(Frame& F, int npn) {
    LAS int* tab = (LAS int*)(F.lds + LDS_TAB_OFF);
    if (F.wave == 0) {
        const int lane = F.lane;
        const int c = lane < 32 ? __hip_atomic_load((const int*)(F.ws + WS_CNT) + lane * 64, __ATOMIC_RELAXED, __HIP_MEMORY_SCOPE_AGENT) : 0;
        const int tl = (c + 255) >> 8;
        int inc = tl;
#pragma unroll
        for (int d = 1; d < 32; d <<= 1) { const int t = __shfl_up(inc, d); if (lane >= d) inc += t; }
        const int rbx = inc - tl;
        if (lane < 32) { tab[lane] = rbx * npn; tab[33 + lane] = rbx; tab[66 + lane] = c; }
        if (lane == 31) { tab[32] = inc * npn; tab[33 + 32] = inc; }
        const int x = lane & 7, t0 = __shfl(tl, x), t1 = __shfl(tl, x + 8), t2 = __shfl(tl, x + 16), t3 = __shfl(tl, x + 24);
        if (lane < 8) { tab[98 + lane * 5] = 0; tab[98 + lane * 5 + 1] = t0 * npn; tab[98 + lane * 5 + 2] = (t0 + t1) * npn; tab[98 + lane * 5 + 3] = (t0 + t1 + t2) * npn; tab[98 + lane * 5 + 4] = (t0 + t1 + t2 + t3) * npn; }
    }
    __syncthreads();
}
__device__ __forceinline__ void phase_m1(Frame& F) {
    moe_tables(F, 4);
    const LAS int* tab = (const LAS int*)(F.lds + LDS_TAB_OFF);
    pg8::Gemm g{(const bf16*)(F.ws + WS_H), (const bf16*)(F.ws + FW_W13T), D, D, D};
    pg8::MoeOrder<true> S{tab, tab + 33, tab + 66, (const int*)(F.ws + WS_LIST), F.G, (int)blockIdx.x, 1024};
    pg8::EpiSwiglu E{(bf16*)(F.ws + WS_HID)};
    pg8::gemm_phase<pg8::EpiSwiglu, pg8::MoeOrder<true>>(F.lds + RING_OFF, g, S, E, F.tid);
}
__device__ __forceinline__ void phase_m2(Frame& F) {
    moe_tables(F, 4);
    const LAS int* tab = (const LAS int*)(F.lds + LDS_TAB_OFF);
    pg8::Gemm g{(const bf16*)(F.ws + WS_HID), (const bf16*)(F.ws + FW_W2T), DE, DE, DE};
    pg8::MoeOrder<false> S{tab, tab + 33, tab + 66, (const int*)(F.ws + WS_LIST), F.G, (int)blockIdx.x, 1024};
    pg8::EpiYs E{F.ws};
    pg8::gemm_phase<pg8::EpiYs, pg8::MoeOrder<false>>(F.lds + RING_OFF, g, S, E, F.tid);
}
__device__ __forceinline__ void phase_final(Frame& F) {
    const int gw = F.vcu * NWAVES + F.wave, NGW = F.G * NWAVES, lane = F.lane;
    const float* mod = (const float*)(F.ws + WS_MOD); const float* fg = F.in[34]; const bf16* YS = (const bf16*)(F.ws + WS_YS);
    const bf16* Yb = (const bf16*)(F.ws + WS_Y);
    v2u an[4], cn[4], yn[4];
#pragma unroll
    for (int j = 0; j < 4; ++j) { an[j] = ((const v2u*)(YS + (size_t)(2 * gw) * D) + lane)[64 * j]; cn[j] = ((const v2u*)(YS + (size_t)(2 * gw + 1) * D) + lane)[64 * j]; yn[j] = ((const v2u*)(Yb + (size_t)gw * D) + lane)[64 * j]; }
    f32x4 fgr[4], g2r[4]; int bcur = -1;
#pragma unroll
    for (int j = 0; j < 4; ++j) fgr[j] = ((const f32x4*)fg)[lane + 64 * j];
    for (int m = gw; m < NTOK; m += NGW) { const int b = m / T;
        if (b != bcur) { bcur = b;
#pragma unroll
            for (int j = 0; j < 4; ++j) g2r[j] = ((const f32x4*)(mod + b * 6144 + 5120))[lane + 64 * j]; }
        f32x4* xr = (f32x4*)(F.out + (size_t)m * D) + lane;
        v2u a4[4], c4[4], y4[4];
#pragma unroll
        for (int j = 0; j < 4; ++j) { a4[j] = an[j]; c4[j] = cn[j]; y4[j] = yn[j]; }
        if (m + NGW < NTOK) { const size_t mn = (size_t)(m + NGW);
#pragma unroll
            for (int j = 0; j < 4; ++j) { an[j] = ((const v2u*)(YS + (2 * mn) * D) + lane)[64 * j]; cn[j] = ((const v2u*)(YS + (2 * mn + 1) * D) + lane)[64 * j]; yn[j] = ((const v2u*)(Yb + mn * D) + lane)[64 * j]; } }
        f32x4 v[4]; float s = 0.f;
#pragma unroll
        for (int j = 0; j < 4; ++j) { const v2u a = a4[j], c = c4[j], yy = y4[j]; const f32x4 g2 = g2r[j];
            f32x4 mo; mo.x = bflo(a.x) + bflo(c.x); mo.y = bfhi(a.x) + bfhi(c.x); mo.z = bflo(a.y) + bflo(c.y); mo.w = bfhi(a.y) + bfhi(c.y);
            f32x4 x1; x1.x = bflo(yy.x); x1.y = bfhi(yy.x); x1.z = bflo(yy.y); x1.w = bfhi(yy.y);
            v[j] = x1 + g2 * mo; s += (v[j].x * v[j].x + v[j].y * v[j].y) + (v[j].z * v[j].z + v[j].w * v[j].w); }
        const float rinv = rsqrtf(wave_sum(s) * (1.f / D) + 1e-6f);
#pragma unroll
        for (int j = 0; j < 4; ++j) xr[64 * j] = v[j] * rinv * fgr[j];
    }
}
#define XB_TMO      128
#define XB_XCNT(j)  (256  + 64 * (j))
#define XB_XSUB(j)  (1280 + 64 * (j))
#define XB_XGEN(j)  (2304 + 64 * (j))
#define XB_TOP      3328
#define XB_TOPGEN   3392
#define XCD_BAR_WORDS 3456
#define XB_SPIN_CAP (1u << 18)

__device__ __forceinline__ int lane_id_() { int l; asm volatile("v_mbcnt_lo_u32_b32 %0, -1, 0\n\tv_mbcnt_hi_u32_b32 %0, -1, %0" : "=v"(l)); return l; }
__device__ __forceinline__ bool is_t0_(int w0) { return w0 == 0 && lane_id_() == 0; }
__device__ __forceinline__ unsigned xb_ld(unsigned* p)              { return __hip_atomic_load(p, __ATOMIC_RELAXED, __HIP_MEMORY_SCOPE_AGENT); }
__device__ __forceinline__ unsigned xb_add(unsigned* p, unsigned v) { return __hip_atomic_fetch_add(p, v, __ATOMIC_RELAXED, __HIP_MEMORY_SCOPE_AGENT); }
__device__ __forceinline__ unsigned xb_xcc_id() { return (unsigned)__builtin_amdgcn_s_getreg((3 << 11) | 20) & 0xFu; }
#define XB_SPIN(cond, bar) do { unsigned _sp = 0; while (cond) { __builtin_amdgcn_s_sleep(1); \
    if ((++_sp & 255u) == 0u) { if (xb_ld(&(bar)[XB_TMO])) break; if (_sp > XB_SPIN_CAP) { atomicAdd(&(bar)[XB_TMO], 1u); break; } } } } while (0)

struct XcdBarrier {
    unsigned* bar; unsigned x; int w0;
    volatile LAS unsigned* st;
};

__device__ __forceinline__ XcdBarrier xcd_barrier_post(unsigned* bar, volatile LAS unsigned* st, int w0) {
    XcdBarrier b; b.bar = bar; b.x = xb_xcc_id(); b.st = st; b.w0 = w0;
    if (is_t0_(w0)) (void)xb_add(&bar[XB_XCNT(b.x)], 1u);
    return b;
}
__device__ __forceinline__ void xcd_barrier_complete(unsigned* bar, unsigned x, unsigned& nloc, unsigned& nx) {
    const unsigned G = gridDim.x * gridDim.y * gridDim.z;
    unsigned sum, cnt, mine, sp = 0u;
    for (;;) {
        sum = 0u; cnt = 0u; mine = 0u;
#pragma unroll
        for (unsigned j = 0; j < 16; ++j) { const unsigned c = xb_ld(&bar[XB_XCNT(j)]); sum += c; cnt += (c > 0u) ? 1u : 0u; mine = (j == x) ? c : mine; }
        if (sum == G) break;
        __builtin_amdgcn_s_sleep(1);
        if ((++sp & 255u) == 0u) { if (xb_ld(&bar[XB_TMO])) break; if (sp > XB_SPIN_CAP) { atomicAdd(&bar[XB_TMO], 1u); break; } }
    }
    nloc = mine > 0u ? mine : 1u; nx = cnt > 0u ? cnt : 1u;
}

__device__ __forceinline__ void xcd_barrier(const XcdBarrier& b) {
    asm volatile("s_waitcnt vmcnt(0)" ::: "memory");
    __syncthreads();
    if (is_t0_(b.w0)) {
        unsigned* bar = b.bar;
        __builtin_amdgcn_s_waitcnt(0);
        unsigned nloc = b.st[0], nx = b.st[1];
        if (nloc == 0u) { xcd_barrier_complete(bar, b.x, nloc, nx); b.st[0] = nloc; b.st[1] = nx; }
        const unsigned old = xb_add(&bar[XB_XSUB(b.x)], 1u);
        const unsigned gen = old / nloc;
        if (old + 1u == (gen + 1u) * nloc) {
            __builtin_amdgcn_fence(__ATOMIC_RELEASE, "agent");
            asm volatile("s_waitcnt vmcnt(0)" ::: "memory");
            const unsigned og = xb_add(&bar[XB_TOP], 1u);
            const unsigned tg = og / nx;
            if (og + 1u == (tg + 1u) * nx) xb_add(&bar[XB_TOPGEN], 1u);
            else XB_SPIN(xb_ld(&bar[XB_TOPGEN]) == tg, bar);
            __builtin_amdgcn_fence(__ATOMIC_ACQUIRE, "agent");
            xb_add(&bar[XB_XGEN(b.x)], 1u);
            asm volatile("s_waitcnt vmcnt(0)" ::: "memory");
        } else {
            XB_SPIN(xb_ld(&bar[XB_XGEN(b.x)]) == gen, bar);
            __builtin_amdgcn_fence(__ATOMIC_ACQUIRE, "agent");
            asm volatile("s_waitcnt vmcnt(0)" ::: "memory");
        }
    }
    __syncthreads();
}


__device__ __forceinline__ void fanin_publish(unsigned* cnt, int w0) {
    asm volatile("s_waitcnt vmcnt(0)" ::: "memory");
    __syncthreads();
    if (is_t0_(w0)) {
        __builtin_amdgcn_fence(__ATOMIC_RELEASE, "agent");
        asm volatile("s_waitcnt vmcnt(0)" ::: "memory");
        (void)xb_add(cnt, 1u);
    }
}
__device__ __forceinline__ void fanin_wait(unsigned* cnt, unsigned need, unsigned* bar, int w0) {
    if (is_t0_(w0)) {
        XB_SPIN(xb_ld(cnt) < need, bar);
        __builtin_amdgcn_fence(__ATOMIC_ACQUIRE, "agent");
        asm volatile("s_waitcnt vmcnt(0)" ::: "memory");
    }
    __syncthreads();
}

constexpr size_t WS_XC = WS_H;
constexpr size_t WS_ALORA = WS_H + 32 * MiB;
constexpr size_t WS_LOGA = 256 * MiB;
constexpr size_t WS_OLOC = 320 * MiB;
constexpr size_t WS_QHAT = 352 * MiB;
constexpr size_t WS_GG = 384 * MiB;
constexpr size_t WS_SB = 12 * MiB;
constexpr size_t WS_LRUA = 13 * MiB;
constexpr size_t WS_LRUB = 14 * MiB;
constexpr size_t WS_LRUH = 15 * MiB;
constexpr size_t DO_LWA = 0;
constexpr size_t DO_PC = 64 * MiB;
constexpr size_t DO_QCT = 96 * MiB;
constexpr size_t DO_HIN = 0;


__device__ __forceinline__ void phase_prepA(Frame& F) {
    const int gw = F.vcu * NWAVES + F.wave, NGW = F.G * NWAVES, lane = F.lane;
    const bf16* P = (const bf16*)(F.ws + WS_P);
    bf16* XC = (bf16*)(F.ws + WS_XC); bf16* AL = (bf16*)(F.ws + WS_ALORA);
    const float* conv_w = F.in[6]; const float* conv_b = F.in[7]; const float* mu = F.in[14];
    float cw[4][8], cb[8];
#pragma unroll
    for (int i = 0; i < 8; ++i) { cb[i] = conv_b[8 * lane + i];
#pragma unroll
        for (int j = 0; j < 4; ++j) cw[j][i] = conv_w[j * 512 + 8 * lane + i]; }
    float mu4[4];
#pragma unroll
    for (int i = 0; i < 4; ++i) mu4[i] = mu[(C_WD - 1024) + 4 * lane + i];
    for (int task = gw; task < NTOK / 16; task += NGW) {
        const int m0 = task * 16, t0 = m0 % T;
        float x1[8], x2[8], x3[8], pl[4];
        v4u ra[16]; v2u rq[16];
#pragma unroll
        for (int tt = 0; tt < 16; ++tt) { const size_t m = (size_t)(m0 + tt); ra[tt] = *(const v4u*)(P + m * PW + 8 * lane); rq[tt] = *(const v2u*)(P + m * PW + C_WD + 4 * lane); }
#pragma unroll
        for (int i = 0; i < 8; ++i) { x1[i] = 0.f; x2[i] = 0.f; x3[i] = 0.f; }
#pragma unroll
        for (int i = 0; i < 4; ++i) pl[i] = 0.f;
        if (t0 > 0) {
            const v4u a = *(const v4u*)(P + (size_t)(m0 - 1) * PW + 8 * lane), b = *(const v4u*)(P + (size_t)(m0 - 2) * PW + 8 * lane), c = *(const v4u*)(P + (size_t)(m0 - 3) * PW + 8 * lane);
            x1[0] = bflo(a.x); x1[1] = bfhi(a.x); x1[2] = bflo(a.y); x1[3] = bfhi(a.y); x1[4] = bflo(a.z); x1[5] = bfhi(a.z); x1[6] = bflo(a.w); x1[7] = bfhi(a.w);
            x2[0] = bflo(b.x); x2[1] = bfhi(b.x); x2[2] = bflo(b.y); x2[3] = bfhi(b.y); x2[4] = bflo(b.z); x2[5] = bfhi(b.z); x2[6] = bflo(b.w); x2[7] = bfhi(b.w);
            x3[0] = bflo(c.x); x3[1] = bfhi(c.x); x3[2] = bflo(c.y); x3[3] = bfhi(c.y); x3[4] = bflo(c.z); x3[5] = bfhi(c.z); x3[6] = bflo(c.w); x3[7] = bfhi(c.w);
            const v2u q = *(const v2u*)(P + (size_t)(m0 - 1) * PW + C_WD + 4 * lane);
            pl[0] = bflo(q.x); pl[1] = bfhi(q.x); pl[2] = bflo(q.y); pl[3] = bfhi(q.y);
        }
#pragma unroll
        for (int tt = 0; tt < 16; ++tt) {
            const size_t m = (size_t)(m0 + tt);
            const v4u a = ra[tt];
            float x0[8] = {bflo(a.x), bfhi(a.x), bflo(a.y), bfhi(a.y), bflo(a.z), bfhi(a.z), bflo(a.w), bfhi(a.w)};
            float xc[8];
#pragma unroll
            for (int i = 0; i < 8; ++i) { xc[i] = x3[i] * cw[0][i] + x2[i] * cw[1][i] + x1[i] * cw[2][i] + x0[i] * cw[3][i] + cb[i]; x3[i] = x2[i]; x2[i] = x1[i]; x1[i] = x0[i]; }
            v4u o; o.x = pk2(xc[0], xc[1]); o.y = pk2(xc[2], xc[3]); o.z = pk2(xc[4], xc[5]); o.w = pk2(xc[6], xc[7]);
            *(v4u*)(XC + m * 512 + 8 * lane) = o;
            const v2u q = rq[tt];
            const float cl[4] = {bflo(q.x), bfhi(q.x), bflo(q.y), bfhi(q.y)};
            float al[4];
#pragma unroll
            for (int i = 0; i < 4; ++i) { const float u = cl[i] + (pl[i] - cl[i]) * mu4[i]; pl[i] = cl[i];
                al[i] = (lane < 16) ? ftanh(u) : ((lane < 32) ? u : sigmoidf_(u)); }
            v2u o2; o2.x = pk2(al[0], al[1]); o2.y = pk2(al[2], al[3]);
            *(v2u*)(AL + m * 256 + 4 * lane) = o2;
        }
    }
}
__device__ __forceinline__ void p0_small_weights(Frame& F) {
    const int gt = F.vcu * NWAVES * 64 + F.tid, NT = F.G * NWAVES * 64;
    bf16* WG = (bf16*)(F.ws + FW_WGT); bf16* WL = (bf16*)(F.ws + FW_WLORAT);
    const float* wa = F.in[8]; const float* wi = F.in[10]; const float* w_up = F.in[16]; const float* a_up = F.in[18]; const float* g_up = F.in[19];
    for (int i = gt; i < 4 * 256 * 128; i += NT) { const int kk = i & 127, r = (i >> 7) & 255, pn = i >> 15;
        const int gate = r >> 7, ch = 128 * pn + (r & 127), hh = ch >> 6, j = ch & 63, kin = 128 * pn + kk;
        float v = 0.f; if ((kin >> 6) == hh) v = (gate ? wi : wa)[hh * 4096 + (kin & 63) * 64 + j];
        WG[i] = f2bf(v); }
    { float* WR = (float*)(F.ws + FW_WR); const float* w_grp = F.in[27]; const float* w_exp = F.in[29];
      for (int i = gt; i < 36 * 1024; i += NT) { const int k = i & 1023, e = i >> 10; WR[i] = e < 4 ? w_grp[k * 4 + e] : w_exp[k * 32 + (e - 4)]; } }
    for (int i = gt; i < 1536 * 128; i += NT) { const int kk = i & 127, n = i >> 7; float v = 0.f;
        if (n < 512) { if (kk < 64) v = w_up[kk * 512 + n]; }
        else if (n < 1024) { if (kk >= 64) v = a_up[(kk - 64) * 512 + n - 512]; }
        else v = g_up[kk * 512 + n - 1024];
        WL[i] = f2bf(v); }
}

namespace pg8 {
struct GateOrder : DenseOrder {
    __device__ __forceinline__ const char* a_base(const Gemm& g, const Unit& u) const { return (const char*)g.A + (size_t)u.pm * (BM * 2) * g.lda + (size_t)u.pn * 256; }
};
struct LoraOrder : DenseOrder {
    __device__ __forceinline__ const char* a_base(const Gemm& g, const Unit& u) const { return (const char*)g.A + (size_t)u.pm * (BM * 2) * g.lda + (u.pn >= 4 ? 256 : 0); }
};
struct EpiLruGate {
    static constexpr bool PERM = true; static constexpr bool ADJ = false;
    unsigned char* ws; const float* ba; const float* bi; const float* lam;
    __device__ __forceinline__ void operator()(const f32x4 (&acc)[2][2][4][2], const Unit& u, int wr, int wc, int fr, int fq) const {
        bf16_t* G = (bf16_t*)(ws + WS_LOGA); const bf16_t* XC = (const bf16_t*)(ws + WS_XC);
        const int row0 = u.pm * BM + wr * 64 + fr, col0 = u.pn * HALF + wc * 32 + 8 * fq;
        float cba[8], cbi[8], csp[8];
#pragma unroll
        for (int c = 0; c < 8; ++c) { cba[c] = ba[col0 + c]; cbi[c] = bi[col0 + c]; const float l = lam[col0 + c]; csp[c] = -8.f * (-l > 20.f ? -l : flog(1.f + fexp(-l))); }
#pragma unroll
        for (int ai = 0; ai < 2; ++ai) {
            u32x4 xqv[4];
#pragma unroll
            for (int k = 0; k < 4; ++k) xqv[k] = *(const u32x4*)(XC + (size_t)(row0 + ai * HALF + k * 16) * 512 + col0);
#pragma unroll
            for (int k = 0; k < 4; ++k) asm volatile("" : "+v"(xqv[k]));
#pragma unroll
            for (int m = 0; m < 4; ++m) { const size_t row = (size_t)(row0 + ai * HALF + m * 16); bf16_t* rowp = G + row * 1024 + col0;
                const u32x4 xq = xqv[m];
                const float xv[8] = {bflo(xq.x), bfhi(xq.x), bflo(xq.y), bfhi(xq.y), bflo(xq.z), bfhi(xq.z), bflo(xq.w), bfhi(xq.w)};
                float la[8], bb[8];
#pragma unroll
                for (int n = 0; n < 2; ++n)
#pragma unroll
                    for (int i = 0; i < 4; ++i) { const int c = n * 4 + i;
                        const float l = frcp(1.f + fexp(-(acc[ai][0][m][n][i] + cba[c]))) * csp[c];
                        la[c] = l; bb[c] = __builtin_amdgcn_sqrtf(fmaxf(1.f - fexp(2.f * l), 0.f)) * (frcp(1.f + fexp(-(acc[ai][1][m][n][i] + cbi[c]))) * xv[c]); }
                u32x4 w; w.x = cvt_pk_bf16(la[0], la[1]); w.y = cvt_pk_bf16(la[2], la[3]); w.z = cvt_pk_bf16(la[4], la[5]); w.w = cvt_pk_bf16(la[6], la[7]);
                *(u32x4*)rowp = w;
                w.x = cvt_pk_bf16(bb[0], bb[1]); w.y = cvt_pk_bf16(bb[2], bb[3]); w.z = cvt_pk_bf16(bb[4], bb[5]); w.w = cvt_pk_bf16(bb[6], bb[7]);
                *(u32x4*)(rowp + 512) = w; }
        }
    }
};
struct EpiLoraStore {
    static constexpr bool PERM = true; static constexpr bool ADJ = false;
    unsigned char* out; unsigned char* ws; const float* w0; const float* a0;
    __device__ __forceinline__ void operator()(const f32x4 (&acc)[2][2][4][2], const Unit& u, int wr, int wc, int fr, int fq) const {
        const int row0 = u.pm * BM + wr * 64 + fr;
        bf16_t* LWA = (bf16_t*)(out + DO_LWA); bf16_t* GG = (bf16_t*)(ws + WS_GG);
        bf16_t* base = u.pn < 4 ? LWA : GG; const int ldc = u.pn < 4 ? 1024 : 512; const int col0 = (u.pn < 4 ? u.pn : u.pn - 4) * BM + wc * 32 + 8 * fq;
        if (u.pn < 4) {
            const float* cst = (u.pn < 2 ? w0 : a0) + (u.pn & 1) * BM + wc * 32 + 8 * fq; const float scl = u.pn < 2 ? 0.60653066f : 1.f;
            f32x4 ccv[2][2];
#pragma unroll
            for (int bj = 0; bj < 2; ++bj) { ccv[bj][0] = *(const f32x4*)(cst + bj * HALF); ccv[bj][1] = *(const f32x4*)(cst + bj * HALF + 4); }
#pragma unroll
            for (int bj = 0; bj < 2; ++bj) asm volatile("" : "+v"(ccv[bj][0]), "+v"(ccv[bj][1]));
#pragma unroll
            for (int bj = 0; bj < 2; ++bj) { const f32x4 c0 = ccv[bj][0], c1 = ccv[bj][1];
#pragma unroll
                for (int ai = 0; ai < 2; ++ai)
#pragma unroll
                    for (int m = 0; m < 4; ++m) { bf16_t* rowp = base + (size_t)(row0 + ai * HALF + m * 16) * ldc + col0;
                        f32x4 v0 = acc[ai][bj][m][0] + c0, v1 = acc[ai][bj][m][1] + c1;
#pragma unroll
                        for (int i = 0; i < 4; ++i) { v0[i] = scl * frcp(1.f + fexp(-v0[i])); v1[i] = scl * frcp(1.f + fexp(-v1[i])); }
                        u32x4 w; w.x = cvt_pk_bf16(v0[0], v0[1]); w.y = cvt_pk_bf16(v0[2], v0[3]); w.z = cvt_pk_bf16(v1[0], v1[1]); w.w = cvt_pk_bf16(v1[2], v1[3]);
                        *(u32x4*)(rowp + bj * HALF) = w; } }
            return;
        }
#pragma unroll
        for (int ai = 0; ai < 2; ++ai)
#pragma unroll
            for (int m = 0; m < 4; ++m) { bf16_t* rowp = base + (size_t)(row0 + ai * HALF + m * 16) * ldc + col0;
#pragma unroll
                for (int bj = 0; bj < 2; ++bj) { const f32x4 v0 = acc[ai][bj][m][0], v1 = acc[ai][bj][m][1];
                    u32x4 w; w.x = cvt_pk_bf16(v0[0], v0[1]); w.y = cvt_pk_bf16(v0[2], v0[3]); w.z = cvt_pk_bf16(v1[0], v1[1]); w.w = cvt_pk_bf16(v1[2], v1[3]);
                    *(u32x4*)(rowp + bj * HALF) = w; } }
    }
};
}
__device__ __forceinline__ void phase_gategemm(Frame& F) {
    {
        pg8::Gemm g{(const bf16*)(F.ws + WS_XC), (const bf16*)(F.ws + FW_WGT), 512, 128, 128};
        pg8::GateOrder S; S.init(NTOK, 1024, F.G, (int)blockIdx.x);
        pg8::EpiLruGate E{F.ws, F.in[9], F.in[11], F.in[12]};
        pg8::gemm_phase<pg8::EpiLruGate, pg8::GateOrder>(F.lds + RING_OFF, g, S, E, F.tid);
    }
}
__device__ __forceinline__ void phase_loragemm(Frame& F) {
    {
        pg8::Gemm g{(const bf16*)(F.ws + WS_ALORA), (const bf16*)(F.ws + FW_WLORAT), 256, 128, 128};
        pg8::LoraOrder S; S.init(NTOK, 1536, F.G, (int)blockIdx.x);
        pg8::EpiLoraStore E{(unsigned char*)F.out, F.ws, F.in[15], F.in[17]};
        pg8::gemm_phase<pg8::EpiLoraStore, pg8::LoraOrder>(F.lds + RING_OFF, g, S, E, F.tid);
    }
}

__device__ __forceinline__ void phase_lrulocal(Frame& F) {
    const int lane = F.lane;
    const bf16* GT = (const bf16*)(F.ws + WS_LOGA);
    float* LA = (float*)(F.ws + WS_LRUA); float* LB = (float*)(F.ws + WS_LRUB);
    LAS f32x4* xch = (LAS f32x4*)(F.lds + RING_OFF) + (F.wave >> 1) * 128 + lane;
    const int half = F.wave & 1;
    for (int base = F.vcu * 4; base < 4 * 128 * 2; base += F.G * 4) {
        const int task = base + (F.wave >> 1), hq = task & 1, bc = task >> 1, ch = (4 * hq + (lane >> 4)) * 64 + 4 * (lane & 15);
        const size_t m0 = (size_t)bc * 64 + 32 * half; f32x4 sl = {0.f, 0.f, 0.f, 0.f}, hl = {0.f, 0.f, 0.f, 0.f};
        {
            constexpr int t16 = 0;
            v2u g0[32], g1[32];
#pragma unroll
            for (int u = 0; u < 32; ++u) { const size_t m = m0 + t16 + u; g0[u] = *(const v2u*)(GT + m * 1024 + ch); g1[u] = *(const v2u*)(GT + m * 1024 + 512 + ch); }
#pragma unroll
            for (int u = 0; u < 32; ++u) {
                const float la[4] = {bflo(g0[u].x), bfhi(g0[u].x), bflo(g0[u].y), bfhi(g0[u].y)}, bb[4] = {bflo(g1[u].x), bfhi(g1[u].x), bflo(g1[u].y), bfhi(g1[u].y)};
#pragma unroll
                for (int i = 0; i < 4; ++i) { sl[i] += la[i]; hl[i] = fexp(la[i]) * hl[i] + bb[i]; } }
        }
        if (half == 0) { xch[0] = sl; xch[64] = hl; }
        __syncthreads();
        if (half == 1) { const f32x4 s0 = xch[0], h0 = xch[64];
#pragma unroll
            for (int i = 0; i < 4; ++i) { hl[i] = fexp(sl[i]) * h0[i] + hl[i]; sl[i] += s0[i]; }
            *(f32x4*)(LA + bc * 512 + ch) = sl; *(f32x4*)(LB + bc * 512 + ch) = hl; }
        __syncthreads();
    }
}
typedef short bf16x8_t __attribute__((ext_vector_type(8)));
typedef float f32x16 __attribute__((ext_vector_type(16)));
typedef __bf16 bf16x2n_t __attribute__((ext_vector_type(2)));
typedef float f32x2c_t __attribute__((ext_vector_type(2)));
__device__ __forceinline__ unsigned pkbf(float a, float b) { f32x2c_t v = {a, b}; bf16x2n_t r = __builtin_convertvector(v, bf16x2n_t); return __builtin_bit_cast(unsigned, r); }
__device__ __forceinline__ bf16 bf1(float a) { return (bf16)(pkbf(a, 0.f) & 0xffffu); }
constexpr int U_AT = 0, U_RT = 4096, U_BT = 8192, U_KT = 12288, U_BH = 16384, U_KH = 20480, U_VT = 24576, U_LM = 28672, U_G31 = 32768, UNIT_LDS = 33024;
__device__ __forceinline__ int a64(int row, int col) { return row * 128 + (((col >> 3) ^ (row & 7)) << 4) + ((col & 7) << 1); }
__device__ __forceinline__ int a32(int row, int col) { return row * 64 + (((col >> 2) ^ ((row >> 2) & 7)) << 3) + ((col & 3) << 1); }
__device__ __forceinline__ int crow_(int i, int h) { return (i & 3) + 8 * (i >> 2) + 4 * h; }
#define MFMA32(a, b, c) __builtin_amdgcn_mfma_f32_32x32x16_bf16((a), (b), (c), 0, 0, 0)
__device__ __forceinline__ bf16x8_t pack8(const f32x16& x, int s) {
    v4u p; p.x = pkbf(x[8 * s], x[8 * s + 1]); p.y = pkbf(x[8 * s + 2], x[8 * s + 3]); p.z = pkbf(x[8 * s + 4], x[8 * s + 5]); p.w = pkbf(x[8 * s + 6], x[8 * s + 7]);
    return __builtin_bit_cast(bf16x8_t, p); }
__device__ __forceinline__ bf16x8_t ld2x8(const LAS unsigned char* p0, const LAS unsigned char* p1) {
    const v2u lo = *(const LAS v2u*)p0, hi = *(const LAS v2u*)p1; v4u p; p.x = lo.x; p.y = lo.y; p.z = hi.x; p.w = hi.y; return __builtin_bit_cast(bf16x8_t, p); }

__device__ __forceinline__ void phase_rwkvlocal_mfma(Frame& F) {
    int lane = F.lane; asm volatile("" : "+v"(lane));
    const int wave = F.wave, u4 = wave >> 1, wh = wave & 1;
    LAS unsigned char* ub = F.lds + RING_OFF + u4 * UNIT_LDS;
    const bf16* P = (const bf16*)(F.ws + WS_P); const bf16* LWA = (const bf16*)((const unsigned char*)F.out + DO_LWA);
    bf16* OLOC = (bf16*)(F.ws + WS_OLOC); bf16* QHAT = (bf16*)(F.ws + WS_QHAT); float* SB = (float*)(F.ws + WS_SB);
    const float* mu = F.in[14];
#pragma unroll 1
    for (int ui = F.vcu; ui < 256; ui += F.G) {
        const int sp = ui >> 1, b = sp >> 5, c = sp & 31, hd = (ui & 1) * 4 + u4, bhd = b * 8 + hd, unit = (bhd << 5) | c;
        const size_t m0 = (size_t)b * T + (size_t)c * 256;
        f32x16 S[2][2];
        { int r = lane & 31, h = lane >> 5; asm volatile("" : "+v"(r), "+v"(h));
#pragma unroll
        for (int jt = 0; jt < 2; ++jt)
#pragma unroll
            for (int kt = 0; kt < 2; ++kt)
#pragma unroll
                for (int i = 0; i < 16; ++i) S[jt][kt][i] = (wh == 0 && jt == kt && crow_(i, h) == r) ? 1.f : 0.f;
        }
#pragma unroll 1
        for (int sc = 0; sc < 8; ++sc) {
            const size_t ms = m0 + 32 * sc;
            {
                int lanep = lane; asm volatile("" : "+v"(lanep));
                const int ch = hd * 64 + lanep;
                const float mu_r = mu[ch], mu_k = mu[512 + ch], mu_v = mu[1024 + ch];
                const float kkv = F.in[20][ch], kav = F.in[21][ch], rkv = F.in[22][ch];
                const size_t mb = ms + 16 * wh;
                bf16 qr[16], qk[16], qv[16], qw[16], qa[16], p3[3] = {0, 0, 0};
                float cc = 0.f;
                {
                    const int lrow = lanep >> 3, lchk = lanep & 7, so = lrow * 128 + lchk * 16;
                    LAS unsigned char* sR = ub + U_AT + 2048 * wh; LAS unsigned char* sK = ub + U_RT + 2048 * wh; LAS unsigned char* sV = ub + U_BT + 2048 * wh;
                    LAS unsigned char* sW = ub + U_KT + 2048 * wh; LAS unsigned char* sA = ub + U_LM + 2048 * wh;
                    v4u gr[2], gk[2], gvv[2], gw[2], ga[2], go[2];
#pragma unroll
                    for (int hf = 0; hf < 2; ++hf) { const size_t m = mb + lrow + 8 * hf; const bf16* prow = P + m * PW + hd * 64 + 8 * lchk; const bf16* lp = LWA + m * 1024 + hd * 64 + 8 * lchk;
                        gr[hf] = *(const v4u*)(prow + C_R); gk[hf] = *(const v4u*)(prow + C_K); gvv[hf] = *(const v4u*)(prow + C_V); gw[hf] = *(const v4u*)lp; ga[hf] = *(const v4u*)(lp + 512); }
                    if (wh) {
#pragma unroll
                        for (int hf = 0; hf < 2; ++hf) go[hf] = *(const v4u*)(LWA + (ms + lrow + 8 * hf) * 1024 + hd * 64 + 8 * lchk);
                    }
                    if ((mb % T) != 0) { const bf16* row = P + (mb - 1) * PW; p3[0] = row[C_R + ch]; p3[1] = row[C_K + ch]; p3[2] = row[C_V + ch]; }
#pragma unroll
                    for (int hf = 0; hf < 2; ++hf) { *(LAS v4u*)(sR + so + hf * 1024) = gr[hf]; *(LAS v4u*)(sK + so + hf * 1024) = gk[hf]; *(LAS v4u*)(sV + so + hf * 1024) = gvv[hf];
                        *(LAS v4u*)(sW + so + hf * 1024) = gw[hf]; *(LAS v4u*)(sA + so + hf * 1024) = ga[hf]; }
#pragma unroll
                    for (int u = 0; u < 16; ++u) { const int o = u * 128 + lanep * 2;
                        qr[u] = *(const LAS bf16*)(sR + o); qk[u] = *(const LAS bf16*)(sK + o); qv[u] = *(const LAS bf16*)(sV + o); qw[u] = *(const LAS bf16*)(sW + o); qa[u] = *(const LAS bf16*)(sA + o); }
                    if (wh) {
#pragma unroll
                        for (int hf = 0; hf < 2; ++hf) *(LAS v4u*)(sW + so + hf * 1024) = go[hf];
#pragma unroll
                        for (int t = 0; t < 16; ++t) cc -= bf2f(*(const LAS bf16*)(sW + t * 128 + lanep * 2));
                    }
                }
                float pr = bf2f(p3[0]), pk = bf2f(p3[1]), pv = bf2f(p3[2]);
                float sbkeep = 0.f, gprev = fexp(cc);
                {
                    constexpr int t8 = 0;
#pragma unroll
                    for (int u = 0; u < 16; ++u) {
                        const int tt = t8 + u, t = 16 * wh + tt;
                        const float cr = bf2f(qr[u]), ck = bf2f(qk[u]), cv = bf2f(qv[u]);
                        const float lw = bf2f(qw[u]), la = bf2f(qa[u]);
                        const float rr = cr + (pr - cr) * mu_r, kx = ck + (pk - ck) * mu_k, v = cv + (pv - cv) * mu_v;
                        pr = cr; pk = ck; pv = cv;
                        cc -= lw;
                        const float a = la;
                        float kk = kx * kkv;
                        const float nrm = __builtin_amdgcn_sqrtf(wave_sum(kk * kk));
                        kk = kk * __builtin_amdgcn_rcpf(fmaxf(nrm, 1e-12f));
                        const float km = kx * (1.f + (a - 1.f) * kav);
                        const float sbv = wave_sum(rr * km * rkv);
                        if (lanep == tt) sbkeep = sbv;
                        const float gp = gprev, g = fexp(cc), ig = frcp(g);
                        gprev = g;
                        const float be = kk * a;
                        *(LAS bf16*)(ub + U_AT + a64(t, lanep)) = bf1(-kk * gp);
                        *(LAS bf16*)(ub + U_RT + a64(t, lanep)) = bf1(rr * g);
                        *(LAS bf16*)(ub + U_BT + a64(t, lanep)) = bf1(be * ig);
                        *(LAS bf16*)(ub + U_KT + a64(t, lanep)) = bf1(km * ig);
                        *(LAS bf16*)(ub + U_BH + a32(lanep, t)) = bf1(be * ig);
                        *(LAS bf16*)(ub + U_KH + a32(lanep, t)) = bf1(km * ig);
                        *(LAS bf16*)(ub + U_VT + a32(lanep, t)) = bf1(v);
                    }
                }
                if (lanep < 16) SB[(mb + lanep) * 8 + hd] = sbkeep;
                if (wh) *(LAS float*)(ub + U_G31 + lanep * 4) = gprev;
            }
            asm volatile("s_waitcnt lgkmcnt(0)" ::: "memory"); __builtin_amdgcn_s_barrier(); asm volatile("" ::: "memory");
            {
                int r = lane & 31, h = lane >> 5; asm volatile("" : "+v"(r), "+v"(h));
                bf16x8_t fT[2], fAk[2], fRb[2], fRk[2];
                {
                    f32x16 M, MT, R, RT;
#pragma unroll
                    for (int i = 0; i < 16; ++i) { M[i] = 0.f; MT[i] = 0.f; }
#pragma unroll
                    for (int ks = 0; ks < 4; ++ks) { const int o = a64(r, 16 * ks + 8 * h);
                        const bf16x8_t fb = *(const LAS bf16x8_t*)(ub + U_BT + o), fa = *(const LAS bf16x8_t*)(ub + U_AT + o);
                        M = MFMA32(fb, fa, M); MT = MFMA32(fa, fb, MT); }
#pragma unroll
                    for (int i = 0; i < 16; ++i) { const int q = crow_(i, h); M[i] = (q < r) ? M[i] : 0.f; MT[i] = (r < q) ? MT[i] : 0.f;
                        R[i] = M[i] + ((q == r) ? 1.f : 0.f); RT[i] = MT[i] + ((q == r) ? 1.f : 0.f); }
#pragma unroll
                    for (int lvl = 0; lvl < 4; ++lvl) {
                        bf16x8_t pm[2], pmt[2];
#pragma unroll
                        for (int ks = 0; ks < 2; ++ks) { pm[ks] = pack8(M, ks); pmt[ks] = pack8(MT, ks); }
                        f32x16 M2, MT2;
#pragma unroll
                        for (int i = 0; i < 16; ++i) { M2[i] = 0.f; MT2[i] = 0.f; }
#pragma unroll
                        for (int ks = 0; ks < 2; ++ks) { M2 = MFMA32(pmt[ks], pm[ks], M2); MT2 = MFMA32(pm[ks], pmt[ks], MT2); }
                        M = M2; MT = MT2;
                        bf16x8_t pr[2], prt[2];
#pragma unroll
                        for (int ks = 0; ks < 2; ++ks) { pm[ks] = pack8(M, ks); pr[ks] = pack8(R, ks); prt[ks] = pack8(RT, ks); }
#pragma unroll
                        for (int ks = 0; ks < 2; ++ks) { R = MFMA32(prt[ks], pm[ks], R); RT = MFMA32(pm[ks], prt[ks], RT); }
                        (void)pr;
                    }
#pragma unroll
                    for (int ks = 0; ks < 2; ++ks) fT[ks] = pack8(R, ks);
                }
                __builtin_amdgcn_sched_barrier(0);
                {
                    f32x16 Xak, Xrb, Xrk;
#pragma unroll
                    for (int i = 0; i < 16; ++i) { Xak[i] = 0.f; Xrb[i] = 0.f; Xrk[i] = 0.f; }
#pragma unroll
                    for (int ks = 0; ks < 4; ++ks) { const int o = a64(r, 16 * ks + 8 * h);
                        const bf16x8_t fb = *(const LAS bf16x8_t*)(ub + U_BT + o), fk = *(const LAS bf16x8_t*)(ub + U_KT + o);
                        const bf16x8_t fa = *(const LAS bf16x8_t*)(ub + U_AT + o), fr = *(const LAS bf16x8_t*)(ub + U_RT + o);
                        Xak = MFMA32(fk, fa, Xak); Xrb = MFMA32(fb, fr, Xrb); Xrk = MFMA32(fk, fr, Xrk); }
#pragma unroll
                    for (int i = 0; i < 16; ++i) { const int s = crow_(i, h); Xak[i] = (s < r) ? Xak[i] : 0.f; Xrb[i] = (s <= r) ? Xrb[i] : 0.f; Xrk[i] = (s <= r) ? Xrk[i] : 0.f; }
#pragma unroll
                    for (int ks = 0; ks < 2; ++ks) { fAk[ks] = pack8(Xak, ks); fRb[ks] = pack8(Xrb, ks); fRk[ks] = pack8(Xrk, ks); }
                }
#pragma unroll
                for (int jt = 0; jt < 2; ++jt) {
                    __builtin_amdgcn_sched_barrier(0);
                    bf16x8_t sf[2][2], vf[2];
#pragma unroll
                    for (int kt = 0; kt < 2; ++kt)
#pragma unroll
                        for (int ks = 0; ks < 2; ++ks) sf[kt][ks] = pack8(S[jt][kt], ks);
                    if (wh) {
#pragma unroll
                        for (int ks = 0; ks < 2; ++ks) vf[ks] = ld2x8(ub + U_VT + a32(32 * jt + r, 16 * ks + 4 * h), ub + U_VT + a32(32 * jt + r, 16 * ks + 8 + 4 * h));
                    }
                    f32x16 X1, Uu, Oo;
#pragma unroll
                    for (int i = 0; i < 16; ++i) { X1[i] = 0.f; Uu[i] = 0.f; Oo[i] = 0.f; }
#pragma unroll
                    for (int kt = 0; kt < 2; ++kt)
#pragma unroll
                        for (int ks = 0; ks < 2; ++ks) { const int c0 = 32 * kt + 16 * ks + 4 * h;
                            X1 = MFMA32(ld2x8(ub + U_AT + a64(r, c0), ub + U_AT + a64(r, c0 + 8)), sf[kt][ks], X1);
                            Oo = MFMA32(ld2x8(ub + U_RT + a64(r, c0), ub + U_RT + a64(r, c0 + 8)), sf[kt][ks], Oo); }
                    if (wh) {
#pragma unroll
                        for (int ks = 0; ks < 2; ++ks) { X1 = MFMA32(fAk[ks], vf[ks], X1); Oo = MFMA32(fRk[ks], vf[ks], Oo); }
                    }
                    __builtin_amdgcn_sched_barrier(0);
#pragma unroll
                    for (int ks = 0; ks < 2; ++ks) Uu = MFMA32(fT[ks], pack8(X1, ks), Uu);
                    bf16x8_t uf[2];
#pragma unroll
                    for (int ks = 0; ks < 2; ++ks) { uf[ks] = pack8(Uu, ks); Oo = MFMA32(fRb[ks], uf[ks], Oo); }
                    {
                        LAS unsigned char* ot = ub + U_LM + wh * 2048;
#pragma unroll
                        for (int i = 0; i < 16; ++i) *(LAS bf16*)(ot + crow_(i, h) * 64 + r * 2) = bf1(Oo[i]);
                        int lo = lane; asm volatile("" : "+v"(lo));
                        bf16* dst = (wh ? OLOC : QHAT) + (ms + (lo >> 2)) * 512 + hd * 64 + 32 * jt + 8 * (lo & 3);
#pragma unroll
                        for (int hf = 0; hf < 2; ++hf) { const v4u o4 = *(const LAS v4u*)(ot + (16 * hf + (lo >> 2)) * 64 + (lo & 3) * 16); *(v4u*)(dst + (size_t)(16 * hf) * 512) = o4; } }
                    __builtin_amdgcn_sched_barrier(0);
#pragma unroll
                    for (int kt = 0; kt < 2; ++kt) {
#pragma unroll
                        for (int ks = 0; ks < 2; ++ks) { const int k = 32 * kt + r, t0 = 16 * ks + 4 * h;
                            S[jt][kt] = MFMA32(ld2x8(ub + U_BH + a32(k, t0), ub + U_BH + a32(k, t0 + 8)), uf[ks], S[jt][kt]);
                            if (wh) S[jt][kt] = MFMA32(ld2x8(ub + U_KH + a32(k, t0), ub + U_KH + a32(k, t0 + 8)), vf[ks], S[jt][kt]); }
#pragma unroll
                        for (int g = 0; g < 4; ++g) { const f32x4 gg = *(const LAS f32x4*)(ub + U_G31 + (32 * kt + 8 * g + 4 * h) * 4);
                            S[jt][kt][4 * g] *= gg.x; S[jt][kt][4 * g + 1] *= gg.y; S[jt][kt][4 * g + 2] *= gg.z; S[jt][kt][4 * g + 3] *= gg.w; }
                    }
                }
            }
            asm volatile("s_waitcnt lgkmcnt(0)" ::: "memory"); __builtin_amdgcn_s_barrier(); asm volatile("" ::: "memory");
        }
        int r = lane & 31, h = lane >> 5; asm volatile("" : "+v"(r), "+v"(h));
        if (wh == 0) { bf16* PC = (bf16*)((unsigned char*)F.out + DO_PC) + (size_t)unit * 4096;
#pragma unroll
            for (int jt = 0; jt < 2; ++jt)
#pragma unroll
                for (int kt = 0; kt < 2; ++kt)
#pragma unroll
                    for (int i = 0; i < 16; ++i) PC[(32 * kt + crow_(i, h)) * 64 + 32 * jt + r] = bf1(S[jt][kt][i]);
        } else { bf16* QCT = (bf16*)((unsigned char*)F.out + DO_QCT) + (size_t)unit * 4096;
#pragma unroll
            for (int jt = 0; jt < 2; ++jt)
#pragma unroll
                for (int kt = 0; kt < 2; ++kt)
#pragma unroll
                    for (int g = 0; g < 4; ++g) { v2u o; o.x = pkbf(S[jt][kt][4 * g], S[jt][kt][4 * g + 1]); o.y = pkbf(S[jt][kt][4 * g + 2], S[jt][kt][4 * g + 3]);
                        *(v2u*)(QCT + (32 * jt + r) * 64 + 32 * kt + 8 * g + 4 * h) = o; }
        }
    }
}

__device__ __forceinline__ void rwkv_scan(Frame& F, int bh) {
    constexpr int LDT = 72;
    constexpr int SBUF = 64 * LDT;
    LAS bf16* S0 = (LAS bf16*)(F.lds + RING_OFF);
    const int lane = F.lane, w = F.wave, q = lane >> 4, l15 = lane & 15;
    for (int i = F.tid; i < 2 * SBUF; i += 512) S0[i] = 0;
    __syncthreads();
    if (w < 4) {
        const int tr = w;
        const bf16* PC = (const bf16*)((const unsigned char*)F.out + DO_PC) + (size_t)bh * 32 * 4096 + (16 * tr + l15) * 64 + 8 * q;
        const bf16* QCT = (const bf16*)((const unsigned char*)F.out + DO_QCT) + (size_t)bh * 32 * 4096 + l15 * 64 + 16 * tr + 4 * q;
        const int boff0 = l15 * LDT + 8 * q, woff0 = l15 * LDT + 16 * tr + 4 * q;
        constexpr int RD = 10;
        bf16x8_t A[RD][2]; v2u Qv[RD][4];
#define SCAN_LOAD(s, cc) do { \
        asm volatile("global_load_dwordx4 %0, %1, off" : "=v"(A[s][0]) : "v"(PC + (size_t)(cc) * 4096) : "memory"); \
        asm volatile("global_load_dwordx4 %0, %1, off offset:64" : "=v"(A[s][1]) : "v"(PC + (size_t)(cc) * 4096) : "memory"); \
        asm volatile("global_load_dwordx2 %0, %1, off" : "=v"(Qv[s][0]) : "v"(QCT + (size_t)(cc) * 4096) : "memory"); \
        asm volatile("global_load_dwordx2 %0, %1, off offset:2048" : "=v"(Qv[s][1]) : "v"(QCT + (size_t)(cc) * 4096) : "memory"); \
        asm volatile("global_load_dwordx2 %0, %1, off" : "=v"(Qv[s][2]) : "v"(QCT + (size_t)(cc) * 4096 + 2048) : "memory"); \
        asm volatile("global_load_dwordx2 %0, %1, off offset:2048" : "=v"(Qv[s][3]) : "v"(QCT + (size_t)(cc) * 4096 + 2048) : "memory"); } while (0)
#pragma unroll
        for (int s = 0; s < RD; ++s) SCAN_LOAD(s, s);
#pragma unroll 1
        for (int c0 = 0; c0 < 32; c0 += RD) {
#pragma unroll
            for (int s = 0; s < RD; ++s) {
                const int c = c0 + s;
                if (c >= 32) break;
                const LAS bf16* Sr = S0 + (s & 1) * SBUF; LAS bf16* Sw = S0 + ((s & 1) ^ 1) * SBUF;
                asm volatile("s_waitcnt vmcnt(54)" : "+v"(A[s][0]), "+v"(A[s][1]), "+v"(Qv[s][0]), "+v"(Qv[s][1]), "+v"(Qv[s][2]), "+v"(Qv[s][3]) :: "memory");
                pg8::f32x4 acc[4];
#pragma unroll
                for (int t = 0; t < 4; ++t) { acc[t][0] = bflo(Qv[s][t].x); acc[t][1] = bfhi(Qv[s][t].x); acc[t][2] = bflo(Qv[s][t].y); acc[t][3] = bfhi(Qv[s][t].y); }
#pragma unroll
                for (int ks = 0; ks < 2; ++ks)
#pragma unroll
                    for (int t = 0; t < 4; ++t) {
                        const bf16x8_t bh_ = *(const LAS bf16x8_t*)(Sr + boff0 + 16 * LDT * t + 32 * ks);
                        acc[t] = __builtin_amdgcn_mfma_f32_16x16x32_bf16(A[s][ks], bh_, acc[t], 0, 0, 0);
                    }
                { const int cn = (c + RD < 32) ? c + RD : 31; SCAN_LOAD(s, cn); }
#pragma unroll
                for (int t = 0; t < 4; ++t) { v2u oh; oh.x = pg8::cvt_pk_bf16(acc[t][0], acc[t][1]); oh.y = pg8::cvt_pk_bf16(acc[t][2], acc[t][3]);
                    *(LAS v2u*)(Sw + woff0 + 16 * LDT * t) = oh; }
                asm volatile("s_waitcnt lgkmcnt(0)" ::: "memory"); __builtin_amdgcn_s_barrier(); asm volatile("" ::: "memory");
            }
        }
#undef SCAN_LOAD
        asm volatile("s_waitcnt vmcnt(0)" ::: "memory");
    } else {
        const int t256 = F.tid - 256;
        bf16* HIN = (bf16*)((unsigned char*)F.out + DO_HIN) + (size_t)bh * 32 * 4096 + (t256 >> 2) * 64 + (t256 & 3) * 16;
        const int hoff = (t256 >> 2) * LDT + (t256 & 3) * 16;
#pragma unroll 1
        for (int c = 0; c < 32; ++c) {
            const LAS bf16* Sr = S0 + (c & 1) * SBUF;
            const v4u x0 = *(const LAS v4u*)(Sr + hoff), x1 = *(const LAS v4u*)(Sr + hoff + 8);
            *(v4u*)(HIN + (size_t)c * 4096) = x0; *(v4u*)(HIN + (size_t)c * 4096 + 8) = x1;
            asm volatile("s_waitcnt lgkmcnt(0)" ::: "memory"); __builtin_amdgcn_s_barrier(); asm volatile("" ::: "memory");
        }
    }
}
__device__ __forceinline__ void phase_scan(Frame& F, int flags) {
    if ((flags & 4) && blockIdx.x >= 36) { expert_transposes(F, ((int)blockIdx.x - 36) * NWAVES + F.wave, ((int)F.G - 36) * NWAVES); }
    if ((flags & 2) && blockIdx.x < 32) rwkv_scan(F, blockIdx.x);
    if ((flags & 1) && blockIdx.x >= 32 && blockIdx.x < 36) {
        const int idx = (blockIdx.x - 32) * 512 + F.tid, b = idx >> 9, ch = idx & 511;
        const float* LA = (const float*)(F.ws + WS_LRUA); const float* LB = (const float*)(F.ws + WS_LRUB); float* LH = (float*)(F.ws + WS_LRUH);
        float h = 0.f;
#pragma unroll 1
        for (int c16 = 0; c16 < 128; c16 += 16) { float a16[16], b16[16];
#pragma unroll
            for (int u = 0; u < 16; ++u) { const int o = (b * 128 + c16 + u) * 512 + ch; a16[u] = LA[o]; b16[u] = LB[o]; }
#pragma unroll
            for (int u = 0; u < 16; ++u) { const int o = (b * 128 + c16 + u) * 512 + ch; LH[o] = h; h = fexp(a16[u]) * h + b16[u]; } }
    }
}

__device__ __forceinline__ void rwkv_post_unit(Frame& F, int unit) {
    int lane = F.lane; asm volatile("" : "+v"(lane));
    const int c = unit & 127, bh = unit >> 7, h = bh & 7, b = bh >> 3, q = lane >> 4, l15 = lane & 15;
    const size_t m0 = (size_t)b * T + (size_t)c * 64;
    const bf16* QHAT = (const bf16*)(F.ws + WS_QHAT); const bf16* OLOC = (const bf16*)(F.ws + WS_OLOC); const bf16* GG = (const bf16*)(F.ws + WS_GG);
    const bf16* HIN = (const bf16*)((const unsigned char*)F.out + DO_HIN) + (size_t)(bh * 32 + (c >> 2)) * 4096; const bf16* P = (const bf16*)(F.ws + WS_P);
    const float* SB = (const float*)(F.ws + WS_SB); bf16* YMIX = (bf16*)(F.ws + WS_YMIX);
    constexpr int TP = 144;
    LAS unsigned char* stg = F.lds + RING_OFF + 4096 + F.wave * (4 * 16 * TP);
    const int lrow = lane >> 3, lchk = lane & 7;
    const int soff = lrow * TP + lchk * 16, roff = l15 * TP + 8 * q;
    bf16x8_t Af[4][2];
#pragma unroll
    for (int jt = 0; jt < 4; ++jt)
#pragma unroll
        for (int ks = 0; ks < 2; ++ks) Af[jt][ks] = *(const bf16x8_t*)(HIN + (16 * jt + l15) * 64 + 32 * ks + 8 * q);
    f32x4 lnw[4], lnb[4], muv[4];
#pragma unroll
    for (int jt = 0; jt < 4; ++jt) { const int ch = h * 64 + 16 * jt + 4 * q; lnw[jt] = *(const f32x4*)(F.in[23] + ch); lnb[jt] = *(const f32x4*)(F.in[24] + ch); muv[jt] = *(const f32x4*)(F.in[14] + 1024 + ch); }
    v2u pc[4];
#pragma unroll
    for (int jt = 0; jt < 4; ++jt) { pc[jt].x = 0u; pc[jt].y = 0u; if (c != 0) pc[jt] = *(const v2u*)(P + (m0 - 1) * PW + C_V + h * 64 + 16 * jt + 4 * q); }
#pragma unroll 1
    for (int tt = 0; tt < 4; ++tt) {
        const size_t m = m0 + 16 * tt + l15, mr = m0 + 16 * tt + lrow;
        v4u go[2], gv[2], gg2[2];
#pragma unroll
        for (int hf = 0; hf < 2; ++hf) { const size_t r = mr + 8 * hf;
            go[hf] = *(const v4u*)(OLOC + r * 512 + h * 64 + 8 * lchk); gv[hf] = *(const v4u*)(P + r * PW + C_V + h * 64 + 8 * lchk); gg2[hf] = *(const v4u*)(GG + r * 512 + h * 64 + 8 * lchk); }
        bf16x8_t Bf[2];
#pragma unroll
        for (int ks = 0; ks < 2; ++ks) Bf[ks] = *(const bf16x8_t*)(QHAT + m * 512 + h * 64 + 32 * ks + 8 * q);
        const float sbv = SB[m * 8 + h];
#pragma unroll
        for (int hf = 0; hf < 2; ++hf) { *(LAS v4u*)(stg + soff + hf * 8 * TP) = go[hf]; *(LAS v4u*)(stg + 16 * TP + soff + hf * 8 * TP) = gv[hf]; *(LAS v4u*)(stg + 32 * TP + soff + hf * 8 * TP) = gg2[hf]; }
        pg8::f32x4 acc[4];
#pragma unroll
        for (int jt = 0; jt < 4; ++jt) { const v2u o = *(const LAS v2u*)(stg + roff + 32 * jt); acc[jt][0] = bflo(o.x); acc[jt][1] = bfhi(o.x); acc[jt][2] = bflo(o.y); acc[jt][3] = bfhi(o.y); }
#pragma unroll
        for (int ks = 0; ks < 2; ++ks)
#pragma unroll
            for (int jt = 0; jt < 4; ++jt) acc[jt] = __builtin_amdgcn_mfma_f32_16x16x32_bf16(Af[jt][ks], Bf[ks], acc[jt], 0, 0, 0);
        float s = 0.f;
#pragma unroll
        for (int jt = 0; jt < 4; ++jt) s += (acc[jt][0] + acc[jt][1]) + (acc[jt][2] + acc[jt][3]);
        s += __shfl_xor(s, 16); s += __shfl_xor(s, 32);
        const float mean = s * (1.f / 64.f);
        float vs = 0.f;
#pragma unroll
        for (int jt = 0; jt < 4; ++jt)
#pragma unroll
            for (int i = 0; i < 4; ++i) { acc[jt][i] -= mean; vs += acc[jt][i] * acc[jt][i]; }
        vs += __shfl_xor(vs, 16); vs += __shfl_xor(vs, 32);
        const float rstd = rsqrtf(vs * (1.f / 64.f) + 64e-5f);
#pragma unroll
        for (int jt = 0; jt < 4; ++jt) {
            const v2u cvq = *(const LAS v2u*)(stg + 16 * TP + roff + 32 * jt); v2u pvq;
            pvq.x = (unsigned)__builtin_amdgcn_update_dpp(__builtin_amdgcn_update_dpp(0, (int)pc[jt].x, 0x121, 0xF, 0xF, false), (int)cvq.x, 0x111, 0xF, 0xF, false);
            pvq.y = (unsigned)__builtin_amdgcn_update_dpp(__builtin_amdgcn_update_dpp(0, (int)pc[jt].y, 0x121, 0xF, 0xF, false), (int)cvq.y, 0x111, 0xF, 0xF, false);
            pc[jt] = cvq;
            const v2u gq = *(const LAS v2u*)(stg + 32 * TP + roff + 32 * jt);
            const float cv[4] = {bflo(cvq.x), bfhi(cvq.x), bflo(cvq.y), bfhi(cvq.y)}, pv[4] = {bflo(pvq.x), bfhi(pvq.x), bflo(pvq.y), bfhi(pvq.y)}, gg[4] = {bflo(gq.x), bfhi(gq.x), bflo(gq.y), bfhi(gq.y)};
            float y[4];
#pragma unroll
            for (int i = 0; i < 4; ++i) { const float v = cv[i] + (pv[i] - cv[i]) * muv[jt][i]; y[i] = (acc[jt][i] * rstd * lnw[jt][i] + lnb[jt][i] + sbv * v) * gg[i]; }
            v2u o; o.x = pk2(y[0], y[1]); o.y = pk2(y[2], y[3]);
            *(LAS v2u*)(stg + 48 * TP + roff + 32 * jt) = o; }
#pragma unroll
        for (int hf = 0; hf < 2; ++hf) { const v4u o4 = *(const LAS v4u*)(stg + 48 * TP + soff + hf * 8 * TP); *(v4u*)(YMIX + (mr + 8 * hf) * D + 512 + h * 64 + 8 * lchk) = o4; }
    }
}
__device__ __forceinline__ void phase_post(Frame& F, int flags) {
    const int gw = F.vcu * NWAVES + F.wave, NGW = F.G * NWAVES, lane = F.lane;
    if ((flags & 2) && F.G * 16 == 4096) {
        if (F.wave >= 4) { for (int k = 0; k < 3; ++k) { const int grp = 2 * F.vcu + (k == 2 ? 1 : 0), hh = (k == 1 ? 4 : 0) + (F.wave - 4);
            rwkv_post_unit(F, ((((grp >> 7) * 8 + hh) << 7) | (grp & 127))); } }
    } else if (flags & 2) for (int unit = gw; unit < 4096; unit += NGW) rwkv_post_unit(F, unit);
    if (flags & 1) {
        const bf16* GT = (const bf16*)(F.ws + WS_LOGA); const bf16* P = (const bf16*)(F.ws + WS_P);
        const float* LH = (const float*)(F.ws + WS_LRUH); bf16* YMIX = (bf16*)(F.ws + WS_YMIX); const float* ng = F.in[13];
        for (int task = (F.wave < 4 ? F.vcu * 4 + F.wave : 1 << 30); task < 4 * 128 * 2; task += F.G * 4) { const int hq = task & 1, bc = task >> 1, ch = (4 * hq + (lane >> 4)) * 64 + 4 * (lane & 15);
            const size_t m0 = (size_t)bc * 64; f32x4 hl = *(const f32x4*)(LH + bc * 512 + ch); const f32x4 g = *(const f32x4*)(ng + ch);
#pragma unroll 1
            for (int t8 = 0; t8 < 64; t8 += 8) {
                v2u g0[8], g1[8], p8[8];
#pragma unroll
                for (int u = 0; u < 8; ++u) { const size_t m = m0 + t8 + u; g0[u] = *(const v2u*)(GT + m * 1024 + ch); g1[u] = *(const v2u*)(GT + m * 1024 + 512 + ch); p8[u] = *(const v2u*)(P + m * PW + C_GATE + ch); }
#pragma unroll
                for (int u = 0; u < 8; ++u) { const size_t m = m0 + t8 + u;
                    const f32x4 la = {bflo(g0[u].x), bfhi(g0[u].x), bflo(g0[u].y), bfhi(g0[u].y)}, bb = {bflo(g1[u].x), bfhi(g1[u].x), bflo(g1[u].y), bfhi(g1[u].y)};
                    const f32x4 gt = {bflo(p8[u].x), bfhi(p8[u].x), bflo(p8[u].y), bfhi(p8[u].y)};
                    f32x4 y;
#pragma unroll
                    for (int i = 0; i < 4; ++i) { hl[i] = fexp(la[i]) * hl[i] + bb[i]; y[i] = hl[i] * gelu_tanh(gt[i]); }
                    float ss = (y.x * y.x + y.y * y.y) + (y.z * y.z + y.w * y.w);
                    ss += __int_as_float(__builtin_amdgcn_update_dpp(0, __float_as_int(ss), 0xB1, 0xF, 0xF, true));
                    ss += __int_as_float(__builtin_amdgcn_update_dpp(0, __float_as_int(ss), 0x4E, 0xF, 0xF, true));
                    ss += __int_as_float(__builtin_amdgcn_update_dpp(0, __float_as_int(ss), 0x141, 0xF, 0xF, true));
                    ss += __int_as_float(__builtin_amdgcn_update_dpp(0, __float_as_int(ss), 0x140, 0xF, 0xF, true));
                    const float rs = rsqrtf(ss * (1.f / 64.f) + 1e-6f);
                    v2u o; o.x = pk2(y.x * rs * g.x, y.y * rs * g.y); o.y = pk2(y.z * rs * g.z, y.w * rs * g.w);
                    *(v2u*)(YMIX + m * D + ch) = o; }
            }
        }
    }
    if ((flags & 2) && F.G * 16 == 4096 && F.wave < 4) { const int grp = 2 * F.vcu + 1, hh = 4 + F.wave; rwkv_post_unit(F, ((((grp >> 7) * 8 + hh) << 7) | (grp & 127))); }
}

struct Args { const float* in[35]; float* out; unsigned char* ws; int ph_lo, ph_hi, flags, pad; };
__global__ void __launch_bounds__(NWAVES * 64, 2) mk_fwd(Args args) {
    extern __shared__ __attribute__((aligned(16))) unsigned char lds[];
    Frame F;
    F.lds = (LAS unsigned char*)lds;
    F.tid = threadIdx.x; F.lane = F.tid & 63; F.wave = __builtin_amdgcn_readfirstlane(F.tid >> 6);
    const int wave0 = F.wave;
    F.G = gridDim.x; { const int bx = blockIdx.x; F.vcu = (F.G % 8 == 0) ? (bx % 8) * (F.G / 8) + bx / 8 : bx; }
    F.in = args.in; F.out = args.out; F.ws = args.ws;
    const int lo = args.ph_lo, hi = args.ph_hi;
#define IN(k) (lo <= (k) && (k) < hi)
    const int flags = args.flags;
    for (int u = threadIdx.x; u < (LDS_BYTES - LDSCTL_OFF) / 4; u += NWAVES * 64) ((LAS unsigned*)(F.lds + LDSCTL_OFF))[u] = 0u;
    __syncthreads();
    XcdBarrier bar; bar.bar = (unsigned*)(args.ws + WS_CTL) + CW_BAR; bar.x = 0; bar.st = nullptr; bar.w0 = wave0;
    if (hi - lo > 1) bar = xcd_barrier_post((unsigned*)(args.ws + WS_CTL) + CW_BAR, (volatile LAS unsigned*)(F.lds + MISC_OFF) + 8, wave0);
#define SEAM(k) if (IN(k) && IN((k) + 1)) xcd_barrier(bar);
#define PH1(k, call) { int t_ = wave0 * 64 + lane_id_(); asm volatile("" : "+v"(t_)); F.tid = t_; F.lane = t_ & 63; F.wave = __builtin_amdgcn_readfirstlane(t_ >> 6); call; }
#define PH(k, bit, call) if (IN(k)) { PH1(k, call) }
    PH(0, 0, (phase0(F), p0_small_weights(F)))
    SEAM(0)
    PH(1, 1, phase1(F))
    SEAM(1)
    PH(2, 2, phase2(F))
    SEAM(2)
    PH(3, 3, phase_prepA(F))
    SEAM(3)
    PH(4, 4, phase_gategemm(F))
    PH(4, 5, phase_loragemm(F))
    SEAM(4)
    PH(5, 30, phase_lrulocal(F))
    PH(5, 7, phase_rwkvlocal_mfma(F))
    SEAM(5)
    PH(6, 30, phase_scan(F, flags | 4))
    if (IN(6) && IN(7)) {
        unsigned* fcnt = (unsigned*)(args.ws + WS_CTL) + CW_FANIN;
        if (blockIdx.x < 36) fanin_publish(fcnt, wave0);
        fanin_wait(fcnt, gridDim.x < 36u ? gridDim.x : 36u, bar.bar, wave0);
    }
    PH(7, 9, phase_post(F, flags))
    SEAM(7)
    PH(8, 10, phase_outproj(F))
    SEAM(8)
    PH(9, 30, phase_route(F))
    SEAM(9)
    PH(10, 12, phase_m1(F))
    SEAM(10)
    PH(11, 13, phase_m2(F))
    SEAM(11)
    PH(12, 30, phase_final(F))
#undef SEAM
#undef PH
#undef PH1
#undef IN
}

extern "C" void kernel_launch(void* const* d_in, const int* in_sizes, int n_in, void* d_out, int out_size, void* d_ws, size_t ws_size, hipStream_t stream) {
    if (n_in != 35 || out_size != NTOK * D || ws_size < WS_END) { fprintf(stderr, "kernel_launch: unexpected shapes (n_in %d out %d ws %zu)\n", n_in, out_size, ws_size); return; }
    static int grid = 0;
    if (grid == 0) {
        int dev = 0, cus = 0;
        if (hipGetDevice(&dev) != hipSuccess || hipDeviceGetAttribute(&cus, hipDeviceAttributeMultiprocessorCount, dev) != hipSuccess) { grid = -1; return; }
        if (hipFuncSetAttribute((const void*)mk_fwd, hipFuncAttributeMaxDynamicSharedMemorySize, LDS_BYTES) != hipSuccess) { fprintf(stderr, "kernel_launch: hipFuncSetAttribute failed\n"); grid = -1; return; }
        int per_cu = 0;
        if (hipOccupancyMaxActiveBlocksPerMultiprocessor(&per_cu, (const void*)mk_fwd, NWAVES * 64, LDS_BYTES) != hipSuccess || per_cu < 1) { fprintf(stderr, "kernel_launch: occupancy query says %d blocks per CU\n", per_cu); (void)hipGetLastError(); }
        grid = cus;
        if (cus != 256) { fprintf(stderr, "kernel_launch: built for a 256-CU device (found %d CUs); nothing launched\n", cus); grid = -1; return; }
    }
    if (grid < 0) return;
    Args a{};
    for (int i = 0; i < 35; ++i) a.in[i] = (const float*)d_in[i];
    a.out = (float*)d_out; a.ws = (unsigned char*)d_ws; a.ph_lo = 0; a.ph_hi = 13; a.flags = 3;
    (void)hipMemsetAsync((char*)d_ws + WS_CTL, 0, 64 * 1024, stream);
    hipLaunchKernelGGL(mk_fwd, dim3(grid), dim3(NWAVES * 64), LDS_BYTES, stream, a);
}
```
